# Optimizing an MI355X kernel written in HIP

```python
import math
import jax, jax.numpy as jnp
from jax import lax
import numpy as np

D_MODEL = 1024
BATCH = 8
SEQ = 4096
DEPTH = 2

CHUNK = 64
S5_WIDTH = 512
S5_GROUP = 16
S5_GROUPS = S5_WIDTH // S5_GROUP
S5_STATE = 64
CONV_WIDTH = 512
CONV_K = 3
ATTN_HEADS = 8
HEAD_DIM = 64
ATTN_WIDTH = ATTN_HEADS * HEAD_DIM
Q_BLOCK = 128
N_BRANCH = 3
MIX_WIDTH = S5_WIDTH + CONV_WIDTH + ATTN_WIDTH
D_FF = 4 * D_MODEL
IN_WIDTH = S5_WIDTH + 3 * CONV_WIDTH + 3 * ATTN_WIDTH + ATTN_HEADS + N_BRANCH * D_MODEL
EPS = 1e-6
NEG_INF = -1e30

kernel_name = "hybrid_s5_shortconv_fox_gated_encoder"


def rmsnorm(x, g):
    xf = x.astype(jnp.float32)
    y = xf * lax.rsqrt(jnp.mean(xf * xf, axis=-1, keepdims=True) + EPS)
    return (y * g.astype(jnp.float32)).astype(x.dtype)


def s5_mixer(u, a_re, a_im, log_dt, b_re, b_im, c_re, c_im, d_skip, w_glu):
    bsz, L, _ = u.shape
    f32 = jnp.float32
    uf = u.astype(f32).reshape(bsz, L, S5_GROUPS, S5_GROUP)
    lam = lax.complex(jnp.minimum(a_re.astype(f32), -1e-4), a_im.astype(f32))
    dt = jnp.exp(log_dt.astype(f32))[:, None]
    a_bar = jnp.exp(lam * dt)
    b = lax.complex(b_re.astype(f32), b_im.astype(f32))
    b_bar = ((a_bar - 1.0) / lam)[..., None] * b
    bu = lax.complex(jnp.einsum('gph,blgh->blgp', jnp.real(b_bar), uf),
                     jnp.einsum('gph,blgh->blgp', jnp.imag(b_bar), uf))
    a_seq = jnp.broadcast_to(a_bar, bu.shape)

    def combine(left, right):
        a_l, s_l = left
        a_r, s_r = right
        return a_r * a_l, a_r * s_l + s_r

    _, states = lax.associative_scan(combine, (a_seq, bu), axis=1)
    y = (jnp.einsum('ghp,blgp->blgh', c_re.astype(f32), jnp.real(states))
         - jnp.einsum('ghp,blgp->blgh', c_im.astype(f32), jnp.imag(states))
         + d_skip.astype(f32) * uf)
    y = jax.nn.gelu(y)
    y = y * jax.nn.sigmoid(jnp.einsum('blgh,ghk->blgk', y, w_glu.astype(f32)))
    return y.reshape(bsz, L, S5_WIDTH).astype(u.dtype)


def short_conv_mixer(x_in, gate_b, gate_c, conv_w):
    L = x_in.shape[1]
    v = gate_c * x_in
    vp = jnp.pad(v, ((0, 0), (CONV_K - 1, 0), (0, 0)))
    conv = vp[:, 0:L] * conv_w[0]
    for tap in range(1, CONV_K):
        conv = conv + vp[:, tap:tap + L] * conv_w[tap]
    return gate_b * conv


def forgetting_attention(q, k, v, f_logit, b_f):
    bsz, L, _ = q.shape
    q = q.reshape(bsz, L, ATTN_HEADS, HEAD_DIM)
    k = k.reshape(bsz, L, ATTN_HEADS, HEAD_DIM)
    v = v.reshape(bsz, L, ATTN_HEADS, HEAD_DIM)
    log_f = jax.nn.log_sigmoid((f_logit + b_f).astype(jnp.float32))
    cum = jnp.cumsum(log_f, axis=1).transpose(0, 2, 1)
    scale = HEAD_DIM ** -0.5
    outs = []
    for blk in range(L // Q_BLOCK):
        q0 = blk * Q_BLOCK
        kend = q0 + Q_BLOCK
        s = jnp.einsum('bqhd,bkhd->bhqk', q[:, q0:kend], k[:, :kend]).astype(jnp.float32) * scale
        s = s + cum[:, :, q0:kend, None] - cum[:, :, None, :kend]
        q_pos = q0 + jnp.arange(Q_BLOCK)
        k_pos = jnp.arange(kend)
        s = jnp.where(k_pos[None, :] <= q_pos[:, None], s, NEG_INF)
        p = jax.nn.softmax(s, axis=-1)
        outs.append(jnp.einsum('bhqk,bkhd->bqhd', p.astype(v.dtype), v[:, :kend]))
    return jnp.concatenate(outs, axis=1).reshape(bsz, L, ATTN_WIDTH)


def hybrid_layer(x, g_pre_mix, w_in, b_gate, a_re, a_im, log_dt, b_re, b_im, c_re, c_im,
                 d_skip, w_glu, conv_w, b_f, w_branch, w_out, g_post_mix, g_pre_mlp,
                 w_ff1, w_ff2, g_post_mlp):
    bsz, L, _ = x.shape
    h = rmsnorm(x, g_pre_mix)
    proj = jnp.einsum('bld,dn->bln', h, w_in)
    widths = [S5_WIDTH, CONV_WIDTH, CONV_WIDTH, CONV_WIDTH, ATTN_WIDTH, ATTN_WIDTH,
              ATTN_WIDTH, ATTN_HEADS, N_BRANCH * D_MODEL]
    offsets = np.cumsum(widths)[:-1].tolist()
    (u_s5, x_conv, b_conv, c_conv, q, k, v, f_logit, gate_logits) = jnp.split(proj, offsets, axis=-1)

    y_a = s5_mixer(u_s5, a_re, a_im, log_dt, b_re, b_im, c_re, c_im, d_skip, w_glu)
    y_b = short_conv_mixer(x_conv, b_conv, c_conv, conv_w)
    y_c = forgetting_attention(q, k, v, f_logit, b_f)

    gates = jax.nn.sigmoid((gate_logits + b_gate).astype(jnp.float32)).astype(x.dtype)
    gates = gates.reshape(bsz, L, N_BRANCH, D_MODEL)
    wa = w_branch[:S5_WIDTH]
    wb = w_branch[S5_WIDTH:S5_WIDTH + CONV_WIDTH]
    wc = w_branch[S5_WIDTH + CONV_WIDTH:]
    merged = (gates[:, :, 0] * jnp.einsum('blc,cd->bld', y_a, wa)
              + gates[:, :, 1] * jnp.einsum('blc,cd->bld', y_b, wb)
              + gates[:, :, 2] * jnp.einsum('blc,cd->bld', y_c, wc))
    mix = jnp.einsum('bld,de->ble', merged, w_out)
    x = x + rmsnorm(mix, g_post_mix)

    h = rmsnorm(x, g_pre_mlp)
    ff = jnp.einsum('blf,fd->bld', jnp.square(jax.nn.relu(jnp.einsum('bld,df->blf', h, w_ff1))), w_ff2)
    return x + rmsnorm(ff, g_post_mlp)


def setup_inputs(seed: int = 0) -> dict:
    key = jax.random.key(seed)
    ks = jax.random.split(key, 24)
    f32 = jnp.float32
    nrm = lambda k, shape, s: (jax.random.normal(k, shape, f32) * s)
    G, P, H = S5_GROUPS, S5_STATE, S5_GROUP
    x = jax.random.normal(ks[0], (BATCH, SEQ, D_MODEL), f32)
    g_pre_mix = 1.0 + nrm(ks[1], (DEPTH, D_MODEL), 0.05)
    w_in = nrm(ks[2], (DEPTH, D_MODEL, IN_WIDTH), D_MODEL ** -0.5)
    b_gate = nrm(ks[3], (DEPTH, N_BRANCH * D_MODEL), 0.01)
    n_idx = jnp.arange(P, dtype=f32)
    s5_a_re = -0.5 + nrm(ks[4], (DEPTH, G, P), 0.01)
    s5_a_im = math.pi * n_idx + nrm(ks[5], (DEPTH, G, P), 0.01)
    s5_log_dt = jax.random.uniform(ks[6], (DEPTH, G), f32, math.log(1e-3), math.log(1e-1))
    s5_b_re = nrm(ks[7], (DEPTH, G, P, H), (2.0 * H) ** -0.5)
    s5_b_im = nrm(ks[8], (DEPTH, G, P, H), (2.0 * H) ** -0.5)
    s5_c_re = nrm(ks[9], (DEPTH, G, H, P), (2.0 * P) ** -0.5)
    s5_c_im = nrm(ks[10], (DEPTH, G, H, P), (2.0 * P) ** -0.5)
    s5_d = nrm(ks[11], (DEPTH, G, H), 1.0)
    s5_w_glu = nrm(ks[12], (DEPTH, G, H, H), H ** -0.5)
    conv_w = nrm(ks[13], (DEPTH, CONV_K, CONV_WIDTH), CONV_K ** -0.5)
    fox_b_f = jnp.linspace(1.0, 6.0, ATTN_HEADS, dtype=f32)[None, :] + nrm(ks[14], (DEPTH, ATTN_HEADS), 0.1)
    w_branch = nrm(ks[15], (DEPTH, MIX_WIDTH, D_MODEL), S5_WIDTH ** -0.5)
    w_out = nrm(ks[16], (DEPTH, D_MODEL, D_MODEL), D_MODEL ** -0.5)
    g_post_mix = 1.0 + nrm(ks[17], (DEPTH, D_MODEL), 0.05)
    g_pre_mlp = 1.0 + nrm(ks[18], (DEPTH, D_MODEL), 0.05)
    w_ff1 = nrm(ks[19], (DEPTH, D_MODEL, D_FF), D_MODEL ** -0.5)
    w_ff2 = nrm(ks[20], (DEPTH, D_FF, D_MODEL), D_FF ** -0.5)
    g_post_mlp = 1.0 + nrm(ks[21], (DEPTH, D_MODEL), 0.05)
    return {"x": x, "g_pre_mix": g_pre_mix, "w_in": w_in, "b_gate": b_gate,
            "s5_a_re": s5_a_re, "s5_a_im": s5_a_im, "s5_log_dt": s5_log_dt,
            "s5_b_re": s5_b_re, "s5_b_im": s5_b_im, "s5_c_re": s5_c_re, "s5_c_im": s5_c_im,
            "s5_d": s5_d, "s5_w_glu": s5_w_glu, "conv_w": conv_w, "fox_b_f": fox_b_f,
            "w_branch": w_branch, "w_out": w_out, "g_post_mix": g_post_mix,
            "g_pre_mlp": g_pre_mlp, "w_ff1": w_ff1, "w_ff2": w_ff2, "g_post_mlp": g_post_mlp}


def reference(x, g_pre_mix, w_in, b_gate, s5_a_re, s5_a_im, s5_log_dt, s5_b_re, s5_b_im,
              s5_c_re, s5_c_im, s5_d, s5_w_glu, conv_w, fox_b_f, w_branch, w_out,
              g_post_mix, g_pre_mlp, w_ff1, w_ff2, g_post_mlp):
    for layer in range(DEPTH):
        x = hybrid_layer(x, g_pre_mix[layer], w_in[layer], b_gate[layer],
                         s5_a_re[layer], s5_a_im[layer], s5_log_dt[layer],
                         s5_b_re[layer], s5_b_im[layer], s5_c_re[layer], s5_c_im[layer],
                         s5_d[layer], s5_w_glu[layer], conv_w[layer], fox_b_f[layer],
                         w_branch[layer], w_out[layer], g_post_mix[layer], g_pre_mlp[layer],
                         w_ff1[layer], w_ff2[layer], g_post_mlp[layer])
    return x
```

```cpp
#include <hip/hip_runtime.h>
#include <hip/hip_cooperative_groups.h>
#include <cstdio>
#include <cstdint>
namespace cg = cooperative_groups;

#define DIAG_STAGE 0
#ifndef PHMASK
#define PHMASK 0xff
#endif

#define LAS __attribute__((address_space(3)))
typedef unsigned short bf16_t;
typedef short bf16x8 __attribute__((ext_vector_type(8)));
typedef short s16x4 __attribute__((ext_vector_type(4)));
typedef float f32x2 __attribute__((ext_vector_type(2)));
typedef float f32x4 __attribute__((ext_vector_type(4)));
typedef float f32x16 __attribute__((ext_vector_type(16)));
typedef unsigned u32x2 __attribute__((ext_vector_type(2)));
typedef unsigned u32x4 __attribute__((ext_vector_type(4)));

constexpr int BATCH = 8, SEQ = 4096, DM = 1024, M = BATCH * SEQ, DEPTH = 2;
constexpr int INW = 6664, NA = 3584, NG = 3072, FF = 4096, YW = 512;
constexpr int COL_XC = 512, COL_BC = 1024, COL_CC = 1536, COL_Q = 2048, COL_K = 2560, COL_V = 3072, COL_F = 3584, COL_G = 3592;
constexpr float EPS = 1e-6f;
constexpr float LOG2E = 1.4426950408889634f;
constexpr float C2 = 0.125f * LOG2E;

constexpr size_t MiB = 1u << 20;
constexpr size_t WS_W = 1 * MiB, W_LAYER = 34 * MiB;
constexpr size_t W_INA = 0, W_G = 7 * MiB, W_BR = 13 * MiB, W_OUT = 16 * MiB, W_1 = 18 * MiB, W_2 = 26 * MiB;
constexpr size_t WS_S5 = 69 * MiB, S5_LAYER = 17 * MiB + 512 * 1024;
constexpr size_t S5_KT = 0, S5_WE = MiB + 256 * 1024, S5_WC = S5_WE + 8 * MiB, S5_A64 = S5_WC + 8 * MiB, S5_GLU = S5_A64 + 64 * 1024;
constexpr size_t WS_LOGF = 104 * MiB, WS_CUM = 105 * MiB, WS_XN = 106 * MiB, WS_P = 170 * MiB, WS_Y = 394 * MiB, WS_END = 490 * MiB;
constexpr int KT_BYTES = 65 * 512;

constexpr int LDS_BYTES = 147456;

typedef __bf16 bf16x2_t __attribute__((ext_vector_type(2)));
__device__ __forceinline__ unsigned cvt_pk_bf16(float lo, float hi) { const f32x2 v = {lo, hi}; const bf16x2_t b = __builtin_convertvector(v, bf16x2_t); return __builtin_bit_cast(unsigned, b); }
__device__ __forceinline__ float bf_lo(unsigned u) { return __uint_as_float(u << 16); }
__device__ __forceinline__ float bf_hi(unsigned u) { return __uint_as_float(u & 0xffff0000u); }
template <int O> __device__ __forceinline__ float swz_xor(float v) { return __int_as_float(__builtin_amdgcn_ds_swizzle(__float_as_int(v), (O << 10) | 0x1f)); }
__device__ __forceinline__ float half_sum(float v) { auto rr = __builtin_amdgcn_permlane32_swap(__float_as_uint(v), __float_as_uint(v), false, false); return __uint_as_float(rr[0]) + __uint_as_float(rr[1]); }
__device__ __forceinline__ float half_max(float v) { auto rr = __builtin_amdgcn_permlane32_swap(__float_as_uint(v), __float_as_uint(v), false, false); return fmaxf(__uint_as_float(rr[0]), __uint_as_float(rr[1])); }
__device__ __forceinline__ float wave_sum(float v) {
    v += swz_xor<1>(v); v += swz_xor<2>(v); v += swz_xor<4>(v); v += swz_xor<8>(v); v += swz_xor<16>(v);
    return half_sum(v);
}
__device__ __forceinline__ int launder_i(int x) { asm volatile("" : "+v"(x)); return x; }
__device__ __forceinline__ float fast_exp2(float x) { return __builtin_amdgcn_exp2f(x); }
__device__ __forceinline__ float fast_rcp(float x) { return __builtin_amdgcn_rcpf(x); }
__device__ __forceinline__ float sigmoid_f(float z) { return fast_rcp(1.0f + fast_exp2(-LOG2E * z)); }
__device__ __forceinline__ float gelu_tanh(float y) { const float t = y + 0.044715f * y * y * y; return y * fast_rcp(1.0f + fast_exp2(-2.302208198f * t)); }

namespace pg8 {
#define PG8_LAS __attribute__((address_space(3)))
constexpr int BM = 256, BK = 64, HALF = 128, HTB = HALF * BK * 2, STAGE_BYTES = 8 * HTB, NXCD = 8, WGM = 8;

__host__ __device__ __forceinline__ int lds_byte(int r, int c) { const int st = (r >> 4) * 2 + (c >> 5), rr = r & 15, cc = c & 31, ob = rr * 64 + cc * 2; return st * 1024 + (ob ^ (((ob >> 9) & 1) << 5)); }
__host__ __device__ __forceinline__ void stage_rc(int b, int& R, int& C) { const int st = b / 1024, sb = b % 1024, swz = sb ^ (((sb >> 9) & 1) << 5); R = (st >> 1) * 16 + swz / 64; C = (st & 1) * 32 + (swz % 64) / 2; }
__host__ __device__ __forceinline__ int perm32(int rho) { const int n = rho >> 4, i = rho & 15; return 8 * (i >> 2) + 4 * n + (i & 3); }

struct Unit { int pm, pn, br; };
struct Gemm { const bf16_t* A; const bf16_t* Bt; int M, N, K; size_t abr, bbr; };

struct StaticOrder {
    int nM, nN, nwg, G, c, nbr;
    __device__ void init(int M_, int N_, int G_, int c_, int nbr_) { nM = M_ / BM; nN = N_ / BM; nwg = nM * nN; G = G_; c = c_; nbr = nbr_; }
    __device__ bool next(int i, Unit& u) const {
        const int it = i / nbr; u.br = i - it * nbr;
        const long L = (long)it * G + c; if (L >= nwg) return false;
        int wgid = (int)L; { const int q = nwg / NXCD, r = nwg % NXCD, xcd = wgid % NXCD, off = wgid / NXCD; wgid = (xcd < r ? xcd * (q + 1) : r * (q + 1) + (xcd - r) * q) + off; }
        const int nig = WGM * nN, gid = wgid / nig, fm = gid * WGM, gsz = (nM - fm) < WGM ? (nM - fm) : WGM;
        u.pm = fm + ((wgid % nig) % gsz); u.pn = (wgid % nig) / gsz; return true;
    }
};

enum { EPI_PROJ = 0, EPI_GATE = 1, EPI_RELU2 = 2, EPI_BRANCH = 3, EPI_PLAIN = 4 };
template <int MODE> struct Epi {
    static constexpr bool PERM = true;
    bf16_t* O; int ldc; const float* bias; const bf16_t* G;
    __device__ __forceinline__ void operator()(const f32x4 (&acc)[2][2][4][2], const Unit& u, int wr, int wc, int fr, int fq) const {
        const int row0 = u.pm * BM + wr * 64 + fr; const int col0 = u.pn * BM + wc * 32 + 8 * fq;
        float sc = 1.f; if (MODE == EPI_PROJ) { if (u.pn >= COL_Q / 256 && u.pn < COL_K / 256) sc = C2; }
        f32x4 bv[2][2];
        if (MODE == EPI_GATE) {
#pragma unroll
            for (int bj = 0; bj < 2; ++bj)
#pragma unroll
                for (int n = 0; n < 2; ++n) bv[bj][n] = *(const f32x4*)(bias + col0 + bj * HALF + 4 * n);
        }
#pragma unroll
        for (int ai = 0; ai < 2; ++ai)
#pragma unroll
            for (int m = 0; m < 4; ++m) {
                const size_t row = (size_t)(row0 + ai * HALF + m * 16);
                bf16_t* rowp = O + row * ldc + col0;
#pragma unroll
                for (int bj = 0; bj < 2; ++bj) {
                    f32x4 v0 = acc[ai][bj][m][0], v1 = acc[ai][bj][m][1];
                    if (MODE == EPI_PROJ) { v0 = v0 * sc; v1 = v1 * sc; }
                    if (MODE == EPI_GATE) {
                        v0 = v0 + bv[bj][0]; v1 = v1 + bv[bj][1];
#pragma unroll
                        for (int i = 0; i < 4; ++i) { v0[i] = sigmoid_f(v0[i]); v1[i] = sigmoid_f(v1[i]); }
                    }
                    if (MODE == EPI_RELU2) {
#pragma unroll
                        for (int i = 0; i < 4; ++i) { const float a = fmaxf(v0[i], 0.f), b = fmaxf(v1[i], 0.f); v0[i] = a * a; v1[i] = b * b; }
                    }
                    if (MODE == EPI_BRANCH) {
                        const u32x4 gt = *(const u32x4*)(G + row * NG + (size_t)u.br * DM + col0 + bj * HALF);
                        v0[0] *= bf_lo(gt.x); v0[1] *= bf_hi(gt.x); v0[2] *= bf_lo(gt.y); v0[3] *= bf_hi(gt.y);
                        v1[0] *= bf_lo(gt.z); v1[1] *= bf_hi(gt.z); v1[2] *= bf_lo(gt.w); v1[3] *= bf_hi(gt.w);
                        if (u.br > 0) {
                            const u32x4 pv = *(const u32x4*)(rowp + bj * HALF);
                            v0[0] += bf_lo(pv.x); v0[1] += bf_hi(pv.x); v0[2] += bf_lo(pv.y); v0[3] += bf_hi(pv.y);
                            v1[0] += bf_lo(pv.z); v1[1] += bf_hi(pv.z); v1[2] += bf_lo(pv.w); v1[3] += bf_hi(pv.w);
                        }
                    }
                    u32x4 w; w.x = cvt_pk_bf16(v0[0], v0[1]); w.y = cvt_pk_bf16(v0[2], v0[3]); w.z = cvt_pk_bf16(v1[0], v1[1]); w.w = cvt_pk_bf16(v1[2], v1[3]);
                    *(u32x4*)(rowp + bj * HALF) = w;
                }
            }
    }
};

template <class EpiT, class Sched, bool ALIGN_EPI, bool SP2>
__device__ __forceinline__ void gemm_phase(PG8_LAS unsigned char* lds, const Gemm g, const Sched& S, const EpiT& E) {
    const int tid = launder_i(threadIdx.x), wid = __builtin_amdgcn_readfirstlane(tid >> 6), lane = tid & 63, wr = wid >> 2, wc = wid & 3, fr = lane & 15, fq = lane >> 4;
    const int K = g.K, nt = K / BK;
    unsigned voffA[2], voffB[2];
#pragma unroll
    for (int i = 0; i < 2; ++i) { int R, C; stage_rc(tid * 16 + i * 8192, R, C); const int Rb = EpiT::PERM ? ((R & ~31) + perm32(R & 31)) : R;
        voffA[i] = (unsigned)(R * K + C) * 2u; voffB[i] = (unsigned)(Rb * K + C) * 2u; }
    const size_t kstep = (size_t)(BK * 2);
    const size_t hstep = (size_t)HALF * K * 2;
    const size_t tstep = 2 * hstep;
    const unsigned ldsw = (unsigned)wid * 1024u;
    const int aoff = lds_byte(wr * 64 + fr, fq * 8), boff = lds_byte(wc * 32 + fr, fq * 8);
#define PG8_SA(b, h) (((b) * 2 + (h)) * HTB)
#define PG8_SB(b, h) ((4 + (b) * 2 + (h)) * HTB)
#define PG8_STAGE(bufoff, gbase, voff) do { _Pragma("unroll") for (int _i = 0; _i < 2; ++_i) \
        __builtin_amdgcn_global_load_lds((const unsigned*)((const char*)(gbase) + (voff)[_i]), (PG8_LAS unsigned*)(lds + (bufoff) + ldsw + _i * 8192), 16, 0, 0); } while (0)
#define PG8_LDA(dst, b, h) do { _Pragma("unroll") for (int m = 0; m < 4; ++m) _Pragma("unroll") for (int k = 0; k < 2; ++k) dst[m][k] = *(const PG8_LAS bf16x8*)(lds + PG8_SA(b, h) + aoff + m * 2048 + k * 1024); } while (0)
#define PG8_LDB(dst, b, h) do { _Pragma("unroll") for (int n = 0; n < 2; ++n) _Pragma("unroll") for (int k = 0; k < 2; ++k) dst[n][k] = *(const PG8_LAS bf16x8*)(lds + PG8_SB(b, h) + boff + n * 2048 + k * 1024); } while (0)
#define PG8_MMA(ai, bj, At, Bt) do { __builtin_amdgcn_s_setprio(1); _Pragma("unroll") for (int m = 0; m < 4; ++m) _Pragma("unroll") for (int n = 0; n < 2; ++n) _Pragma("unroll") for (int k = 0; k < 2; ++k) \
        acc[ai][bj][m][n] = __builtin_amdgcn_mfma_f32_16x16x32_bf16(Bt[n][k], At[m][k], acc[ai][bj][m][n], 0, 0, 0); __builtin_amdgcn_s_setprio(0); } while (0)
#define PG8_WAIT_V(n) asm volatile("s_waitcnt vmcnt(" #n ")" ::: "memory")
#define PG8_WAIT_L(n) asm volatile("s_waitcnt lgkmcnt(" #n ")" ::: "memory")
#define PG8_BAR __builtin_amdgcn_s_barrier()
#define PG8_SCHED __builtin_amdgcn_sched_barrier(0)
    Unit cur, nxt; int ui = 0;
    if (!S.next(0, cur)) return;
    f32x4 acc[2][2][4][2];
#pragma unroll
    for (int a = 0; a < 2; ++a)
#pragma unroll
        for (int b = 0; b < 2; ++b)
#pragma unroll
            for (int m = 0; m < 4; ++m)
#pragma unroll
                for (int n = 0; n < 2; ++n) acc[a][b][m][n] = (f32x4){0.f, 0.f, 0.f, 0.f};
    bf16x8 At[4][2], B0[2][2], B1[2][2];
    const char* cA = (const char*)g.A + (size_t)cur.pm * tstep + (size_t)cur.br * g.abr; const char* cB = (const char*)g.Bt + (size_t)cur.pn * tstep + (size_t)cur.br * g.bbr;
    if constexpr (SP2) {
        PG8_STAGE(PG8_SB(0, 0), cB, voffB); PG8_STAGE(PG8_SB(0, 1), cB + hstep, voffB); PG8_STAGE(PG8_SA(0, 0), cA, voffA); PG8_STAGE(PG8_SA(0, 1), cA + hstep, voffA);
        if (wr == 1) PG8_BAR;
        PG8_WAIT_V(2); PG8_BAR;
        PG8_STAGE(PG8_SB(1, 0), cB + kstep, voffB); PG8_STAGE(PG8_SA(1, 0), cA + kstep, voffA); PG8_STAGE(PG8_SB(1, 1), cB + hstep + kstep, voffB);
        PG8_WAIT_V(6); PG8_BAR;
    } else {
        PG8_STAGE(PG8_SB(0, 0), cB, voffB); PG8_STAGE(PG8_SA(0, 0), cA, voffA); PG8_STAGE(PG8_SB(0, 1), cB + hstep, voffB); PG8_STAGE(PG8_SA(0, 1), cA + hstep, voffA);
        if (wr == 1) PG8_BAR;
        PG8_WAIT_V(4); PG8_BAR;
        PG8_STAGE(PG8_SB(1, 0), cB + kstep, voffB); PG8_STAGE(PG8_SA(1, 0), cA + kstep, voffA); PG8_STAGE(PG8_SB(1, 1), cB + hstep + kstep, voffB);
        PG8_WAIT_V(6); PG8_BAR;
    }
    for (;;) {
        const bool has_next = S.next(ui + 1, nxt);
        const char* nA = has_next ? (const char*)g.A + (size_t)nxt.pm * tstep + (size_t)nxt.br * g.abr : cA;
        const char* nB = has_next ? (const char*)g.Bt + (size_t)nxt.pn * tstep + (size_t)nxt.br * g.bbr : cB;
        for (int t = 0; t < nt; t += 2) {
            const bool last = (t == nt - 2);
            const char* a1 = cA + (size_t)(t + 1) * kstep;
            const char* a2 = last ? nA : cA + (size_t)(t + 2) * kstep; const char* b2 = last ? nB : cB + (size_t)(t + 2) * kstep;
            const char* a3 = a2 + kstep; const char* b3 = b2 + kstep;
            if constexpr (SP2) {
            PG8_LDB(B0, 0, 0); PG8_LDB(B1, 0, 1); PG8_SCHED; PG8_LDA(At, 0, 0); PG8_STAGE(PG8_SA(1, 1), a1 + hstep, voffA);
            PG8_WAIT_V(8); PG8_WAIT_L(0); PG8_BAR; PG8_MMA(0, 0, At, B0); PG8_MMA(0, 1, At, B1); PG8_BAR; PG8_SCHED;
            PG8_LDA(At, 0, 1); PG8_STAGE(PG8_SB(0, 0), b2, voffB); PG8_STAGE(PG8_SB(0, 1), b2 + hstep, voffB); PG8_STAGE(PG8_SA(0, 0), a2, voffA);
            PG8_WAIT_V(8); PG8_WAIT_L(0); PG8_BAR; PG8_MMA(1, 0, At, B0); PG8_MMA(1, 1, At, B1); PG8_BAR; PG8_SCHED;
            PG8_LDB(B0, 1, 0); PG8_LDB(B1, 1, 1); PG8_SCHED; PG8_LDA(At, 1, 0); PG8_STAGE(PG8_SA(0, 1), a2 + hstep, voffA);
            PG8_WAIT_V(8); PG8_WAIT_L(0); PG8_BAR; PG8_MMA(0, 0, At, B0); PG8_MMA(0, 1, At, B1); PG8_BAR; PG8_SCHED;
            PG8_LDA(At, 1, 1); PG8_STAGE(PG8_SB(1, 0), b3, voffB); PG8_STAGE(PG8_SB(1, 1), b3 + hstep, voffB); PG8_STAGE(PG8_SA(1, 0), a3, voffA);
            PG8_WAIT_V(8); PG8_WAIT_L(0); PG8_BAR; PG8_MMA(1, 0, At, B0); PG8_MMA(1, 1, At, B1); PG8_BAR; PG8_SCHED;
            } else {
            PG8_LDB(B0, 0, 0); PG8_SCHED; PG8_LDA(At, 0, 0); PG8_STAGE(PG8_SA(1, 1), a1 + hstep, voffA);
            PG8_WAIT_L(8); PG8_BAR; PG8_WAIT_L(0); PG8_MMA(0, 0, At, B0); PG8_BAR; PG8_SCHED;
            PG8_LDB(B1, 0, 1); PG8_STAGE(PG8_SB(0, 0), b2, voffB);
            PG8_BAR; PG8_WAIT_L(0); PG8_MMA(0, 1, At, B1); PG8_BAR;
            PG8_LDA(At, 0, 1); PG8_STAGE(PG8_SA(0, 0), a2, voffA);
            PG8_BAR; PG8_WAIT_L(0); PG8_MMA(1, 0, At, B0); PG8_BAR; PG8_SCHED;
            PG8_STAGE(PG8_SB(0, 1), b2 + hstep, voffB);
            PG8_WAIT_V(6); PG8_BAR; PG8_MMA(1, 1, At, B1); PG8_BAR;
            PG8_LDB(B0, 1, 0); PG8_SCHED; PG8_LDA(At, 1, 0); PG8_STAGE(PG8_SA(0, 1), a2 + hstep, voffA);
            PG8_WAIT_L(8); PG8_BAR; PG8_WAIT_L(0); PG8_MMA(0, 0, At, B0); PG8_BAR; PG8_SCHED;
            PG8_LDB(B1, 1, 1); PG8_STAGE(PG8_SB(1, 0), b3, voffB);
            PG8_BAR; PG8_WAIT_L(0); PG8_MMA(0, 1, At, B1); PG8_BAR;
            PG8_LDA(At, 1, 1); PG8_STAGE(PG8_SA(1, 0), a3, voffA);
            PG8_BAR; PG8_WAIT_L(0); PG8_MMA(1, 0, At, B0); PG8_BAR; PG8_SCHED;
            PG8_STAGE(PG8_SB(1, 1), b3 + hstep, voffB);
            PG8_WAIT_V(6); PG8_BAR; PG8_MMA(1, 1, At, B1); PG8_BAR;
            }
        }
        if constexpr (ALIGN_EPI) { if (wr == 0) PG8_BAR; }
        E(acc, cur, wr, wc, fr, fq);
        if (!has_next) break;
#pragma unroll
        for (int a = 0; a < 2; ++a)
#pragma unroll
            for (int b = 0; b < 2; ++b)
#pragma unroll
                for (int m = 0; m < 4; ++m)
#pragma unroll
                    for (int n = 0; n < 2; ++n) acc[a][b][m][n] = (f32x4){0.f, 0.f, 0.f, 0.f};
        cur = nxt; cA = nA; cB = nB; ++ui;
        if constexpr (ALIGN_EPI) { if (wr == 1) PG8_BAR; }
    }
    PG8_WAIT_V(0);
    if constexpr (!ALIGN_EPI) { if (wr == 0) PG8_BAR; }
    PG8_BAR;
#undef PG8_SA
#undef PG8_SB
#undef PG8_STAGE
#undef PG8_LDA
#undef PG8_LDB
#undef PG8_MMA
#undef PG8_WAIT_V
#undef PG8_WAIT_L
#undef PG8_BAR
#undef PG8_SCHED
}
}

struct Args { const float* in[22]; float* out; unsigned char* ws; };

__device__ __forceinline__ void transpose_item(const float* W, int ldw, int col_off, int K, int N, bf16_t* WT, LAS float* scr, int item, int lane) {
    const int nblk = N / 32, kb = item / nblk, nb = item % nblk, k0 = 64 * kb, n0 = 32 * nb;
#pragma unroll 8
    for (int i = 0; i < 32; ++i) { const int kk = 2 * i + (lane >> 5); scr[kk * 33 + (lane & 31)] = W[(size_t)(k0 + kk) * ldw + col_off + n0 + (lane & 31)]; }
    asm volatile("s_waitcnt lgkmcnt(0)" ::: "memory");
    const int c = lane & 7;
#pragma unroll
    for (int j = 0; j < 4; ++j) { const int n = (lane >> 3) + 8 * j; const LAS float* s = scr + (8 * c) * 33 + n;
        u32x4 o; o.x = cvt_pk_bf16(s[0 * 33], s[1 * 33]); o.y = cvt_pk_bf16(s[2 * 33], s[3 * 33]); o.z = cvt_pk_bf16(s[4 * 33], s[5 * 33]); o.w = cvt_pk_bf16(s[6 * 33], s[7 * 33]);
        *(u32x4*)(WT + (size_t)(n0 + n) * K + k0 + 8 * c) = o; }
    asm volatile("s_waitcnt lgkmcnt(0)" ::: "memory");
}

__device__ __forceinline__ void s5_tables(LAS unsigned char* lds, const Args& a, int l, int g, int tid) {
    LAS f32x2* AP = (LAS f32x2*)lds;
    LAS f32x2* BB = AP + 65 * 64;
    LAS f32x2* CC = BB + 64 * 16;
    const int lg = l * 32 + g;
    const float* are = a.in[4] + lg * 64; const float* aim = a.in[5] + lg * 64;
    const float dt = expf(a.in[6][lg]);
    unsigned char* tab = a.ws + WS_S5 + (size_t)l * S5_LAYER;
    for (int idx = tid; idx < 65 * 64; idx += 512) {
        const int d = idx >> 6, p = idx & 63;
        const float lr = fminf(are[p], -1e-4f), li = aim[p];
        const float mag = expf(lr * dt * (float)d);
        double rev = (double)li * (double)dt * (double)d * 0.15915494309189535;
        rev -= floor(rev); if (rev > 0.5) rev -= 1.0;
        const float th = (float)(rev * 6.283185307179586);
        AP[idx] = (f32x2){mag * cosf(th), mag * sinf(th)};
    }
    for (int idx = tid; idx < 1024; idx += 512) CC[idx] = (f32x2){a.in[9][(size_t)lg * 1024 + idx], a.in[10][(size_t)lg * 1024 + idx]};
    for (int idx = tid; idx < 1024; idx += 512) {
        const int p = idx >> 4;
        const float lr = fminf(are[p], -1e-4f), li = aim[p];
        double rev = (double)li * (double)dt * 0.15915494309189535;
        rev -= floor(rev); if (rev > 0.5) rev -= 1.0;
        const float th = (float)(rev * 6.283185307179586);
        const float em1 = expm1f(lr * dt), c = cosf(th), s = sinf(th), sh = sinf(0.5f * th);
        const float nr = em1 * c - 2.f * sh * sh, ni = (1.f + em1) * s;
        const float den = 1.f / (lr * lr + li * li);
        const float qr = (nr * lr + ni * li) * den, qi = (ni * lr - nr * li) * den;
        const float br = a.in[7][(size_t)lg * 1024 + idx], bi = a.in[8][(size_t)lg * 1024 + idx];
        BB[idx] = (f32x2){qr * br - qi * bi, qr * bi + qi * br};
    }
    __syncthreads();
    bf16_t* kt = (bf16_t*)(tab + S5_KT) + (size_t)g * (65 * 256);
    for (int s = tid; s < 1024; s += 512) {
        const int d = s >> 4, h = s & 15;
        float acc[16];
#pragma unroll
        for (int i = 0; i < 16; ++i) acc[i] = 0.f;
        for (int p = 0; p < 64; ++p) {
            const f32x2 cc = CC[h * 64 + p], ap = AP[d * 64 + p];
            const float cr = cc.x * ap.x - cc.y * ap.y, ci = cc.x * ap.y + cc.y * ap.x;
#pragma unroll
            for (int i = 0; i < 16; ++i) { const f32x2 bb = BB[p * 16 + i]; acc[i] += cr * bb.x - ci * bb.y; }
        }
        if (d == 0) { const float dsk = a.in[11][lg * 16 + h];
#pragma unroll
            for (int i = 0; i < 16; ++i) if (i == h) acc[i] += dsk; }
        u32x4 o0, o1;
        o0.x = cvt_pk_bf16(acc[0], acc[1]); o0.y = cvt_pk_bf16(acc[2], acc[3]); o0.z = cvt_pk_bf16(acc[4], acc[5]); o0.w = cvt_pk_bf16(acc[6], acc[7]);
        o1.x = cvt_pk_bf16(acc[8], acc[9]); o1.y = cvt_pk_bf16(acc[10], acc[11]); o1.z = cvt_pk_bf16(acc[12], acc[13]); o1.w = cvt_pk_bf16(acc[14], acc[15]);
        u32x4* dst = (u32x4*)(kt + (size_t)(63 - d) * 256 + h * 16);
        dst[0] = o0; dst[1] = o1;
    }
    if (tid < 32) ((u32x4*)(kt + 64 * 256))[tid] = (u32x4){0u, 0u, 0u, 0u};
    bf16_t* we = (bf16_t*)(tab + S5_WE) + (size_t)g * 128 * 1024;
    for (int idx = tid; idx < 16384; idx += 512) {
        const int half = idx & 1, j = (idx >> 1) & 63, row = idx >> 7, p = row & 63, im = row >> 6;
        const f32x2 ap = AP[(63 - j) * 64 + p];
        float v[8];
#pragma unroll
        for (int i = 0; i < 8; ++i) { const f32x2 bb = BB[p * 16 + 8 * half + i]; v[i] = im ? (ap.x * bb.y + ap.y * bb.x) : (ap.x * bb.x - ap.y * bb.y); }
        u32x4 o; o.x = cvt_pk_bf16(v[0], v[1]); o.y = cvt_pk_bf16(v[2], v[3]); o.z = cvt_pk_bf16(v[4], v[5]); o.w = cvt_pk_bf16(v[6], v[7]);
        *(u32x4*)(we + (size_t)row * 1024 + j * 16 + 8 * half) = o;
    }
    bf16_t* wc = (bf16_t*)(tab + S5_WC) + (size_t)g * 1024 * 128;
    for (int idx = tid; idx < 16384; idx += 512) {
        const int kgp = idx & 15, rowi = idx >> 4, t = rowi >> 4, h = rowi & 15, im = kgp >> 3, p0 = (kgp & 7) * 8;
        float v[8];
#pragma unroll
        for (int i = 0; i < 8; ++i) { const f32x2 cc = CC[h * 64 + p0 + i], ap = AP[(t + 1) * 64 + p0 + i];
            v[i] = im ? -(cc.x * ap.y + cc.y * ap.x) : (cc.x * ap.x - cc.y * ap.y); }
        u32x4 o; o.x = cvt_pk_bf16(v[0], v[1]); o.y = cvt_pk_bf16(v[2], v[3]); o.z = cvt_pk_bf16(v[4], v[5]); o.w = cvt_pk_bf16(v[6], v[7]);
        *(u32x4*)(wc + (size_t)rowi * 128 + kgp * 8) = o;
    }
    if (tid < 64) {
        ((f32x2*)(tab + S5_A64))[g * 64 + tid] = AP[64 * 64 + tid];
        const int k = tid & 15, kg = tid >> 4; const float* wg = a.in[12] + (size_t)lg * 256;
        u32x4 o; o.x = cvt_pk_bf16(wg[(4 * kg + 0) * 16 + k], wg[(4 * kg + 1) * 16 + k]); o.y = cvt_pk_bf16(wg[(4 * kg + 2) * 16 + k], wg[(4 * kg + 3) * 16 + k]); o.z = 0u; o.w = 0u;
        ((u32x4*)(tab + S5_GLU))[g * 64 + tid] = o;
    }
    __syncthreads();
}

struct NormArgs { const float* resid; const bf16_t* add; const float* g_add; float* xout; const float* g_xn; bf16_t* xn; const float* wf; const float* bfh; float* logf; };
__device__ __forceinline__ void norm_phase(LAS unsigned char* lds, const NormArgs n, int gw, int ngw, int lane, int tid) {
    if (n.wf) {
        for (int i = tid; i < 2048; i += 512) { const int d = i >> 1, hh = i & 1; const f32x4 v = *(const f32x4*)(n.wf + (size_t)d * INW + 4 * hh);
            *(LAS f32x4*)(lds + d * 32 + 16 * (d >> 3) + 16 * hh) = v; }
        __syncthreads();
    }
    f32x4 ga[4], gx[4];
#pragma unroll
    for (int j = 0; j < 4; ++j) { ga[j] = n.add ? *(const f32x4*)(n.g_add + 4 * lane + 256 * j) : (f32x4){0.f, 0.f, 0.f, 0.f}; gx[j] = n.xn ? *(const f32x4*)(n.g_xn + 4 * lane + 256 * j) : (f32x4){0.f, 0.f, 0.f, 0.f}; }
    for (int row = gw; row < M; row += ngw) {
        f32x4 v[4];
#pragma unroll
        for (int j = 0; j < 4; ++j) v[j] = *(const f32x4*)(n.resid + (size_t)row * DM + 4 * lane + 256 * j);
        if (n.add) {
            f32x4 av[4]; float ss = 0.f;
#pragma unroll
            for (int j = 0; j < 4; ++j) { const u32x2 u = *(const u32x2*)(n.add + (size_t)row * DM + 4 * lane + 256 * j);
                av[j] = (f32x4){bf_lo(u.x), bf_hi(u.x), bf_lo(u.y), bf_hi(u.y)}; ss += (av[j].x * av[j].x + av[j].y * av[j].y) + (av[j].z * av[j].z + av[j].w * av[j].w); }
            const float rs = rsqrtf(wave_sum(ss) * (1.f / DM) + EPS);
#pragma unroll
            for (int j = 0; j < 4; ++j) v[j] = v[j] + av[j] * rs * ga[j];
        }
        if (n.xout) {
#ifdef SANITIZE
#pragma unroll
            for (int j = 0; j < 4; ++j)
#pragma unroll
                for (int i = 0; i < 4; ++i) if (!(fabsf(v[j][i]) < 1e30f)) v[j][i] = 0.f;
#endif
#pragma unroll
            for (int j = 0; j < 4; ++j) *(f32x4*)(n.xout + (size_t)row * DM + 4 * lane + 256 * j) = v[j];
        }
        if (n.xn) {
            float ss = 0.f;
#pragma unroll
            for (int j = 0; j < 4; ++j) ss += (v[j].x * v[j].x + v[j].y * v[j].y) + (v[j].z * v[j].z + v[j].w * v[j].w);
            const float rs = rsqrtf(wave_sum(ss) * (1.f / DM) + EPS);
            f32x4 hn[4];
#pragma unroll
            for (int j = 0; j < 4; ++j) { hn[j] = v[j] * rs * gx[j]; u32x2 o; o.x = cvt_pk_bf16(hn[j].x, hn[j].y); o.y = cvt_pk_bf16(hn[j].z, hn[j].w);
                *(u32x2*)(n.xn + (size_t)row * DM + 4 * lane + 256 * j) = o; }
            if (n.wf) {
                f32x4 f0 = (f32x4){0.f, 0.f, 0.f, 0.f}, f1 = f0;
#pragma unroll
                for (int j = 0; j < 4; ++j)
#pragma unroll
                    for (int i = 0; i < 4; ++i) { const int d = 4 * lane + 256 * j + i; const LAS unsigned char* wp = lds + d * 32 + 16 * (d >> 3);
                        const f32x4 w0 = *(const LAS f32x4*)wp, w1 = *(const LAS f32x4*)(wp + 16); f0 = f0 + w0 * hn[j][i]; f1 = f1 + w1 * hn[j][i]; }
                float z = 0.f;
#pragma unroll
                for (int hh = 0; hh < 4; ++hh) { const float s0 = wave_sum(f0[hh]), s1 = wave_sum(f1[hh]); if (lane == hh) z = s0; if (lane == hh + 4) z = s1; }
                if (lane < 8) { z += n.bfh[lane]; n.logf[(size_t)row * 8 + lane] = fminf(z, 0.f) - log1pf(expf(-fabsf(z))); }
            }
        }
    }
}

__device__ __forceinline__ void cum_scan(LAS unsigned char* lds, const float* logf, float* cum, int bh, int tid, int lane, int w) {
    LAS float* ws = (LAS float*)lds;
    const int b = bh >> 3, h = bh & 7;
    float v[8]; float run = 0.f;
#pragma unroll
    for (int i = 0; i < 8; ++i) { run += logf[((size_t)b * SEQ + 8 * tid + i) * 8 + h]; v[i] = run; }
    float inc = run;
#pragma unroll
    for (int o = 1; o < 64; o <<= 1) { const float t = __int_as_float(__builtin_amdgcn_ds_bpermute((lane - o) << 2, __float_as_int(inc))); if (lane >= o) inc += t; }
    if (lane == 63) ws[w] = inc;
    __syncthreads();
    float base = inc - run;
    for (int i = 0; i < w; ++i) base += ws[i];
#pragma unroll
    for (int i = 0; i < 8; ++i) cum[(size_t)bh * SEQ + 8 * tid + i] = (base + v[i]) * LOG2E;
    __syncthreads();
}

#define MFMA16(a, b, c) __builtin_amdgcn_mfma_f32_16x16x32_bf16((a), (b), (c), 0, 0, 0)
#define MFMA32(a, b, c) __builtin_amdgcn_mfma_f32_32x32x16_bf16((a), (b), (c), 0, 0, 0)
__device__ __forceinline__ bf16x8 ldg16(const void* ubase, unsigned off) { return *(const bf16x8*)((const char*)ubase + off); }
__device__ __forceinline__ void s5_unit(LAS unsigned char* lds, const bf16_t* P, const unsigned char* tab, bf16_t* Ya, const int b, const int g, int tid, int lane, int w) {
    LAS unsigned char* KT = lds; LAS float* EL = (LAS float*)(lds + 33280); LAS unsigned char* SPT = lds + 66560;
    const unsigned char* ktab = tab + S5_KT + (size_t)g * KT_BYTES;
    const int n = lane & 15, kg = lane >> 4, ntile = w & 3, wh = w >> 2;
    const bf16_t* WEu = (const bf16_t*)(tab + S5_WE) + (size_t)g * 128 * 1024 + (size_t)(64 * wh) * 1024;
    const bf16_t* WCu = (const bf16_t*)(tab + S5_WC) + (size_t)g * 1024 * 128 + (size_t)(wh * 16) * 128;
    const bf16_t* Uu = P + ((size_t)b * SEQ + (size_t)(16 * ntile) * 64) * NA + 16 * g;
    const unsigned uoff = (unsigned)((n * 64 + (kg >> 1)) * NA + 8 * (kg & 1)) * 2u;
    const unsigned weoff = (unsigned)(n * 1024 + 8 * kg) * 2u;
    const unsigned wcoff = (unsigned)(n * 128 + 8 * kg) * 2u;
    for (int i = tid; i < KT_BYTES / 16; i += 512) *(LAS u32x4*)(KT + i * 16) = *(const u32x4*)(ktab + i * 16);
    {
        f32x4 e[4];
#pragma unroll
        for (int mt = 0; mt < 4; ++mt) e[mt] = (f32x4){0.f, 0.f, 0.f, 0.f};
#pragma unroll 2
        for (int ks = 0; ks < 32; ++ks) {
            const bf16x8 bf = ldg16(Uu + (size_t)(2 * ks) * NA, uoff);
#pragma unroll
            for (int mt = 0; mt < 4; ++mt) { const bf16x8 af = ldg16(WEu + (size_t)(16 * mt) * 1024 + 32 * ks, weoff); e[mt] = MFMA16(af, bf, e[mt]); }
        }
#pragma unroll
        for (int mt = 0; mt < 4; ++mt)
#pragma unroll
            for (int i = 0; i < 4; ++i) EL[(64 * wh + 16 * mt + 4 * kg + i) * 65 + 16 * ntile + n] = e[mt][i];
    }
    __syncthreads();
    if (tid < 64) {
        const f32x2 a64 = ((const f32x2*)(tab + S5_A64))[g * 64 + tid];
        float sr = 0.f, si = 0.f;
        for (int c = 0; c < 64; ++c) {
            *(LAS bf16_t*)(SPT + c * 272 + 2 * tid) = (bf16_t)(cvt_pk_bf16(sr, 0.f) & 0xffffu);
            *(LAS bf16_t*)(SPT + c * 272 + 2 * (64 + tid)) = (bf16_t)(cvt_pk_bf16(si, 0.f) & 0xffffu);
            const float er = EL[tid * 65 + c], ei = EL[(64 + tid) * 65 + c];
            const float nr = a64.x * sr - a64.y * si + er, ni = a64.x * si + a64.y * sr + ei;
            sr = nr; si = ni;
        }
    }
    __syncthreads();
    const LAS unsigned char* klow = KT + (1 - wh + (lane >> 5)) * 512 + (lane & 15) * 32 + ((lane >> 4) & 1) * 16;
    const LAS unsigned char* spb = SPT + (16 * ntile + n) * 272 + 16 * kg;
    const bf16x8 aglu = *(const bf16x8*)(tab + S5_GLU + (size_t)(g * 64 + lane) * 16);
    const unsigned yoff = (unsigned)(n * 64 * YW + 4 * kg) * 2u;
#pragma unroll 1
    for (int pass = 0; pass < 2; ++pass) {
        f32x4 acc[16];
#pragma unroll
        for (int i = 0; i < 16; ++i) acc[i] = (f32x4){0.f, 0.f, 0.f, 0.f};
        bf16x8 bq[4], ca[2][4];
        if (pass == 1) {
            bq[0] = ldg16(Uu, uoff); bq[1] = ldg16(Uu + (size_t)2 * NA, uoff); bq[2] = ldg16(Uu + (size_t)4 * NA, uoff);
            __builtin_amdgcn_sched_barrier(0);
#pragma unroll
            for (int jj = 0; jj < 16; ++jj) {
                if (jj + 3 < 16) bq[(jj + 3) & 3] = ldg16(Uu + (size_t)(2 * (jj + 3)) * NA, uoff);
#pragma unroll
                for (int ii = 0; ii < 16; ++ii) { const bf16x8 af = *(const LAS bf16x8*)(klow + (30 - 2 * (ii - jj)) * 512); acc[ii] = MFMA16(af, bq[jj & 3], acc[ii]); }
                __builtin_amdgcn_sched_barrier(0);
            }
        }
        const bf16_t* Up = Uu + (size_t)(32 * pass) * NA;
        const bf16_t* WCp = WCu + (size_t)(32 * pass) * 2048;
#define S5_LDC(st, slot) do { _Pragma("unroll") for (int _q = 0; _q < 4; ++_q) ca[slot][_q] = ldg16(WCp + (size_t)(2 * (4 * ((st) & 3) + _q)) * 2048 + 32 * ((st) >> 2), wcoff); } while (0)
        bq[0] = ldg16(Up, uoff); bq[1] = ldg16(Up + (size_t)2 * NA, uoff); bq[2] = ldg16(Up + (size_t)4 * NA, uoff);
        S5_LDC(0, 0); S5_LDC(1, 1);
        __builtin_amdgcn_sched_barrier(0);
#pragma unroll
        for (int jj = 0; jj < 16; ++jj) {
            if (jj + 3 < 16) bq[(jj + 3) & 3] = ldg16(Up + (size_t)(2 * (jj + 3)) * NA, uoff);
            const bf16x8 cb = *(const LAS bf16x8*)(spb + 64 * (jj >> 2));
#pragma unroll
            for (int ii = 0; ii < 16; ++ii) if (ii >= jj) { const bf16x8 af = *(const LAS bf16x8*)(klow + (62 - 2 * (ii - jj)) * 512); acc[ii] = MFMA16(af, bq[jj & 3], acc[ii]); }
#pragma unroll
            for (int q = 0; q < 4; ++q) acc[4 * (jj & 3) + q] = MFMA16(ca[jj & 1][q], cb, acc[4 * (jj & 3) + q]);
            __builtin_amdgcn_sched_barrier(0);
            if (jj + 2 < 16) S5_LDC(jj + 2, jj & 1);
            __builtin_amdgcn_sched_barrier(0);
        }
#undef S5_LDC
        bf16_t* Yu = Ya + ((size_t)b * SEQ + (size_t)(16 * ntile) * 64 + wh + 32 * pass) * YW + 16 * g;
#pragma unroll
        for (int ii = 0; ii < 16; ++ii) {
            f32x4 y;
#pragma unroll
            for (int k = 0; k < 4; ++k) y[k] = gelu_tanh(acc[ii][k]);
            u32x4 bp; bp.x = cvt_pk_bf16(y[0], y[1]); bp.y = cvt_pk_bf16(y[2], y[3]); bp.z = 0u; bp.w = 0u;
            const f32x4 z = MFMA16(aglu, __builtin_bit_cast(bf16x8, bp), ((f32x4){0.f, 0.f, 0.f, 0.f}));
            u32x2 o; o.x = cvt_pk_bf16(y[0] * sigmoid_f(z[0]), y[1] * sigmoid_f(z[1])); o.y = cvt_pk_bf16(y[2] * sigmoid_f(z[2]), y[3] * sigmoid_f(z[3]));
            *(u32x2*)((char*)(Yu + (size_t)(2 * ii) * YW) + yoff) = o;
        }
    }
    __syncthreads();
}

constexpr int AT_KS = 0, AT_VT = 9216, AT_BS = 9216 + 8704, AT_BUF = 9216 + 8704 + 256;
__device__ __forceinline__ int crow(int r, int hi) { return (r & 3) + 8 * (r >> 2) + 4 * hi; }
__device__ __forceinline__ void attn_unit(LAS unsigned char* lds, const bf16_t* P, const float* cum, bf16_t* Yc, const int b, const int h, const int qb, int tid, int lane, int w) {
    const int r32 = lane & 31, hi = lane >> 5;
    const size_t row0 = (size_t)b * SEQ;
    const int q0 = qb * 256, qrow = q0 + 32 * w + r32;
    bf16x8 qf[4];
    { const bf16_t* qp = P + (row0 + qrow) * NA + COL_Q + 64 * h + 8 * hi;
#pragma unroll
      for (int s = 0; s < 4; ++s) qf[s] = *(const bf16x8*)(qp + 16 * s); }
    const float* cumbh = cum + (size_t)(b * 8 + h) * SEQ;
    const float ref = cumbh[q0];
    const int skey = tid >> 3, spc = tid & 7;
    const bf16_t* kgp = P + (row0 + skey) * NA + COL_K + 64 * h + 8 * spc;
    const int NT = 4 * qb + 4;
    u32x4 kreg = *(const u32x4*)kgp, vreg = *(const u32x4*)(kgp + (COL_V - COL_K)); float breg = 0.f; if (tid < 64) breg = ref - cumbh[tid];
#define AT_WRITE(bufp) do { LAS unsigned char* _b = (bufp); *(LAS u32x4*)(_b + AT_KS + skey * 144 + 16 * spc) = kreg; \
        LAS bf16_t* _v = (LAS bf16_t*)(_b + AT_VT) + (8 * spc) * 68 + skey; \
        _v[0 * 68] = (bf16_t)(vreg.x & 0xffffu); _v[1 * 68] = (bf16_t)(vreg.x >> 16); _v[2 * 68] = (bf16_t)(vreg.y & 0xffffu); _v[3 * 68] = (bf16_t)(vreg.y >> 16); \
        _v[4 * 68] = (bf16_t)(vreg.z & 0xffffu); _v[5 * 68] = (bf16_t)(vreg.z >> 16); _v[6 * 68] = (bf16_t)(vreg.w & 0xffffu); _v[7 * 68] = (bf16_t)(vreg.w >> 16); \
        if (tid < 64) *(LAS float*)(_b + AT_BS + 4 * tid) = breg; } while (0)
    AT_WRITE(lds);
    __syncthreads();
    float mrun = -1e30f, lrun = 0.f; f32x16 o0, o1;
#pragma unroll
    for (int r = 0; r < 16; ++r) { o0[r] = 0.f; o1[r] = 0.f; }
    for (int kt = 0; kt < NT; ++kt) {
        const int cur = kt & 1; const bool more = (kt + 1 < NT);
        if (more) { const bf16_t* kp = kgp + (size_t)(kt + 1) * 64 * NA; kreg = *(const u32x4*)kp; vreg = *(const u32x4*)(kp + (COL_V - COL_K)); if (tid < 64) breg = ref - cumbh[64 * (kt + 1) + tid]; }
        if (64 * kt <= q0 + 32 * w + 31) {
            const LAS unsigned char* Kb = lds + cur * AT_BUF + AT_KS; const LAS unsigned char* Vb = lds + cur * AT_BUF + AT_VT; const LAS unsigned char* Bb = lds + cur * AT_BUF + AT_BS;
            f32x16 p[2];
#pragma unroll
            for (int rb = 0; rb < 2; ++rb) {
                f32x16 c;
#pragma unroll
                for (int g4 = 0; g4 < 4; ++g4) { const f32x4 bv = *(const LAS f32x4*)(Bb + (32 * rb + 8 * g4 + 4 * hi) * 4); c[4 * g4 + 0] = bv.x; c[4 * g4 + 1] = bv.y; c[4 * g4 + 2] = bv.z; c[4 * g4 + 3] = bv.w; }
#pragma unroll
                for (int s = 0; s < 4; ++s) { const bf16x8 af = *(const LAS bf16x8*)(Kb + (32 * rb + r32) * 144 + 32 * s + 16 * hi); c = MFMA32(af, qf[s], c); }
                p[rb] = c;
            }
            if (64 * kt + 63 > q0 + 32 * w) {
#pragma unroll
                for (int rb = 0; rb < 2; ++rb)
#pragma unroll
                    for (int r = 0; r < 16; ++r) { const int key = 64 * kt + 32 * rb + crow(r, hi); if (key > qrow) p[rb][r] = -1e30f; }
            }
            float mt = p[0][0];
#pragma unroll
            for (int r = 1; r < 16; ++r) mt = fmaxf(mt, p[0][r]);
#pragma unroll
            for (int r = 0; r < 16; ++r) mt = fmaxf(mt, p[1][r]);
            mt = half_max(mt);
            const float mnew = fmaxf(mrun, mt), alpha = fast_exp2(mrun - mnew);
            mrun = mnew;
            float ls = 0.f;
#pragma unroll
            for (int rb = 0; rb < 2; ++rb)
#pragma unroll
                for (int r = 0; r < 16; ++r) { p[rb][r] = fast_exp2(p[rb][r] - mnew); ls += p[rb][r]; }
            lrun = lrun * alpha + ls;
#pragma unroll
            for (int r = 0; r < 16; ++r) { o0[r] *= alpha; o1[r] *= alpha; }
            bf16x8 pf[4];
#pragma unroll
            for (int s = 0; s < 4; ++s) { const int rb = s >> 1, r0 = 8 * (s & 1); u32x4 pk; pk.x = cvt_pk_bf16(p[rb][r0 + 0], p[rb][r0 + 1]); pk.y = cvt_pk_bf16(p[rb][r0 + 2], p[rb][r0 + 3]);
                pk.z = cvt_pk_bf16(p[rb][r0 + 4], p[rb][r0 + 5]); pk.w = cvt_pk_bf16(p[rb][r0 + 6], p[rb][r0 + 7]); pf[s] = __builtin_bit_cast(bf16x8, pk); }
#pragma unroll
            for (int s = 0; s < 4; ++s) {
                { const LAS unsigned char* vp = Vb + r32 * 136 + 2 * (16 * s + 4 * hi); const s16x4 lo = *(const LAS s16x4*)vp, hh = *(const LAS s16x4*)(vp + 16);
                  const bf16x8 af = __builtin_shufflevector(lo, hh, 0, 1, 2, 3, 4, 5, 6, 7); o0 = MFMA32(af, pf[s], o0); }
                { const LAS unsigned char* vp = Vb + (32 + r32) * 136 + 2 * (16 * s + 4 * hi); const s16x4 lo = *(const LAS s16x4*)vp, hh = *(const LAS s16x4*)(vp + 16);
                  const bf16x8 af = __builtin_shufflevector(lo, hh, 0, 1, 2, 3, 4, 5, 6, 7); o1 = MFMA32(af, pf[s], o1); }
            }
        }
        if (more) AT_WRITE(lds + (cur ^ 1) * AT_BUF);
        __syncthreads();
    }
#undef AT_WRITE
    const float ltot = half_sum(lrun);
    const float inv = 1.0f / ltot;
    bf16_t* op = Yc + (row0 + qrow) * YW + 64 * h + 4 * hi;
#pragma unroll
    for (int g4 = 0; g4 < 4; ++g4) {
        u32x2 a, c2;
        a.x = cvt_pk_bf16(o0[4 * g4 + 0] * inv, o0[4 * g4 + 1] * inv); a.y = cvt_pk_bf16(o0[4 * g4 + 2] * inv, o0[4 * g4 + 3] * inv);
        c2.x = cvt_pk_bf16(o1[4 * g4 + 0] * inv, o1[4 * g4 + 1] * inv); c2.y = cvt_pk_bf16(o1[4 * g4 + 2] * inv, o1[4 * g4 + 3] * inv);
        *(u32x2*)(op + 8 * g4) = a; *(u32x2*)(op + 32 + 8 * g4) = c2;
    }
}

__device__ __forceinline__ void conv_phase(const bf16_t* P, const float* cw, bf16_t* Yb, int gtid, int ngt) {
    for (int item = gtid; item < M * 64; item += ngt) {
        const int token = item >> 6, c0 = (item & 63) * 8, t = token & (SEQ - 1);
        float acc[8];
#pragma unroll
        for (int i = 0; i < 8; ++i) acc[i] = 0.f;
#pragma unroll
        for (int tap = 0; tap < 3; ++tap) {
            if (t - 2 + tap >= 0) {
                const bf16_t* rp = P + (size_t)(token - 2 + tap) * NA + c0;
                const u32x4 xc = *(const u32x4*)(rp + COL_XC), cc = *(const u32x4*)(rp + COL_CC);
                const f32x4 w0 = *(const f32x4*)(cw + tap * 512 + c0), w1 = *(const f32x4*)(cw + tap * 512 + c0 + 4);
                acc[0] += w0.x * bf_lo(xc.x) * bf_lo(cc.x); acc[1] += w0.y * bf_hi(xc.x) * bf_hi(cc.x); acc[2] += w0.z * bf_lo(xc.y) * bf_lo(cc.y); acc[3] += w0.w * bf_hi(xc.y) * bf_hi(cc.y);
                acc[4] += w1.x * bf_lo(xc.z) * bf_lo(cc.z); acc[5] += w1.y * bf_hi(xc.z) * bf_hi(cc.z); acc[6] += w1.z * bf_lo(xc.w) * bf_lo(cc.w); acc[7] += w1.w * bf_hi(xc.w) * bf_hi(cc.w);
            }
        }
        const u32x4 bc = *(const u32x4*)(P + (size_t)token * NA + COL_BC + c0);
        u32x4 o; o.x = cvt_pk_bf16(acc[0] * bf_lo(bc.x), acc[1] * bf_hi(bc.x)); o.y = cvt_pk_bf16(acc[2] * bf_lo(bc.y), acc[3] * bf_hi(bc.y));
        o.z = cvt_pk_bf16(acc[4] * bf_lo(bc.z), acc[5] * bf_hi(bc.z)); o.w = cvt_pk_bf16(acc[6] * bf_lo(bc.w), acc[7] * bf_hi(bc.w));
        *(u32x4*)(Yb + (size_t)token * YW + c0) = o;
    }
}

__device__ __forceinline__ void grid_barrier(cg::grid_group& grid) {
    asm volatile("s_waitcnt vmcnt(0) lgkmcnt(0)" ::: "memory");
    __syncthreads();
    grid.sync();
    if (threadIdx.x == 0) { __builtin_amdgcn_fence(__ATOMIC_ACQUIRE, "agent"); asm volatile("s_waitcnt vmcnt(0)" ::: "memory"); }
    __syncthreads();
}

#ifndef DIAG_STAGE
#define DIAG_STAGE 0
#endif
__device__ __forceinline__ void diag_dump(float* out, const bf16_t* src, int ld, int ncols) {
    for (size_t i = (size_t)blockIdx.x * 512 + threadIdx.x; i < (size_t)M * DM; i += (size_t)gridDim.x * 512) {
        const size_t row = i >> 10; const int c = (int)(i & 1023); float v = 0.f;
        for (int cc = c; cc < ncols; cc += 1024) v += bf_lo((unsigned)src[row * ld + cc]);
        out[i] = v;
    }
}
#define DIAG(k, src, ld, ncols) do { if (DIAG_STAGE == (k)) { grid_barrier(grid); diag_dump(a.out, (src), (ld), (ncols)); return; } } while (0)

__global__ void __launch_bounds__(512, 2) fwd_kernel(Args a) {
    extern __shared__ __attribute__((aligned(16))) unsigned char lds_raw[];
    LAS unsigned char* lds = (LAS unsigned char*)lds_raw;
    cg::grid_group grid = cg::this_grid();
    const int G = gridDim.x, bid = blockIdx.x, ngw = G * 8;
#define FRESH() const int tid = launder_i(threadIdx.x), lane = tid & 63, w = __builtin_amdgcn_readfirstlane(tid >> 6), gw = bid * 8 + w; (void)lane; (void)gw
    unsigned char* ws = a.ws;
    bf16_t* XN = (bf16_t*)(ws + WS_XN); bf16_t* PR = (bf16_t*)(ws + WS_P); bf16_t* Y = (bf16_t*)(ws + WS_Y);
    float* LOGF = (float*)(ws + WS_LOGF); float* CUM = (float*)(ws + WS_CUM);

    {
        FRESH();
#ifndef NO_TAB
        if (bid < 64) s5_tables(lds, a, bid >> 5, bid & 31, tid);
#endif
        LAS float* scr = (LAS float*)(lds + w * 16384);
        constexpr int I_A = 16 * 112, I_G = 16 * 96, I_B = 8 * 32, I_O = 16 * 32, I_1 = 16 * 128, I_2 = 64 * 32, I_L = I_A + I_G + 3 * I_B + I_O + I_1 + I_2;
        for (int it = gw; it < 2 * I_L; it += ngw) {
            const int l = it / I_L; int r = it - l * I_L;
            unsigned char* wl = ws + WS_W + (size_t)l * W_LAYER;
            const float* win = a.in[2] + (size_t)l * DM * INW;
            if (r < I_A) { transpose_item(win, INW, 0, DM, NA, (bf16_t*)(wl + W_INA), scr, r, lane); continue; } r -= I_A;
            if (r < I_G) { transpose_item(win, INW, COL_G, DM, NG, (bf16_t*)(wl + W_G), scr, r, lane); continue; } r -= I_G;
            if (r < 3 * I_B) { const int br = r / I_B; transpose_item(a.in[15] + (size_t)l * 1536 * DM + (size_t)br * 512 * DM, DM, 0, 512, DM, (bf16_t*)(wl + W_BR) + (size_t)br * DM * 512, scr, r - br * I_B, lane); continue; } r -= 3 * I_B;
            if (r < I_O) { transpose_item(a.in[16] + (size_t)l * DM * DM, DM, 0, DM, DM, (bf16_t*)(wl + W_OUT), scr, r, lane); continue; } r -= I_O;
            if (r < I_1) { transpose_item(a.in[19] + (size_t)l * DM * FF, FF, 0, DM, FF, (bf16_t*)(wl + W_1), scr, r, lane); continue; } r -= I_1;
            transpose_item(a.in[20] + (size_t)l * FF * DM, DM, 0, FF, DM, (bf16_t*)(wl + W_2), scr, r, lane);
        }
        __syncthreads();
        NormArgs n{a.in[0], nullptr, nullptr, nullptr, a.in[1], XN, a.in[2] + COL_F, a.in[14], LOGF};
        norm_phase(lds, n, gw, ngw, lane, tid);
    }
    grid_barrier(grid);

    DIAG(1, XN, DM, DM);
#pragma unroll 1
    for (int l = 0; l < DEPTH; ++l) {
        unsigned char* wl = ws + WS_W + (size_t)l * W_LAYER;
        const unsigned char* s5tab = ws + WS_S5 + (size_t)l * S5_LAYER;
        const float* xin = (l == 0) ? a.in[0] : a.out;

        { FRESH(); for (int bh = bid; bh < 64; bh += G) cum_scan(lds, LOGF, CUM, bh, tid, lane, w); }
        {
            pg8::Gemm g{XN, (const bf16_t*)(wl + W_INA), M, NA, DM, 0, 0}; pg8::StaticOrder S; S.init(M, NA, G, bid, 1);
            pg8::Epi<pg8::EPI_PROJ> E{PR, NA, nullptr, nullptr};
#if (PHMASK >> 0) & 1
            pg8::gemm_phase<pg8::Epi<pg8::EPI_PROJ>, pg8::StaticOrder, true, true>(lds, g, S, E);
#endif
        }
        grid_barrier(grid);

        DIAG(2, PR, NA, NA);
#ifndef NO_S5
        { FRESH(); for (int v = bid; v < 256; v += G) s5_unit(lds, PR, s5tab, Y, v >> 5, v & 31, tid, lane, w); }
#endif
#ifndef NO_ATTN
        for (int v = bid; v < 256; v += G) {
            FRESH(); const int bh = v >> 2, s = v & 3;
#pragma unroll 1
            for (int k = 0; k < 4; ++k) { const int qb = (k == 0) ? 15 - s : (k == 1) ? s : (k == 2) ? 11 - s : s + 4;
                attn_unit(lds, PR, CUM, Y + 2 * (size_t)M * YW, bh >> 3, bh & 7, qb, tid, lane, w); }
        }
#endif
        { FRESH(); conv_phase(PR, a.in[13] + (size_t)l * 3 * 512, Y + (size_t)M * YW, bid * 512 + tid, G * 512); }
        grid_barrier(grid);

        if (DIAG_STAGE == 3) { grid_barrier(grid); for (size_t i = (size_t)blockIdx.x * 512 + threadIdx.x; i < (size_t)M * DM; i += (size_t)gridDim.x * 512) { const size_t row = i >> 10; const int c = (int)(i & 511); a.out[i] = bf_lo((unsigned)Y[row * YW + c]) + bf_lo((unsigned)Y[(size_t)M * YW + row * YW + c]) + bf_lo((unsigned)Y[2 * (size_t)M * YW + row * YW + c]); } return; }
        DIAG(31, Y + (size_t)M * YW, YW, YW); DIAG(32, Y + 2 * (size_t)M * YW, YW, YW);
        {
            pg8::Gemm g{XN, (const bf16_t*)(wl + W_G), M, NG, DM, 0, 0}; pg8::StaticOrder S; S.init(M, NG, G, bid, 1);
            pg8::Epi<pg8::EPI_GATE> E{PR, NG, a.in[3] + (size_t)l * NG, nullptr};
#if (PHMASK >> 1) & 1
            pg8::gemm_phase<pg8::Epi<pg8::EPI_GATE>, pg8::StaticOrder, true, true>(lds, g, S, E);
#endif
        }
        grid_barrier(grid);

        DIAG(4, PR, NG, NG);
        {
            pg8::Gemm g{Y, (const bf16_t*)(wl + W_BR), M, DM, 512, (size_t)M * YW * 2, (size_t)DM * 512 * 2}; pg8::StaticOrder S; S.init(M, DM, G, bid, 3);
            pg8::Epi<pg8::EPI_BRANCH> E{XN, DM, nullptr, PR};
#if (PHMASK >> 2) & 1
            pg8::gemm_phase<pg8::Epi<pg8::EPI_BRANCH>, pg8::StaticOrder, true, true>(lds, g, S, E);
#endif
        }
        grid_barrier(grid);

        DIAG(5, XN, DM, DM);
        {
            pg8::Gemm g{XN, (const bf16_t*)(wl + W_OUT), M, DM, DM, 0, 0}; pg8::StaticOrder S; S.init(M, DM, G, bid, 1);
            pg8::Epi<pg8::EPI_PLAIN> E{PR, DM, nullptr, nullptr};
#if (PHMASK >> 3) & 1
            pg8::gemm_phase<pg8::Epi<pg8::EPI_PLAIN>, pg8::StaticOrder, true, true>(lds, g, S, E);
#endif
        }
        grid_barrier(grid);

        DIAG(6, PR, DM, DM);
        {
            FRESH(); NormArgs n{xin, PR, a.in[17] + (size_t)l * DM, a.out, a.in[18] + (size_t)l * DM, XN, nullptr, nullptr, nullptr};
            norm_phase(lds, n, gw, ngw, lane, tid);
        }
        grid_barrier(grid);

        DIAG(7, XN, DM, DM);
        {
            pg8::Gemm g{XN, (const bf16_t*)(wl + W_1), M, FF, DM, 0, 0}; pg8::StaticOrder S; S.init(M, FF, G, bid, 1);
            pg8::Epi<pg8::EPI_RELU2> E{PR, FF, nullptr, nullptr};
#if (PHMASK >> 4) & 1
            pg8::gemm_phase<pg8::Epi<pg8::EPI_RELU2>, pg8::StaticOrder, true, true>(lds, g, S, E);
#endif
        }
        grid_barrier(grid);

        DIAG(8, PR, FF, FF);
        {
            pg8::Gemm g{PR, (const bf16_t*)(wl + W_2), M, DM, FF, 0, 0}; pg8::StaticOrder S; S.init(M, DM, G, bid, 1);
            pg8::Epi<pg8::EPI_PLAIN> E{XN, DM, nullptr, nullptr};
#if (PHMASK >> 5) & 1
            pg8::gemm_phase<pg8::Epi<pg8::EPI_PLAIN>, pg8::StaticOrder, true, true>(lds, g, S, E);
#endif
        }
        grid_barrier(grid);

        DIAG(9, XN, DM, DM);
        if (l + 1 < DEPTH) {
            FRESH(); NormArgs n{a.out, XN, a.in[21] + (size_t)l * DM, a.out, a.in[1] + (size_t)(l + 1) * DM, XN, a.in[2] + (size_t)(l + 1) * DM * INW + COL_F, a.in[14] + (l + 1) * 8, LOGF};
            norm_phase(lds, n, gw, ngw, lane, tid);
            grid_barrier(grid);
        } else {
            FRESH(); NormArgs n{a.out, XN, a.in[21] + (size_t)l * DM, a.out, nullptr, nullptr, nullptr, nullptr, nullptr};
            norm_phase(lds, n, gw, ngw, lane, tid);
        }
    }
}

extern "C" void kernel_launch(void* const* d_in, const int* in_sizes, int n_in, void* d_out, int out_size, void* d_ws, size_t ws_size, hipStream_t stream) {
    static int grid = 0;
    if (grid == 0) {
        if (n_in != 22 || in_sizes[0] != M * DM || out_size != M * DM || ws_size < WS_END) { fprintf(stderr, "kernel_launch: unexpected shapes (n_in %d, in0 %d, out %d, ws %zu)\n", n_in, n_in > 0 ? in_sizes[0] : -1, out_size, ws_size); grid = -1; return; }
        int dev = 0, cus = 0, per_cu = 0;
        (void)hipGetDevice(&dev);
        (void)hipDeviceGetAttribute(&cus, hipDeviceAttributeMultiprocessorCount, dev);
        if (hipFuncSetAttribute((const void*)fwd_kernel, hipFuncAttributeMaxDynamicSharedMemorySize, LDS_BYTES) != hipSuccess) fprintf(stderr, "kernel_launch: hipFuncSetAttribute failed\n");
        if (hipOccupancyMaxActiveBlocksPerMultiprocessor(&per_cu, (const void*)fwd_kernel, 512, LDS_BYTES) != hipSuccess || per_cu < 1) { fprintf(stderr, "kernel_launch: occupancy query gave %d\n", per_cu); per_cu = 1; }
        (void)hipGetLastError();
        grid = cus * per_cu; if (grid > 256) grid = 256; if (grid < 1) grid = 256;
    }
    if (grid < 0) return;
    Args a{};
    for (int i = 0; i < 22; ++i) a.in[i] = (const float*)d_in[i];
    a.out = (float*)d_out; a.ws = (unsigned char*)d_ws;
    void* args[] = {&a};
    hipError_t e = hipLaunchCooperativeKernel((const void*)fwd_kernel, dim3(grid), dim3(512), args, LDS_BYTES, stream);
    if (e != hipSuccess) fprintf(stderr, "kernel_launch: cooperative launch failed: %s (grid %d)\n", hipGetErrorString(e), grid);
}
```

```cpp
#include <hip/hip_runtime.h>
#include <hip/hip_cooperative_groups.h>
#include <cstdio>
#include <cstdint>
namespace cg = cooperative_groups;

#define DIAG_STAGE 0
#ifndef PHMASK
#define PHMASK 0xff
#endif

#define LAS __attribute__((address_space(3)))
typedef unsigned short bf16_t;
typedef short bf16x8 __attribute__((ext_vector_type(8)));
typedef short s16x4 __attribute__((ext_vector_type(4)));
typedef float f32x2 __attribute__((ext_vector_type(2)));
typedef float f32x4 __attribute__((ext_vector_type(4)));
typedef float f32x16 __attribute__((ext_vector_type(16)));
typedef unsigned u32x2 __attribute__((ext_vector_type(2)));
typedef unsigned u32x4 __attribute__((ext_vector_type(4)));

constexpr int BATCH = 8, SEQ = 4096, DM = 1024, M = BATCH * SEQ, DEPTH = 2;
constexpr int INW = 6664, NA = 3584, NG = 3072, FF = 4096, YW = 512;
constexpr int COL_XC = 512, COL_BC = 1024, COL_CC = 1536, COL_Q = 2048, COL_K = 2560, COL_V = 3072, COL_F = 3584, COL_G = 3592;
constexpr float EPS = 1e-6f;
constexpr float LOG2E = 1.4426950408889634f;
constexpr float C2 = 0.125f * LOG2E;

constexpr size_t MiB = 1u << 20;
constexpr size_t WS_W = 1 * MiB, W_LAYER = 34 * MiB;
constexpr size_t W_INA = 0, W_G = 7 * MiB, W_BR = 13 * MiB, W_OUT = 16 * MiB, W_1 = 18 * MiB, W_2 = 26 * MiB;
constexpr size_t WS_S5 = 69 * MiB, S5_LAYER = 17 * MiB + 512 * 1024;
constexpr size_t S5_KT = 0, S5_WE = MiB + 256 * 1024, S5_WC = S5_WE + 8 * MiB, S5_A64 = S5_WC + 8 * MiB, S5_GLU = S5_A64 + 64 * 1024;
constexpr size_t WS_LOGF = 104 * MiB, WS_CUM = 105 * MiB, WS_XN = 106 * MiB, WS_P = 170 * MiB, WS_Y = 394 * MiB, WS_END = 490 * MiB;
constexpr int KT_BYTES = 65 * 512;

constexpr int LDS_BYTES = 147456;

typedef __bf16 bf16x2_t __attribute__((ext_vector_type(2)));
__device__ __forceinline__ unsigned cvt_pk_bf16(float lo, float hi) { const f32x2 v = {lo, hi}; const bf16x2_t b = __builtin_convertvector(v, bf16x2_t); return __builtin_bit_cast(unsigned, b); }
__device__ __forceinline__ float bf_lo(unsigned u) { return __uint_as_float(u << 16); }
__device__ __forceinline__ float bf_hi(unsigned u) { return __uint_as_float(u & 0xffff0000u); }
template <int O> __device__ __forceinline__ float swz_xor(float v) { return __int_as_float(__builtin_amdgcn_ds_swizzle(__float_as_int(v), (O << 10) | 0x1f)); }
__device__ __forceinline__ float half_sum(float v) { auto rr = __builtin_amdgcn_permlane32_swap(__float_as_uint(v), __float_as_uint(v), false, false); return __uint_as_float(rr[0]) + __uint_as_float(rr[1]); }
__device__ __forceinline__ float half_max(float v) { auto rr = __builtin_amdgcn_permlane32_swap(__float_as_uint(v), __float_as_uint(v), false, false); return fmaxf(__uint_as_float(rr[0]), __uint_as_float(rr[1])); }
__device__ __forceinline__ float wave_sum(float v) {
    v += swz_xor<1>(v); v += swz_xor<2>(v); v += swz_xor<4>(v); v += swz_xor<8>(v); v += swz_xor<16>(v);
    return half_sum(v);
}
__device__ __forceinline__ int launder_i(int x) { asm volatile("" : "+v"(x)); return x; }
__device__ __forceinline__ float fast_exp2(float x) { return __builtin_amdgcn_exp2f(x); }
__device__ __forceinline__ float fast_rcp(float x) { return __builtin_amdgcn_rcpf(x); }
__device__ __forceinline__ float sigmoid_f(float z) { return fast_rcp(1.0f + fast_exp2(-LOG2E * z)); }
__device__ __forceinline__ float gelu_tanh(float y) { const float t = y + 0.044715f * y * y * y; return y * fast_rcp(1.0f + fast_exp2(-2.302208198f * t)); }

namespace pg8 {
#define PG8_LAS __attribute__((address_space(3)))
constexpr int BM = 256, BK = 64, HALF = 128, HTB = HALF * BK * 2, STAGE_BYTES = 8 * HTB, NXCD = 8, WGM = 8;

__host__ __device__ __forceinline__ int lds_byte(int r, int c) { const int st = (r >> 4) * 2 + (c >> 5), rr = r & 15, cc = c & 31, ob = rr * 64 + cc * 2; return st * 1024 + (ob ^ (((ob >> 9) & 1) << 5)); }
__host__ __device__ __forceinline__ void stage_rc(int b, int& R, int& C) { const int st = b / 1024, sb = b % 1024, swz = sb ^ (((sb >> 9) & 1) << 5); R = (st >> 1) * 16 + swz / 64; C = (st & 1) * 32 + (swz % 64) / 2; }
__host__ __device__ __forceinline__ int perm32(int rho) { const int n = rho >> 4, i = rho & 15; return 8 * (i >> 2) + 4 * n + (i & 3); }

struct Unit { int pm, pn, br; };
struct Gemm { const bf16_t* A; const bf16_t* Bt; int M, N, K; size_t abr, bbr; };

struct StaticOrder {
    int nM, nN, nwg, G, c, nbr;
    __device__ void init(int M_, int N_, int G_, int c_, int nbr_) { nM = M_ / BM; nN = N_ / BM; nwg = nM * nN; G = G_; c = c_; nbr = nbr_; }
    __device__ bool next(int i, Unit& u) const {
        const int it = i / nbr; u.br = i - it * nbr;
        const long L = (long)it * G + c; if (L >= nwg) return false;
        int wgid = (int)L; { const int q = nwg / NXCD, r = nwg % NXCD, xcd = wgid % NXCD, off = wgid / NXCD; wgid = (xcd < r ? xcd * (q + 1) : r * (q + 1) + (xcd - r) * q) + off; }
        const int nig = WGM * nN, gid = wgid / nig, fm = gid * WGM, gsz = (nM - fm) < WGM ? (nM - fm) : WGM;
        u.pm = fm + ((wgid % nig) % gsz); u.pn = (wgid % nig) / gsz; return true;
    }
};

enum { EPI_PROJ = 0, EPI_GATE = 1, EPI_RELU2 = 2, EPI_BRANCH = 3, EPI_PLAIN = 4 };
template <int MODE> struct Epi {
    static constexpr bool PERM = true;
    bf16_t* O; int ldc; const float* bias; const bf16_t* G;
    __device__ __forceinline__ void operator()(const f32x4 (&acc)[2][2][4][2], const Unit& u, int wr, int wc, int fr, int fq) const {
        const int row0 = u.pm * BM + wr * 64 + fr; const int col0 = u.pn * BM + wc * 32 + 8 * fq;
        float sc = 1.f; if (MODE == EPI_PROJ) { if (u.pn >= COL_Q / 256 && u.pn < COL_K / 256) sc = C2; }
        f32x4 bv[2][2];
        if (MODE == EPI_GATE) {
#pragma unroll
            for (int bj = 0; bj < 2; ++bj)
#pragma unroll
                for (int n = 0; n < 2; ++n) bv[bj][n] = *(const f32x4*)(bias + col0 + bj * HALF + 4 * n);
        }
#pragma unroll
        for (int ai = 0; ai < 2; ++ai)
#pragma unroll
            for (int m = 0; m < 4; ++m) {
                const size_t row = (size_t)(row0 + ai * HALF + m * 16);
                bf16_t* rowp = O + row * ldc + col0;
#pragma unroll
                for (int bj = 0; bj < 2; ++bj) {
                    f32x4 v0 = acc[ai][bj][m][0], v1 = acc[ai][bj][m][1];
                    if (MODE == EPI_PROJ) { v0 = v0 * sc; v1 = v1 * sc; }
                    if (MODE == EPI_GATE) {
                        v0 = v0 + bv[bj][0]; v1 = v1 + bv[bj][1];
#pragma unroll
                        for (int i = 0; i < 4; ++i) { v0[i] = sigmoid_f(v0[i]); v1[i] = sigmoid_f(v1[i]); }
                    }
                    if (MODE == EPI_RELU2) {
#pragma unroll
                        for (int i = 0; i < 4; ++i) { const float a = fmaxf(v0[i], 0.f), b = fmaxf(v1[i], 0.f); v0[i] = a * a; v1[i] = b * b; }
                    }
                    if (MODE == EPI_BRANCH) {
                        const u32x4 gt = *(const u32x4*)(G + row * NG + (size_t)u.br * DM + col0 + bj * HALF);
                        v0[0] *= bf_lo(gt.x); v0[1] *= bf_hi(gt.x); v0[2] *= bf_lo(gt.y); v0[3] *= bf_hi(gt.y);
                        v1[0] *= bf_lo(gt.z); v1[1] *= bf_hi(gt.z); v1[2] *= bf_lo(gt.w); v1[3] *= bf_hi(gt.w);
                        if (u.br > 0) {
                            const u32x4 pv = *(const u32x4*)(rowp + bj * HALF);
                            v0[0] += bf_lo(pv.x); v0[1] += bf_hi(pv.x); v0[2] += bf_lo(pv.y); v0[3] += bf_hi(pv.y);
                            v1[0] += bf_lo(pv.z); v1[1] += bf_hi(pv.z); v1[2] += bf_lo(pv.w); v1[3] += bf_hi(pv.w);
                        }
                    }
                    u32x4 w; w.x = cvt_pk_bf16(v0[0], v0[1]); w.y = cvt_pk_bf16(v0[2], v0[3]); w.z = cvt_pk_bf16(v1[0], v1[1]); w.w = cvt_pk_bf16(v1[2], v1[3]);
                    *(u32x4*)(rowp + bj * HALF) = w;
                }
            }
    }
};

template <class EpiT, class Sched, bool ALIGN_EPI, bool SP2>
__device__ __forceinline__ void gemm_phase(PG8_LAS unsigned char* lds, const Gemm g, const Sched& S, const EpiT& E) {
    const int tid = launder_i(threadIdx.x), wid = __builtin_amdgcn_readfirstlane(tid >> 6), lane = tid & 63, wr = wid >> 2, wc = wid & 3, fr = lane & 15, fq = lane >> 4;
    const int K = g.K, nt = K / BK;
    unsigned voffA[2], voffB[2];
#pragma unroll
    for (int i = 0; i < 2; ++i) { int R, C; stage_rc(tid * 16 + i * 8192, R, C); const int Rb = EpiT::PERM ? ((R & ~31) + perm32(R & 31)) : R;
        voffA[i] = (unsigned)(R * K + C) * 2u; voffB[i] = (unsigned)(Rb * K + C) * 2u; }
    const size_t kstep = (size_t)(BK * 2);
    const size_t hstep = (size_t)HALF * K * 2;
    const size_t tstep = 2 * hstep;
    const unsigned ldsw = (unsigned)wid * 1024u;
    const int aoff = lds_byte(wr * 64 + fr, fq * 8), boff = lds_byte(wc * 32 + fr, fq * 8);
#define PG8_SA(b, h) (((b) * 2 + (h)) * HTB)
#define PG8_SB(b, h) ((4 + (b) * 2 + (h)) * HTB)
#define PG8_STAGE(bufoff, gbase, voff) do { _Pragma("unroll") for (int _i = 0; _i < 2; ++_i) \
        __builtin_amdgcn_global_load_lds((const unsigned*)((const char*)(gbase) + (voff)[_i]), (PG8_LAS unsigned*)(lds + (bufoff) + ldsw + _i * 8192), 16, 0, 0); } while (0)
#define PG8_LDA(dst, b, h) do { _Pragma("unroll") for (int m = 0; m < 4; ++m) _Pragma("unroll") for (int k = 0; k < 2; ++k) dst[m][k] = *(const PG8_LAS bf16x8*)(lds + PG8_SA(b, h) + aoff + m * 2048 + k * 1024); } while (0)
#define PG8_LDB(dst, b, h) do { _Pragma("unroll") for (int n = 0; n < 2; ++n) _Pragma("unroll") for (int k = 0; k < 2; ++k) dst[n][k] = *(const PG8_LAS bf16x8*)(lds + PG8_SB(b, h) + boff + n * 2048 + k * 1024); } while (0)
#define PG8_MMA(ai, bj, At, Bt) do { __builtin_amdgcn_s_setprio(1); _Pragma("unroll") for (int m = 0; m < 4; ++m) _Pragma("unroll") for (int n = 0; n < 2; ++n) _Pragma("unroll") for (int k = 0; k < 2; ++k) \
        acc[ai][bj][m][n] = __builtin_amdgcn_mfma_f32_16x16x32_bf16(Bt[n][k], At[m][k], acc[ai][bj][m][n], 0, 0, 0); __builtin_amdgcn_s_setprio(0); } while (0)
#define PG8_WAIT_V(n) asm volatile("s_waitcnt vmcnt(" #n ")" ::: "memory")
#define PG8_WAIT_L(n) asm volatile("s_waitcnt lgkmcnt(" #n ")" ::: "memory")
#define PG8_BAR __builtin_amdgcn_s_barrier()
#define PG8_SCHED __builtin_amdgcn_sched_barrier(0)
    Unit cur, nxt; int ui = 0;
    if (!S.next(0, cur)) return;
    f32x4 acc[2][2][4][2];
#pragma unroll
    for (int a = 0; a < 2; ++a)
#pragma unroll
        for (int b = 0; b < 2; ++b)
#pragma unroll
            for (int m = 0; m < 4; ++m)
#pragma unroll
                for (int n = 0; n < 2; ++n) acc[a][b][m][n] = (f32x4){0.f, 0.f, 0.f, 0.f};
    bf16x8 At[4][2], B0[2][2], B1[2][2];
    const char* cA = (const char*)g.A + (size_t)cur.pm * tstep + (size_t)cur.br * g.abr; const char* cB = (const char*)g.Bt + (size_t)cur.pn * tstep + (size_t)cur.br * g.bbr;
    if constexpr (SP2) {
        PG8_STAGE(PG8_SB(0, 0), cB, voffB); PG8_STAGE(PG8_SB(0, 1), cB + hstep, voffB); PG8_STAGE(PG8_SA(0, 0), cA, voffA); PG8_STAGE(PG8_SA(0, 1), cA + hstep, voffA);
        if (wr == 1) PG8_BAR;
        PG8_WAIT_V(2); PG8_BAR;
        PG8_STAGE(PG8_SB(1, 0), cB + kstep, voffB); PG8_STAGE(PG8_SA(1, 0), cA + kstep, voffA); PG8_STAGE(PG8_SB(1, 1), cB + hstep + kstep, voffB);
        PG8_WAIT_V(6); PG8_BAR;
    } else {
        PG8_STAGE(PG8_SB(0, 0), cB, voffB); PG8_STAGE(PG8_SA(0, 0), cA, voffA); PG8_STAGE(PG8_SB(0, 1), cB + hstep, voffB); PG8_STAGE(PG8_SA(0, 1), cA + hstep, voffA);
        if (wr == 1) PG8_BAR;
        PG8_WAIT_V(4); PG8_BAR;
        PG8_STAGE(PG8_SB(1, 0), cB + kstep, voffB); PG8_STAGE(PG8_SA(1, 0), cA + kstep, voffA); PG8_STAGE(PG8_SB(1, 1), cB + hstep + kstep, voffB);
        PG8_WAIT_V(6); PG8_BAR;
    }
    for (;;) {
        const bool has_next = S.next(ui + 1, nxt);
        const char* nA = has_next ? (const char*)g.A + (size_t)nxt.pm * tstep + (size_t)nxt.br * g.abr : cA;
        const char* nB = has_next ? (const char*)g.Bt + (size_t)nxt.pn * tstep + (size_t)nxt.br * g.bbr : cB;
        for (int t = 0; t < nt; t += 2) {
            const bool last = (t == nt - 2);
            const char* a1 = cA + (size_t)(t + 1) * kstep;
            const char* a2 = last ? nA : cA + (size_t)(t + 2) * kstep; const char* b2 = last ? nB : cB + (size_t)(t + 2) * kstep;
            const char* a3 = a2 + kstep; const char* b3 = b2 + kstep;
            if constexpr (SP2) {
            PG8_LDB(B0, 0, 0); PG8_LDB(B1, 0, 1); PG8_SCHED; PG8_LDA(At, 0, 0); PG8_STAGE(PG8_SA(1, 1), a1 + hstep, voffA);
            PG8_WAIT_V(8); PG8_WAIT_L(0); PG8_BAR; PG8_MMA(0, 0, At, B0); PG8_MMA(0, 1, At, B1); PG8_BAR; PG8_SCHED;
            PG8_LDA(At, 0, 1); PG8_STAGE(PG8_SB(0, 0), b2, voffB); PG8_STAGE(PG8_SB(0, 1), b2 + hstep, voffB); PG8_STAGE(PG8_SA(0, 0), a2, voffA);
            PG8_WAIT_V(8); PG8_WAIT_L(0); PG8_BAR; PG8_MMA(1, 0, At, B0); PG8_MMA(1, 1, At, B1); PG8_BAR; PG8_SCHED;
            PG8_LDB(B0, 1, 0); PG8_LDB(B1, 1, 1); PG8_SCHED; PG8_LDA(At, 1, 0); PG8_STAGE(PG8_SA(0, 1), a2 + hstep, voffA);
            PG8_WAIT_V(8); PG8_WAIT_L(0); PG8_BAR; PG8_MMA(0, 0, At, B0); PG8_MMA(0, 1, At, B1); PG8_BAR; PG8_SCHED;
            PG8_LDA(At, 1, 1); PG8_STAGE(PG8_SB(1, 0), b3, voffB); PG8_STAGE(PG8_SB(1, 1), b3 + hstep, voffB); PG8_STAGE(PG8_SA(1, 0), a3, voffA);
            PG8_WAIT_V(8); PG8_WAIT_L(0); PG8_BAR; PG8_MMA(1, 0, At, B0); PG8_MMA(1, 1, At, B1); PG8_BAR; PG8_SCHED;
            } else {
            PG8_LDB(B0, 0, 0); PG8_SCHED; PG8_LDA(At, 0, 0); PG8_STAGE(PG8_SA(1, 1), a1 + hstep, voffA);
            PG8_WAIT_L(8); PG8_BAR; PG8_WAIT_L(0); PG8_MMA(0, 0, At, B0); PG8_BAR; PG8_SCHED;
            PG8_LDB(B1, 0, 1); PG8_STAGE(PG8_SB(0, 0), b2, voffB);
            PG8_BAR; PG8_WAIT_L(0); PG8_MMA(0, 1, At, B1); PG8_BAR;
            PG8_LDA(At, 0, 1); PG8_STAGE(PG8_SA(0, 0), a2, voffA);
            PG8_BAR; PG8_WAIT_L(0); PG8_MMA(1, 0, At, B0); PG8_BAR; PG8_SCHED;
            PG8_STAGE(PG8_SB(0, 1), b2 + hstep, voffB);
            PG8_WAIT_V(6); PG8_BAR; PG8_MMA(1, 1, At, B1); PG8_BAR;
            PG8_LDB(B0, 1, 0); PG8_SCHED; PG8_LDA(At, 1, 0); PG8_STAGE(PG8_SA(0, 1), a2 + hstep, voffA);
            PG8_WAIT_L(8); PG8_BAR; PG8_WAIT_L(0); PG8_MMA(0, 0, At, B0); PG8_BAR; PG8_SCHED;
            PG8_LDB(B1, 1, 1); PG8_STAGE(PG8_SB(1, 0), b3, voffB);
            PG8_BAR; PG8_WAIT_L(0); PG8_MMA(0, 1, At, B1); PG8_BAR;
            PG8_LDA(At, 1, 1); PG8_STAGE(PG8_SA(1, 0), a3, voffA);
            PG8_BAR; PG8_WAIT_L(0); PG8_MMA(1, 0, At, B0); PG8_BAR; PG8_SCHED;
            PG8_STAGE(PG8_SB(1, 1), b3 + hstep, voffB);
            PG8_WAIT_V(6); PG8_BAR; PG8_MMA(1, 1, At, B1); PG8_BAR;
            }
        }
        if constexpr (ALIGN_EPI) { if (wr == 0) PG8_BAR; }
        E(acc, cur, wr, wc, fr, fq);
        if (!has_next) break;
#pragma unroll
        for (int a = 0; a < 2; ++a)
#pragma unroll
            for (int b = 0; b < 2; ++b)
#pragma unroll
                for (int m = 0; m < 4; ++m)
#pragma unroll
                    for (int n = 0; n < 2; ++n) acc[a][b][m][n] = (f32x4){0.f, 0.f, 0.f, 0.f};
        cur = nxt; cA = nA; cB = nB; ++ui;
        if constexpr (ALIGN_EPI) { if (wr == 1) PG8_BAR; }
    }
    PG8_WAIT_V(0);
    if constexpr (!ALIGN_EPI) { if (wr == 0) PG8_BAR; }
    PG8_BAR;
#undef PG8_SA
#undef PG8_SB
#undef PG8_STAGE
#undef PG8_LDA
#undef PG8_LDB
#undef PG8_MMA
#undef PG8_WAIT_V
#undef PG8_WAIT_L
#undef PG8_BAR
#undef PG8_SCHED
}
}

struct Args { const float* in[22]; float* out; unsigned char* ws; };

__device__ __forceinline__ void transpose_item(const float* W, int ldw, int col_off, int K, int N, bf16_t* WT, LAS float* scr, int item, int lane) {
    const int nblk = N / 64, kb = item / nblk, nb = item % nblk, k0 = 64 * kb, n0 = 64 * nb;
    const int r = lane >> 4, c4 = lane & 15;
    f32x4 v[16];
#pragma unroll
    for (int i = 0; i < 16; ++i) v[i] = *(const f32x4*)(W + (size_t)(k0 + 4 * i + r) * ldw + col_off + n0 + 4 * c4);
#pragma unroll
    for (int i = 0; i < 16; ++i) { LAS float* d = scr + (4 * i + r) * 65 + 4 * c4; d[0] = v[i].x; d[1] = v[i].y; d[2] = v[i].z; d[3] = v[i].w; }
    asm volatile("s_waitcnt lgkmcnt(0)" ::: "memory");
    const int c = lane & 7;
#pragma unroll
    for (int j = 0; j < 8; ++j) { const int n = (lane >> 3) + 8 * j; const LAS float* s = scr + (8 * c) * 65 + n;
        u32x4 o; o.x = cvt_pk_bf16(s[0 * 65], s[1 * 65]); o.y = cvt_pk_bf16(s[2 * 65], s[3 * 65]); o.z = cvt_pk_bf16(s[4 * 65], s[5 * 65]); o.w = cvt_pk_bf16(s[6 * 65], s[7 * 65]);
        *(u32x4*)(WT + (size_t)(n0 + n) * K + k0 + 8 * c) = o; }
    asm volatile("s_waitcnt lgkmcnt(0)" ::: "memory");
}

__device__ __forceinline__ void s5_tables(LAS unsigned char* lds, const Args& a, int l, int g, int qt, int tid) {
    LAS f32x2* AP = (LAS f32x2*)lds;
    LAS f32x2* BB = AP + 65 * 64;
    LAS f32x2* CC = BB + 64 * 16;
    const int lg = l * 32 + g;
    const float* are = a.in[4] + lg * 64; const float* aim = a.in[5] + lg * 64;
    const float dt = expf(a.in[6][lg]);
    unsigned char* tab = a.ws + WS_S5 + (size_t)l * S5_LAYER;
    for (int idx = tid; idx < 65 * 64; idx += 512) {
        const int d = idx >> 6, p = idx & 63;
        const float lr = fminf(are[p], -1e-4f), li = aim[p];
        const float mag = expf(lr * dt * (float)d);
        double rev = (double)li * (double)dt * (double)d * 0.15915494309189535;
        rev -= floor(rev); if (rev > 0.5) rev -= 1.0;
        const float th = (float)(rev * 6.283185307179586);
        AP[idx] = (f32x2){mag * cosf(th), mag * sinf(th)};
    }
    for (int idx = tid; idx < 1024; idx += 512) CC[idx] = (f32x2){a.in[9][(size_t)lg * 1024 + idx], a.in[10][(size_t)lg * 1024 + idx]};
    for (int idx = tid; idx < 1024; idx += 512) {
        const int p = idx >> 4;
        const float lr = fminf(are[p], -1e-4f), li = aim[p];
        double rev = (double)li * (double)dt * 0.15915494309189535;
        rev -= floor(rev); if (rev > 0.5) rev -= 1.0;
        const float th = (float)(rev * 6.283185307179586);
        const float em1 = expm1f(lr * dt), c = cosf(th), s = sinf(th), sh = sinf(0.5f * th);
        const float nr = em1 * c - 2.f * sh * sh, ni = (1.f + em1) * s;
        const float den = 1.f / (lr * lr + li * li);
        const float qr = (nr * lr + ni * li) * den, qi = (ni * lr - nr * li) * den;
        const float br = a.in[7][(size_t)lg * 1024 + idx], bi = a.in[8][(size_t)lg * 1024 + idx];
        BB[idx] = (f32x2){qr * br - qi * bi, qr * bi + qi * br};
    }
    __syncthreads();
    bf16_t* kt = (bf16_t*)(tab + S5_KT) + (size_t)g * (65 * 256);
    if (tid < 256) { const int s = qt * 256 + tid;
        const int d = s >> 4, h = s & 15;
        float acc[16];
#pragma unroll
        for (int i = 0; i < 16; ++i) acc[i] = 0.f;
        for (int p = 0; p < 64; ++p) {
            const f32x2 cc = CC[h * 64 + p], ap = AP[d * 64 + p];
            const float cr = cc.x * ap.x - cc.y * ap.y, ci = cc.x * ap.y + cc.y * ap.x;
#pragma unroll
            for (int i = 0; i < 16; ++i) { const f32x2 bb = BB[p * 16 + i]; acc[i] += cr * bb.x - ci * bb.y; }
        }
        if (d == 0) { const float dsk = a.in[11][lg * 16 + h];
#pragma unroll
            for (int i = 0; i < 16; ++i) if (i == h) acc[i] += dsk; }
        u32x4 o0, o1;
        o0.x = cvt_pk_bf16(acc[0], acc[1]); o0.y = cvt_pk_bf16(acc[2], acc[3]); o0.z = cvt_pk_bf16(acc[4], acc[5]); o0.w = cvt_pk_bf16(acc[6], acc[7]);
        o1.x = cvt_pk_bf16(acc[8], acc[9]); o1.y = cvt_pk_bf16(acc[10], acc[11]); o1.z = cvt_pk_bf16(acc[12], acc[13]); o1.w = cvt_pk_bf16(acc[14], acc[15]);
        u32x4* dst = (u32x4*)(kt + (size_t)(63 - d) * 256 + h * 16);
        dst[0] = o0; dst[1] = o1;
    }
    if (qt == 0 && tid >= 256 && tid < 288) ((u32x4*)(kt + 64 * 256))[tid - 256] = (u32x4){0u, 0u, 0u, 0u};
    bf16_t* we = (bf16_t*)(tab + S5_WE) + (size_t)g * 128 * 1024;
    for (int idx = qt * 4096 + tid; idx < (qt + 1) * 4096; idx += 512) {
        const int half = idx & 1, j = (idx >> 1) & 63, row = idx >> 7, p = row & 63, im = row >> 6;
        const f32x2 ap = AP[(63 - j) * 64 + p];
        float v[8];
#pragma unroll
        for (int i = 0; i < 8; ++i) { const f32x2 bb = BB[p * 16 + 8 * half + i]; v[i] = im ? (ap.x * bb.y + ap.y * bb.x) : (ap.x * bb.x - ap.y * bb.y); }
        u32x4 o; o.x = cvt_pk_bf16(v[0], v[1]); o.y = cvt_pk_bf16(v[2], v[3]); o.z = cvt_pk_bf16(v[4], v[5]); o.w = cvt_pk_bf16(v[6], v[7]);
        *(u32x4*)(we + (size_t)row * 1024 + j * 16 + 8 * half) = o;
    }
    bf16_t* wc = (bf16_t*)(tab + S5_WC) + (size_t)g * 1024 * 128;
    for (int idx = qt * 4096 + tid; idx < (qt + 1) * 4096; idx += 512) {
        const int kgp = idx & 15, rowi = idx >> 4, t = rowi >> 4, h = rowi & 15, im = kgp >> 3, p0 = (kgp & 7) * 8;
        float v[8];
#pragma unroll
        for (int i = 0; i < 8; ++i) { const f32x2 cc = CC[h * 64 + p0 + i], ap = AP[(t + 1) * 64 + p0 + i];
            v[i] = im ? -(cc.x * ap.y + cc.y * ap.x) : (cc.x * ap.x - cc.y * ap.y); }
        u32x4 o; o.x = cvt_pk_bf16(v[0], v[1]); o.y = cvt_pk_bf16(v[2], v[3]); o.z = cvt_pk_bf16(v[4], v[5]); o.w = cvt_pk_bf16(v[6], v[7]);
        *(u32x4*)(wc + (size_t)rowi * 128 + kgp * 8) = o;
    }
    if (qt == 1 && tid < 64) {
        ((f32x2*)(tab + S5_A64))[g * 64 + tid] = AP[64 * 64 + tid];
        const int k = tid & 15, kg = tid >> 4; const float* wg = a.in[12] + (size_t)lg * 256;
        u32x4 o; o.x = cvt_pk_bf16(wg[(4 * kg + 0) * 16 + k], wg[(4 * kg + 1) * 16 + k]); o.y = cvt_pk_bf16(wg[(4 * kg + 2) * 16 + k], wg[(4 * kg + 3) * 16 + k]); o.z = 0u; o.w = 0u;
        ((u32x4*)(tab + S5_GLU))[g * 64 + tid] = o;
    }
    __syncthreads();
}

struct NormArgs { const float* resid; const bf16_t* add; const float* g_add; float* xout; const float* g_xn; bf16_t* xn; const float* wf; const float* bfh; float* logf; };
__device__ __forceinline__ void norm_phase(LAS unsigned char* lds, const NormArgs n, int gw, int ngw, int lane, int tid) {
    if (n.wf) {
        for (int i = tid; i < 2048; i += 512) { const int d = i >> 1, hh = i & 1; const f32x4 v = *(const f32x4*)(n.wf + (size_t)d * INW + 4 * hh);
            *(LAS f32x4*)(lds + d * 32 + 16 * (d >> 3) + 16 * hh) = v; }
        __syncthreads();
    }
    f32x4 ga[4], gx[4];
#pragma unroll
    for (int j = 0; j < 4; ++j) { ga[j] = n.add ? *(const f32x4*)(n.g_add + 4 * lane + 256 * j) : (f32x4){0.f, 0.f, 0.f, 0.f}; gx[j] = n.xn ? *(const f32x4*)(n.g_xn + 4 * lane + 256 * j) : (f32x4){0.f, 0.f, 0.f, 0.f}; }
    for (int row = gw; row < M; row += ngw) {
        f32x4 v[4];
#pragma unroll
        for (int j = 0; j < 4; ++j) v[j] = *(const f32x4*)(n.resid + (size_t)row * DM + 4 * lane + 256 * j);
        if (n.add) {
            f32x4 av[4]; float ss = 0.f;
#pragma unroll
            for (int j = 0; j < 4; ++j) { const u32x2 u = *(const u32x2*)(n.add + (size_t)row * DM + 4 * lane + 256 * j);
                av[j] = (f32x4){bf_lo(u.x), bf_hi(u.x), bf_lo(u.y), bf_hi(u.y)}; ss += (av[j].x * av[j].x + av[j].y * av[j].y) + (av[j].z * av[j].z + av[j].w * av[j].w); }
            const float rs = rsqrtf(wave_sum(ss) * (1.f / DM) + EPS);
#pragma unroll
            for (int j = 0; j < 4; ++j) v[j] = v[j] + av[j] * rs * ga[j];
        }
        if (n.xout) {
#ifdef SANITIZE
#pragma unroll
            for (int j = 0; j < 4; ++j)
#pragma unroll
                for (int i = 0; i < 4; ++i) if (!(fabsf(v[j][i]) < 1e30f)) v[j][i] = 0.f;
#endif
#pragma unroll
            for (int j = 0; j < 4; ++j) *(f32x4*)(n.xout + (size_t)row * DM + 4 * lane + 256 * j) = v[j];
        }
        if (n.xn) {
            float ss = 0.f;
#pragma unroll
            for (int j = 0; j < 4; ++j) ss += (v[j].x * v[j].x + v[j].y * v[j].y) + (v[j].z * v[j].z + v[j].w * v[j].w);
            const float rs = rsqrtf(wave_sum(ss) * (1.f / DM) + EPS);
            f32x4 hn[4];
#pragma unroll
            for (int j = 0; j < 4; ++j) { hn[j] = v[j] * rs * gx[j]; u32x2 o; o.x = cvt_pk_bf16(hn[j].x, hn[j].y); o.y = cvt_pk_bf16(hn[j].z, hn[j].w);
                *(u32x2*)(n.xn + (size_t)row * DM + 4 * lane + 256 * j) = o; }
            if (n.wf) {
                f32x4 f0 = (f32x4){0.f, 0.f, 0.f, 0.f}, f1 = f0;
#pragma unroll
                for (int j = 0; j < 4; ++j)
#pragma unroll
                    for (int i = 0; i < 4; ++i) { const int d = 4 * lane + 256 * j + i; const LAS unsigned char* wp = lds + d * 32 + 16 * (d >> 3);
                        const f32x4 w0 = *(const LAS f32x4*)wp, w1 = *(const LAS f32x4*)(wp + 16); f0 = f0 + w0 * hn[j][i]; f1 = f1 + w1 * hn[j][i]; }
                float z = 0.f;
#pragma unroll
                for (int hh = 0; hh < 4; ++hh) { const float s0 = wave_sum(f0[hh]), s1 = wave_sum(f1[hh]); if (lane == hh) z = s0; if (lane == hh + 4) z = s1; }
                if (lane < 8) { z += n.bfh[lane]; n.logf[(size_t)row * 8 + lane] = fminf(z, 0.f) - log1pf(expf(-fabsf(z))); }
            }
        }
    }
}

__device__ __forceinline__ void cum_scan(LAS unsigned char* lds, const float* logf, float* cum, int bh, int tid, int lane, int w) {
    LAS float* ws = (LAS float*)lds;
    const int b = bh >> 3, h = bh & 7;
    float v[8]; float run = 0.f;
#pragma unroll
    for (int i = 0; i < 8; ++i) { run += logf[((size_t)b * SEQ + 8 * tid + i) * 8 + h]; v[i] = run; }
    float inc = run;
#pragma unroll
    for (int o = 1; o < 64; o <<= 1) { const float t = __int_as_float(__builtin_amdgcn_ds_bpermute((lane - o) << 2, __float_as_int(inc))); if (lane >= o) inc += t; }
    if (lane == 63) ws[w] = inc;
    __syncthreads();
    float base = inc - run;
    for (int i = 0; i < w; ++i) base += ws[i];
#pragma unroll
    for (int i = 0; i < 8; ++i) cum[(size_t)bh * SEQ + 8 * tid + i] = (base + v[i]) * LOG2E;
    __syncthreads();
}

#define MFMA16(a, b, c) __builtin_amdgcn_mfma_f32_16x16x32_bf16((a), (b), (c), 0, 0, 0)
#define MFMA32(a, b, c) __builtin_amdgcn_mfma_f32_32x32x16_bf16((a), (b), (c), 0, 0, 0)
__device__ __forceinline__ bf16x8 ldg16(const void* ubase, unsigned off) { return *(const bf16x8*)((const char*)ubase + off); }
__device__ __forceinline__ void s5_unit(LAS unsigned char* lds, const bf16_t* P, const unsigned char* tab, bf16_t* Ya, const int b, const int g, int tid, int lane, int w) {
    LAS unsigned char* KT = lds; LAS float* EL = (LAS float*)(lds + 33280); LAS unsigned char* SPT = lds + 66560;
    const unsigned char* ktab = tab + S5_KT + (size_t)g * KT_BYTES;
    const int n = lane & 15, kg = lane >> 4, ntile = w & 3, wh = w >> 2;
    const bf16_t* WEu = (const bf16_t*)(tab + S5_WE) + (size_t)g * 128 * 1024 + (size_t)(64 * wh) * 1024;
    const bf16_t* WCu = (const bf16_t*)(tab + S5_WC) + (size_t)g * 1024 * 128 + (size_t)(wh * 16) * 128;
    const bf16_t* Uu = P + ((size_t)b * SEQ + (size_t)(16 * ntile) * 64) * NA + 16 * g;
    const unsigned uoff = (unsigned)((n * 64 + (kg >> 1)) * NA + 8 * (kg & 1)) * 2u;
    const unsigned weoff = (unsigned)(n * 1024 + 8 * kg) * 2u;
    const unsigned wcoff = (unsigned)(n * 128 + 8 * kg) * 2u;
    for (int i = tid; i < KT_BYTES / 16; i += 512) *(LAS u32x4*)(KT + i * 16) = *(const u32x4*)(ktab + i * 16);
    {
        f32x4 e[4];
#pragma unroll
        for (int mt = 0; mt < 4; ++mt) e[mt] = (f32x4){0.f, 0.f, 0.f, 0.f};
        bf16x8 eb[4], ea[4][4];
#define S5_ELD(ks) do { eb[(ks) & 3] = ldg16(Uu + (size_t)(2 * (ks)) * NA, uoff); _Pragma("unroll") for (int _m = 0; _m < 4; ++_m) ea[(ks) & 3][_m] = ldg16(WEu + (size_t)(16 * _m) * 1024 + 32 * (ks), weoff); } while (0)
        S5_ELD(0); S5_ELD(1); S5_ELD(2);
        __builtin_amdgcn_sched_barrier(0);
#pragma unroll
        for (int ks = 0; ks < 32; ++ks) {
            if (ks + 3 < 32) S5_ELD(ks + 3);
#pragma unroll
            for (int mt = 0; mt < 4; ++mt) e[mt] = MFMA16(ea[ks & 3][mt], eb[ks & 3], e[mt]);
            __builtin_amdgcn_sched_barrier(0);
        }
#undef S5_ELD
#pragma unroll
        for (int mt = 0; mt < 4; ++mt)
#pragma unroll
            for (int i = 0; i < 4; ++i) EL[(64 * wh + 16 * mt + 4 * kg + i) * 65 + 16 * ntile + n] = e[mt][i];
    }
    __syncthreads();
    {
        const int p = tid & 63, seg = tid >> 6;
        const f32x2 a1 = ((const f32x2*)(tab + S5_A64))[g * 64 + p];
        float lr[8], li[8]; float sr = 0.f, si = 0.f;
#pragma unroll
        for (int j = 0; j < 8; ++j) { const float er = EL[p * 65 + 8 * seg + j], ei = EL[(64 + p) * 65 + 8 * seg + j];
            const float nr = a1.x * sr - a1.y * si + er, ni = a1.x * si + a1.y * sr + ei; sr = nr; si = ni; lr[j] = sr; li[j] = si; }
        LAS f32x2* TT = (LAS f32x2*)(lds + 66560 + 17408);
        TT[seg * 64 + p] = (f32x2){sr, si};
        f32x2 a2 = {a1.x * a1.x - a1.y * a1.y, 2.f * a1.x * a1.y}; f32x2 a4 = {a2.x * a2.x - a2.y * a2.y, 2.f * a2.x * a2.y}; const f32x2 a8 = {a4.x * a4.x - a4.y * a4.y, 2.f * a4.x * a4.y};
        __syncthreads();
        float cr = 0.f, ci = 0.f;
        for (int s2 = 0; s2 < seg; ++s2) { const f32x2 t = TT[s2 * 64 + p]; const float nr = a8.x * cr - a8.y * ci + t.x, ni = a8.x * ci + a8.y * cr + t.y; cr = nr; ci = ni; }
        float pr = cr, pi = ci, wr_ = cr, wi_ = ci;
#pragma unroll
        for (int j = 0; j < 8; ++j) {
            *(LAS bf16_t*)(SPT + (8 * seg + j) * 272 + 2 * p) = (bf16_t)(cvt_pk_bf16(pr, 0.f) & 0xffffu);
            *(LAS bf16_t*)(SPT + (8 * seg + j) * 272 + 2 * (64 + p)) = (bf16_t)(cvt_pk_bf16(pi, 0.f) & 0xffffu);
            const float nr = a1.x * wr_ - a1.y * wi_, ni = a1.x * wi_ + a1.y * wr_; wr_ = nr; wi_ = ni;
            pr = lr[j] + wr_; pi = li[j] + wi_;
        }
    }
    __syncthreads();
    const LAS unsigned char* klow = KT + (1 - wh + (lane >> 5)) * 512 + (lane & 15) * 32 + ((lane >> 4) & 1) * 16;
    const LAS unsigned char* spb = SPT + (16 * ntile + n) * 272 + 16 * kg;
    const bf16x8 aglu = *(const bf16x8*)(tab + S5_GLU + (size_t)(g * 64 + lane) * 16);
    const unsigned yoff = (unsigned)(n * 64 * YW + 4 * kg) * 2u;
#pragma unroll 1
    for (int pass = 0; pass < 2; ++pass) {
        f32x4 acc[16];
#pragma unroll
        for (int i = 0; i < 16; ++i) acc[i] = (f32x4){0.f, 0.f, 0.f, 0.f};
        bf16x8 bq[4], ca[2][4], bt[8], bu[8];
        const bf16_t* Up = Uu + (size_t)(32 * pass) * NA;
        const bf16_t* WCp = WCu + (size_t)(32 * pass) * 2048;
#define S5_LDC(st, slot) do { _Pragma("unroll") for (int _q = 0; _q < 4; ++_q) ca[slot][_q] = ldg16(WCp + (size_t)(2 * (4 * ((st) & 3) + _q)) * 2048 + 32 * ((st) >> 2), wcoff); } while (0)
#pragma unroll
        for (int jj = 0; jj < 8; ++jj) bt[jj] = ldg16(Up + (size_t)(2 * jj) * NA, uoff);
        S5_LDC(0, 0); S5_LDC(1, 1);
        if (pass == 1) {
            bq[0] = ldg16(Uu, uoff); bq[1] = ldg16(Uu + (size_t)2 * NA, uoff); bq[2] = ldg16(Uu + (size_t)4 * NA, uoff);
            __builtin_amdgcn_sched_barrier(0);
#pragma unroll
            for (int jj = 0; jj < 16; ++jj) {
                if (jj + 3 < 16) bq[(jj + 3) & 3] = ldg16(Uu + (size_t)(2 * (jj + 3)) * NA, uoff);
#pragma unroll
                for (int ii = 0; ii < 16; ++ii) { const bf16x8 af = *(const LAS bf16x8*)(klow + (30 - 2 * (ii - jj)) * 512); acc[ii] = MFMA16(af, bq[jj & 3], acc[ii]); }
                __builtin_amdgcn_sched_barrier(0);
            }
        }
        __builtin_amdgcn_sched_barrier(0);
#pragma unroll
        for (int jj = 0; jj < 16; ++jj) {
            const bf16x8 cb = *(const LAS bf16x8*)(spb + 64 * (jj >> 2));
            if (jj < 8) bu[jj] = ldg16(Up + (size_t)(2 * (jj + 8)) * NA, uoff);
#pragma unroll
            for (int ii = 0; ii < 16; ++ii) if (ii >= jj) { const bf16x8 af = *(const LAS bf16x8*)(klow + (62 - 2 * (ii - jj)) * 512); acc[ii] = MFMA16(af, (jj < 8 ? bt[jj & 7] : bu[jj & 7]), acc[ii]); }
#pragma unroll
            for (int q = 0; q < 4; ++q) acc[4 * (jj & 3) + q] = MFMA16(ca[jj & 1][q], cb, acc[4 * (jj & 3) + q]);
            __builtin_amdgcn_sched_barrier(0);
            if (jj + 2 < 16) S5_LDC(jj + 2, jj & 1);
            __builtin_amdgcn_sched_barrier(0);
        }
#undef S5_LDC
        bf16_t* Yu = Ya + ((size_t)b * SEQ + (size_t)(16 * ntile) * 64 + wh + 32 * pass) * YW + 16 * g;
#pragma unroll
        for (int ii = 0; ii < 16; ++ii) {
            f32x4 y;
#pragma unroll
            for (int k = 0; k < 4; ++k) y[k] = gelu_tanh(acc[ii][k]);
            u32x4 bp; bp.x = cvt_pk_bf16(y[0], y[1]); bp.y = cvt_pk_bf16(y[2], y[3]); bp.z = 0u; bp.w = 0u;
            const f32x4 z = MFMA16(aglu, __builtin_bit_cast(bf16x8, bp), ((f32x4){0.f, 0.f, 0.f, 0.f}));
            u32x2 o; o.x = cvt_pk_bf16(y[0] * sigmoid_f(z[0]), y[1] * sigmoid_f(z[1])); o.y = cvt_pk_bf16(y[2] * sigmoid_f(z[2]), y[3] * sigmoid_f(z[3]));
            *(u32x2*)((char*)(Yu + (size_t)(2 * ii) * YW) + yoff) = o;
        }
    }
    __syncthreads();
}

constexpr int AT_KS = 0, AT_VT = 9216, AT_BS = 9216 + 8704, AT_BUF = 9216 + 8704 + 256;
__device__ __forceinline__ int crow(int r, int hi) { return (r & 3) + 8 * (r >> 2) + 4 * hi; }
__device__ __forceinline__ void attn_unit(LAS unsigned char* lds, const bf16_t* P, const float* cum, bf16_t* Yc, const int b, const int h, const int qb, int tid, int lane, int w) {
    const int r32 = lane & 31, hi = lane >> 5;
    const size_t row0 = (size_t)b * SEQ;
    const int q0 = qb * 256, qrow = q0 + 32 * w + r32;
    bf16x8 qf[4];
    { const bf16_t* qp = P + (row0 + qrow) * NA + COL_Q + 64 * h + 8 * hi;
#pragma unroll
      for (int s = 0; s < 4; ++s) qf[s] = *(const bf16x8*)(qp + 16 * s); }
    const float* cumbh = cum + (size_t)(b * 8 + h) * SEQ;
    const float ref = cumbh[q0];
    const int skey = tid >> 3, spc = tid & 7;
    const bf16_t* kgp = P + (row0 + skey) * NA + COL_K + 64 * h + 8 * spc;
    const int NT = 4 * qb + 4;
    u32x4 kreg = *(const u32x4*)kgp, vreg = *(const u32x4*)(kgp + (COL_V - COL_K)); float breg = 0.f; if (tid < 64) breg = ref - cumbh[tid];
#define AT_WRITE(bufp) do { LAS unsigned char* _b = (bufp); *(LAS u32x4*)(_b + AT_KS + skey * 144 + 16 * spc) = kreg; \
        LAS bf16_t* _v = (LAS bf16_t*)(_b + AT_VT) + (8 * spc) * 68 + skey; \
        _v[0 * 68] = (bf16_t)(vreg.x & 0xffffu); _v[1 * 68] = (bf16_t)(vreg.x >> 16); _v[2 * 68] = (bf16_t)(vreg.y & 0xffffu); _v[3 * 68] = (bf16_t)(vreg.y >> 16); \
        _v[4 * 68] = (bf16_t)(vreg.z & 0xffffu); _v[5 * 68] = (bf16_t)(vreg.z >> 16); _v[6 * 68] = (bf16_t)(vreg.w & 0xffffu); _v[7 * 68] = (bf16_t)(vreg.w >> 16); \
        if (tid < 64) *(LAS float*)(_b + AT_BS + 4 * tid) = breg; } while (0)
    AT_WRITE(lds);
    __syncthreads();
    float mrun = -1e30f, lrun = 0.f; f32x16 o0, o1;
#pragma unroll
    for (int r = 0; r < 16; ++r) { o0[r] = 0.f; o1[r] = 0.f; }
    for (int kt = 0; kt < NT; ++kt) {
        const int cur = kt & 1; const bool more = (kt + 1 < NT);
        if (more) { const bf16_t* kp = kgp + (size_t)(kt + 1) * 64 * NA; kreg = *(const u32x4*)kp; vreg = *(const u32x4*)(kp + (COL_V - COL_K)); if (tid < 64) breg = ref - cumbh[64 * (kt + 1) + tid]; }
        if (64 * kt <= q0 + 32 * w + 31) {
            const LAS unsigned char* Kb = lds + cur * AT_BUF + AT_KS; const LAS unsigned char* Vb = lds + cur * AT_BUF + AT_VT; const LAS unsigned char* Bb = lds + cur * AT_BUF + AT_BS;
            f32x16 p[2];
#pragma unroll
            for (int rb = 0; rb < 2; ++rb) {
                f32x16 c;
#pragma unroll
                for (int g4 = 0; g4 < 4; ++g4) { const f32x4 bv = *(const LAS f32x4*)(Bb + (32 * rb + 8 * g4 + 4 * hi) * 4); c[4 * g4 + 0] = bv.x; c[4 * g4 + 1] = bv.y; c[4 * g4 + 2] = bv.z; c[4 * g4 + 3] = bv.w; }
#pragma unroll
                for (int s = 0; s < 4; ++s) { const bf16x8 af = *(const LAS bf16x8*)(Kb + (32 * rb + r32) * 144 + 32 * s + 16 * hi); c = MFMA32(af, qf[s], c); }
                p[rb] = c;
            }
            if (64 * kt + 63 > q0 + 32 * w) {
#pragma unroll
                for (int rb = 0; rb < 2; ++rb)
#pragma unroll
                    for (int r = 0; r < 16; ++r) { const int key = 64 * kt + 32 * rb + crow(r, hi); if (key > qrow) p[rb][r] = -1e30f; }
            }
            float mt = p[0][0];
#pragma unroll
            for (int r = 1; r < 16; ++r) mt = fmaxf(mt, p[0][r]);
#pragma unroll
            for (int r = 0; r < 16; ++r) mt = fmaxf(mt, p[1][r]);
            mt = half_max(mt);
            const float mnew = fmaxf(mrun, mt), alpha = fast_exp2(mrun - mnew);
            mrun = mnew;
            float ls = 0.f;
#pragma unroll
            for (int rb = 0; rb < 2; ++rb)
#pragma unroll
                for (int r = 0; r < 16; ++r) { p[rb][r] = fast_exp2(p[rb][r] - mnew); ls += p[rb][r]; }
            lrun = lrun * alpha + ls;
#pragma unroll
            for (int r = 0; r < 16; ++r) { o0[r] *= alpha; o1[r] *= alpha; }
            bf16x8 pf[4];
#pragma unroll
            for (int s = 0; s < 4; ++s) { const int rb = s >> 1, r0 = 8 * (s & 1); u32x4 pk; pk.x = cvt_pk_bf16(p[rb][r0 + 0], p[rb][r0 + 1]); pk.y = cvt_pk_bf16(p[rb][r0 + 2], p[rb][r0 + 3]);
                pk.z = cvt_pk_bf16(p[rb][r0 + 4], p[rb][r0 + 5]); pk.w = cvt_pk_bf16(p[rb][r0 + 6], p[rb][r0 + 7]); pf[s] = __builtin_bit_cast(bf16x8, pk); }
#pragma unroll
            for (int s = 0; s < 4; ++s) {
                { const LAS unsigned char* vp = Vb + r32 * 136 + 2 * (16 * s + 4 * hi); const s16x4 lo = *(const LAS s16x4*)vp, hh = *(const LAS s16x4*)(vp + 16);
                  const bf16x8 af = __builtin_shufflevector(lo, hh, 0, 1, 2, 3, 4, 5, 6, 7); o0 = MFMA32(af, pf[s], o0); }
                { const LAS unsigned char* vp = Vb + (32 + r32) * 136 + 2 * (16 * s + 4 * hi); const s16x4 lo = *(const LAS s16x4*)vp, hh = *(const LAS s16x4*)(vp + 16);
                  const bf16x8 af = __builtin_shufflevector(lo, hh, 0, 1, 2, 3, 4, 5, 6, 7); o1 = MFMA32(af, pf[s], o1); }
            }
        }
        if (more) AT_WRITE(lds + (cur ^ 1) * AT_BUF);
        __syncthreads();
    }
#undef AT_WRITE
    const float ltot = half_sum(lrun);
    const float inv = 1.0f / ltot;
    bf16_t* op = Yc + (row0 + qrow) * YW + 64 * h + 4 * hi;
#pragma unroll
    for (int g4 = 0; g4 < 4; ++g4) {
        u32x2 a, c2;
        a.x = cvt_pk_bf16(o0[4 * g4 + 0] * inv, o0[4 * g4 + 1] * inv); a.y = cvt_pk_bf16(o0[4 * g4 + 2] * inv, o0[4 * g4 + 3] * inv);
        c2.x = cvt_pk_bf16(o1[4 * g4 + 0] * inv, o1[4 * g4 + 1] * inv); c2.y = cvt_pk_bf16(o1[4 * g4 + 2] * inv, o1[4 * g4 + 3] * inv);
        *(u32x2*)(op + 8 * g4) = a; *(u32x2*)(op + 32 + 8 * g4) = c2;
    }
}

__device__ __forceinline__ void conv_phase(const bf16_t* P, const float* cw, bf16_t* Yb, int gtid, int ngt) {
    for (int item = gtid; item < M * 64; item += ngt) {
        const int token = item >> 6, c0 = (item & 63) * 8, t = token & (SEQ - 1);
        float acc[8];
#pragma unroll
        for (int i = 0; i < 8; ++i) acc[i] = 0.f;
#pragma unroll
        for (int tap = 0; tap < 3; ++tap) {
            if (t - 2 + tap >= 0) {
                const bf16_t* rp = P + (size_t)(token - 2 + tap) * NA + c0;
                const u32x4 xc = *(const u32x4*)(rp + COL_XC), cc = *(const u32x4*)(rp + COL_CC);
                const f32x4 w0 = *(const f32x4*)(cw + tap * 512 + c0), w1 = *(const f32x4*)(cw + tap * 512 + c0 + 4);
                acc[0] += w0.x * bf_lo(xc.x) * bf_lo(cc.x); acc[1] += w0.y * bf_hi(xc.x) * bf_hi(cc.x); acc[2] += w0.z * bf_lo(xc.y) * bf_lo(cc.y); acc[3] += w0.w * bf_hi(xc.y) * bf_hi(cc.y);
                acc[4] += w1.x * bf_lo(xc.z) * bf_lo(cc.z); acc[5] += w1.y * bf_hi(xc.z) * bf_hi(cc.z); acc[6] += w1.z * bf_lo(xc.w) * bf_lo(cc.w); acc[7] += w1.w * bf_hi(xc.w) * bf_hi(cc.w);
            }
        }
        const u32x4 bc = *(const u32x4*)(P + (size_t)token * NA + COL_BC + c0);
        u32x4 o; o.x = cvt_pk_bf16(acc[0] * bf_lo(bc.x), acc[1] * bf_hi(bc.x)); o.y = cvt_pk_bf16(acc[2] * bf_lo(bc.y), acc[3] * bf_hi(bc.y));
        o.z = cvt_pk_bf16(acc[4] * bf_lo(bc.z), acc[5] * bf_hi(bc.z)); o.w = cvt_pk_bf16(acc[6] * bf_lo(bc.w), acc[7] * bf_hi(bc.w));
        *(u32x4*)(Yb + (size_t)token * YW + c0) = o;
    }
}

__device__ __forceinline__ void grid_barrier(cg::grid_group& grid) {
    asm volatile("s_waitcnt vmcnt(0) lgkmcnt(0)" ::: "memory");
    __syncthreads();
    grid.sync();
    if (threadIdx.x == 0) { __builtin_amdgcn_fence(__ATOMIC_ACQUIRE, "agent"); asm volatile("s_waitcnt vmcnt(0)" ::: "memory"); }
    __syncthreads();
}

#ifndef DIAG_STAGE
#define DIAG_STAGE 0
#endif
__device__ __forceinline__ void diag_dump(float* out, const bf16_t* src, int ld, int ncols) {
    for (size_t i = (size_t)blockIdx.x * 512 + threadIdx.x; i < (size_t)M * DM; i += (size_t)gridDim.x * 512) {
        const size_t row = i >> 10; const int c = (int)(i & 1023); float v = 0.f;
        for (int cc = c; cc < ncols; cc += 1024) v += bf_lo((unsigned)src[row * ld + cc]);
        out[i] = v;
    }
}
#define DIAG(k, src, ld, ncols) do { if (DIAG_STAGE == (k)) { grid_barrier(grid); diag_dump(a.out, (src), (ld), (ncols)); return; } } while (0)

__global__ void __launch_bounds__(512, 2) fwd_kernel(Args a) {
    extern __shared__ __attribute__((aligned(16))) unsigned char lds_raw[];
    LAS unsigned char* lds = (LAS unsigned char*)lds_raw;
    cg::grid_group grid = cg::this_grid();
    const int G = gridDim.x, bid = blockIdx.x, ngw = G * 8;
#define FRESH() const int tid = launder_i(threadIdx.x), lane = tid & 63, w = __builtin_amdgcn_readfirstlane(tid >> 6), gw = bid * 8 + w; (void)lane; (void)gw
    unsigned char* ws = a.ws;
    bf16_t* XN = (bf16_t*)(ws + WS_XN); bf16_t* PR = (bf16_t*)(ws + WS_P); bf16_t* Y = (bf16_t*)(ws + WS_Y);
    float* LOGF = (float*)(ws + WS_LOGF); float* CUM = (float*)(ws + WS_CUM);

    {
        FRESH();
#ifndef NO_TAB
        for (int u = bid; u < 256; u += G) s5_tables(lds, a, u >> 7, (u >> 2) & 31, u & 3, tid);
#endif
        LAS float* scr = (LAS float*)(lds + w * 16640);
        constexpr int I_A = 16 * 56, I_G = 16 * 48, I_B = 8 * 16, I_O = 16 * 16, I_1 = 16 * 64, I_2 = 64 * 16, I_L = I_A + I_G + 3 * I_B + I_O + I_1 + I_2;
        for (int it = gw; it < 2 * I_L; it += ngw) {
            const int l = it / I_L; int r = it - l * I_L;
            unsigned char* wl = ws + WS_W + (size_t)l * W_LAYER;
            const float* win = a.in[2] + (size_t)l * DM * INW;
            if (r < I_A) { transpose_item(win, INW, 0, DM, NA, (bf16_t*)(wl + W_INA), scr, r, lane); continue; } r -= I_A;
            if (r < I_G) { transpose_item(win, INW, COL_G, DM, NG, (bf16_t*)(wl + W_G), scr, r, lane); continue; } r -= I_G;
            if (r < 3 * I_B) { const int br = r / I_B; transpose_item(a.in[15] + (size_t)l * 1536 * DM + (size_t)br * 512 * DM, DM, 0, 512, DM, (bf16_t*)(wl + W_BR) + (size_t)br * DM * 512, scr, r - br * I_B, lane); continue; } r -= 3 * I_B;
            if (r < I_O) { transpose_item(a.in[16] + (size_t)l * DM * DM, DM, 0, DM, DM, (bf16_t*)(wl + W_OUT), scr, r, lane); continue; } r -= I_O;
            if (r < I_1) { transpose_item(a.in[19] + (size_t)l * DM * FF, FF, 0, DM, FF, (bf16_t*)(wl + W_1), scr, r, lane); continue; } r -= I_1;
            transpose_item(a.in[20] + (size_t)l * FF * DM, DM, 0, FF, DM, (bf16_t*)(wl + W_2), scr, r, lane);
        }
        __syncthreads();
        NormArgs n{a.in[0], nullptr, nullptr, nullptr, a.in[1], XN, a.in[2] + COL_F, a.in[14], LOGF};
        norm_phase(lds, n, gw, ngw, lane, tid);
    }
    grid_barrier(grid);

    DIAG(1, XN, DM, DM);
#pragma unroll 1
    for (int l = 0; l < DEPTH; ++l) {
        unsigned char* wl = ws + WS_W + (size_t)l * W_LAYER;
        const unsigned char* s5tab = ws + WS_S5 + (size_t)l * S5_LAYER;
        const float* xin = (l == 0) ? a.in[0] : a.out;

        { FRESH(); for (int bh = bid; bh < 64; bh += G) cum_scan(lds, LOGF, CUM, bh, tid, lane, w); }
        {
            pg8::Gemm g{XN, (const bf16_t*)(wl + W_INA), M, NA, DM, 0, 0}; pg8::StaticOrder S; S.init(M, NA, G, bid, 1);
            pg8::Epi<pg8::EPI_PROJ> E{PR, NA, nullptr, nullptr};
#if (PHMASK >> 0) & 1
            pg8::gemm_phase<pg8::Epi<pg8::EPI_PROJ>, pg8::StaticOrder, true, true>(lds, g, S, E);
#endif
        }
        grid_barrier(grid);

        DIAG(2, PR, NA, NA);
#ifndef NO_S5
        { FRESH(); for (int v = bid; v < 256; v += G) s5_unit(lds, PR, s5tab, Y, v >> 5, v & 31, tid, lane, w); }
#endif
#ifndef NO_ATTN
        for (int v = bid; v < 256; v += G) {
            FRESH(); const int bh = v >> 2, s = v & 3;
#pragma unroll 1
            for (int k = 0; k < 4; ++k) { const int qb = (k == 0) ? 15 - s : (k == 1) ? s : (k == 2) ? 11 - s : s + 4;
                attn_unit(lds, PR, CUM, Y + 2 * (size_t)M * YW, bh >> 3, bh & 7, qb, tid, lane, w); }
        }
#endif
        { FRESH(); conv_phase(PR, a.in[13] + (size_t)l * 3 * 512, Y + (size_t)M * YW, bid * 512 + tid, G * 512); }
        grid_barrier(grid);

        if (DIAG_STAGE == 3) { grid_barrier(grid); for (size_t i = (size_t)blockIdx.x * 512 + threadIdx.x; i < (size_t)M * DM; i += (size_t)gridDim.x * 512) { const size_t row = i >> 10; const int c = (int)(i & 511); a.out[i] = bf_lo((unsigned)Y[row * YW + c]) + bf_lo((unsigned)Y[(size_t)M * YW + row * YW + c]) + bf_lo((unsigned)Y[2 * (size_t)M * YW + row * YW + c]); } return; }
        DIAG(31, Y + (size_t)M * YW, YW, YW); DIAG(32, Y + 2 * (size_t)M * YW, YW, YW);
        {
            pg8::Gemm g{XN, (const bf16_t*)(wl + W_G), M, NG, DM, 0, 0}; pg8::StaticOrder S; S.init(M, NG, G, bid, 1);
            pg8::Epi<pg8::EPI_GATE> E{PR, NG, a.in[3] + (size_t)l * NG, nullptr};
#if (PHMASK >> 1) & 1
            pg8::gemm_phase<pg8::Epi<pg8::EPI_GATE>, pg8::StaticOrder, true, true>(lds, g, S, E);
#endif
        }
        grid_barrier(grid);

        DIAG(4, PR, NG, NG);
        {
            pg8::Gemm g{Y, (const bf16_t*)(wl + W_BR), M, DM, 512, (size_t)M * YW * 2, (size_t)DM * 512 * 2}; pg8::StaticOrder S; S.init(M, DM, G, bid, 3);
            pg8::Epi<pg8::EPI_BRANCH> E{XN, DM, nullptr, PR};
#if (PHMASK >> 2) & 1
            pg8::gemm_phase<pg8::Epi<pg8::EPI_BRANCH>, pg8::StaticOrder, true, true>(lds, g, S, E);
#endif
        }
        grid_barrier(grid);

        DIAG(5, XN, DM, DM);
        {
            pg8::Gemm g{XN, (const bf16_t*)(wl + W_OUT), M, DM, DM, 0, 0}; pg8::StaticOrder S; S.init(M, DM, G, bid, 1);
            pg8::Epi<pg8::EPI_PLAIN> E{PR, DM, nullptr, nullptr};
#if (PHMASK >> 3) & 1
            pg8::gemm_phase<pg8::Epi<pg8::EPI_PLAIN>, pg8::StaticOrder, true, true>(lds, g, S, E);
#endif
        }
        grid_barrier(grid);

        DIAG(6, PR, DM, DM);
        {
            FRESH(); NormArgs n{xin, PR, a.in[17] + (size_t)l * DM, a.out, a.in[18] + (size_t)l * DM, XN, nullptr, nullptr, nullptr};
            norm_phase(lds, n, gw, ngw, lane, tid);
        }
        grid_barrier(grid);

        DIAG(7, XN, DM, DM);
        {
            pg8::Gemm g{XN, (const bf16_t*)(wl + W_1), M, FF, DM, 0, 0}; pg8::StaticOrder S; S.init(M, FF, G, bid, 1);
            pg8::Epi<pg8::EPI_RELU2> E{PR, FF, nullptr, nullptr};
#if (PHMASK >> 4) & 1
            pg8::gemm_phase<pg8::Epi<pg8::EPI_RELU2>, pg8::StaticOrder, true, true>(lds, g, S, E);
#endif
        }
        grid_barrier(grid);

        DIAG(8, PR, FF, FF);
        {
            pg8::Gemm g{PR, (const bf16_t*)(wl + W_2), M, DM, FF, 0, 0}; pg8::StaticOrder S; S.init(M, DM, G, bid, 1);
            pg8::Epi<pg8::EPI_PLAIN> E{XN, DM, nullptr, nullptr};
#if (PHMASK >> 5) & 1
            pg8::gemm_phase<pg8::Epi<pg8::EPI_PLAIN>, pg8::StaticOrder, true, true>(lds, g, S, E);
#endif
        }
        grid_barrier(grid);

        DIAG(9, XN, DM, DM);
        if (l + 1 < DEPTH) {
            FRESH(); NormArgs n{a.out, XN, a.in[21] + (size_t)l * DM, a.out, a.in[1] + (size_t)(l + 1) * DM, XN, a.in[2] + (size_t)(l + 1) * DM * INW + COL_F, a.in[14] + (l + 1) * 8, LOGF};
            norm_phase(lds, n, gw, ngw, lane, tid);
            grid_barrier(grid);
        } else {
            FRESH(); NormArgs n{a.out, XN, a.in[21] + (size_t)l * DM, a.out, nullptr, nullptr, nullptr, nullptr, nullptr};
            norm_phase(lds, n, gw, ngw, lane, tid);
        }
    }
}

extern "C" void kernel_launch(void* const* d_in, const int* in_sizes, int n_in, void* d_out, int out_size, void* d_ws, size_t ws_size, hipStream_t stream) {
    static int grid = 0;
    if (grid == 0) {
        if (n_in != 22 || in_sizes[0] != M * DM || out_size != M * DM || ws_size < WS_END) { fprintf(stderr, "kernel_launch: unexpected shapes (n_in %d, in0 %d, out %d, ws %zu)\n", n_in, n_in > 0 ? in_sizes[0] : -1, out_size, ws_size); grid = -1; return; }
        int dev = 0, cus = 0, per_cu = 0;
        (void)hipGetDevice(&dev);
        (void)hipDeviceGetAttribute(&cus, hipDeviceAttributeMultiprocessorCount, dev);
        if (hipFuncSetAttribute((const void*)fwd_kernel, hipFuncAttributeMaxDynamicSharedMemorySize, LDS_BYTES) != hipSuccess) fprintf(stderr, "kernel_launch: hipFuncSetAttribute failed\n");
        if (hipOccupancyMaxActiveBlocksPerMultiprocessor(&per_cu, (const void*)fwd_kernel, 512, LDS_BYTES) != hipSuccess || per_cu < 1) { fprintf(stderr, "kernel_launch: occupancy query gave %d\n", per_cu); per_cu = 1; }
        (void)hipGetLastError();
        grid = cus * per_cu; if (grid > 256) grid = 256; if (grid < 1) grid = 256;
    }
    if (grid < 0) return;
    Args a{};
    for (int i = 0; i < 22; ++i) a.in[i] = (const float*)d_in[i];
    a.out = (float*)d_out; a.ws = (unsigned char*)d_ws;
    void* args[] = {&a};
    hipError_t e = hipLaunchCooperativeKernel((const void*)fwd_kernel, dim3(grid), dim3(512), args, LDS_BYTES, stream);
    if (e != hipSuccess) fprintf(stderr, "kernel_launch: cooperative launch failed: %s (grid %d)\n", hipGetErrorString(e), grid);
}
```

```cpp
#include <hip/hip_runtime.h>
#include <hip/hip_cooperative_groups.h>
#include <cstdio>
#include <cstdint>
namespace cg = cooperative_groups;

#define DIAG_STAGE 0
#ifndef PHMASK
#define PHMASK 0xff
#endif

#define LAS __attribute__((address_space(3)))
typedef unsigned short bf16_t;
typedef short bf16x8 __attribute__((ext_vector_type(8)));
typedef short s16x4 __attribute__((ext_vector_type(4)));
typedef float f32x2 __attribute__((ext_vector_type(2)));
typedef float f32x4 __attribute__((ext_vector_type(4)));
typedef float f32x16 __attribute__((ext_vector_type(16)));
typedef unsigned u32x2 __attribute__((ext_vector_type(2)));
typedef unsigned u32x4 __attribute__((ext_vector_type(4)));

constexpr int BATCH = 8, SEQ = 4096, DM = 1024, M = BATCH * SEQ, DEPTH = 2;
constexpr int INW = 6664, NA = 3584, NG = 3072, FF = 4096, YW = 512;
constexpr int COL_XC = 512, COL_BC = 1024, COL_CC = 1536, COL_Q = 2048, COL_K = 2560, COL_V = 3072, COL_F = 3584, COL_G = 3592;
constexpr float EPS = 1e-6f;
constexpr float LOG2E = 1.4426950408889634f;
constexpr float C2 = 0.125f * LOG2E;

constexpr size_t MiB = 1u << 20;
constexpr size_t WS_W = 1 * MiB, W_LAYER = 34 * MiB;
constexpr size_t W_INA = 0, W_G = 7 * MiB, W_BR = 13 * MiB, W_OUT = 16 * MiB, W_1 = 18 * MiB, W_2 = 26 * MiB;
constexpr size_t WS_S5 = 69 * MiB, S5_LAYER = 17 * MiB + 512 * 1024;
constexpr size_t S5_KT = 0, S5_WE = MiB + 256 * 1024, S5_WC = S5_WE + 8 * MiB, S5_A64 = S5_WC + 8 * MiB, S5_GLU = S5_A64 + 64 * 1024;
constexpr size_t WS_LOGF = 104 * MiB, WS_CUM = 105 * MiB, WS_XN = 106 * MiB, WS_P = 170 * MiB, WS_Y = 394 * MiB, WS_END = 490 * MiB;
constexpr int KT_BYTES = 65 * 512;

constexpr int LDS_BYTES = 147456;

typedef __bf16 bf16x2_t __attribute__((ext_vector_type(2)));
__device__ __forceinline__ unsigned cvt_pk_bf16(float lo, float hi) { const f32x2 v = {lo, hi}; const bf16x2_t b = __builtin_convertvector(v, bf16x2_t); return __builtin_bit_cast(unsigned, b); }
__device__ __forceinline__ float bf_lo(unsigned u) { return __uint_as_float(u << 16); }
__device__ __forceinline__ float bf_hi(unsigned u) { return __uint_as_float(u & 0xffff0000u); }
template <int O> __device__ __forceinline__ float swz_xor(float v) { return __int_as_float(__builtin_amdgcn_ds_swizzle(__float_as_int(v), (O << 10) | 0x1f)); }
__device__ __forceinline__ float half_sum(float v) { auto rr = __builtin_amdgcn_permlane32_swap(__float_as_uint(v), __float_as_uint(v), false, false); return __uint_as_float(rr[0]) + __uint_as_float(rr[1]); }
__device__ __forceinline__ float half_max(float v) { auto rr = __builtin_amdgcn_permlane32_swap(__float_as_uint(v), __float_as_uint(v), false, false); return fmaxf(__uint_as_float(rr[0]), __uint_as_float(rr[1])); }
__device__ __forceinline__ float wave_sum(float v) {
    v += swz_xor<1>(v); v += swz_xor<2>(v); v += swz_xor<4>(v); v += swz_xor<8>(v); v += swz_xor<16>(v);
    return half_sum(v);
}
__device__ __forceinline__ int launder_i(int x) { asm volatile("" : "+v"(x)); return x; }
__device__ __forceinline__ float fast_exp2(float x) { return __builtin_amdgcn_exp2f(x); }
__device__ __forceinline__ float fast_rcp(float x) { return __builtin_amdgcn_rcpf(x); }
__device__ __forceinline__ float sigmoid_f(float z) { return fast_rcp(1.0f + fast_exp2(-LOG2E * z)); }
__device__ __forceinline__ float gelu_tanh(float y) { const float t = y + 0.044715f * y * y * y; return y * fast_rcp(1.0f + fast_exp2(-2.302208198f * t)); }

namespace pg8 {
#define PG8_LAS __attribute__((address_space(3)))
constexpr int BM = 256, BK = 64, HALF = 128, HTB = HALF * BK * 2, STAGE_BYTES = 8 * HTB, NXCD = 8, WGM = 8;

__host__ __device__ __forceinline__ int lds_byte(int r, int c) { const int st = (r >> 4) * 2 + (c >> 5), rr = r & 15, cc = c & 31, ob = rr * 64 + cc * 2; return st * 1024 + (ob ^ (((ob >> 9) & 1) << 5)); }
__host__ __device__ __forceinline__ void stage_rc(int b, int& R, int& C) { const int st = b / 1024, sb = b % 1024, swz = sb ^ (((sb >> 9) & 1) << 5); R = (st >> 1) * 16 + swz / 64; C = (st & 1) * 32 + (swz % 64) / 2; }
__host__ __device__ __forceinline__ int perm32(int rho) { const int n = rho >> 4, i = rho & 15; return 8 * (i >> 2) + 4 * n + (i & 3); }

struct Unit { int pm, pn, br; };
struct Gemm { const bf16_t* A; const bf16_t* Bt; int M, N, K; size_t abr, bbr; };

struct StaticOrder {
    int nM, nN, nwg, G, c, nbr;
    __device__ void init(int M_, int N_, int G_, int c_, int nbr_) { nM = M_ / BM; nN = N_ / BM; nwg = nM * nN; G = G_; c = c_; nbr = nbr_; }
    __device__ bool next(int i, Unit& u) const {
        const int it = i / nbr; u.br = i - it * nbr;
        const long L = (long)it * G + c; if (L >= nwg) return false;
        int wgid = (int)L; { const int q = nwg / NXCD, r = nwg % NXCD, xcd = wgid % NXCD, off = wgid / NXCD; wgid = (xcd < r ? xcd * (q + 1) : r * (q + 1) + (xcd - r) * q) + off; }
        const int nig = WGM * nN, gid = wgid / nig, fm = gid * WGM, gsz = (nM - fm) < WGM ? (nM - fm) : WGM;
        u.pm = fm + ((wgid % nig) % gsz); u.pn = (wgid % nig) / gsz; return true;
    }
};

enum { EPI_PROJ = 0, EPI_GATE = 1, EPI_RELU2 = 2, EPI_BRANCH = 3, EPI_PLAIN = 4 };
template <int MODE> struct Epi {
    static constexpr bool PERM = true;
    bf16_t* O; int ldc; const float* bias; const bf16_t* G;
    __device__ __forceinline__ void operator()(const f32x4 (&acc)[2][2][4][2], const Unit& u, int wr, int wc, int fr, int fq) const {
        const int row0 = u.pm * BM + wr * 64 + fr; const int col0 = u.pn * BM + wc * 32 + 8 * fq;
        float sc = 1.f; if (MODE == EPI_PROJ) { if (u.pn >= COL_Q / 256 && u.pn < COL_K / 256) sc = C2; }
        f32x4 bv[2][2];
        if (MODE == EPI_GATE) {
#pragma unroll
            for (int bj = 0; bj < 2; ++bj)
#pragma unroll
                for (int n = 0; n < 2; ++n) bv[bj][n] = *(const f32x4*)(bias + col0 + bj * HALF + 4 * n);
        }
        if (MODE == EPI_BRANCH) {
#pragma unroll
            for (int ai = 0; ai < 2; ++ai) {
                u32x4 gt[4][2], pv[4][2];
#pragma unroll
                for (int m = 0; m < 4; ++m)
#pragma unroll
                    for (int bj = 0; bj < 2; ++bj) {
                        const size_t row = (size_t)(row0 + ai * HALF + m * 16);
                        gt[m][bj] = *(const u32x4*)(G + row * NG + (size_t)u.br * DM + col0 + bj * HALF);
                        pv[m][bj] = (u.br > 0) ? *(const u32x4*)(O + row * ldc + col0 + bj * HALF) : (u32x4){0u, 0u, 0u, 0u};
                    }
                __builtin_amdgcn_sched_barrier(0);
#pragma unroll
                for (int m = 0; m < 4; ++m)
#pragma unroll
                    for (int bj = 0; bj < 2; ++bj) {
                        const size_t row = (size_t)(row0 + ai * HALF + m * 16);
                        f32x4 v0 = acc[ai][bj][m][0], v1 = acc[ai][bj][m][1];
                        const u32x4 g4 = gt[m][bj], p4 = pv[m][bj];
                        v0[0] = v0[0] * bf_lo(g4.x) + bf_lo(p4.x); v0[1] = v0[1] * bf_hi(g4.x) + bf_hi(p4.x); v0[2] = v0[2] * bf_lo(g4.y) + bf_lo(p4.y); v0[3] = v0[3] * bf_hi(g4.y) + bf_hi(p4.y);
                        v1[0] = v1[0] * bf_lo(g4.z) + bf_lo(p4.z); v1[1] = v1[1] * bf_hi(g4.z) + bf_hi(p4.z); v1[2] = v1[2] * bf_lo(g4.w) + bf_lo(p4.w); v1[3] = v1[3] * bf_hi(g4.w) + bf_hi(p4.w);
                        u32x4 wv; wv.x = cvt_pk_bf16(v0[0], v0[1]); wv.y = cvt_pk_bf16(v0[2], v0[3]); wv.z = cvt_pk_bf16(v1[0], v1[1]); wv.w = cvt_pk_bf16(v1[2], v1[3]);
                        *(u32x4*)(O + row * ldc + col0 + bj * HALF) = wv;
                    }
                __builtin_amdgcn_sched_barrier(0);
            }
            return;
        }
#pragma unroll
        for (int ai = 0; ai < 2; ++ai)
#pragma unroll
            for (int m = 0; m < 4; ++m) {
                const size_t row = (size_t)(row0 + ai * HALF + m * 16);
                bf16_t* rowp = O + row * ldc + col0;
#pragma unroll
                for (int bj = 0; bj < 2; ++bj) {
                    f32x4 v0 = acc[ai][bj][m][0], v1 = acc[ai][bj][m][1];
                    if (MODE == EPI_PROJ) { v0 = v0 * sc; v1 = v1 * sc; }
                    if (MODE == EPI_GATE) {
                        v0 = v0 + bv[bj][0]; v1 = v1 + bv[bj][1];
#pragma unroll
                        for (int i = 0; i < 4; ++i) { v0[i] = sigmoid_f(v0[i]); v1[i] = sigmoid_f(v1[i]); }
                    }
                    if (MODE == EPI_RELU2) {
#pragma unroll
                        for (int i = 0; i < 4; ++i) { const float a = fmaxf(v0[i], 0.f), b = fmaxf(v1[i], 0.f); v0[i] = a * a; v1[i] = b * b; }
                    }
                    if (MODE == EPI_BRANCH) {
                        const u32x4 gt = *(const u32x4*)(G + row * NG + (size_t)u.br * DM + col0 + bj * HALF);
                        v0[0] *= bf_lo(gt.x); v0[1] *= bf_hi(gt.x); v0[2] *= bf_lo(gt.y); v0[3] *= bf_hi(gt.y);
                        v1[0] *= bf_lo(gt.z); v1[1] *= bf_hi(gt.z); v1[2] *= bf_lo(gt.w); v1[3] *= bf_hi(gt.w);
                        if (u.br > 0) {
                            const u32x4 pv = *(const u32x4*)(rowp + bj * HALF);
                            v0[0] += bf_lo(pv.x); v0[1] += bf_hi(pv.x); v0[2] += bf_lo(pv.y); v0[3] += bf_hi(pv.y);
                            v1[0] += bf_lo(pv.z); v1[1] += bf_hi(pv.z); v1[2] += bf_lo(pv.w); v1[3] += bf_hi(pv.w);
                        }
                    }
                    u32x4 w; w.x = cvt_pk_bf16(v0[0], v0[1]); w.y = cvt_pk_bf16(v0[2], v0[3]); w.z = cvt_pk_bf16(v1[0], v1[1]); w.w = cvt_pk_bf16(v1[2], v1[3]);
                    *(u32x4*)(rowp + bj * HALF) = w;
                }
            }
    }
};

template <class EpiT, class Sched, bool ALIGN_EPI, bool SP2>
__device__ __forceinline__ void gemm_phase(PG8_LAS unsigned char* lds, const Gemm g, const Sched& S, const EpiT& E) {
    const int tid = launder_i(threadIdx.x), wid = __builtin_amdgcn_readfirstlane(tid >> 6), lane = tid & 63, wr = wid >> 2, wc = wid & 3, fr = lane & 15, fq = lane >> 4;
    const int K = g.K, nt = K / BK;
    unsigned voffA[2], voffB[2];
#pragma unroll
    for (int i = 0; i < 2; ++i) { int R, C; stage_rc(tid * 16 + i * 8192, R, C); const int Rb = EpiT::PERM ? ((R & ~31) + perm32(R & 31)) : R;
        voffA[i] = (unsigned)(R * K + C) * 2u; voffB[i] = (unsigned)(Rb * K + C) * 2u; }
    const size_t kstep = (size_t)(BK * 2);
    const size_t hstep = (size_t)HALF * K * 2;
    const size_t tstep = 2 * hstep;
    const unsigned ldsw = (unsigned)wid * 1024u;
    const int aoff = lds_byte(wr * 64 + fr, fq * 8), boff = lds_byte(wc * 32 + fr, fq * 8);
#define PG8_SA(b, h) (((b) * 2 + (h)) * HTB)
#define PG8_SB(b, h) ((4 + (b) * 2 + (h)) * HTB)
#define PG8_STAGE(bufoff, gbase, voff) do { _Pragma("unroll") for (int _i = 0; _i < 2; ++_i) \
        __builtin_amdgcn_global_load_lds((const unsigned*)((const char*)(gbase) + (voff)[_i]), (PG8_LAS unsigned*)(lds + (bufoff) + ldsw + _i * 8192), 16, 0, 0); } while (0)
#define PG8_LDA(dst, b, h) do { _Pragma("unroll") for (int m = 0; m < 4; ++m) _Pragma("unroll") for (int k = 0; k < 2; ++k) dst[m][k] = *(const PG8_LAS bf16x8*)(lds + PG8_SA(b, h) + aoff + m * 2048 + k * 1024); } while (0)
#define PG8_LDB(dst, b, h) do { _Pragma("unroll") for (int n = 0; n < 2; ++n) _Pragma("unroll") for (int k = 0; k < 2; ++k) dst[n][k] = *(const PG8_LAS bf16x8*)(lds + PG8_SB(b, h) + boff + n * 2048 + k * 1024); } while (0)
#define PG8_MMA(ai, bj, At, Bt) do { __builtin_amdgcn_s_setprio(1); _Pragma("unroll") for (int m = 0; m < 4; ++m) _Pragma("unroll") for (int n = 0; n < 2; ++n) _Pragma("unroll") for (int k = 0; k < 2; ++k) \
        acc[ai][bj][m][n] = __builtin_amdgcn_mfma_f32_16x16x32_bf16(Bt[n][k], At[m][k], acc[ai][bj][m][n], 0, 0, 0); __builtin_amdgcn_s_setprio(0); } while (0)
#define PG8_WAIT_V(n) asm volatile("s_waitcnt vmcnt(" #n ")" ::: "memory")
#define PG8_WAIT_L(n) asm volatile("s_waitcnt lgkmcnt(" #n ")" ::: "memory")
#define PG8_BAR __builtin_amdgcn_s_barrier()
#define PG8_SCHED __builtin_amdgcn_sched_barrier(0)
    Unit cur, nxt; int ui = 0;
    if (!S.next(0, cur)) return;
    f32x4 acc[2][2][4][2];
#pragma unroll
    for (int a = 0; a < 2; ++a)
#pragma unroll
        for (int b = 0; b < 2; ++b)
#pragma unroll
            for (int m = 0; m < 4; ++m)
#pragma unroll
                for (int n = 0; n < 2; ++n) acc[a][b][m][n] = (f32x4){0.f, 0.f, 0.f, 0.f};
    bf16x8 At[4][2], B0[2][2], B1[2][2];
    const char* cA = (const char*)g.A + (size_t)cur.pm * tstep + (size_t)cur.br * g.abr; const char* cB = (const char*)g.Bt + (size_t)cur.pn * tstep + (size_t)cur.br * g.bbr;
    if constexpr (SP2) {
        PG8_STAGE(PG8_SB(0, 0), cB, voffB); PG8_STAGE(PG8_SB(0, 1), cB + hstep, voffB); PG8_STAGE(PG8_SA(0, 0), cA, voffA); PG8_STAGE(PG8_SA(0, 1), cA + hstep, voffA);
        if (wr == 1) PG8_BAR;
        PG8_WAIT_V(2); PG8_BAR;
        PG8_STAGE(PG8_SB(1, 0), cB + kstep, voffB); PG8_STAGE(PG8_SA(1, 0), cA + kstep, voffA); PG8_STAGE(PG8_SB(1, 1), cB + hstep + kstep, voffB);
        PG8_WAIT_V(6); PG8_BAR;
    } else {
        PG8_STAGE(PG8_SB(0, 0), cB, voffB); PG8_STAGE(PG8_SA(0, 0), cA, voffA); PG8_STAGE(PG8_SB(0, 1), cB + hstep, voffB); PG8_STAGE(PG8_SA(0, 1), cA + hstep, voffA);
        if (wr == 1) PG8_BAR;
        PG8_WAIT_V(4); PG8_BAR;
        PG8_STAGE(PG8_SB(1, 0), cB + kstep, voffB); PG8_STAGE(PG8_SA(1, 0), cA + kstep, voffA); PG8_STAGE(PG8_SB(1, 1), cB + hstep + kstep, voffB);
        PG8_WAIT_V(6); PG8_BAR;
    }
    for (;;) {
        const bool has_next = S.next(ui + 1, nxt);
        const char* nA = has_next ? (const char*)g.A + (size_t)nxt.pm * tstep + (size_t)nxt.br * g.abr : cA;
        const char* nB = has_next ? (const char*)g.Bt + (size_t)nxt.pn * tstep + (size_t)nxt.br * g.bbr : cB;
        for (int t = 0; t < nt; t += 2) {
            const bool last = (t == nt - 2);
            const char* a1 = cA + (size_t)(t + 1) * kstep;
            const char* a2 = last ? nA : cA + (size_t)(t + 2) * kstep; const char* b2 = last ? nB : cB + (size_t)(t + 2) * kstep;
            const char* a3 = a2 + kstep; const char* b3 = b2 + kstep;
            if constexpr (SP2) {
            PG8_LDB(B0, 0, 0); PG8_LDB(B1, 0, 1); PG8_SCHED; PG8_LDA(At, 0, 0); PG8_STAGE(PG8_SA(1, 1), a1 + hstep, voffA);
            PG8_WAIT_V(8); PG8_WAIT_L(0); PG8_BAR; PG8_MMA(0, 0, At, B0); PG8_MMA(0, 1, At, B1); PG8_BAR; PG8_SCHED;
            PG8_LDA(At, 0, 1); PG8_STAGE(PG8_SB(0, 0), b2, voffB); PG8_STAGE(PG8_SB(0, 1), b2 + hstep, voffB); PG8_STAGE(PG8_SA(0, 0), a2, voffA);
            PG8_WAIT_V(8); PG8_WAIT_L(0); PG8_BAR; PG8_MMA(1, 0, At, B0); PG8_MMA(1, 1, At, B1); PG8_BAR; PG8_SCHED;
            PG8_LDB(B0, 1, 0); PG8_LDB(B1, 1, 1); PG8_SCHED; PG8_LDA(At, 1, 0); PG8_STAGE(PG8_SA(0, 1), a2 + hstep, voffA);
            PG8_WAIT_V(8); PG8_WAIT_L(0); PG8_BAR; PG8_MMA(0, 0, At, B0); PG8_MMA(0, 1, At, B1); PG8_BAR; PG8_SCHED;
            PG8_LDA(At, 1, 1); PG8_STAGE(PG8_SB(1, 0), b3, voffB); PG8_STAGE(PG8_SB(1, 1), b3 + hstep, voffB); PG8_STAGE(PG8_SA(1, 0), a3, voffA);
            PG8_WAIT_V(8); PG8_WAIT_L(0); PG8_BAR; PG8_MMA(1, 0, At, B0); PG8_MMA(1, 1, At, B1); PG8_BAR; PG8_SCHED;
            } else {
            PG8_LDB(B0, 0, 0); PG8_SCHED; PG8_LDA(At, 0, 0); PG8_STAGE(PG8_SA(1, 1), a1 + hstep, voffA);
            PG8_WAIT_L(8); PG8_BAR; PG8_WAIT_L(0); PG8_MMA(0, 0, At, B0); PG8_BAR; PG8_SCHED;
            PG8_LDB(B1, 0, 1); PG8_STAGE(PG8_SB(0, 0), b2, voffB);
            PG8_BAR; PG8_WAIT_L(0); PG8_MMA(0, 1, At, B1); PG8_BAR;
            PG8_LDA(At, 0, 1); PG8_STAGE(PG8_SA(0, 0), a2, voffA);
            PG8_BAR; PG8_WAIT_L(0); PG8_MMA(1, 0, At, B0); PG8_BAR; PG8_SCHED;
            PG8_STAGE(PG8_SB(0, 1), b2 + hstep, voffB);
            PG8_WAIT_V(6); PG8_BAR; PG8_MMA(1, 1, At, B1); PG8_BAR;
            PG8_LDB(B0, 1, 0); PG8_SCHED; PG8_LDA(At, 1, 0); PG8_STAGE(PG8_SA(0, 1), a2 + hstep, voffA);
            PG8_WAIT_L(8); PG8_BAR; PG8_WAIT_L(0); PG8_MMA(0, 0, At, B0); PG8_BAR; PG8_SCHED;
            PG8_LDB(B1, 1, 1); PG8_STAGE(PG8_SB(1, 0), b3, voffB);
            PG8_BAR; PG8_WAIT_L(0); PG8_MMA(0, 1, At, B1); PG8_BAR;
            PG8_LDA(At, 1, 1); PG8_STAGE(PG8_SA(1, 0), a3, voffA);
            PG8_BAR; PG8_WAIT_L(0); PG8_MMA(1, 0, At, B0); PG8_BAR; PG8_SCHED;
            PG8_STAGE(PG8_SB(1, 1), b3 + hstep, voffB);
            PG8_WAIT_V(6); PG8_BAR; PG8_MMA(1, 1, At, B1); PG8_BAR;
            }
        }
        if constexpr (ALIGN_EPI) { if (wr == 0) PG8_BAR; }
        E(acc, cur, wr, wc, fr, fq);
        if (!has_next) break;
#pragma unroll
        for (int a = 0; a < 2; ++a)
#pragma unroll
            for (int b = 0; b < 2; ++b)
#pragma unroll
                for (int m = 0; m < 4; ++m)
#pragma unroll
                    for (int n = 0; n < 2; ++n) acc[a][b][m][n] = (f32x4){0.f, 0.f, 0.f, 0.f};
        cur = nxt; cA = nA; cB = nB; ++ui;
        if constexpr (ALIGN_EPI) { if (wr == 1) PG8_BAR; }
    }
    PG8_WAIT_V(0);
    if constexpr (!ALIGN_EPI) { if (wr == 0) PG8_BAR; }
    PG8_BAR;
#undef PG8_SA
#undef PG8_SB
#undef PG8_STAGE
#undef PG8_LDA
#undef PG8_LDB
#undef PG8_MMA
#undef PG8_WAIT_V
#undef PG8_WAIT_L
#undef PG8_BAR
#undef PG8_SCHED
}
}

struct Args { const float* in[22]; float* out; unsigned char* ws; };

__device__ __forceinline__ void transpose_item(const float* W, int ldw, int col_off, int K, int N, bf16_t* WT, LAS float* scr, int item, int lane) {
    const int nblk = N / 64, kb = item / nblk, nb = item % nblk, k0 = 64 * kb, n0 = 64 * nb;
    const int r = lane >> 4, c4 = lane & 15;
    f32x4 v[16];
#pragma unroll
    for (int i = 0; i < 16; ++i) v[i] = *(const f32x4*)(W + (size_t)(k0 + 4 * i + r) * ldw + col_off + n0 + 4 * c4);
#pragma unroll
    for (int i = 0; i < 16; ++i) { LAS float* d = scr + (4 * i + r) * 65 + 4 * c4; d[0] = v[i].x; d[1] = v[i].y; d[2] = v[i].z; d[3] = v[i].w; }
    asm volatile("s_waitcnt lgkmcnt(0)" ::: "memory");
    const int c = lane & 7;
#pragma unroll
    for (int j = 0; j < 8; ++j) { const int n = (lane >> 3) + 8 * j; const LAS float* s = scr + (8 * c) * 65 + n;
        u32x4 o; o.x = cvt_pk_bf16(s[0 * 65], s[1 * 65]); o.y = cvt_pk_bf16(s[2 * 65], s[3 * 65]); o.z = cvt_pk_bf16(s[4 * 65], s[5 * 65]); o.w = cvt_pk_bf16(s[6 * 65], s[7 * 65]);
        *(u32x4*)(WT + (size_t)(n0 + n) * K + k0 + 8 * c) = o; }
    asm volatile("s_waitcnt lgkmcnt(0)" ::: "memory");
}

__device__ __forceinline__ void s5_tables(LAS unsigned char* lds, const Args& a, int l, int g, int qt, int tid) {
    LAS f32x2* AP = (LAS f32x2*)lds;
    LAS f32x2* BB = AP + 65 * 64;
    LAS f32x2* CC = BB + 64 * 16;
    const int lg = l * 32 + g;
    const float* are = a.in[4] + lg * 64; const float* aim = a.in[5] + lg * 64;
    const float dt = expf(a.in[6][lg]);
    unsigned char* tab = a.ws + WS_S5 + (size_t)l * S5_LAYER;
    for (int idx = tid; idx < 65 * 64; idx += 512) {
        const int d = idx >> 6, p = idx & 63;
        const float lr = fminf(are[p], -1e-4f), li = aim[p];
        const float mag = expf(lr * dt * (float)d);
        double rev = (double)li * (double)dt * (double)d * 0.15915494309189535;
        rev -= floor(rev); if (rev > 0.5) rev -= 1.0;
        const float th = (float)(rev * 6.283185307179586);
        AP[idx] = (f32x2){mag * cosf(th), mag * sinf(th)};
    }
    for (int idx = tid; idx < 1024; idx += 512) CC[idx] = (f32x2){a.in[9][(size_t)lg * 1024 + idx], a.in[10][(size_t)lg * 1024 + idx]};
    for (int idx = tid; idx < 1024; idx += 512) {
        const int p = idx >> 4;
        const float lr = fminf(are[p], -1e-4f), li = aim[p];
        double rev = (double)li * (double)dt * 0.15915494309189535;
        rev -= floor(rev); if (rev > 0.5) rev -= 1.0;
        const float th = (float)(rev * 6.283185307179586);
        const float em1 = expm1f(lr * dt), c = cosf(th), s = sinf(th), sh = sinf(0.5f * th);
        const float nr = em1 * c - 2.f * sh * sh, ni = (1.f + em1) * s;
        const float den = 1.f / (lr * lr + li * li);
        const float qr = (nr * lr + ni * li) * den, qi = (ni * lr - nr * li) * den;
        const float br = a.in[7][(size_t)lg * 1024 + idx], bi = a.in[8][(size_t)lg * 1024 + idx];
        BB[idx] = (f32x2){qr * br - qi * bi, qr * bi + qi * br};
    }
    __syncthreads();
    bf16_t* kt = (bf16_t*)(tab + S5_KT) + (size_t)g * (65 * 256);
    if (tid < 256) { const int s = qt * 256 + tid;
        const int d = s >> 4, h = s & 15;
        float acc[16];
#pragma unroll
        for (int i = 0; i < 16; ++i) acc[i] = 0.f;
        for (int p = 0; p < 64; ++p) {
            const f32x2 cc = CC[h * 64 + p], ap = AP[d * 64 + p];
            const float cr = cc.x * ap.x - cc.y * ap.y, ci = cc.x * ap.y + cc.y * ap.x;
#pragma unroll
            for (int i = 0; i < 16; ++i) { const f32x2 bb = BB[p * 16 + i]; acc[i] += cr * bb.x - ci * bb.y; }
        }
        if (d == 0) { const float dsk = a.in[11][lg * 16 + h];
#pragma unroll
            for (int i = 0; i < 16; ++i) if (i == h) acc[i] += dsk; }
        u32x4 o0, o1;
        o0.x = cvt_pk_bf16(acc[0], acc[1]); o0.y = cvt_pk_bf16(acc[2], acc[3]); o0.z = cvt_pk_bf16(acc[4], acc[5]); o0.w = cvt_pk_bf16(acc[6], acc[7]);
        o1.x = cvt_pk_bf16(acc[8], acc[9]); o1.y = cvt_pk_bf16(acc[10], acc[11]); o1.z = cvt_pk_bf16(acc[12], acc[13]); o1.w = cvt_pk_bf16(acc[14], acc[15]);
        u32x4* dst = (u32x4*)(kt + (size_t)(63 - d) * 256 + h * 16);
        dst[0] = o0; dst[1] = o1;
    }
    if (qt == 0 && tid >= 256 && tid < 288) ((u32x4*)(kt + 64 * 256))[tid - 256] = (u32x4){0u, 0u, 0u, 0u};
    bf16_t* we = (bf16_t*)(tab + S5_WE) + (size_t)g * 128 * 1024;
    for (int idx = qt * 4096 + tid; idx < (qt + 1) * 4096; idx += 512) {
        const int half = idx & 1, j = (idx >> 1) & 63, row = idx >> 7, p = row & 63, im = row >> 6;
        const f32x2 ap = AP[(63 - j) * 64 + p];
        float v[8];
#pragma unroll
        for (int i = 0; i < 8; ++i) { const f32x2 bb = BB[p * 16 + 8 * half + i]; v[i] = im ? (ap.x * bb.y + ap.y * bb.x) : (ap.x * bb.x - ap.y * bb.y); }
        u32x4 o; o.x = cvt_pk_bf16(v[0], v[1]); o.y = cvt_pk_bf16(v[2], v[3]); o.z = cvt_pk_bf16(v[4], v[5]); o.w = cvt_pk_bf16(v[6], v[7]);
        *(u32x4*)(we + (size_t)row * 1024 + j * 16 + 8 * half) = o;
    }
    bf16_t* wc = (bf16_t*)(tab + S5_WC) + (size_t)g * 1024 * 128;
    for (int idx = qt * 4096 + tid; idx < (qt + 1) * 4096; idx += 512) {
        const int kgp = idx & 15, rowi = idx >> 4, t = rowi >> 4, h = rowi & 15, im = kgp >> 3, p0 = (kgp & 7) * 8;
        float v[8];
#pragma unroll
        for (int i = 0; i < 8; ++i) { const f32x2 cc = CC[h * 64 + p0 + i], ap = AP[(t + 1) * 64 + p0 + i];
            v[i] = im ? -(cc.x * ap.y + cc.y * ap.x) : (cc.x * ap.x - cc.y * ap.y); }
        u32x4 o; o.x = cvt_pk_bf16(v[0], v[1]); o.y = cvt_pk_bf16(v[2], v[3]); o.z = cvt_pk_bf16(v[4], v[5]); o.w = cvt_pk_bf16(v[6], v[7]);
        *(u32x4*)(wc + (size_t)rowi * 128 + kgp * 8) = o;
    }
    if (qt == 1 && tid < 64) {
        ((f32x2*)(tab + S5_A64))[g * 64 + tid] = AP[64 * 64 + tid];
        const int k = tid & 15, kg = tid >> 4; const float* wg = a.in[12] + (size_t)lg * 256;
        u32x4 o; o.x = cvt_pk_bf16(wg[(4 * kg + 0) * 16 + k], wg[(4 * kg + 1) * 16 + k]); o.y = cvt_pk_bf16(wg[(4 * kg + 2) * 16 + k], wg[(4 * kg + 3) * 16 + k]); o.z = 0u; o.w = 0u;
        ((u32x4*)(tab + S5_GLU))[g * 64 + tid] = o;
    }
    __syncthreads();
}

struct NormArgs { const float* resid; const bf16_t* add; const float* g_add; float* xout; const float* g_xn; bf16_t* xn; const float* wf; const float* bfh; float* logf; };
__device__ __forceinline__ void norm_phase(LAS unsigned char* lds, const NormArgs n, int gw, int ngw, int lane, int tid) {
    if (n.wf) {
        for (int i = tid; i < 2048; i += 512) { const int d = i >> 1, hh = i & 1; const f32x4 v = *(const f32x4*)(n.wf + (size_t)d * INW + 4 * hh);
            *(LAS f32x4*)(lds + d * 32 + 16 * (d >> 3) + 16 * hh) = v; }
        __syncthreads();
    }
    f32x4 ga[4], gx[4];
#pragma unroll
    for (int j = 0; j < 4; ++j) { ga[j] = n.add ? *(const f32x4*)(n.g_add + 4 * lane + 256 * j) : (f32x4){0.f, 0.f, 0.f, 0.f}; gx[j] = n.xn ? *(const f32x4*)(n.g_xn + 4 * lane + 256 * j) : (f32x4){0.f, 0.f, 0.f, 0.f}; }
    for (int rbase = gw; rbase < M; rbase += 2 * ngw) {
        f32x4 v[2][4]; f32x4 av[2][4];
#pragma unroll
        for (int rr = 0; rr < 2; ++rr) { const size_t row = (size_t)rbase + (size_t)rr * ngw;
#pragma unroll
            for (int j = 0; j < 4; ++j) v[rr][j] = *(const f32x4*)(n.resid + row * DM + 4 * lane + 256 * j);
            if (n.add) {
#pragma unroll
                for (int j = 0; j < 4; ++j) { const u32x2 u = *(const u32x2*)(n.add + row * DM + 4 * lane + 256 * j); av[rr][j] = (f32x4){bf_lo(u.x), bf_hi(u.x), bf_lo(u.y), bf_hi(u.y)}; }
            }
        }
#pragma unroll
        for (int rr = 0; rr < 2; ++rr) { const size_t row = (size_t)rbase + (size_t)rr * ngw;
            if (n.add) {
                float ss = 0.f;
#pragma unroll
                for (int j = 0; j < 4; ++j) ss += (av[rr][j].x * av[rr][j].x + av[rr][j].y * av[rr][j].y) + (av[rr][j].z * av[rr][j].z + av[rr][j].w * av[rr][j].w);
                const float rs = rsqrtf(wave_sum(ss) * (1.f / DM) + EPS);
#pragma unroll
                for (int j = 0; j < 4; ++j) v[rr][j] = v[rr][j] + av[rr][j] * rs * ga[j];
            }
            if (n.xout) {
#pragma unroll
                for (int j = 0; j < 4; ++j) *(f32x4*)(n.xout + row * DM + 4 * lane + 256 * j) = v[rr][j];
            }
            if (n.xn) {
                float ss = 0.f;
#pragma unroll
                for (int j = 0; j < 4; ++j) ss += (v[rr][j].x * v[rr][j].x + v[rr][j].y * v[rr][j].y) + (v[rr][j].z * v[rr][j].z + v[rr][j].w * v[rr][j].w);
                const float rs = rsqrtf(wave_sum(ss) * (1.f / DM) + EPS);
                f32x4 hn[4];
#pragma unroll
                for (int j = 0; j < 4; ++j) { hn[j] = v[rr][j] * rs * gx[j]; u32x2 o; o.x = cvt_pk_bf16(hn[j].x, hn[j].y); o.y = cvt_pk_bf16(hn[j].z, hn[j].w);
                    *(u32x2*)(n.xn + row * DM + 4 * lane + 256 * j) = o; }
                if (n.wf) {
                    f32x4 f0 = (f32x4){0.f, 0.f, 0.f, 0.f}, f1 = f0;
#pragma unroll
                    for (int j = 0; j < 4; ++j)
#pragma unroll
                        for (int i = 0; i < 4; ++i) { const int d = 4 * lane + 256 * j + i; const LAS unsigned char* wp = lds + d * 32 + 16 * (d >> 3);
                            const f32x4 w0 = *(const LAS f32x4*)wp, w1 = *(const LAS f32x4*)(wp + 16); f0 = f0 + w0 * hn[j][i]; f1 = f1 + w1 * hn[j][i]; }
                    float z = 0.f;
#pragma unroll
                    for (int hh = 0; hh < 4; ++hh) { const float s0 = wave_sum(f0[hh]), s1 = wave_sum(f1[hh]); if (lane == hh) z = s0; if (lane == hh + 4) z = s1; }
                    if (lane < 8) { z += n.bfh[lane]; n.logf[row * 8 + lane] = fminf(z, 0.f) - log1pf(expf(-fabsf(z))); }
                }
            }
        }
    }
}

__device__ __forceinline__ void cum_scan(LAS unsigned char* lds, const float* logf, float* cum, int bh, int tid, int lane, int w) {
    LAS float* ws = (LAS float*)lds;
    const int b = bh >> 3, h = bh & 7;
    float v[8]; float run = 0.f;
#pragma unroll
    for (int i = 0; i < 8; ++i) { run += logf[((size_t)b * SEQ + 8 * tid + i) * 8 + h]; v[i] = run; }
    float inc = run;
#pragma unroll
    for (int o = 1; o < 64; o <<= 1) { const float t = __int_as_float(__builtin_amdgcn_ds_bpermute((lane - o) << 2, __float_as_int(inc))); if (lane >= o) inc += t; }
    if (lane == 63) ws[w] = inc;
    __syncthreads();
    float base = inc - run;
    for (int i = 0; i < w; ++i) base += ws[i];
#pragma unroll
    for (int i = 0; i < 8; ++i) cum[(size_t)bh * SEQ + 8 * tid + i] = (base + v[i]) * LOG2E;
    __syncthreads();
}

#define MFMA16(a, b, c) __builtin_amdgcn_mfma_f32_16x16x32_bf16((a), (b), (c), 0, 0, 0)
#define MFMA32(a, b, c) __builtin_amdgcn_mfma_f32_32x32x16_bf16((a), (b), (c), 0, 0, 0)
__device__ __forceinline__ bf16x8 ldg16(const void* ubase, unsigned off) { return *(const bf16x8*)((const char*)ubase + off); }
__device__ __forceinline__ void s5_unit(LAS unsigned char* lds, const bf16_t* P, const unsigned char* tab, bf16_t* Ya, const int b, const int g, int tid, int lane, int w) {
    LAS unsigned char* KT = lds; LAS float* EL = (LAS float*)(lds + 33280); LAS unsigned char* SPT = lds + 66560;
    const unsigned char* ktab = tab + S5_KT + (size_t)g * KT_BYTES;
    const int n = lane & 15, kg = lane >> 4, ntile = w & 3, wh = w >> 2;
    const bf16_t* WEu = (const bf16_t*)(tab + S5_WE) + (size_t)g * 128 * 1024 + (size_t)(64 * wh) * 1024;
    const bf16_t* WCu = (const bf16_t*)(tab + S5_WC) + (size_t)g * 1024 * 128 + (size_t)(wh * 16) * 128;
    const bf16_t* Uu = P + ((size_t)b * SEQ + (size_t)(16 * ntile) * 64) * NA + 16 * g;
    const unsigned uoff = (unsigned)((n * 64 + (kg >> 1)) * NA + 8 * (kg & 1)) * 2u;
    const unsigned weoff = (unsigned)(n * 1024 + 8 * kg) * 2u;
    const unsigned wcoff = (unsigned)(n * 128 + 8 * kg) * 2u;
    for (int i = tid; i < KT_BYTES / 16; i += 512) *(LAS u32x4*)(KT + i * 16) = *(const u32x4*)(ktab + i * 16);
    {
        f32x4 e[4];
#pragma unroll
        for (int mt = 0; mt < 4; ++mt) e[mt] = (f32x4){0.f, 0.f, 0.f, 0.f};
        bf16x8 eb[4], ea[4][4];
#define S5_ELD(ks) do { eb[(ks) & 3] = ldg16(Uu + (size_t)(2 * (ks)) * NA, uoff); _Pragma("unroll") for (int _m = 0; _m < 4; ++_m) ea[(ks) & 3][_m] = ldg16(WEu + (size_t)(16 * _m) * 1024 + 32 * (ks), weoff); } while (0)
        S5_ELD(0); S5_ELD(1); S5_ELD(2);
        __builtin_amdgcn_sched_barrier(0);
#pragma unroll
        for (int ks = 0; ks < 32; ++ks) {
            if (ks + 3 < 32) S5_ELD(ks + 3);
#pragma unroll
            for (int mt = 0; mt < 4; ++mt) e[mt] = MFMA16(ea[ks & 3][mt], eb[ks & 3], e[mt]);
            __builtin_amdgcn_sched_barrier(0);
        }
#undef S5_ELD
#pragma unroll
        for (int mt = 0; mt < 4; ++mt)
#pragma unroll
            for (int i = 0; i < 4; ++i) EL[(64 * wh + 16 * mt + 4 * kg + i) * 65 + 16 * ntile + n] = e[mt][i];
    }
    __syncthreads();
    {
        const int p = tid & 63, seg = tid >> 6;
        const f32x2 a1 = ((const f32x2*)(tab + S5_A64))[g * 64 + p];
        float lr[8], li[8]; float sr = 0.f, si = 0.f;
#pragma unroll
        for (int j = 0; j < 8; ++j) { const float er = EL[p * 65 + 8 * seg + j], ei = EL[(64 + p) * 65 + 8 * seg + j];
            const float nr = a1.x * sr - a1.y * si + er, ni = a1.x * si + a1.y * sr + ei; sr = nr; si = ni; lr[j] = sr; li[j] = si; }
        LAS f32x2* TT = (LAS f32x2*)(lds + 66560 + 17408);
        TT[seg * 64 + p] = (f32x2){sr, si};
        f32x2 a2 = {a1.x * a1.x - a1.y * a1.y, 2.f * a1.x * a1.y}; f32x2 a4 = {a2.x * a2.x - a2.y * a2.y, 2.f * a2.x * a2.y}; const f32x2 a8 = {a4.x * a4.x - a4.y * a4.y, 2.f * a4.x * a4.y};
        __syncthreads();
        float cr = 0.f, ci = 0.f;
        for (int s2 = 0; s2 < seg; ++s2) { const f32x2 t = TT[s2 * 64 + p]; const float nr = a8.x * cr - a8.y * ci + t.x, ni = a8.x * ci + a8.y * cr + t.y; cr = nr; ci = ni; }
        float pr = cr, pi = ci, wr_ = cr, wi_ = ci;
#pragma unroll
        for (int j = 0; j < 8; ++j) {
            *(LAS bf16_t*)(SPT + (8 * seg + j) * 272 + 2 * p) = (bf16_t)(cvt_pk_bf16(pr, 0.f) & 0xffffu);
            *(LAS bf16_t*)(SPT + (8 * seg + j) * 272 + 2 * (64 + p)) = (bf16_t)(cvt_pk_bf16(pi, 0.f) & 0xffffu);
            const float nr = a1.x * wr_ - a1.y * wi_, ni = a1.x * wi_ + a1.y * wr_; wr_ = nr; wi_ = ni;
            pr = lr[j] + wr_; pi = li[j] + wi_;
        }
    }
    __syncthreads();
    const LAS unsigned char* klow = KT + (1 - wh + (lane >> 5)) * 512 + (lane & 15) * 32 + ((lane >> 4) & 1) * 16;
    const LAS unsigned char* spb = SPT + (16 * ntile + n) * 272 + 16 * kg;
    const bf16x8 aglu = *(const bf16x8*)(tab + S5_GLU + (size_t)(g * 64 + lane) * 16);
    const unsigned yoff = (unsigned)(n * 64 * YW + 4 * kg) * 2u;
#pragma unroll 1
    for (int pass = 0; pass < 2; ++pass) {
        f32x4 acc[16];
#pragma unroll
        for (int i = 0; i < 16; ++i) acc[i] = (f32x4){0.f, 0.f, 0.f, 0.f};
        bf16x8 bq[4], ca[2][4], bt[8], bu[8];
        const bf16_t* Up = Uu + (size_t)(32 * pass) * NA;
        const bf16_t* WCp = WCu + (size_t)(32 * pass) * 2048;
#define S5_LDC(st, slot) do { _Pragma("unroll") for (int _q = 0; _q < 4; ++_q) ca[slot][_q] = ldg16(WCp + (size_t)(2 * (4 * ((st) & 3) + _q)) * 2048 + 32 * ((st) >> 2), wcoff); } while (0)
#pragma unroll
        for (int jj = 0; jj < 8; ++jj) bt[jj] = ldg16(Up + (size_t)(2 * jj) * NA, uoff);
        S5_LDC(0, 0); S5_LDC(1, 1);
        if (pass == 1) {
            bq[0] = ldg16(Uu, uoff); bq[1] = ldg16(Uu + (size_t)2 * NA, uoff); bq[2] = ldg16(Uu + (size_t)4 * NA, uoff);
            __builtin_amdgcn_sched_barrier(0);
#pragma unroll
            for (int jj = 0; jj < 16; ++jj) {
                if (jj + 3 < 16) bq[(jj + 3) & 3] = ldg16(Uu + (size_t)(2 * (jj + 3)) * NA, uoff);
#pragma unroll
                for (int ii = 0; ii < 16; ++ii) { const bf16x8 af = *(const LAS bf16x8*)(klow + (30 - 2 * (ii - jj)) * 512); acc[ii] = MFMA16(af, bq[jj & 3], acc[ii]); }
                __builtin_amdgcn_sched_barrier(0);
            }
        }
        __builtin_amdgcn_sched_barrier(0);
#pragma unroll
        for (int jj = 0; jj < 16; ++jj) {
            const bf16x8 cb = *(const LAS bf16x8*)(spb + 64 * (jj >> 2));
            if (jj < 8) bu[jj] = ldg16(Up + (size_t)(2 * (jj + 8)) * NA, uoff);
#pragma unroll
            for (int ii = 0; ii < 16; ++ii) if (ii >= jj) { const bf16x8 af = *(const LAS bf16x8*)(klow + (62 - 2 * (ii - jj)) * 512); acc[ii] = MFMA16(af, (jj < 8 ? bt[jj & 7] : bu[jj & 7]), acc[ii]); }
#pragma unroll
            for (int q = 0; q < 4; ++q) acc[4 * (jj & 3) + q] = MFMA16(ca[jj & 1][q], cb, acc[4 * (jj & 3) + q]);
            __builtin_amdgcn_sched_barrier(0);
            if (jj + 2 < 16) S5_LDC(jj + 2, jj & 1);
            __builtin_amdgcn_sched_barrier(0);
        }
#undef S5_LDC
        bf16_t* Yu = Ya + ((size_t)b * SEQ + (size_t)(16 * ntile) * 64 + wh + 32 * pass) * YW + 16 * g;
#pragma unroll
        for (int ii = 0; ii < 16; ++ii) {
            f32x4 y;
#pragma unroll
            for (int k = 0; k < 4; ++k) y[k] = gelu_tanh(acc[ii][k]);
            u32x4 bp; bp.x = cvt_pk_bf16(y[0], y[1]); bp.y = cvt_pk_bf16(y[2], y[3]); bp.z = 0u; bp.w = 0u;
            const f32x4 z = MFMA16(aglu, __builtin_bit_cast(bf16x8, bp), ((f32x4){0.f, 0.f, 0.f, 0.f}));
            u32x2 o; o.x = cvt_pk_bf16(y[0] * sigmoid_f(z[0]), y[1] * sigmoid_f(z[1])); o.y = cvt_pk_bf16(y[2] * sigmoid_f(z[2]), y[3] * sigmoid_f(z[3]));
            *(u32x2*)((char*)(Yu + (size_t)(2 * ii) * YW) + yoff) = o;
        }
    }
    __syncthreads();
}

constexpr int AT_KS = 0, AT_VT = 9216, AT_BS = 9216 + 8704, AT_BUF = 9216 + 8704 + 256;
__device__ __forceinline__ int crow(int r, int hi) { return (r & 3) + 8 * (r >> 2) + 4 * hi; }
__device__ __forceinline__ void attn_unit(LAS unsigned char* lds, const bf16_t* P, const float* cum, bf16_t* Yc, const int b, const int h, const int qb, int tid, int lane, int w) {
    const int r32 = lane & 31, hi = lane >> 5;
    const size_t row0 = (size_t)b * SEQ;
    const int q0 = qb * 256, qrow = q0 + 32 * w + r32;
    bf16x8 qf[4];
    { const bf16_t* qp = P + (row0 + qrow) * NA + COL_Q + 64 * h + 8 * hi;
#pragma unroll
      for (int s = 0; s < 4; ++s) qf[s] = *(const bf16x8*)(qp + 16 * s); }
    const float* cumbh = cum + (size_t)(b * 8 + h) * SEQ;
    const float ref = cumbh[q0];
    const int skey = tid >> 3, spc = tid & 7;
    const bf16_t* kgp = P + (row0 + skey) * NA + COL_K + 64 * h + 8 * spc;
    const int NT = 4 * qb + 4;
    u32x4 kreg = *(const u32x4*)kgp, vreg = *(const u32x4*)(kgp + (COL_V - COL_K)); float breg = 0.f; if (tid < 64) breg = ref - cumbh[tid];
#define AT_WRITE(bufp) do { LAS unsigned char* _b = (bufp); *(LAS u32x4*)(_b + AT_KS + skey * 144 + 16 * spc) = kreg; \
        LAS bf16_t* _v = (LAS bf16_t*)(_b + AT_VT) + (8 * spc) * 68 + skey; \
        _v[0 * 68] = (bf16_t)(vreg.x & 0xffffu); _v[1 * 68] = (bf16_t)(vreg.x >> 16); _v[2 * 68] = (bf16_t)(vreg.y & 0xffffu); _v[3 * 68] = (bf16_t)(vreg.y >> 16); \
        _v[4 * 68] = (bf16_t)(vreg.z & 0xffffu); _v[5 * 68] = (bf16_t)(vreg.z >> 16); _v[6 * 68] = (bf16_t)(vreg.w & 0xffffu); _v[7 * 68] = (bf16_t)(vreg.w >> 16); \
        if (tid < 64) *(LAS float*)(_b + AT_BS + 4 * tid) = breg; } while (0)
    AT_WRITE(lds);
    __syncthreads();
    float mrun = -1e30f, lrun = 0.f; f32x16 o0, o1;
#pragma unroll
    for (int r = 0; r < 16; ++r) { o0[r] = 0.f; o1[r] = 0.f; }
    for (int kt = 0; kt < NT; ++kt) {
        const int cur = kt & 1; const bool more = (kt + 1 < NT);
        if (more) { const bf16_t* kp = kgp + (size_t)(kt + 1) * 64 * NA; kreg = *(const u32x4*)kp; vreg = *(const u32x4*)(kp + (COL_V - COL_K)); if (tid < 64) breg = ref - cumbh[64 * (kt + 1) + tid]; }
        if (64 * kt <= q0 + 32 * w + 31) {
            const LAS unsigned char* Kb = lds + cur * AT_BUF + AT_KS; const LAS unsigned char* Vb = lds + cur * AT_BUF + AT_VT; const LAS unsigned char* Bb = lds + cur * AT_BUF + AT_BS;
            f32x16 p[2];
#pragma unroll
            for (int rb = 0; rb < 2; ++rb) {
                f32x16 c;
#pragma unroll
                for (int g4 = 0; g4 < 4; ++g4) { const f32x4 bv = *(const LAS f32x4*)(Bb + (32 * rb + 8 * g4 + 4 * hi) * 4); c[4 * g4 + 0] = bv.x; c[4 * g4 + 1] = bv.y; c[4 * g4 + 2] = bv.z; c[4 * g4 + 3] = bv.w; }
#pragma unroll
                for (int s = 0; s < 4; ++s) { const bf16x8 af = *(const LAS bf16x8*)(Kb + (32 * rb + r32) * 144 + 32 * s + 16 * hi); c = MFMA32(af, qf[s], c); }
                p[rb] = c;
            }
            if (64 * kt + 63 > q0 + 32 * w) {
#pragma unroll
                for (int rb = 0; rb < 2; ++rb)
#pragma unroll
                    for (int r = 0; r < 16; ++r) { const int key = 64 * kt + 32 * rb + crow(r, hi); if (key > qrow) p[rb][r] = -1e30f; }
            }
            float mt = p[0][0];
#pragma unroll
            for (int r = 1; r < 16; ++r) mt = fmaxf(mt, p[0][r]);
#pragma unroll
            for (int r = 0; r < 16; ++r) mt = fmaxf(mt, p[1][r]);
            mt = half_max(mt);
            const float mnew = fmaxf(mrun, mt), alpha = fast_exp2(mrun - mnew);
            mrun = mnew;
            float ls = 0.f;
#pragma unroll
            for (int rb = 0; rb < 2; ++rb)
#pragma unroll
                for (int r = 0; r < 16; ++r) { p[rb][r] = fast_exp2(p[rb][r] - mnew); ls += p[rb][r]; }
            lrun = lrun * alpha + ls;
#pragma unroll
            for (int r = 0; r < 16; ++r) { o0[r] *= alpha; o1[r] *= alpha; }
            bf16x8 pf[4];
#pragma unroll
            for (int s = 0; s < 4; ++s) { const int rb = s >> 1, r0 = 8 * (s & 1); u32x4 pk; pk.x = cvt_pk_bf16(p[rb][r0 + 0], p[rb][r0 + 1]); pk.y = cvt_pk_bf16(p[rb][r0 + 2], p[rb][r0 + 3]);
                pk.z = cvt_pk_bf16(p[rb][r0 + 4], p[rb][r0 + 5]); pk.w = cvt_pk_bf16(p[rb][r0 + 6], p[rb][r0 + 7]); pf[s] = __builtin_bit_cast(bf16x8, pk); }
#pragma unroll
            for (int s = 0; s < 4; ++s) {
                { const LAS unsigned char* vp = Vb + r32 * 136 + 2 * (16 * s + 4 * hi); const s16x4 lo = *(const LAS s16x4*)vp, hh = *(const LAS s16x4*)(vp + 16);
                  const bf16x8 af = __builtin_shufflevector(lo, hh, 0, 1, 2, 3, 4, 5, 6, 7); o0 = MFMA32(af, pf[s], o0); }
                { const LAS unsigned char* vp = Vb + (32 + r32) * 136 + 2 * (16 * s + 4 * hi); const s16x4 lo = *(const LAS s16x4*)vp, hh = *(const LAS s16x4*)(vp + 16);
                  const bf16x8 af = __builtin_shufflevector(lo, hh, 0, 1, 2, 3, 4, 5, 6, 7); o1 = MFMA32(af, pf[s], o1); }
            }
        }
        if (more) AT_WRITE(lds + (cur ^ 1) * AT_BUF);
        __syncthreads();
    }
#undef AT_WRITE
    const float ltot = half_sum(lrun);
    const float inv = 1.0f / ltot;
    bf16_t* op = Yc + (row0 + qrow) * YW + 64 * h + 4 * hi;
#pragma unroll
    for (int g4 = 0; g4 < 4; ++g4) {
        u32x2 a, c2;
        a.x = cvt_pk_bf16(o0[4 * g4 + 0] * inv, o0[4 * g4 + 1] * inv); a.y = cvt_pk_bf16(o0[4 * g4 + 2] * inv, o0[4 * g4 + 3] * inv);
        c2.x = cvt_pk_bf16(o1[4 * g4 + 0] * inv, o1[4 * g4 + 1] * inv); c2.y = cvt_pk_bf16(o1[4 * g4 + 2] * inv, o1[4 * g4 + 3] * inv);
        *(u32x2*)(op + 8 * g4) = a; *(u32x2*)(op + 32 + 8 * g4) = c2;
    }
}

__device__ __forceinline__ u32x4 conv_item(const bf16_t* P, const float* cw, int item) {
    const int token = item >> 6, c0 = (item & 63) * 8, t = token & (SEQ - 1);
    float acc[8];
#pragma unroll
    for (int i = 0; i < 8; ++i) acc[i] = 0.f;
    u32x4 xc[3], cc[3];
#pragma unroll
    for (int tap = 0; tap < 3; ++tap) {
        const bool ok = (t - 2 + tap >= 0);
        const bf16_t* rp = P + (size_t)(ok ? token - 2 + tap : token) * NA + c0;
        xc[tap] = *(const u32x4*)(rp + COL_XC); cc[tap] = *(const u32x4*)(rp + COL_CC);
        if (!ok) { xc[tap] = (u32x4){0u, 0u, 0u, 0u}; }
    }
    const u32x4 bc = *(const u32x4*)(P + (size_t)token * NA + COL_BC + c0);
#pragma unroll
    for (int tap = 0; tap < 3; ++tap) {
        const f32x4 w0 = *(const f32x4*)(cw + tap * 512 + c0), w1 = *(const f32x4*)(cw + tap * 512 + c0 + 4);
        const u32x4 x = xc[tap], c = cc[tap];
        acc[0] += w0.x * bf_lo(x.x) * bf_lo(c.x); acc[1] += w0.y * bf_hi(x.x) * bf_hi(c.x); acc[2] += w0.z * bf_lo(x.y) * bf_lo(c.y); acc[3] += w0.w * bf_hi(x.y) * bf_hi(c.y);
        acc[4] += w1.x * bf_lo(x.z) * bf_lo(c.z); acc[5] += w1.y * bf_hi(x.z) * bf_hi(c.z); acc[6] += w1.z * bf_lo(x.w) * bf_lo(c.w); acc[7] += w1.w * bf_hi(x.w) * bf_hi(c.w);
    }
    u32x4 o; o.x = cvt_pk_bf16(acc[0] * bf_lo(bc.x), acc[1] * bf_hi(bc.x)); o.y = cvt_pk_bf16(acc[2] * bf_lo(bc.y), acc[3] * bf_hi(bc.y));
    o.z = cvt_pk_bf16(acc[4] * bf_lo(bc.z), acc[5] * bf_hi(bc.z)); o.w = cvt_pk_bf16(acc[6] * bf_lo(bc.w), acc[7] * bf_hi(bc.w));
    return o;
}
__device__ __forceinline__ void conv_phase(const bf16_t* P, const float* cw, bf16_t* Yb, int gtid, int ngt) {
    for (int item = gtid; item < M * 64; item += 4 * ngt) {
        u32x4 o[4];
#pragma unroll
        for (int q = 0; q < 4; ++q) o[q] = conv_item(P, cw, item + q * ngt);
#pragma unroll
        for (int q = 0; q < 4; ++q) { const int it = item + q * ngt; *(u32x4*)(Yb + (size_t)(it >> 6) * YW + (it & 63) * 8) = o[q]; }
    }
}

__device__ __forceinline__ void grid_barrier(cg::grid_group& grid) {
    asm volatile("s_waitcnt vmcnt(0) lgkmcnt(0)" ::: "memory");
    __syncthreads();
    grid.sync();
    if (threadIdx.x == 0) { __builtin_amdgcn_fence(__ATOMIC_ACQUIRE, "agent"); asm volatile("s_waitcnt vmcnt(0)" ::: "memory"); }
    __syncthreads();
}

#ifndef DIAG_STAGE
#define DIAG_STAGE 0
#endif
__device__ __forceinline__ void diag_dump(float* out, const bf16_t* src, int ld, int ncols) {
    for (size_t i = (size_t)blockIdx.x * 512 + threadIdx.x; i < (size_t)M * DM; i += (size_t)gridDim.x * 512) {
        const size_t row = i >> 10; const int c = (int)(i & 1023); float v = 0.f;
        for (int cc = c; cc < ncols; cc += 1024) v += bf_lo((unsigned)src[row * ld + cc]);
        out[i] = v;
    }
}
#define DIAG(k, src, ld, ncols) do { if (DIAG_STAGE == (k)) { grid_barrier(grid); diag_dump(a.out, (src), (ld), (ncols)); return; } } while (0)

__global__ void __launch_bounds__(512, 2) fwd_kernel(Args a) {
    extern __shared__ __attribute__((aligned(16))) unsigned char lds_raw[];
    LAS unsigned char* lds = (LAS unsigned char*)lds_raw;
    cg::grid_group grid = cg::this_grid();
    const int G = gridDim.x, bid = blockIdx.x, ngw = G * 8;
#define FRESH() const int tid = launder_i(threadIdx.x), lane = tid & 63, w = __builtin_amdgcn_readfirstlane(tid >> 6), gw = bid * 8 + w; (void)lane; (void)gw
    unsigned char* ws = a.ws;
    bf16_t* XN = (bf16_t*)(ws + WS_XN); bf16_t* PR = (bf16_t*)(ws + WS_P); bf16_t* Y = (bf16_t*)(ws + WS_Y);
    float* LOGF = (float*)(ws + WS_LOGF); float* CUM = (float*)(ws + WS_CUM);

    {
        FRESH();
#ifndef NO_TAB
        for (int u = bid; u < 256; u += G) s5_tables(lds, a, u >> 7, (u >> 2) & 31, u & 3, tid);
#endif
        LAS float* scr = (LAS float*)(lds + w * 16640);
        constexpr int I_A = 16 * 56, I_G = 16 * 48, I_B = 8 * 16, I_O = 16 * 16, I_1 = 16 * 64, I_2 = 64 * 16, I_L = I_A + I_G + 3 * I_B + I_O + I_1 + I_2;
        for (int it = gw; it < 2 * I_L; it += ngw) {
            const int l = it / I_L; int r = it - l * I_L;
            unsigned char* wl = ws + WS_W + (size_t)l * W_LAYER;
            const float* win = a.in[2] + (size_t)l * DM * INW;
            if (r < I_A) { transpose_item(win, INW, 0, DM, NA, (bf16_t*)(wl + W_INA), scr, r, lane); continue; } r -= I_A;
            if (r < I_G) { transpose_item(win, INW, COL_G, DM, NG, (bf16_t*)(wl + W_G), scr, r, lane); continue; } r -= I_G;
            if (r < 3 * I_B) { const int br = r / I_B; transpose_item(a.in[15] + (size_t)l * 1536 * DM + (size_t)br * 512 * DM, DM, 0, 512, DM, (bf16_t*)(wl + W_BR) + (size_t)br * DM * 512, scr, r - br * I_B, lane); continue; } r -= 3 * I_B;
            if (r < I_O) { transpose_item(a.in[16] + (size_t)l * DM * DM, DM, 0, DM, DM, (bf16_t*)(wl + W_OUT), scr, r, lane); continue; } r -= I_O;
            if (r < I_1) { transpose_item(a.in[19] + (size_t)l * DM * FF, FF, 0, DM, FF, (bf16_t*)(wl + W_1), scr, r, lane); continue; } r -= I_1;
            transpose_item(a.in[20] + (size_t)l * FF * DM, DM, 0, FF, DM, (bf16_t*)(wl + W_2), scr, r, lane);
        }
        __syncthreads();
        NormArgs n{a.in[0], nullptr, nullptr, nullptr, a.in[1], XN, a.in[2] + COL_F, a.in[14], LOGF};
        norm_phase(lds, n, gw, ngw, lane, tid);
    }
    grid_barrier(grid);

    DIAG(1, XN, DM, DM);
#pragma unroll 1
    for (int l = 0; l < DEPTH; ++l) {
        unsigned char* wl = ws + WS_W + (size_t)l * W_LAYER;
        const unsigned char* s5tab = ws + WS_S5 + (size_t)l * S5_LAYER;
        const float* xin = (l == 0) ? a.in[0] : a.out;

        { FRESH(); for (int bh = bid; bh < 64; bh += G) cum_scan(lds, LOGF, CUM, bh, tid, lane, w); }
        {
            pg8::Gemm g{XN, (const bf16_t*)(wl + W_INA), M, NA, DM, 0, 0}; pg8::StaticOrder S; S.init(M, NA, G, bid, 1);
            pg8::Epi<pg8::EPI_PROJ> E{PR, NA, nullptr, nullptr};
#if (PHMASK >> 0) & 1
            pg8::gemm_phase<pg8::Epi<pg8::EPI_PROJ>, pg8::StaticOrder, true, true>(lds, g, S, E);
#endif
        }
        grid_barrier(grid);

        DIAG(2, PR, NA, NA);
#ifndef NO_S5
        { FRESH(); for (int v = bid; v < 256; v += G) s5_unit(lds, PR, s5tab, Y, v >> 5, v & 31, tid, lane, w); }
#endif
#ifndef NO_ATTN
        for (int v = bid; v < 256; v += G) {
            FRESH(); const int bh = v >> 2, s = v & 3;
#pragma unroll 1
            for (int k = 0; k < 4; ++k) { const int qb = (k == 0) ? 15 - s : (k == 1) ? s : (k == 2) ? 11 - s : s + 4;
                attn_unit(lds, PR, CUM, Y + 2 * (size_t)M * YW, bh >> 3, bh & 7, qb, tid, lane, w); }
        }
#endif
        { FRESH(); conv_phase(PR, a.in[13] + (size_t)l * 3 * 512, Y + (size_t)M * YW, bid * 512 + tid, G * 512); }
        grid_barrier(grid);

        if (DIAG_STAGE == 3) { grid_barrier(grid); for (size_t i = (size_t)blockIdx.x * 512 + threadIdx.x; i < (size_t)M * DM; i += (size_t)gridDim.x * 512) { const size_t row = i >> 10; const int c = (int)(i & 511); a.out[i] = bf_lo((unsigned)Y[row * YW + c]) + bf_lo((unsigned)Y[(size_t)M * YW + row * YW + c]) + bf_lo((unsigned)Y[2 * (size_t)M * YW + row * YW + c]); } return; }
        DIAG(31, Y + (size_t)M * YW, YW, YW); DIAG(32, Y + 2 * (size_t)M * YW, YW, YW);
        {
            pg8::Gemm g{XN, (const bf16_t*)(wl + W_G), M, NG, DM, 0, 0}; pg8::StaticOrder S; S.init(M, NG, G, bid, 1);
            pg8::Epi<pg8::EPI_GATE> E{PR, NG, a.in[3] + (size_t)l * NG, nullptr};
#if (PHMASK >> 1) & 1
            pg8::gemm_phase<pg8::Epi<pg8::EPI_GATE>, pg8::StaticOrder, true, true>(lds, g, S, E);
#endif
        }
        grid_barrier(grid);

        DIAG(4, PR, NG, NG);
        {
            pg8::Gemm g{Y, (const bf16_t*)(wl + W_BR), M, DM, 512, (size_t)M * YW * 2, (size_t)DM * 512 * 2}; pg8::StaticOrder S; S.init(M, DM, G, bid, 3);
            pg8::Epi<pg8::EPI_BRANCH> E{XN, DM, nullptr, PR};
#if (PHMASK >> 2) & 1
            pg8::gemm_phase<pg8::Epi<pg8::EPI_BRANCH>, pg8::StaticOrder, true, true>(lds, g, S, E);
#endif
        }
        grid_barrier(grid);

        DIAG(5, XN, DM, DM);
        {
            pg8::Gemm g{XN, (const bf16_t*)(wl + W_OUT), M, DM, DM, 0, 0}; pg8::StaticOrder S; S.init(M, DM, G, bid, 1);
            pg8::Epi<pg8::EPI_PLAIN> E{PR, DM, nullptr, nullptr};
#if (PHMASK >> 3) & 1
            pg8::gemm_phase<pg8::Epi<pg8::EPI_PLAIN>, pg8::StaticOrder, true, true>(lds, g, S, E);
#endif
        }
        grid_barrier(grid);

        DIAG(6, PR, DM, DM);
        {
            FRESH(); NormArgs n{xin, PR, a.in[17] + (size_t)l * DM, a.out, a.in[18] + (size_t)l * DM, XN, nullptr, nullptr, nullptr};
            norm_phase(lds, n, gw, ngw, lane, tid);
        }
        grid_barrier(grid);

        DIAG(7, XN, DM, DM);
        {
            pg8::Gemm g{XN, (const bf16_t*)(wl + W_1), M, FF, DM, 0, 0}; pg8::StaticOrder S; S.init(M, FF, G, bid, 1);
            pg8::Epi<pg8::EPI_RELU2> E{PR, FF, nullptr, nullptr};
#if (PHMASK >> 4) & 1
            pg8::gemm_phase<pg8::Epi<pg8::EPI_RELU2>, pg8::StaticOrder, true, true>(lds, g, S, E);
#endif
        }
        grid_barrier(grid);

        DIAG(8, PR, FF, FF);
        {
            pg8::Gemm g{PR, (const bf16_t*)(wl + W_2), M, DM, FF, 0, 0}; pg8::StaticOrder S; S.init(M, DM, G, bid, 1);
            pg8::Epi<pg8::EPI_PLAIN> E{XN, DM, nullptr, nullptr};
#if (PHMASK >> 5) & 1
            pg8::gemm_phase<pg8::Epi<pg8::EPI_PLAIN>, pg8::StaticOrder, true, true>(lds, g, S, E);
#endif
        }
        grid_barrier(grid);

        DIAG(9, XN, DM, DM);
        if (l + 1 < DEPTH) {
            FRESH(); NormArgs n{a.out, XN, a.in[21] + (size_t)l * DM, a.out, a.in[1] + (size_t)(l + 1) * DM, XN, a.in[2] + (size_t)(l + 1) * DM * INW + COL_F, a.in[14] + (l + 1) * 8, LOGF};
            norm_phase(lds, n, gw, ngw, lane, tid);
            grid_barrier(grid);
        } else {
            FRESH(); NormArgs n{a.out, XN, a.in[21] + (size_t)l * DM, a.out, nullptr, nullptr, nullptr, nullptr, nullptr};
            norm_phase(lds, n, gw, ngw, lane, tid);
        }
    }
}

extern "C" void kernel_launch(void* const* d_in, const int* in_sizes, int n_in, void* d_out, int out_size, void* d_ws, size_t ws_size, hipStream_t stream) {
    static int grid = 0;
    if (grid == 0) {
        if (n_in != 22 || in_sizes[0] != M * DM || out_size != M * DM || ws_size < WS_END) { fprintf(stderr, "kernel_launch: unexpected shapes (n_in %d, in0 %d, out %d, ws %zu)\n", n_in, n_in > 0 ? in_sizes[0] : -1, out_size, ws_size); grid = -1; return; }
        int dev = 0, cus = 0, per_cu = 0;
        (void)hipGetDevice(&dev);
        (void)hipDeviceGetAttribute(&cus, hipDeviceAttributeMultiprocessorCount, dev);
        if (hipFuncSetAttribute((const void*)fwd_kernel, hipFuncAttributeMaxDynamicSharedMemorySize, LDS_BYTES) != hipSuccess) fprintf(stderr, "kernel_launch: hipFuncSetAttribute failed\n");
        if (hipOccupancyMaxActiveBlocksPerMultiprocessor(&per_cu, (const void*)fwd_kernel, 512, LDS_BYTES) != hipSuccess || per_cu < 1) { fprintf(stderr, "kernel_launch: occupancy query gave %d\n", per_cu); per_cu = 1; }
        (void)hipGetLastError();
        grid = cus * per_cu; if (grid > 256) grid = 256; if (grid < 1) grid = 256;
    }
    if (grid < 0) return;
    Args a{};
    for (int i = 0; i < 22; ++i) a.in[i] = (const float*)d_in[i];
    a.out = (float*)d_out; a.ws = (unsigned char*)d_ws;
    void* args[] = {&a};
    hipError_t e = hipLaunchCooperativeKernel((const void*)fwd_kernel, dim3(grid), dim3(512), args, LDS_BYTES, stream);
    if (e != hipSuccess) fprintf(stderr, "kernel_launch: cooperative launch failed: %s (grid %d)\n", hipGetErrorString(e), grid);
}
```

```cpp
#include <hip/hip_runtime.h>
#include <hip/hip_cooperative_groups.h>
#include <cstdio>
#include <cstdint>
namespace cg = cooperative_groups;

#define DIAG_STAGE 0
#ifndef PHMASK
#define PHMASK 0xff
#endif

#define LAS __attribute__((address_space(3)))
typedef unsigned short bf16_t;
typedef short bf16x8 __attribute__((ext_vector_type(8)));
typedef short s16x4 __attribute__((ext_vector_type(4)));
typedef float f32x2 __attribute__((ext_vector_type(2)));
typedef float f32x4 __attribute__((ext_vector_type(4)));
typedef float f32x16 __attribute__((ext_vector_type(16)));
typedef unsigned u32x2 __attribute__((ext_vector_type(2)));
typedef unsigned u32x4 __attribute__((ext_vector_type(4)));

constexpr int BATCH = 8, SEQ = 4096, DM = 1024, M = BATCH * SEQ, DEPTH = 2;
constexpr int INW = 6664, NA = 3584, NG = 3072, FF = 4096, YW = 512;
constexpr int COL_XC = 512, COL_BC = 1024, COL_CC = 1536, COL_Q = 2048, COL_K = 2560, COL_V = 3072, COL_F = 3584, COL_G = 3592;
constexpr float EPS = 1e-6f;
constexpr float LOG2E = 1.4426950408889634f;
constexpr float C2 = 0.125f * LOG2E;

constexpr size_t MiB = 1u << 20;
constexpr size_t WS_W = 1 * MiB, W_LAYER = 34 * MiB;
constexpr size_t W_INA = 0, W_G = 7 * MiB, W_BR = 13 * MiB, W_OUT = 16 * MiB, W_1 = 18 * MiB, W_2 = 26 * MiB;
constexpr size_t WS_S5 = 69 * MiB, S5_LAYER = 17 * MiB + 512 * 1024;
constexpr size_t S5_KT = 0, S5_WE = MiB + 256 * 1024, S5_WC = S5_WE + 8 * MiB, S5_A64 = S5_WC + 8 * MiB, S5_GLU = S5_A64 + 64 * 1024;
constexpr size_t WS_LOGF = 104 * MiB, WS_CUM = 105 * MiB, WS_XN = 106 * MiB, WS_P = 170 * MiB, WS_Y = 394 * MiB, WS_END = 490 * MiB;
constexpr int KT_BYTES = 65 * 512;

constexpr int LDS_BYTES = 147456;

typedef __bf16 bf16x2_t __attribute__((ext_vector_type(2)));
__device__ __forceinline__ unsigned cvt_pk_bf16(float lo, float hi) { const f32x2 v = {lo, hi}; const bf16x2_t b = __builtin_convertvector(v, bf16x2_t); return __builtin_bit_cast(unsigned, b); }
__device__ __forceinline__ float bf_lo(unsigned u) { return __uint_as_float(u << 16); }
__device__ __forceinline__ float bf_hi(unsigned u) { return __uint_as_float(u & 0xffff0000u); }
template <int O> __device__ __forceinline__ float swz_xor(float v) { return __int_as_float(__builtin_amdgcn_ds_swizzle(__float_as_int(v), (O << 10) | 0x1f)); }
__device__ __forceinline__ float half_sum(float v) { auto rr = __builtin_amdgcn_permlane32_swap(__float_as_uint(v), __float_as_uint(v), false, false); return __uint_as_float(rr[0]) + __uint_as_float(rr[1]); }
__device__ __forceinline__ float half_max(float v) { auto rr = __builtin_amdgcn_permlane32_swap(__float_as_uint(v), __float_as_uint(v), false, false); return fmaxf(__uint_as_float(rr[0]), __uint_as_float(rr[1])); }
__device__ __forceinline__ float wave_sum(float v) {
    v += swz_xor<1>(v); v += swz_xor<2>(v); v += swz_xor<4>(v); v += swz_xor<8>(v); v += swz_xor<16>(v);
    return half_sum(v);
}
__device__ __forceinline__ int launder_i(int x) { asm volatile("" : "+v"(x)); return x; }
__device__ __forceinline__ float fast_exp2(float x) { return __builtin_amdgcn_exp2f(x); }
__device__ __forceinline__ float fast_rcp(float x) { return __builtin_amdgcn_rcpf(x); }
__device__ __forceinline__ float sigmoid_f(float z) { return fast_rcp(1.0f + fast_exp2(-LOG2E * z)); }
__device__ __forceinline__ float gelu_tanh(float y) { const float t = y + 0.044715f * y * y * y; return y * fast_rcp(1.0f + fast_exp2(-2.302208198f * t)); }

namespace pg8 {
#define PG8_LAS __attribute__((address_space(3)))
constexpr int BM = 256, BK = 64, HALF = 128, HTB = HALF * BK * 2, STAGE_BYTES = 8 * HTB, NXCD = 8, WGM = 8;

__host__ __device__ __forceinline__ int lds_byte(int r, int c) { const int st = (r >> 4) * 2 + (c >> 5), rr = r & 15, cc = c & 31, ob = rr * 64 + cc * 2; return st * 1024 + (ob ^ (((ob >> 9) & 1) << 5)); }
__host__ __device__ __forceinline__ void stage_rc(int b, int& R, int& C) { const int st = b / 1024, sb = b % 1024, swz = sb ^ (((sb >> 9) & 1) << 5); R = (st >> 1) * 16 + swz / 64; C = (st & 1) * 32 + (swz % 64) / 2; }
__host__ __device__ __forceinline__ int perm32(int rho) { const int n = rho >> 4, i = rho & 15; return 8 * (i >> 2) + 4 * n + (i & 3); }

struct Unit { int pm, pn, br; };
struct Gemm { const bf16_t* A; const bf16_t* Bt; int M, N, K; size_t abr, bbr; };

struct StaticOrder {
    int nM, nN, nwg, G, c, nbr;
    __device__ void init(int M_, int N_, int G_, int c_, int nbr_) { nM = M_ / BM; nN = N_ / BM; nwg = nM * nN; G = G_; c = c_; nbr = nbr_; }
    __device__ bool next(int i, Unit& u) const {
        const int it = i / nbr; u.br = i - it * nbr;
        const long L = (long)it * G + c; if (L >= nwg) return false;
        int wgid = (int)L; { const int q = nwg / NXCD, r = nwg % NXCD, xcd = wgid % NXCD, off = wgid / NXCD; wgid = (xcd < r ? xcd * (q + 1) : r * (q + 1) + (xcd - r) * q) + off; }
        const int nig = WGM * nN, gid = wgid / nig, fm = gid * WGM, gsz = (nM - fm) < WGM ? (nM - fm) : WGM;
        u.pm = fm + ((wgid % nig) % gsz); u.pn = (wgid % nig) / gsz; return true;
    }
};

enum { EPI_PROJ = 0, EPI_GATE = 1, EPI_RELU2 = 2, EPI_BRANCH = 3, EPI_PLAIN = 4 };
template <int MODE> struct Epi {
    static constexpr bool PERM = true;
    bf16_t* O; int ldc; const float* bias; const bf16_t* G;
    __device__ __forceinline__ void operator()(const f32x4 (&acc)[2][2][4][2], const Unit& u, int wr, int wc, int fr, int fq) const {
        const int row0 = u.pm * BM + wr * 64 + fr; const int col0 = u.pn * BM + wc * 32 + 8 * fq;
        float sc = 1.f; if (MODE == EPI_PROJ) { if (u.pn >= COL_Q / 256 && u.pn < COL_K / 256) sc = C2; }
        f32x4 bv[2][2];
        if (MODE == EPI_GATE) {
#pragma unroll
            for (int bj = 0; bj < 2; ++bj)
#pragma unroll
                for (int n = 0; n < 2; ++n) bv[bj][n] = *(const f32x4*)(bias + col0 + bj * HALF + 4 * n);
        }
        if (MODE == EPI_BRANCH) {
#pragma unroll
            for (int ai = 0; ai < 2; ++ai) {
                u32x4 gt[4][2], pv[4][2];
#pragma unroll
                for (int m = 0; m < 4; ++m)
#pragma unroll
                    for (int bj = 0; bj < 2; ++bj) {
                        const size_t row = (size_t)(row0 + ai * HALF + m * 16);
                        gt[m][bj] = *(const u32x4*)(G + row * NG + (size_t)u.br * DM + col0 + bj * HALF);
                        pv[m][bj] = (u.br > 0) ? *(const u32x4*)(O + row * ldc + col0 + bj * HALF) : (u32x4){0u, 0u, 0u, 0u};
                    }
                __builtin_amdgcn_sched_barrier(0);
#pragma unroll
                for (int m = 0; m < 4; ++m)
#pragma unroll
                    for (int bj = 0; bj < 2; ++bj) {
                        const size_t row = (size_t)(row0 + ai * HALF + m * 16);
                        f32x4 v0 = acc[ai][bj][m][0], v1 = acc[ai][bj][m][1];
                        const u32x4 g4 = gt[m][bj], p4 = pv[m][bj];
                        v0[0] = v0[0] * bf_lo(g4.x) + bf_lo(p4.x); v0[1] = v0[1] * bf_hi(g4.x) + bf_hi(p4.x); v0[2] = v0[2] * bf_lo(g4.y) + bf_lo(p4.y); v0[3] = v0[3] * bf_hi(g4.y) + bf_hi(p4.y);
                        v1[0] = v1[0] * bf_lo(g4.z) + bf_lo(p4.z); v1[1] = v1[1] * bf_hi(g4.z) + bf_hi(p4.z); v1[2] = v1[2] * bf_lo(g4.w) + bf_lo(p4.w); v1[3] = v1[3] * bf_hi(g4.w) + bf_hi(p4.w);
                        u32x4 wv; wv.x = cvt_pk_bf16(v0[0], v0[1]); wv.y = cvt_pk_bf16(v0[2], v0[3]); wv.z = cvt_pk_bf16(v1[0], v1[1]); wv.w = cvt_pk_bf16(v1[2], v1[3]);
                        *(u32x4*)(O + row * ldc + col0 + bj * HALF) = wv;
                    }
                __builtin_amdgcn_sched_barrier(0);
            }
            return;
        }
#pragma unroll
        for (int ai = 0; ai < 2; ++ai)
#pragma unroll
            for (int m = 0; m < 4; ++m) {
                const size_t row = (size_t)(row0 + ai * HALF + m * 16);
                bf16_t* rowp = O + row * ldc + col0;
#pragma unroll
                for (int bj = 0; bj < 2; ++bj) {
                    f32x4 v0 = acc[ai][bj][m][0], v1 = acc[ai][bj][m][1];
                    if (MODE == EPI_PROJ) { v0 = v0 * sc; v1 = v1 * sc; }
                    if (MODE == EPI_GATE) {
                        v0 = v0 + bv[bj][0]; v1 = v1 + bv[bj][1];
#pragma unroll
                        for (int i = 0; i < 4; ++i) { v0[i] = sigmoid_f(v0[i]); v1[i] = sigmoid_f(v1[i]); }
                    }
                    if (MODE == EPI_RELU2) {
#pragma unroll
                        for (int i = 0; i < 4; ++i) { const float a = fmaxf(v0[i], 0.f), b = fmaxf(v1[i], 0.f); v0[i] = a * a; v1[i] = b * b; }
                    }
                    if (MODE == EPI_BRANCH) {
                        const u32x4 gt = *(const u32x4*)(G + row * NG + (size_t)u.br * DM + col0 + bj * HALF);
                        v0[0] *= bf_lo(gt.x); v0[1] *= bf_hi(gt.x); v0[2] *= bf_lo(gt.y); v0[3] *= bf_hi(gt.y);
                        v1[0] *= bf_lo(gt.z); v1[1] *= bf_hi(gt.z); v1[2] *= bf_lo(gt.w); v1[3] *= bf_hi(gt.w);
                        if (u.br > 0) {
                            const u32x4 pv = *(const u32x4*)(rowp + bj * HALF);
                            v0[0] += bf_lo(pv.x); v0[1] += bf_hi(pv.x); v0[2] += bf_lo(pv.y); v0[3] += bf_hi(pv.y);
                            v1[0] += bf_lo(pv.z); v1[1] += bf_hi(pv.z); v1[2] += bf_lo(pv.w); v1[3] += bf_hi(pv.w);
                        }
                    }
                    u32x4 w; w.x = cvt_pk_bf16(v0[0], v0[1]); w.y = cvt_pk_bf16(v0[2], v0[3]); w.z = cvt_pk_bf16(v1[0], v1[1]); w.w = cvt_pk_bf16(v1[2], v1[3]);
                    *(u32x4*)(rowp + bj * HALF) = w;
                }
            }
    }
};

template <class EpiT, class Sched, bool ALIGN_EPI, bool SP2>
__device__ __forceinline__ void gemm_phase(PG8_LAS unsigned char* lds, const Gemm g, const Sched& S, const EpiT& E) {
    const int tid = launder_i(threadIdx.x), wid = __builtin_amdgcn_readfirstlane(tid >> 6), lane = tid & 63, wr = wid >> 2, wc = wid & 3, fr = lane & 15, fq = lane >> 4;
    const int K = g.K, nt = K / BK;
    unsigned voffA[2], voffB[2];
#pragma unroll
    for (int i = 0; i < 2; ++i) { int R, C; stage_rc(tid * 16 + i * 8192, R, C); const int Rb = EpiT::PERM ? ((R & ~31) + perm32(R & 31)) : R;
        voffA[i] = (unsigned)(R * K + C) * 2u; voffB[i] = (unsigned)(Rb * K + C) * 2u; }
    const size_t kstep = (size_t)(BK * 2);
    const size_t hstep = (size_t)HALF * K * 2;
    const size_t tstep = 2 * hstep;
    const unsigned ldsw = (unsigned)wid * 1024u;
    const int aoff = lds_byte(wr * 64 + fr, fq * 8), boff = lds_byte(wc * 32 + fr, fq * 8);
#define PG8_SA(b, h) (((b) * 2 + (h)) * HTB)
#define PG8_SB(b, h) ((4 + (b) * 2 + (h)) * HTB)
#define PG8_STAGE(bufoff, gbase, voff) do { _Pragma("unroll") for (int _i = 0; _i < 2; ++_i) \
        __builtin_amdgcn_global_load_lds((const unsigned*)((const char*)(gbase) + (voff)[_i]), (PG8_LAS unsigned*)(lds + (bufoff) + ldsw + _i * 8192), 16, 0, 0); } while (0)
#define PG8_LDA(dst, b, h) do { _Pragma("unroll") for (int m = 0; m < 4; ++m) _Pragma("unroll") for (int k = 0; k < 2; ++k) dst[m][k] = *(const PG8_LAS bf16x8*)(lds + PG8_SA(b, h) + aoff + m * 2048 + k * 1024); } while (0)
#define PG8_LDB(dst, b, h) do { _Pragma("unroll") for (int n = 0; n < 2; ++n) _Pragma("unroll") for (int k = 0; k < 2; ++k) dst[n][k] = *(const PG8_LAS bf16x8*)(lds + PG8_SB(b, h) + boff + n * 2048 + k * 1024); } while (0)
#define PG8_MMA(ai, bj, At, Bt) do { __builtin_amdgcn_s_setprio(1); _Pragma("unroll") for (int m = 0; m < 4; ++m) _Pragma("unroll") for (int n = 0; n < 2; ++n) _Pragma("unroll") for (int k = 0; k < 2; ++k) \
        acc[ai][bj][m][n] = __builtin_amdgcn_mfma_f32_16x16x32_bf16(Bt[n][k], At[m][k], acc[ai][bj][m][n], 0, 0, 0); __builtin_amdgcn_s_setprio(0); } while (0)
#define PG8_WAIT_V(n) asm volatile("s_waitcnt vmcnt(" #n ")" ::: "memory")
#define PG8_WAIT_L(n) asm volatile("s_waitcnt lgkmcnt(" #n ")" ::: "memory")
#define PG8_BAR __builtin_amdgcn_s_barrier()
#define PG8_SCHED __builtin_amdgcn_sched_barrier(0)
    Unit cur, nxt; int ui = 0;
    if (!S.next(0, cur)) return;
    f32x4 acc[2][2][4][2];
#pragma unroll
    for (int a = 0; a < 2; ++a)
#pragma unroll
        for (int b = 0; b < 2; ++b)
#pragma unroll
            for (int m = 0; m < 4; ++m)
#pragma unroll
                for (int n = 0; n < 2; ++n) acc[a][b][m][n] = (f32x4){0.f, 0.f, 0.f, 0.f};
    bf16x8 At[4][2], B0[2][2], B1[2][2];
    const char* cA = (const char*)g.A + (size_t)cur.pm * tstep + (size_t)cur.br * g.abr; const char* cB = (const char*)g.Bt + (size_t)cur.pn * tstep + (size_t)cur.br * g.bbr;
    if constexpr (SP2) {
        PG8_STAGE(PG8_SB(0, 0), cB, voffB); PG8_STAGE(PG8_SB(0, 1), cB + hstep, voffB); PG8_STAGE(PG8_SA(0, 0), cA, voffA); PG8_STAGE(PG8_SA(0, 1), cA + hstep, voffA);
        if (wr == 1) PG8_BAR;
        PG8_WAIT_V(2); PG8_BAR;
        PG8_STAGE(PG8_SB(1, 0), cB + kstep, voffB); PG8_STAGE(PG8_SA(1, 0), cA + kstep, voffA); PG8_STAGE(PG8_SB(1, 1), cB + hstep + kstep, voffB);
        PG8_WAIT_V(6); PG8_BAR;
    } else {
        PG8_STAGE(PG8_SB(0, 0), cB, voffB); PG8_STAGE(PG8_SA(0, 0), cA, voffA); PG8_STAGE(PG8_SB(0, 1), cB + hstep, voffB); PG8_STAGE(PG8_SA(0, 1), cA + hstep, voffA);
        if (wr == 1) PG8_BAR;
        PG8_WAIT_V(4); PG8_BAR;
        PG8_STAGE(PG8_SB(1, 0), cB + kstep, voffB); PG8_STAGE(PG8_SA(1, 0), cA + kstep, voffA); PG8_STAGE(PG8_SB(1, 1), cB + hstep + kstep, voffB);
        PG8_WAIT_V(6); PG8_BAR;
    }
    for (;;) {
        const bool has_next = S.next(ui + 1, nxt);
        const char* nA = has_next ? (const char*)g.A + (size_t)nxt.pm * tstep + (size_t)nxt.br * g.abr : cA;
        const char* nB = has_next ? (const char*)g.Bt + (size_t)nxt.pn * tstep + (size_t)nxt.br * g.bbr : cB;
        for (int t = 0; t < nt; t += 2) {
            const bool last = (t == nt - 2);
            const char* a1 = cA + (size_t)(t + 1) * kstep;
            const char* a2 = last ? nA : cA + (size_t)(t + 2) * kstep; const char* b2 = last ? nB : cB + (size_t)(t + 2) * kstep;
            const char* a3 = a2 + kstep; const char* b3 = b2 + kstep;
            if constexpr (SP2) {
            PG8_LDB(B0, 0, 0); PG8_LDB(B1, 0, 1); PG8_SCHED; PG8_LDA(At, 0, 0); PG8_STAGE(PG8_SA(1, 1), a1 + hstep, voffA);
            PG8_WAIT_V(8); PG8_WAIT_L(0); PG8_BAR; PG8_MMA(0, 0, At, B0); PG8_MMA(0, 1, At, B1); PG8_BAR; PG8_SCHED;
            PG8_LDA(At, 0, 1); PG8_STAGE(PG8_SB(0, 0), b2, voffB); PG8_STAGE(PG8_SB(0, 1), b2 + hstep, voffB); PG8_STAGE(PG8_SA(0, 0), a2, voffA);
            PG8_WAIT_V(8); PG8_WAIT_L(0); PG8_BAR; PG8_MMA(1, 0, At, B0); PG8_MMA(1, 1, At, B1); PG8_BAR; PG8_SCHED;
            PG8_LDB(B0, 1, 0); PG8_LDB(B1, 1, 1); PG8_SCHED; PG8_LDA(At, 1, 0); PG8_STAGE(PG8_SA(0, 1), a2 + hstep, voffA);
            PG8_WAIT_V(8); PG8_WAIT_L(0); PG8_BAR; PG8_MMA(0, 0, At, B0); PG8_MMA(0, 1, At, B1); PG8_BAR; PG8_SCHED;
            PG8_LDA(At, 1, 1); PG8_STAGE(PG8_SB(1, 0), b3, voffB); PG8_STAGE(PG8_SB(1, 1), b3 + hstep, voffB); PG8_STAGE(PG8_SA(1, 0), a3, voffA);
            PG8_WAIT_V(8); PG8_WAIT_L(0); PG8_BAR; PG8_MMA(1, 0, At, B0); PG8_MMA(1, 1, At, B1); PG8_BAR; PG8_SCHED;
            } else {
            PG8_LDB(B0, 0, 0); PG8_SCHED; PG8_LDA(At, 0, 0); PG8_STAGE(PG8_SA(1, 1), a1 + hstep, voffA);
            PG8_WAIT_L(8); PG8_BAR; PG8_WAIT_L(0); PG8_MMA(0, 0, At, B0); PG8_BAR; PG8_SCHED;
            PG8_LDB(B1, 0, 1); PG8_STAGE(PG8_SB(0, 0), b2, voffB);
            PG8_BAR; PG8_WAIT_L(0); PG8_MMA(0, 1, At, B1); PG8_BAR;
            PG8_LDA(At, 0, 1); PG8_STAGE(PG8_SA(0, 0), a2, voffA);
            PG8_BAR; PG8_WAIT_L(0); PG8_MMA(1, 0, At, B0); PG8_BAR; PG8_SCHED;
            PG8_STAGE(PG8_SB(0, 1), b2 + hstep, voffB);
            PG8_WAIT_V(6); PG8_BAR; PG8_MMA(1, 1, At, B1); PG8_BAR;
            PG8_LDB(B0, 1, 0); PG8_SCHED; PG8_LDA(At, 1, 0); PG8_STAGE(PG8_SA(0, 1), a2 + hstep, voffA);
            PG8_WAIT_L(8); PG8_BAR; PG8_WAIT_L(0); PG8_MMA(0, 0, At, B0); PG8_BAR; PG8_SCHED;
            PG8_LDB(B1, 1, 1); PG8_STAGE(PG8_SB(1, 0), b3, voffB);
            PG8_BAR; PG8_WAIT_L(0); PG8_MMA(0, 1, At, B1); PG8_BAR;
            PG8_LDA(At, 1, 1); PG8_STAGE(PG8_SA(1, 0), a3, voffA);
            PG8_BAR; PG8_WAIT_L(0); PG8_MMA(1, 0, At, B0); PG8_BAR; PG8_SCHED;
            PG8_STAGE(PG8_SB(1, 1), b3 + hstep, voffB);
            PG8_WAIT_V(6); PG8_BAR; PG8_MMA(1, 1, At, B1); PG8_BAR;
            }
        }
        if constexpr (ALIGN_EPI) { if (wr == 0) PG8_BAR; }
        E(acc, cur, wr, wc, fr, fq);
        if (!has_next) break;
#pragma unroll
        for (int a = 0; a < 2; ++a)
#pragma unroll
            for (int b = 0; b < 2; ++b)
#pragma unroll
                for (int m = 0; m < 4; ++m)
#pragma unroll
                    for (int n = 0; n < 2; ++n) acc[a][b][m][n] = (f32x4){0.f, 0.f, 0.f, 0.f};
        cur = nxt; cA = nA; cB = nB; ++ui;
        if constexpr (ALIGN_EPI) { if (wr == 1) PG8_BAR; }
    }
    PG8_WAIT_V(0);
    if constexpr (!ALIGN_EPI) { if (wr == 0) PG8_BAR; }
    PG8_BAR;
#undef PG8_SA
#undef PG8_SB
#undef PG8_STAGE
#undef PG8_LDA
#undef PG8_LDB
#undef PG8_MMA
#undef PG8_WAIT_V
#undef PG8_WAIT_L
#undef PG8_BAR
#undef PG8_SCHED
}
}

struct Args { const float* in[22]; float* out; unsigned char* ws; };

__device__ __forceinline__ void transpose_item(const float* W, int ldw, int col_off, int K, int N, bf16_t* WT, LAS float* scr, int item, int lane) {
    const int nblk = N / 64, kb = item / nblk, nb = item % nblk, k0 = 64 * kb, n0 = 64 * nb;
    const int r = lane >> 4, c4 = lane & 15;
    f32x4 v[16];
#pragma unroll
    for (int i = 0; i < 16; ++i) v[i] = *(const f32x4*)(W + (size_t)(k0 + 4 * i + r) * ldw + col_off + n0 + 4 * c4);
#pragma unroll
    for (int i = 0; i < 16; ++i) { LAS float* d = scr + (4 * i + r) * 65 + 4 * c4; d[0] = v[i].x; d[1] = v[i].y; d[2] = v[i].z; d[3] = v[i].w; }
    asm volatile("s_waitcnt lgkmcnt(0)" ::: "memory");
    const int c = lane & 7;
#pragma unroll
    for (int j = 0; j < 8; ++j) { const int n = (lane >> 3) + 8 * j; const LAS float* s = scr + (8 * c) * 65 + n;
        u32x4 o; o.x = cvt_pk_bf16(s[0 * 65], s[1 * 65]); o.y = cvt_pk_bf16(s[2 * 65], s[3 * 65]); o.z = cvt_pk_bf16(s[4 * 65], s[5 * 65]); o.w = cvt_pk_bf16(s[6 * 65], s[7 * 65]);
        *(u32x4*)(WT + (size_t)(n0 + n) * K + k0 + 8 * c) = o; }
    asm volatile("s_waitcnt lgkmcnt(0)" ::: "memory");
}

__device__ __forceinline__ void s5_tables(LAS unsigned char* lds, const Args& a, int l, int g, int qt, int tid) {
    LAS f32x2* AP = (LAS f32x2*)lds;
    LAS f32x2* BB = AP + 65 * 64;
    LAS f32x2* CC = BB + 64 * 16;
    const int lg = l * 32 + g;
    const float* are = a.in[4] + lg * 64; const float* aim = a.in[5] + lg * 64;
    const float dt = expf(a.in[6][lg]);
    unsigned char* tab = a.ws + WS_S5 + (size_t)l * S5_LAYER;
    for (int idx = tid; idx < 65 * 64; idx += 512) {
        const int d = idx >> 6, p = idx & 63;
        const float lr = fminf(are[p], -1e-4f), li = aim[p];
        const float mag = expf(lr * dt * (float)d);
        double rev = (double)li * (double)dt * (double)d * 0.15915494309189535;
        rev -= floor(rev); if (rev > 0.5) rev -= 1.0;
        const float th = (float)(rev * 6.283185307179586);
        AP[idx] = (f32x2){mag * cosf(th), mag * sinf(th)};
    }
    for (int idx = tid; idx < 1024; idx += 512) CC[idx] = (f32x2){a.in[9][(size_t)lg * 1024 + idx], a.in[10][(size_t)lg * 1024 + idx]};
    for (int idx = tid; idx < 1024; idx += 512) {
        const int p = idx >> 4;
        const float lr = fminf(are[p], -1e-4f), li = aim[p];
        double rev = (double)li * (double)dt * 0.15915494309189535;
        rev -= floor(rev); if (rev > 0.5) rev -= 1.0;
        const float th = (float)(rev * 6.283185307179586);
        const float em1 = expm1f(lr * dt), c = cosf(th), s = sinf(th), sh = sinf(0.5f * th);
        const float nr = em1 * c - 2.f * sh * sh, ni = (1.f + em1) * s;
        const float den = 1.f / (lr * lr + li * li);
        const float qr = (nr * lr + ni * li) * den, qi = (ni * lr - nr * li) * den;
        const float br = a.in[7][(size_t)lg * 1024 + idx], bi = a.in[8][(size_t)lg * 1024 + idx];
        BB[idx] = (f32x2){qr * br - qi * bi, qr * bi + qi * br};
    }
    __syncthreads();
    bf16_t* kt = (bf16_t*)(tab + S5_KT) + (size_t)g * (65 * 256);
    if (tid < 256) { const int s = qt * 256 + tid;
        const int d = s >> 4, h = s & 15;
        float acc[16];
#pragma unroll
        for (int i = 0; i < 16; ++i) acc[i] = 0.f;
        for (int p = 0; p < 64; ++p) {
            const f32x2 cc = CC[h * 64 + p], ap = AP[d * 64 + p];
            const float cr = cc.x * ap.x - cc.y * ap.y, ci = cc.x * ap.y + cc.y * ap.x;
#pragma unroll
            for (int i = 0; i < 16; ++i) { const f32x2 bb = BB[p * 16 + i]; acc[i] += cr * bb.x - ci * bb.y; }
        }
        if (d == 0) { const float dsk = a.in[11][lg * 16 + h];
#pragma unroll
            for (int i = 0; i < 16; ++i) if (i == h) acc[i] += dsk; }
        u32x4 o0, o1;
        o0.x = cvt_pk_bf16(acc[0], acc[1]); o0.y = cvt_pk_bf16(acc[2], acc[3]); o0.z = cvt_pk_bf16(acc[4], acc[5]); o0.w = cvt_pk_bf16(acc[6], acc[7]);
        o1.x = cvt_pk_bf16(acc[8], acc[9]); o1.y = cvt_pk_bf16(acc[10], acc[11]); o1.z = cvt_pk_bf16(acc[12], acc[13]); o1.w = cvt_pk_bf16(acc[14], acc[15]);
        u32x4* dst = (u32x4*)(kt + (size_t)(63 - d) * 256 + h * 16);
        dst[0] = o0; dst[1] = o1;
    }
    if (qt == 0 && tid >= 256 && tid < 288) ((u32x4*)(kt + 64 * 256))[tid - 256] = (u32x4){0u, 0u, 0u, 0u};
    bf16_t* we = (bf16_t*)(tab + S5_WE) + (size_t)g * 128 * 1024;
    for (int idx = qt * 4096 + tid; idx < (qt + 1) * 4096; idx += 512) {
        const int half = idx & 1, j = (idx >> 1) & 63, row = idx >> 7, p = row & 63, im = row >> 6;
        const f32x2 ap = AP[(63 - j) * 64 + p];
        float v[8];
#pragma unroll
        for (int i = 0; i < 8; ++i) { const f32x2 bb = BB[p * 16 + 8 * half + i]; v[i] = im ? (ap.x * bb.y + ap.y * bb.x) : (ap.x * bb.x - ap.y * bb.y); }
        u32x4 o; o.x = cvt_pk_bf16(v[0], v[1]); o.y = cvt_pk_bf16(v[2], v[3]); o.z = cvt_pk_bf16(v[4], v[5]); o.w = cvt_pk_bf16(v[6], v[7]);
        *(u32x4*)(we + (size_t)row * 1024 + j * 16 + 8 * half) = o;
    }
    bf16_t* wc = (bf16_t*)(tab + S5_WC) + (size_t)g * 1024 * 128;
    for (int idx = qt * 4096 + tid; idx < (qt + 1) * 4096; idx += 512) {
        const int kgp = idx & 15, rowi = idx >> 4, t = rowi >> 4, h = rowi & 15, im = kgp >> 3, p0 = (kgp & 7) * 8;
        float v[8];
#pragma unroll
        for (int i = 0; i < 8; ++i) { const f32x2 cc = CC[h * 64 + p0 + i], ap = AP[(t + 1) * 64 + p0 + i];
            v[i] = im ? -(cc.x * ap.y + cc.y * ap.x) : (cc.x * ap.x - cc.y * ap.y); }
        u32x4 o; o.x = cvt_pk_bf16(v[0], v[1]); o.y = cvt_pk_bf16(v[2], v[3]); o.z = cvt_pk_bf16(v[4], v[5]); o.w = cvt_pk_bf16(v[6], v[7]);
        *(u32x4*)(wc + (size_t)rowi * 128 + kgp * 8) = o;
    }
    if (qt == 1 && tid < 64) {
        ((f32x2*)(tab + S5_A64))[g * 64 + tid] = AP[64 * 64 + tid];
        const int k = tid & 15, kg = tid >> 4; const float* wg = a.in[12] + (size_t)lg * 256;
        u32x4 o; o.x = cvt_pk_bf16(wg[(4 * kg + 0) * 16 + k], wg[(4 * kg + 1) * 16 + k]); o.y = cvt_pk_bf16(wg[(4 * kg + 2) * 16 + k], wg[(4 * kg + 3) * 16 + k]); o.z = 0u; o.w = 0u;
        ((u32x4*)(tab + S5_GLU))[g * 64 + tid] = o;
    }
    __syncthreads();
}

struct NormArgs { const float* resid; const bf16_t* add; const float* g_add; float* xout; const float* g_xn; bf16_t* xn; const float* wf; const float* bfh; float* logf; };
__device__ __forceinline__ void norm_phase(LAS unsigned char* lds, const NormArgs n, int gw, int ngw, int lane, int tid) {
    if (n.wf) {
        for (int i = tid; i < 2048; i += 512) { const int d = i >> 1, hh = i & 1; const f32x4 v = *(const f32x4*)(n.wf + (size_t)d * INW + 4 * hh);
            *(LAS f32x4*)(lds + d * 32 + 16 * (d >> 3) + 16 * hh) = v; }
        __syncthreads();
    }
    f32x4 ga[4], gx[4];
#pragma unroll
    for (int j = 0; j < 4; ++j) { ga[j] = n.add ? *(const f32x4*)(n.g_add + 4 * lane + 256 * j) : (f32x4){0.f, 0.f, 0.f, 0.f}; gx[j] = n.xn ? *(const f32x4*)(n.g_xn + 4 * lane + 256 * j) : (f32x4){0.f, 0.f, 0.f, 0.f}; }
    for (int rbase = gw; rbase < M; rbase += 2 * ngw) {
        f32x4 v[2][4]; f32x4 av[2][4];
#pragma unroll
        for (int rr = 0; rr < 2; ++rr) { const size_t row = (size_t)rbase + (size_t)rr * ngw;
#pragma unroll
            for (int j = 0; j < 4; ++j) v[rr][j] = *(const f32x4*)(n.resid + row * DM + 4 * lane + 256 * j);
            if (n.add) {
#pragma unroll
                for (int j = 0; j < 4; ++j) { const u32x2 u = *(const u32x2*)(n.add + row * DM + 4 * lane + 256 * j); av[rr][j] = (f32x4){bf_lo(u.x), bf_hi(u.x), bf_lo(u.y), bf_hi(u.y)}; }
            }
        }
#pragma unroll
        for (int rr = 0; rr < 2; ++rr) { const size_t row = (size_t)rbase + (size_t)rr * ngw;
            if (n.add) {
                float ss = 0.f;
#pragma unroll
                for (int j = 0; j < 4; ++j) ss += (av[rr][j].x * av[rr][j].x + av[rr][j].y * av[rr][j].y) + (av[rr][j].z * av[rr][j].z + av[rr][j].w * av[rr][j].w);
                const float rs = rsqrtf(wave_sum(ss) * (1.f / DM) + EPS);
#pragma unroll
                for (int j = 0; j < 4; ++j) v[rr][j] = v[rr][j] + av[rr][j] * rs * ga[j];
            }
            if (n.xout) {
#pragma unroll
                for (int j = 0; j < 4; ++j) *(f32x4*)(n.xout + row * DM + 4 * lane + 256 * j) = v[rr][j];
            }
            if (n.xn) {
                float ss = 0.f;
#pragma unroll
                for (int j = 0; j < 4; ++j) ss += (v[rr][j].x * v[rr][j].x + v[rr][j].y * v[rr][j].y) + (v[rr][j].z * v[rr][j].z + v[rr][j].w * v[rr][j].w);
                const float rs = rsqrtf(wave_sum(ss) * (1.f / DM) + EPS);
                f32x4 hn[4];
#pragma unroll
                for (int j = 0; j < 4; ++j) { hn[j] = v[rr][j] * rs * gx[j]; u32x2 o; o.x = cvt_pk_bf16(hn[j].x, hn[j].y); o.y = cvt_pk_bf16(hn[j].z, hn[j].w);
                    *(u32x2*)(n.xn + row * DM + 4 * lane + 256 * j) = o; }
                if (n.wf) {
                    f32x4 f0 = (f32x4){0.f, 0.f, 0.f, 0.f}, f1 = f0;
#pragma unroll
                    for (int j = 0; j < 4; ++j)
#pragma unroll
                        for (int i = 0; i < 4; ++i) { const int d = 4 * lane + 256 * j + i; const LAS unsigned char* wp = lds + d * 32 + 16 * (d >> 3);
                            const f32x4 w0 = *(const LAS f32x4*)wp, w1 = *(const LAS f32x4*)(wp + 16); f0 = f0 + w0 * hn[j][i]; f1 = f1 + w1 * hn[j][i]; }
                    float z = 0.f;
#pragma unroll
                    for (int hh = 0; hh < 4; ++hh) { const float s0 = wave_sum(f0[hh]), s1 = wave_sum(f1[hh]); if (lane == hh) z = s0; if (lane == hh + 4) z = s1; }
                    if (lane < 8) { z += n.bfh[lane]; n.logf[row * 8 + lane] = fminf(z, 0.f) - log1pf(expf(-fabsf(z))); }
                }
            }
        }
    }
}

__device__ __forceinline__ void cum_scan(LAS unsigned char* lds, const float* logf, float* cum, int bh, int tid, int lane, int w) {
    LAS float* ws = (LAS float*)lds;
    const int b = bh >> 3, h = bh & 7;
    float v[8]; float run = 0.f;
#pragma unroll
    for (int i = 0; i < 8; ++i) { run += logf[((size_t)b * SEQ + 8 * tid + i) * 8 + h]; v[i] = run; }
    float inc = run;
#pragma unroll
    for (int o = 1; o < 64; o <<= 1) { const float t = __int_as_float(__builtin_amdgcn_ds_bpermute((lane - o) << 2, __float_as_int(inc))); if (lane >= o) inc += t; }
    if (lane == 63) ws[w] = inc;
    __syncthreads();
    float base = inc - run;
    for (int i = 0; i < w; ++i) base += ws[i];
#pragma unroll
    for (int i = 0; i < 8; ++i) cum[(size_t)bh * SEQ + 8 * tid + i] = (base + v[i]) * LOG2E;
    __syncthreads();
}

#define MFMA16(a, b, c) __builtin_amdgcn_mfma_f32_16x16x32_bf16((a), (b), (c), 0, 0, 0)
#define MFMA32(a, b, c) __builtin_amdgcn_mfma_f32_32x32x16_bf16((a), (b), (c), 0, 0, 0)
__device__ __forceinline__ bf16x8 ldg16(const void* ubase, unsigned off) { return *(const bf16x8*)((const char*)ubase + off); }
__device__ __forceinline__ void s5_unit(LAS unsigned char* lds, const bf16_t* P, const unsigned char* tab, bf16_t* Ya, const int b, const int g, int tid, int lane, int w) {
    LAS unsigned char* KT = lds; LAS float* EL = (LAS float*)(lds + 33280); LAS unsigned char* SPT = lds + 66560;
    const unsigned char* ktab = tab + S5_KT + (size_t)g * KT_BYTES;
    const int n = lane & 15, kg = lane >> 4, ntile = w & 3, wh = w >> 2;
    const bf16_t* WEu = (const bf16_t*)(tab + S5_WE) + (size_t)g * 128 * 1024 + (size_t)(64 * wh) * 1024;
    const bf16_t* WCu = (const bf16_t*)(tab + S5_WC) + (size_t)g * 1024 * 128 + (size_t)(wh * 16) * 128;
    const bf16_t* Uu = P + ((size_t)b * SEQ + (size_t)(16 * ntile) * 64) * NA + 16 * g;
    const unsigned uoff = (unsigned)((n * 64 + (kg >> 1)) * NA + 8 * (kg & 1)) * 2u;
    const unsigned weoff = (unsigned)(n * 1024 + 8 * kg) * 2u;
    const unsigned wcoff = (unsigned)(n * 128 + 8 * kg) * 2u;
    for (int i = tid; i < KT_BYTES / 16; i += 512) *(LAS u32x4*)(KT + i * 16) = *(const u32x4*)(ktab + i * 16);
    {
        f32x4 e[4];
#pragma unroll
        for (int mt = 0; mt < 4; ++mt) e[mt] = (f32x4){0.f, 0.f, 0.f, 0.f};
        bf16x8 eb[4], ea[4][4];
#define S5_ELD(ks) do { eb[(ks) & 3] = ldg16(Uu + (size_t)(2 * (ks)) * NA, uoff); _Pragma("unroll") for (int _m = 0; _m < 4; ++_m) ea[(ks) & 3][_m] = ldg16(WEu + (size_t)(16 * _m) * 1024 + 32 * (ks), weoff); } while (0)
        S5_ELD(0); S5_ELD(1); S5_ELD(2);
        __builtin_amdgcn_sched_barrier(0);
#pragma unroll
        for (int ks = 0; ks < 32; ++ks) {
            if (ks + 3 < 32) S5_ELD(ks + 3);
#pragma unroll
            for (int mt = 0; mt < 4; ++mt) e[mt] = MFMA16(ea[ks & 3][mt], eb[ks & 3], e[mt]);
            __builtin_amdgcn_sched_barrier(0);
        }
#undef S5_ELD
#pragma unroll
        for (int mt = 0; mt < 4; ++mt)
#pragma unroll
            for (int i = 0; i < 4; ++i) EL[(64 * wh + 16 * mt + 4 * kg + i) * 65 + 16 * ntile + n] = e[mt][i];
    }
    __syncthreads();
    {
        const int p = tid & 63, seg = tid >> 6;
        const f32x2 a1 = ((const f32x2*)(tab + S5_A64))[g * 64 + p];
        float lr[8], li[8]; float sr = 0.f, si = 0.f;
#pragma unroll
        for (int j = 0; j < 8; ++j) { const float er = EL[p * 65 + 8 * seg + j], ei = EL[(64 + p) * 65 + 8 * seg + j];
            const float nr = a1.x * sr - a1.y * si + er, ni = a1.x * si + a1.y * sr + ei; sr = nr; si = ni; lr[j] = sr; li[j] = si; }
        LAS f32x2* TT = (LAS f32x2*)(lds + 66560 + 17408);
        TT[seg * 64 + p] = (f32x2){sr, si};
        f32x2 a2 = {a1.x * a1.x - a1.y * a1.y, 2.f * a1.x * a1.y}; f32x2 a4 = {a2.x * a2.x - a2.y * a2.y, 2.f * a2.x * a2.y}; const f32x2 a8 = {a4.x * a4.x - a4.y * a4.y, 2.f * a4.x * a4.y};
        __syncthreads();
        float cr = 0.f, ci = 0.f;
        for (int s2 = 0; s2 < seg; ++s2) { const f32x2 t = TT[s2 * 64 + p]; const float nr = a8.x * cr - a8.y * ci + t.x, ni = a8.x * ci + a8.y * cr + t.y; cr = nr; ci = ni; }
        float pr = cr, pi = ci, wr_ = cr, wi_ = ci;
#pragma unroll
        for (int j = 0; j < 8; ++j) {
            *(LAS bf16_t*)(SPT + (8 * seg + j) * 272 + 2 * p) = (bf16_t)(cvt_pk_bf16(pr, 0.f) & 0xffffu);
            *(LAS bf16_t*)(SPT + (8 * seg + j) * 272 + 2 * (64 + p)) = (bf16_t)(cvt_pk_bf16(pi, 0.f) & 0xffffu);
            const float nr = a1.x * wr_ - a1.y * wi_, ni = a1.x * wi_ + a1.y * wr_; wr_ = nr; wi_ = ni;
            pr = lr[j] + wr_; pi = li[j] + wi_;
        }
    }
    __syncthreads();
    const LAS unsigned char* klow = KT + (1 - wh + (lane >> 5)) * 512 + (lane & 15) * 32 + ((lane >> 4) & 1) * 16;
    const LAS unsigned char* spb = SPT + (16 * ntile + n) * 272 + 16 * kg;
    const bf16x8 aglu = *(const bf16x8*)(tab + S5_GLU + (size_t)(g * 64 + lane) * 16);
    const unsigned yoff = (unsigned)(n * 64 * YW + 4 * kg) * 2u;
#pragma unroll 1
    for (int pass = 0; pass < 2; ++pass) {
        f32x4 acc[16];
#pragma unroll
        for (int i = 0; i < 16; ++i) acc[i] = (f32x4){0.f, 0.f, 0.f, 0.f};
        bf16x8 bq[4], ca[2][4], bt[8], bu[8];
        const bf16_t* Up = Uu + (size_t)(32 * pass) * NA;
        const bf16_t* WCp = WCu + (size_t)(32 * pass) * 2048;
#define S5_LDC(st, slot) do { _Pragma("unroll") for (int _q = 0; _q < 4; ++_q) ca[slot][_q] = ldg16(WCp + (size_t)(2 * (4 * ((st) & 3) + _q)) * 2048 + 32 * ((st) >> 2), wcoff); } while (0)
#pragma unroll
        for (int jj = 0; jj < 8; ++jj) bt[jj] = ldg16(Up + (size_t)(2 * jj) * NA, uoff);
        S5_LDC(0, 0); S5_LDC(1, 1);
        if (pass == 1) {
            bq[0] = ldg16(Uu, uoff); bq[1] = ldg16(Uu + (size_t)2 * NA, uoff); bq[2] = ldg16(Uu + (size_t)4 * NA, uoff);
            __builtin_amdgcn_sched_barrier(0);
#pragma unroll
            for (int jj = 0; jj < 16; ++jj) {
                if (jj + 3 < 16) bq[(jj + 3) & 3] = ldg16(Uu + (size_t)(2 * (jj + 3)) * NA, uoff);
#pragma unroll
                for (int ii = 0; ii < 16; ++ii) { const bf16x8 af = *(const LAS bf16x8*)(klow + (30 - 2 * (ii - jj)) * 512); acc[ii] = MFMA16(af, bq[jj & 3], acc[ii]); }
                __builtin_amdgcn_sched_barrier(0);
            }
        }
        __builtin_amdgcn_sched_barrier(0);
#pragma unroll
        for (int jj = 0; jj < 16; ++jj) {
            const bf16x8 cb = *(const LAS bf16x8*)(spb + 64 * (jj >> 2));
            if (jj < 8) bu[jj] = ldg16(Up + (size_t)(2 * (jj + 8)) * NA, uoff);
#pragma unroll
            for (int ii = 0; ii < 16; ++ii) if (ii >= jj) { const bf16x8 af = *(const LAS bf16x8*)(klow + (62 - 2 * (ii - jj)) * 512); acc[ii] = MFMA16(af, (jj < 8 ? bt[jj & 7] : bu[jj & 7]), acc[ii]); }
#pragma unroll
            for (int q = 0; q < 4; ++q) acc[4 * (jj & 3) + q] = MFMA16(ca[jj & 1][q], cb, acc[4 * (jj & 3) + q]);
            __builtin_amdgcn_sched_barrier(0);
            if (jj + 2 < 16) S5_LDC(jj + 2, jj & 1);
            __builtin_amdgcn_sched_barrier(0);
        }
#undef S5_LDC
        bf16_t* Yu = Ya + ((size_t)b * SEQ + (size_t)(16 * ntile) * 64 + wh + 32 * pass) * YW + 16 * g;
#pragma unroll
        for (int ii = 0; ii < 16; ++ii) {
            f32x4 y;
#pragma unroll
            for (int k = 0; k < 4; ++k) y[k] = gelu_tanh(acc[ii][k]);
            u32x4 bp; bp.x = cvt_pk_bf16(y[0], y[1]); bp.y = cvt_pk_bf16(y[2], y[3]); bp.z = 0u; bp.w = 0u;
            const f32x4 z = MFMA16(aglu, __builtin_bit_cast(bf16x8, bp), ((f32x4){0.f, 0.f, 0.f, 0.f}));
            u32x2 o; o.x = cvt_pk_bf16(y[0] * sigmoid_f(z[0]), y[1] * sigmoid_f(z[1])); o.y = cvt_pk_bf16(y[2] * sigmoid_f(z[2]), y[3] * sigmoid_f(z[3]));
            *(u32x2*)((char*)(Yu + (size_t)(2 * ii) * YW) + yoff) = o;
        }
    }
    __syncthreads();
}

constexpr int AT_KS = 0, AT_VT = 9216, AT_VP = 192, AT_BS = 9216 + 64 * AT_VP, AT_BUF = AT_BS + 256;
__device__ __forceinline__ int crow(int r, int hi) { return (r & 3) + 8 * (r >> 2) + 4 * hi; }
__device__ __forceinline__ void attn_unit(LAS unsigned char* lds, const bf16_t* P, const float* cum, bf16_t* Yc, const int b, const int h, const int qb, int tid, int lane, int w) {
    const int r32 = lane & 31, hi = lane >> 5;
    const size_t row0 = (size_t)b * SEQ;
    const int q0 = qb * 256, qrow = q0 + 32 * w + r32;
    bf16x8 qf[4];
    { const bf16_t* qp = P + (row0 + qrow) * NA + COL_Q + 64 * h + 8 * hi;
#pragma unroll
      for (int s = 0; s < 4; ++s) qf[s] = *(const bf16x8*)(qp + 16 * s); }
    const float* cumbh = cum + (size_t)(b * 8 + h) * SEQ;
    const float ref = cumbh[q0];
    const int vlane = (4 * hi + ((lane & 15) >> 2)) * AT_VP + 32 * ((lane >> 4) & 1) + 8 * (lane & 3);
    const int skey = tid >> 3, spc = tid & 7;
    const bf16_t* kgp = P + (row0 + skey) * NA + COL_K + 64 * h + 8 * spc;
    const int NT = 4 * qb + 4;
    u32x4 kreg = *(const u32x4*)kgp, vreg = *(const u32x4*)(kgp + (COL_V - COL_K)); float breg = 0.f; if (tid < 64) breg = ref - cumbh[tid];
#define AT_WRITE(bufp) do { LAS unsigned char* _b = (bufp); *(LAS u32x4*)(_b + AT_KS + skey * 144 + 16 * spc) = kreg; \
        *(LAS u32x4*)(_b + AT_VT + skey * AT_VP + 16 * spc) = vreg; \
        if (tid < 64) *(LAS float*)(_b + AT_BS + 4 * tid) = breg; } while (0)
    AT_WRITE(lds);
    __syncthreads();
    float mrun = -1e30f, lrun = 0.f; f32x16 o0, o1;
#pragma unroll
    for (int r = 0; r < 16; ++r) { o0[r] = 0.f; o1[r] = 0.f; }
    for (int kt = 0; kt < NT; ++kt) {
        const int cur = kt & 1; const bool more = (kt + 1 < NT);
        if (more) { const bf16_t* kp = kgp + (size_t)(kt + 1) * 64 * NA; kreg = *(const u32x4*)kp; vreg = *(const u32x4*)(kp + (COL_V - COL_K)); if (tid < 64) breg = ref - cumbh[64 * (kt + 1) + tid]; }
        if (64 * kt <= q0 + 32 * w + 31) {
            const LAS unsigned char* Kb = lds + cur * AT_BUF + AT_KS; const LAS unsigned char* Vb = lds + cur * AT_BUF + AT_VT; const LAS unsigned char* Bb = lds + cur * AT_BUF + AT_BS;
            f32x16 p[2];
#pragma unroll
            for (int rb = 0; rb < 2; ++rb) {
                f32x16 c;
#pragma unroll
                for (int g4 = 0; g4 < 4; ++g4) { const f32x4 bv = *(const LAS f32x4*)(Bb + (32 * rb + 8 * g4 + 4 * hi) * 4); c[4 * g4 + 0] = bv.x; c[4 * g4 + 1] = bv.y; c[4 * g4 + 2] = bv.z; c[4 * g4 + 3] = bv.w; }
#pragma unroll
                for (int s = 0; s < 4; ++s) { const bf16x8 af = *(const LAS bf16x8*)(Kb + (32 * rb + r32) * 144 + 32 * s + 16 * hi); c = MFMA32(af, qf[s], c); }
                p[rb] = c;
            }
            if (64 * kt + 63 > q0 + 32 * w) {
#pragma unroll
                for (int rb = 0; rb < 2; ++rb)
#pragma unroll
                    for (int r = 0; r < 16; ++r) { const int key = 64 * kt + 32 * rb + crow(r, hi); if (key > qrow) p[rb][r] = -1e30f; }
            }
            float mt = p[0][0];
#pragma unroll
            for (int r = 1; r < 16; ++r) mt = fmaxf(mt, p[0][r]);
#pragma unroll
            for (int r = 0; r < 16; ++r) mt = fmaxf(mt, p[1][r]);
            mt = half_max(mt);
            const float mnew = fmaxf(mrun, mt), alpha = fast_exp2(mrun - mnew);
            mrun = mnew;
            float ls = 0.f;
#pragma unroll
            for (int rb = 0; rb < 2; ++rb)
#pragma unroll
                for (int r = 0; r < 16; ++r) { p[rb][r] = fast_exp2(p[rb][r] - mnew); ls += p[rb][r]; }
            lrun = lrun * alpha + ls;
#pragma unroll
            for (int r = 0; r < 16; ++r) { o0[r] *= alpha; o1[r] *= alpha; }
            bf16x8 pf[4];
#pragma unroll
            for (int s = 0; s < 4; ++s) { const int rb = s >> 1, r0 = 8 * (s & 1); u32x4 pk; pk.x = cvt_pk_bf16(p[rb][r0 + 0], p[rb][r0 + 1]); pk.y = cvt_pk_bf16(p[rb][r0 + 2], p[rb][r0 + 3]);
                pk.z = cvt_pk_bf16(p[rb][r0 + 4], p[rb][r0 + 5]); pk.w = cvt_pk_bf16(p[rb][r0 + 6], p[rb][r0 + 7]); pf[s] = __builtin_bit_cast(bf16x8, pk); }
#pragma unroll
            for (int s = 0; s < 4; ++s) {
                typedef short v4i16_t __attribute__((ext_vector_type(4)));
                const LAS unsigned char* vp = Vb + vlane + 16 * s * AT_VP;
                { const s16x4 lo = __builtin_bit_cast(s16x4, __builtin_amdgcn_ds_read_tr16_b64_v4i16((LAS v4i16_t*)(vp))), hh = __builtin_bit_cast(s16x4, __builtin_amdgcn_ds_read_tr16_b64_v4i16((LAS v4i16_t*)(vp + 8 * AT_VP)));
                  const bf16x8 af = __builtin_shufflevector(lo, hh, 0, 1, 2, 3, 4, 5, 6, 7); o0 = MFMA32(af, pf[s], o0); }
                { const s16x4 lo = __builtin_bit_cast(s16x4, __builtin_amdgcn_ds_read_tr16_b64_v4i16((LAS v4i16_t*)(vp + 64))), hh = __builtin_bit_cast(s16x4, __builtin_amdgcn_ds_read_tr16_b64_v4i16((LAS v4i16_t*)(vp + 64 + 8 * AT_VP)));
                  const bf16x8 af = __builtin_shufflevector(lo, hh, 0, 1, 2, 3, 4, 5, 6, 7); o1 = MFMA32(af, pf[s], o1); }
            }
        }
        if (more) AT_WRITE(lds + (cur ^ 1) * AT_BUF);
        __syncthreads();
    }
#undef AT_WRITE
    const float ltot = half_sum(lrun);
    const float inv = 1.0f / ltot;
    bf16_t* op = Yc + (row0 + qrow) * YW + 64 * h + 4 * hi;
#pragma unroll
    for (int g4 = 0; g4 < 4; ++g4) {
        u32x2 a, c2;
        a.x = cvt_pk_bf16(o0[4 * g4 + 0] * inv, o0[4 * g4 + 1] * inv); a.y = cvt_pk_bf16(o0[4 * g4 + 2] * inv, o0[4 * g4 + 3] * inv);
        c2.x = cvt_pk_bf16(o1[4 * g4 + 0] * inv, o1[4 * g4 + 1] * inv); c2.y = cvt_pk_bf16(o1[4 * g4 + 2] * inv, o1[4 * g4 + 3] * inv);
        *(u32x2*)(op + 8 * g4) = a; *(u32x2*)(op + 32 + 8 * g4) = c2;
    }
}

__device__ __forceinline__ u32x4 conv_item(const bf16_t* P, const float* cw, int item) {
    const int token = item >> 6, c0 = (item & 63) * 8, t = token & (SEQ - 1);
    float acc[8];
#pragma unroll
    for (int i = 0; i < 8; ++i) acc[i] = 0.f;
    u32x4 xc[3], cc[3];
#pragma unroll
    for (int tap = 0; tap < 3; ++tap) {
        const bool ok = (t - 2 + tap >= 0);
        const bf16_t* rp = P + (size_t)(ok ? token - 2 + tap : token) * NA + c0;
        xc[tap] = *(const u32x4*)(rp + COL_XC); cc[tap] = *(const u32x4*)(rp + COL_CC);
        if (!ok) { xc[tap] = (u32x4){0u, 0u, 0u, 0u}; }
    }
    const u32x4 bc = *(const u32x4*)(P + (size_t)token * NA + COL_BC + c0);
#pragma unroll
    for (int tap = 0; tap < 3; ++tap) {
        const f32x4 w0 = *(const f32x4*)(cw + tap * 512 + c0), w1 = *(const f32x4*)(cw + tap * 512 + c0 + 4);
        const u32x4 x = xc[tap], c = cc[tap];
        acc[0] += w0.x * bf_lo(x.x) * bf_lo(c.x); acc[1] += w0.y * bf_hi(x.x) * bf_hi(c.x); acc[2] += w0.z * bf_lo(x.y) * bf_lo(c.y); acc[3] += w0.w * bf_hi(x.y) * bf_hi(c.y);
        acc[4] += w1.x * bf_lo(x.z) * bf_lo(c.z); acc[5] += w1.y * bf_hi(x.z) * bf_hi(c.z); acc[6] += w1.z * bf_lo(x.w) * bf_lo(c.w); acc[7] += w1.w * bf_hi(x.w) * bf_hi(c.w);
    }
    u32x4 o; o.x = cvt_pk_bf16(acc[0] * bf_lo(bc.x), acc[1] * bf_hi(bc.x)); o.y = cvt_pk_bf16(acc[2] * bf_lo(bc.y), acc[3] * bf_hi(bc.y));
    o.z = cvt_pk_bf16(acc[4] * bf_lo(bc.z), acc[5] * bf_hi(bc.z)); o.w = cvt_pk_bf16(acc[6] * bf_lo(bc.w), acc[7] * bf_hi(bc.w));
    return o;
}
__device__ __forceinline__ void conv_phase(const bf16_t* P, const float* cw, bf16_t* Yb, int gtid, int ngt) {
    for (int item = gtid; item < M * 64; item += 4 * ngt) {
        u32x4 o[4];
#pragma unroll
        for (int q = 0; q < 4; ++q) o[q] = conv_item(P, cw, item + q * ngt);
#pragma unroll
        for (int q = 0; q < 4; ++q) { const int it = item + q * ngt; *(u32x4*)(Yb + (size_t)(it >> 6) * YW + (it & 63) * 8) = o[q]; }
    }
}

#define XB_TMO      128
#define XB_XCNT(j)  (256  + 64 * (j))
#define XB_XSUB(j)  (1280 + 64 * (j))
#define XB_XGEN(j)  (2304 + 64 * (j))
#define XB_TOP      3328
#define XB_TOPGEN   3392
#define XCD_BAR_WORDS 3456
#define XB_SPIN_CAP (1u << 18)
__device__ __forceinline__ unsigned xb_ld(unsigned* p)              { return __hip_atomic_load(p, __ATOMIC_RELAXED, __HIP_MEMORY_SCOPE_AGENT); }
__device__ __forceinline__ unsigned xb_add(unsigned* p, unsigned v) { return __hip_atomic_fetch_add(p, v, __ATOMIC_RELAXED, __HIP_MEMORY_SCOPE_AGENT); }
__device__ __forceinline__ unsigned xb_xcc_id() { return (unsigned)__builtin_amdgcn_s_getreg((3 << 11) | 20) & 0xFu; }
#define XB_SPIN(cond, bar) do { unsigned _sp = 0; while (cond) { __builtin_amdgcn_s_sleep(1); \
    if ((++_sp & 255u) == 0u) { if (xb_ld(&(bar)[XB_TMO])) break; if (_sp > XB_SPIN_CAP) { atomicAdd(&(bar)[XB_TMO], 1u); break; } } } } while (0)
struct XcdBarrier { unsigned* bar; unsigned x; volatile LAS unsigned* st; };
__device__ __forceinline__ XcdBarrier xcd_barrier_post(unsigned* bar, volatile LAS unsigned* st) {
    XcdBarrier b; b.bar = bar; b.x = xb_xcc_id(); b.st = st;
    if (threadIdx.x == 0) (void)xb_add(&bar[XB_XCNT(b.x)], 1u);
    return b;
}
__device__ __forceinline__ void xcd_barrier_complete(unsigned* bar, unsigned x, unsigned& nloc, unsigned& nx) {
    const unsigned G = gridDim.x * gridDim.y * gridDim.z;
    unsigned sum, cnt, mine, sp = 0u;
    for (;;) {
        sum = 0u; cnt = 0u; mine = 0u;
#pragma unroll
        for (unsigned j = 0; j < 16; ++j) { const unsigned c = xb_ld(&bar[XB_XCNT(j)]); sum += c; cnt += (c > 0u) ? 1u : 0u; mine = (j == x) ? c : mine; }
        if (sum == G) break;
        __builtin_amdgcn_s_sleep(1);
        if ((++sp & 255u) == 0u) { if (xb_ld(&bar[XB_TMO])) break; if (sp > XB_SPIN_CAP) { atomicAdd(&bar[XB_TMO], 1u); break; } }
    }
    nloc = mine > 0u ? mine : 1u; nx = cnt > 0u ? cnt : 1u;
}
__device__ __forceinline__ void xcd_barrier(const XcdBarrier& b) {
    asm volatile("s_waitcnt vmcnt(0) lgkmcnt(0)" ::: "memory");
    __syncthreads();
    if (threadIdx.x == 0) {
        unsigned* bar = b.bar;
        __builtin_amdgcn_s_waitcnt(0);
        unsigned nloc = b.st[0], nx = b.st[1];
        if (nloc == 0u) { xcd_barrier_complete(bar, b.x, nloc, nx); b.st[0] = nloc; b.st[1] = nx; }
        const unsigned old = xb_add(&bar[XB_XSUB(b.x)], 1u);
        const unsigned gen = old / nloc;
        if (old + 1u == (gen + 1u) * nloc) {
            __builtin_amdgcn_fence(__ATOMIC_RELEASE, "agent");
            asm volatile("s_waitcnt vmcnt(0)" ::: "memory");
            const unsigned og = xb_add(&bar[XB_TOP], 1u);
            const unsigned tg = og / nx;
            if (og + 1u == (tg + 1u) * nx) xb_add(&bar[XB_TOPGEN], 1u);
            else XB_SPIN(xb_ld(&bar[XB_TOPGEN]) == tg, bar);
            __builtin_amdgcn_fence(__ATOMIC_ACQUIRE, "agent");
            xb_add(&bar[XB_XGEN(b.x)], 1u);
            asm volatile("s_waitcnt vmcnt(0)" ::: "memory");
        } else {
            XB_SPIN(xb_ld(&bar[XB_XGEN(b.x)]) == gen, bar);
            __builtin_amdgcn_fence(__ATOMIC_ACQUIRE, "agent");
            asm volatile("s_waitcnt vmcnt(0)" ::: "memory");
        }
    }
    __syncthreads();
}
__device__ __forceinline__ void cg_barrier(cg::grid_group& grid) {
    asm volatile("s_waitcnt vmcnt(0) lgkmcnt(0)" ::: "memory");
    __syncthreads();
    grid.sync();
    if (threadIdx.x == 0) { __builtin_amdgcn_fence(__ATOMIC_ACQUIRE, "agent"); asm volatile("s_waitcnt vmcnt(0)" ::: "memory"); }
    __syncthreads();
}
#define grid_barrier(g_) xcd_barrier(xbar)

#ifndef DIAG_STAGE
#define DIAG_STAGE 0
#endif
__device__ __forceinline__ void diag_dump(float* out, const bf16_t* src, int ld, int ncols) {
    for (size_t i = (size_t)blockIdx.x * 512 + threadIdx.x; i < (size_t)M * DM; i += (size_t)gridDim.x * 512) {
        const size_t row = i >> 10; const int c = (int)(i & 1023); float v = 0.f;
        for (int cc = c; cc < ncols; cc += 1024) v += bf_lo((unsigned)src[row * ld + cc]);
        out[i] = v;
    }
}
#define DIAG(k, src, ld, ncols) do { if (DIAG_STAGE == (k)) { grid_barrier(grid); diag_dump(a.out, (src), (ld), (ncols)); return; } } while (0)

__global__ void __launch_bounds__(512, 2) fwd_kernel(Args a) {
    extern __shared__ __attribute__((aligned(16))) unsigned char lds_raw[];
    LAS unsigned char* lds = (LAS unsigned char*)lds_raw;
    cg::grid_group grid = cg::this_grid();
    volatile LAS unsigned* xst = (volatile LAS unsigned*)((LAS unsigned char*)lds_raw + LDS_BYTES - 64);
    if (threadIdx.x == 0) { xst[0] = 0u; xst[1] = 0u; }
    __syncthreads();
    const XcdBarrier xbar = xcd_barrier_post((unsigned*)(a.ws + 16384), xst);
    const int G = gridDim.x, bid = blockIdx.x, ngw = G * 8;
#define FRESH() const int tid = launder_i(threadIdx.x), lane = tid & 63, w = __builtin_amdgcn_readfirstlane(tid >> 6), gw = bid * 8 + w; (void)lane; (void)gw
    unsigned char* ws = a.ws;
    bf16_t* XN = (bf16_t*)(ws + WS_XN); bf16_t* PR = (bf16_t*)(ws + WS_P); bf16_t* Y = (bf16_t*)(ws + WS_Y);
    float* LOGF = (float*)(ws + WS_LOGF); float* CUM = (float*)(ws + WS_CUM);

    {
        FRESH();
#ifndef NO_TAB
        for (int u = bid; u < 256; u += G) s5_tables(lds, a, u >> 7, (u >> 2) & 31, u & 3, tid);
#endif
        LAS float* scr = (LAS float*)(lds + w * 16640);
        constexpr int I_A = 16 * 56, I_G = 16 * 48, I_B = 8 * 16, I_O = 16 * 16, I_1 = 16 * 64, I_2 = 64 * 16, I_L = I_A + I_G + 3 * I_B + I_O + I_1 + I_2;
        for (int it = gw; it < 2 * I_L; it += ngw) {
            const int l = it / I_L; int r = it - l * I_L;
            unsigned char* wl = ws + WS_W + (size_t)l * W_LAYER;
            const float* win = a.in[2] + (size_t)l * DM * INW;
            if (r < I_A) { transpose_item(win, INW, 0, DM, NA, (bf16_t*)(wl + W_INA), scr, r, lane); continue; } r -= I_A;
            if (r < I_G) { transpose_item(win, INW, COL_G, DM, NG, (bf16_t*)(wl + W_G), scr, r, lane); continue; } r -= I_G;
            if (r < 3 * I_B) { const int br = r / I_B; transpose_item(a.in[15] + (size_t)l * 1536 * DM + (size_t)br * 512 * DM, DM, 0, 512, DM, (bf16_t*)(wl + W_BR) + (size_t)br * DM * 512, scr, r - br * I_B, lane); continue; } r -= 3 * I_B;
            if (r < I_O) { transpose_item(a.in[16] + (size_t)l * DM * DM, DM, 0, DM, DM, (bf16_t*)(wl + W_OUT), scr, r, lane); continue; } r -= I_O;
            if (r < I_1) { transpose_item(a.in[19] + (size_t)l * DM * FF, FF, 0, DM, FF, (bf16_t*)(wl + W_1), scr, r, lane); continue; } r -= I_1;
            transpose_item(a.in[20] + (size_t)l * FF * DM, DM, 0, FF, DM, (bf16_t*)(wl + W_2), scr, r, lane);
        }
        __syncthreads();
        NormArgs n{a.in[0], nullptr, nullptr, nullptr, a.in[1], XN, a.in[2] + COL_F, a.in[14], LOGF};
        norm_phase(lds, n, gw, ngw, lane, tid);
    }
    cg_barrier(grid);

    DIAG(1, XN, DM, DM);
#pragma unroll 1
    for (int l = 0; l < DEPTH; ++l) {
        unsigned char* wl = ws + WS_W + (size_t)l * W_LAYER;
        const unsigned char* s5tab = ws + WS_S5 + (size_t)l * S5_LAYER;
        const float* xin = (l == 0) ? a.in[0] : a.out;

        { FRESH(); for (int bh = bid; bh < 64; bh += G) cum_scan(lds, LOGF, CUM, bh, tid, lane, w); }
        {
            pg8::Gemm g{XN, (const bf16_t*)(wl + W_INA), M, NA, DM, 0, 0}; pg8::StaticOrder S; S.init(M, NA, G, bid, 1);
            pg8::Epi<pg8::EPI_PROJ> E{PR, NA, nullptr, nullptr};
#if (PHMASK >> 0) & 1
            pg8::gemm_phase<pg8::Epi<pg8::EPI_PROJ>, pg8::StaticOrder, true, true>(lds, g, S, E);
#endif
        }
        grid_barrier(grid);

        DIAG(2, PR, NA, NA);
#ifndef NO_S5
        { FRESH(); for (int v = bid; v < 256; v += G) s5_unit(lds, PR, s5tab, Y, v >> 5, v & 31, tid, lane, w); }
#endif
#ifndef NO_ATTN
        for (int v = bid; v < 256; v += G) {
            FRESH(); const int bh = v >> 2, s = v & 3;
#pragma unroll 1
            for (int k = 0; k < 4; ++k) { const int qb = (k == 0) ? 15 - s : (k == 1) ? s : (k == 2) ? 11 - s : s + 4;
                attn_unit(lds, PR, CUM, Y + 2 * (size_t)M * YW, bh >> 3, bh & 7, qb, tid, lane, w); }
        }
#endif
        { FRESH(); conv_phase(PR, a.in[13] + (size_t)l * 3 * 512, Y + (size_t)M * YW, bid * 512 + tid, G * 512); }
        grid_barrier(grid);

        if (DIAG_STAGE == 3) { grid_barrier(grid); for (size_t i = (size_t)blockIdx.x * 512 + threadIdx.x; i < (size_t)M * DM; i += (size_t)gridDim.x * 512) { const size_t row = i >> 10; const int c = (int)(i & 511); a.out[i] = bf_lo((unsigned)Y[row * YW + c]) + bf_lo((unsigned)Y[(size_t)M * YW + row * YW + c]) + bf_lo((unsigned)Y[2 * (size_t)M * YW + row * YW + c]); } return; }
        DIAG(31, Y + (size_t)M * YW, YW, YW); DIAG(32, Y + 2 * (size_t)M * YW, YW, YW);
        {
            pg8::Gemm g{XN, (const bf16_t*)(wl + W_G), M, NG, DM, 0, 0}; pg8::StaticOrder S; S.init(M, NG, G, bid, 1);
            pg8::Epi<pg8::EPI_GATE> E{PR, NG, a.in[3] + (size_t)l * NG, nullptr};
#if (PHMASK >> 1) & 1
            pg8::gemm_phase<pg8::Epi<pg8::EPI_GATE>, pg8::StaticOrder, true, true>(lds, g, S, E);
#endif
        }
        grid_barrier(grid);

        DIAG(4, PR, NG, NG);
        {
            pg8::Gemm g{Y, (const bf16_t*)(wl + W_BR), M, DM, 512, (size_t)M * YW * 2, (size_t)DM * 512 * 2}; pg8::StaticOrder S; S.init(M, DM, G, bid, 3);
            pg8::Epi<pg8::EPI_BRANCH> E{XN, DM, nullptr, PR};
#if (PHMASK >> 2) & 1
            pg8::gemm_phase<pg8::Epi<pg8::EPI_BRANCH>, pg8::StaticOrder, true, true>(lds, g, S, E);
#endif
        }
        grid_barrier(grid);

        DIAG(5, XN, DM, DM);
        {
            pg8::Gemm g{XN, (const bf16_t*)(wl + W_OUT), M, DM, DM, 0, 0}; pg8::StaticOrder S; S.init(M, DM, G, bid, 1);
            pg8::Epi<pg8::EPI_PLAIN> E{PR, DM, nullptr, nullptr};
#if (PHMASK >> 3) & 1
            pg8::gemm_phase<pg8::Epi<pg8::EPI_PLAIN>, pg8::StaticOrder, true, true>(lds, g, S, E);
#endif
        }
        grid_barrier(grid);

        DIAG(6, PR, DM, DM);
        {
            FRESH(); NormArgs n{xin, PR, a.in[17] + (size_t)l * DM, a.out, a.in[18] + (size_t)l * DM, XN, nullptr, nullptr, nullptr};
            norm_phase(lds, n, gw, ngw, lane, tid);
        }
        grid_barrier(grid);

        DIAG(7, XN, DM, DM);
        {
            pg8::Gemm g{XN, (const bf16_t*)(wl + W_1), M, FF, DM, 0, 0}; pg8::StaticOrder S; S.init(M, FF, G, bid, 1);
            pg8::Epi<pg8::EPI_RELU2> E{PR, FF, nullptr, nullptr};
#if (PHMASK >> 4) & 1
            pg8::gemm_phase<pg8::Epi<pg8::EPI_RELU2>, pg8::StaticOrder, true, true>(lds, g, S, E);
#endif
        }
        grid_barrier(grid);

        DIAG(8, PR, FF, FF);
        {
            pg8::Gemm g{PR, (const bf16_t*)(wl + W_2), M, DM, FF, 0, 0}; pg8::StaticOrder S; S.init(M, DM, G, bid, 1);
            pg8::Epi<pg8::EPI_PLAIN> E{XN, DM, nullptr, nullptr};
#if (PHMASK >> 5) & 1
            pg8::gemm_phase<pg8::Epi<pg8::EPI_PLAIN>, pg8::StaticOrder, true, true>(lds, g, S, E);
#endif
        }
        grid_barrier(grid);

        DIAG(9, XN, DM, DM);
        if (l + 1 < DEPTH) {
            FRESH(); NormArgs n{a.out, XN, a.in[21] + (size_t)l * DM, a.out, a.in[1] + (size_t)(l + 1) * DM, XN, a.in[2] + (size_t)(l + 1) * DM * INW + COL_F, a.in[14] + (l + 1) * 8, LOGF};
            norm_phase(lds, n, gw, ngw, lane, tid);
            grid_barrier(grid);
        } else {
            FRESH(); NormArgs n{a.out, XN, a.in[21] + (size_t)l * DM, a.out, nullptr, nullptr, nullptr, nullptr, nullptr};
            norm_phase(lds, n, gw, ngw, lane, tid);
        }
    }
}

extern "C" void kernel_launch(void* const* d_in, const int* in_sizes, int n_in, void* d_out, int out_size, void* d_ws, size_t ws_size, hipStream_t stream) {
    static int grid = 0;
    if (grid == 0) {
        if (n_in != 22 || in_sizes[0] != M * DM || out_size != M * DM || ws_size < WS_END) { fprintf(stderr, "kernel_launch: unexpected shapes (n_in %d, in0 %d, out %d, ws %zu)\n", n_in, n_in > 0 ? in_sizes[0] : -1, out_size, ws_size); grid = -1; return; }
        int dev = 0, cus = 0, per_cu = 0;
        (void)hipGetDevice(&dev);
        (void)hipDeviceGetAttribute(&cus, hipDeviceAttributeMultiprocessorCount, dev);
        if (hipFuncSetAttribute((const void*)fwd_kernel, hipFuncAttributeMaxDynamicSharedMemorySize, LDS_BYTES) != hipSuccess) fprintf(stderr, "kernel_launch: hipFuncSetAttribute failed\n");
        if (hipOccupancyMaxActiveBlocksPerMultiprocessor(&per_cu, (const void*)fwd_kernel, 512, LDS_BYTES) != hipSuccess || per_cu < 1) { fprintf(stderr, "kernel_launch: occupancy query gave %d\n", per_cu); per_cu = 1; }
        (void)hipGetLastError();
        grid = cus * per_cu; if (grid > 256) grid = 256; if (grid < 1) grid = 256;
    }
    if (grid < 0) return;
    (void)hipMemsetAsync(d_ws, 0, 65536, stream);
    Args a{};
    for (int i = 0; i < 22; ++i) a.in[i] = (const float*)d_in[i];
    a.out = (float*)d_out; a.ws = (unsigned char*)d_ws;
    void* args[] = {&a};
    hipError_t e = hipLaunchCooperativeKernel((const void*)fwd_kernel, dim3(grid), dim3(512), args, LDS_BYTES, stream);
    if (e != hipSuccess) fprintf(stderr, "kernel_launch: cooperative launch failed: %s (grid %d)\n", hipGetErrorString(e), grid);
}
```

```cpp
#include <hip/hip_runtime.h>
#include <hip/hip_cooperative_groups.h>
#include <cstdio>
#include <cstdint>
namespace cg = cooperative_groups;

#define DIAG_STAGE 0
#ifndef PHMASK
#define PHMASK 0xff
#endif

#define LAS __attribute__((address_space(3)))
typedef unsigned short bf16_t;
typedef short bf16x8 __attribute__((ext_vector_type(8)));
typedef short s16x4 __attribute__((ext_vector_type(4)));
typedef float f32x2 __attribute__((ext_vector_type(2)));
typedef float f32x4 __attribute__((ext_vector_type(4)));
typedef float f32x16 __attribute__((ext_vector_type(16)));
typedef unsigned u32x2 __attribute__((ext_vector_type(2)));
typedef unsigned u32x4 __attribute__((ext_vector_type(4)));

constexpr int BATCH = 8, SEQ = 4096, DM = 1024, M = BATCH * SEQ, DEPTH = 2;
constexpr int INW = 6664, NA = 3584, NG = 3072, FF = 4096, YW = 512;
constexpr int COL_XC = 512, COL_BC = 1024, COL_CC = 1536, COL_Q = 2048, COL_K = 2560, COL_V = 3072, COL_F = 3584, COL_G = 3592;
constexpr float EPS = 1e-6f;
constexpr float LOG2E = 1.4426950408889634f;
constexpr float C2 = 0.125f * LOG2E;

constexpr size_t MiB = 1u << 20;
constexpr size_t WS_W = 1 * MiB, W_LAYER = 34 * MiB;
constexpr size_t W_INA = 0, W_G = 7 * MiB, W_BR = 13 * MiB, W_OUT = 16 * MiB, W_1 = 18 * MiB, W_2 = 26 * MiB;
constexpr size_t WS_S5 = 69 * MiB, S5_LAYER = 17 * MiB + 512 * 1024;
constexpr size_t S5_KT = 0, S5_WE = MiB + 256 * 1024, S5_WC = S5_WE + 8 * MiB, S5_A64 = S5_WC + 8 * MiB, S5_GLU = S5_A64 + 64 * 1024;
constexpr size_t WS_LOGF = 104 * MiB, WS_CUM = 105 * MiB, WS_XN = 106 * MiB, WS_P = 170 * MiB, WS_Y = 394 * MiB, WS_END = 490 * MiB;
constexpr int KT_BYTES = 65 * 512;

constexpr int LDS_BYTES = 147456;

typedef __bf16 bf16x2_t __attribute__((ext_vector_type(2)));
__device__ __forceinline__ unsigned cvt_pk_bf16(float lo, float hi) { const f32x2 v = {lo, hi}; const bf16x2_t b = __builtin_convertvector(v, bf16x2_t); return __builtin_bit_cast(unsigned, b); }
__device__ __forceinline__ float bf_lo(unsigned u) { return __uint_as_float(u << 16); }
__device__ __forceinline__ float bf_hi(unsigned u) { return __uint_as_float(u & 0xffff0000u); }
template <int O> __device__ __forceinline__ float swz_xor(float v) { return __int_as_float(__builtin_amdgcn_ds_swizzle(__float_as_int(v), (O << 10) | 0x1f)); }
__device__ __forceinline__ float half_sum(float v) { auto rr = __builtin_amdgcn_permlane32_swap(__float_as_uint(v), __float_as_uint(v), false, false); return __uint_as_float(rr[0]) + __uint_as_float(rr[1]); }
__device__ __forceinline__ float half_max(float v) { auto rr = __builtin_amdgcn_permlane32_swap(__float_as_uint(v), __float_as_uint(v), false, false); return fmaxf(__uint_as_float(rr[0]), __uint_as_float(rr[1])); }
__device__ __forceinline__ float wave_sum(float v) {
    v += swz_xor<1>(v); v += swz_xor<2>(v); v += swz_xor<4>(v); v += swz_xor<8>(v); v += swz_xor<16>(v);
    return half_sum(v);
}
__device__ __forceinline__ int launder_i(int x) { asm volatile("" : "+v"(x)); return x; }
__device__ __forceinline__ float fast_exp2(float x) { return __builtin_amdgcn_exp2f(x); }
__device__ __forceinline__ float fast_rcp(float x) { return __builtin_amdgcn_rcpf(x); }
__device__ __forceinline__ float sigmoid_f(float z) { return fast_rcp(1.0f + fast_exp2(-LOG2E * z)); }
__device__ __forceinline__ float gelu_tanh(float y) { const float t = y + 0.044715f * y * y * y; return y * fast_rcp(1.0f + fast_exp2(-2.302208198f * t)); }

namespace pg8 {
#define PG8_LAS __attribute__((address_space(3)))
constexpr int BM = 256, BK = 64, HALF = 128, HTB = HALF * BK * 2, STAGE_BYTES = 8 * HTB, NXCD = 8, WGM = 8;

__host__ __device__ __forceinline__ int lds_byte(int r, int c) { const int st = (r >> 4) * 2 + (c >> 5), rr = r & 15, cc = c & 31, ob = rr * 64 + cc * 2; return st * 1024 + (ob ^ (((ob >> 9) & 1) << 5)); }
__host__ __device__ __forceinline__ void stage_rc(int b, int& R, int& C) { const int st = b / 1024, sb = b % 1024, swz = sb ^ (((sb >> 9) & 1) << 5); R = (st >> 1) * 16 + swz / 64; C = (st & 1) * 32 + (swz % 64) / 2; }
__host__ __device__ __forceinline__ int perm32(int rho) { const int n = rho >> 4, i = rho & 15; return 8 * (i >> 2) + 4 * n + (i & 3); }

struct Unit { int pm, pn, br; };
struct Gemm { const bf16_t* A; const bf16_t* Bt; int M, N, K; size_t abr, bbr; };

struct StaticOrder {
    int nM, nN, nwg, G, c, nbr;
    __device__ void init(int M_, int N_, int G_, int c_, int nbr_) { nM = M_ / BM; nN = N_ / BM; nwg = nM * nN; G = G_; c = c_; nbr = nbr_; }
    __device__ bool next(int i, Unit& u) const {
        const int it = i / nbr; u.br = i - it * nbr;
        const long L = (long)it * G + c; if (L >= nwg) return false;
        int wgid = (int)L; { const int q = nwg / NXCD, r = nwg % NXCD, xcd = wgid % NXCD, off = wgid / NXCD; wgid = (xcd < r ? xcd * (q + 1) : r * (q + 1) + (xcd - r) * q) + off; }
        const int nig = WGM * nN, gid = wgid / nig, fm = gid * WGM, gsz = (nM - fm) < WGM ? (nM - fm) : WGM;
        u.pm = fm + ((wgid % nig) % gsz); u.pn = (wgid % nig) / gsz; return true;
    }
};

enum { EPI_PROJ = 0, EPI_GATE = 1, EPI_RELU2 = 2, EPI_BRANCH = 3, EPI_PLAIN = 4 };
template <int MODE> struct Epi {
    static constexpr bool PERM = true;
    bf16_t* O; int ldc; const float* bias; const bf16_t* G;
    __device__ __forceinline__ void operator()(const f32x4 (&acc)[2][2][4][2], const Unit& u, int wr, int wc, int fr, int fq) const {
        const int row0 = u.pm * BM + wr * 64 + fr; const int col0 = u.pn * BM + wc * 32 + 8 * fq;
        float sc = 1.f; if (MODE == EPI_PROJ) { if (u.pn >= COL_Q / 256 && u.pn < COL_K / 256) sc = C2; }
        f32x4 bv[2][2];
        if (MODE == EPI_GATE) {
#pragma unroll
            for (int bj = 0; bj < 2; ++bj)
#pragma unroll
                for (int n = 0; n < 2; ++n) bv[bj][n] = *(const f32x4*)(bias + col0 + bj * HALF + 4 * n);
        }
        if (MODE == EPI_BRANCH) {
#pragma unroll
            for (int ai = 0; ai < 2; ++ai) {
                u32x2 gt[4][2]; u32x4 pv[4][2];
#pragma unroll
                for (int m = 0; m < 4; ++m)
#pragma unroll
                    for (int bj = 0; bj < 2; ++bj) {
                        const size_t row = (size_t)(row0 + ai * HALF + m * 16);
                        gt[m][bj] = *(const u32x2*)((const unsigned char*)G + row * NG + (size_t)u.br * DM + col0 + bj * HALF);
                        pv[m][bj] = (u.br > 0) ? *(const u32x4*)(O + row * ldc + col0 + bj * HALF) : (u32x4){0u, 0u, 0u, 0u};
                    }
                __builtin_amdgcn_sched_barrier(0);
#pragma unroll
                for (int m = 0; m < 4; ++m)
#pragma unroll
                    for (int bj = 0; bj < 2; ++bj) {
                        const size_t row = (size_t)(row0 + ai * HALF + m * 16);
                        f32x4 v0 = acc[ai][bj][m][0], v1 = acc[ai][bj][m][1];
                        const u32x2 g8 = gt[m][bj]; const u32x4 p4 = pv[m][bj];
                        v0 = v0 * (1.f / 255.f); v1 = v1 * (1.f / 255.f);
                        v0[0] = v0[0] * (float)(g8.x & 0xffu) + bf_lo(p4.x); v0[1] = v0[1] * (float)((g8.x >> 8) & 0xffu) + bf_hi(p4.x); v0[2] = v0[2] * (float)((g8.x >> 16) & 0xffu) + bf_lo(p4.y); v0[3] = v0[3] * (float)(g8.x >> 24) + bf_hi(p4.y);
                        v1[0] = v1[0] * (float)(g8.y & 0xffu) + bf_lo(p4.z); v1[1] = v1[1] * (float)((g8.y >> 8) & 0xffu) + bf_hi(p4.z); v1[2] = v1[2] * (float)((g8.y >> 16) & 0xffu) + bf_lo(p4.w); v1[3] = v1[3] * (float)(g8.y >> 24) + bf_hi(p4.w);
                        u32x4 wv; wv.x = cvt_pk_bf16(v0[0], v0[1]); wv.y = cvt_pk_bf16(v0[2], v0[3]); wv.z = cvt_pk_bf16(v1[0], v1[1]); wv.w = cvt_pk_bf16(v1[2], v1[3]);
                        *(u32x4*)(O + row * ldc + col0 + bj * HALF) = wv;
                    }
                __builtin_amdgcn_sched_barrier(0);
            }
            return;
        }
#pragma unroll
        for (int ai = 0; ai < 2; ++ai)
#pragma unroll
            for (int m = 0; m < 4; ++m) {
                const size_t row = (size_t)(row0 + ai * HALF + m * 16);
                bf16_t* rowp = O + row * ldc + col0;
#pragma unroll
                for (int bj = 0; bj < 2; ++bj) {
                    f32x4 v0 = acc[ai][bj][m][0], v1 = acc[ai][bj][m][1];
                    if (MODE == EPI_PROJ) { v0 = v0 * sc; v1 = v1 * sc; }
                    if (MODE == EPI_GATE) {
                        v0 = v0 + bv[bj][0]; v1 = v1 + bv[bj][1];
                        u32x2 w8; w8.x = 0u; w8.y = 0u;
#pragma unroll
                        for (int i = 0; i < 4; ++i) { w8.x |= (unsigned)(sigmoid_f(v0[i]) * 255.f + 0.5f) << (8 * i); w8.y |= (unsigned)(sigmoid_f(v1[i]) * 255.f + 0.5f) << (8 * i); }
                        *(u32x2*)((unsigned char*)O + row * ldc + col0 + bj * HALF) = w8;
                        continue;
                    }
                    if (MODE == EPI_RELU2) {
#pragma unroll
                        for (int i = 0; i < 4; ++i) { const float a = fmaxf(v0[i], 0.f), b = fmaxf(v1[i], 0.f); v0[i] = a * a; v1[i] = b * b; }
                    }
                    if (MODE == EPI_BRANCH) {
                        const u32x4 gt = *(const u32x4*)(G + row * NG + (size_t)u.br * DM + col0 + bj * HALF);
                        v0[0] *= bf_lo(gt.x); v0[1] *= bf_hi(gt.x); v0[2] *= bf_lo(gt.y); v0[3] *= bf_hi(gt.y);
                        v1[0] *= bf_lo(gt.z); v1[1] *= bf_hi(gt.z); v1[2] *= bf_lo(gt.w); v1[3] *= bf_hi(gt.w);
                        if (u.br > 0) {
                            const u32x4 pv = *(const u32x4*)(rowp + bj * HALF);
                            v0[0] += bf_lo(pv.x); v0[1] += bf_hi(pv.x); v0[2] += bf_lo(pv.y); v0[3] += bf_hi(pv.y);
                            v1[0] += bf_lo(pv.z); v1[1] += bf_hi(pv.z); v1[2] += bf_lo(pv.w); v1[3] += bf_hi(pv.w);
                        }
                    }
                    u32x4 w; w.x = cvt_pk_bf16(v0[0], v0[1]); w.y = cvt_pk_bf16(v0[2], v0[3]); w.z = cvt_pk_bf16(v1[0], v1[1]); w.w = cvt_pk_bf16(v1[2], v1[3]);
                    *(u32x4*)(rowp + bj * HALF) = w;
                }
            }
    }
};

template <class EpiT, class Sched, bool ALIGN_EPI, bool SP2>
__device__ __forceinline__ void gemm_phase(PG8_LAS unsigned char* lds, const Gemm g, const Sched& S, const EpiT& E) {
    const int tid = launder_i(threadIdx.x), wid = __builtin_amdgcn_readfirstlane(tid >> 6), lane = tid & 63, wr = wid >> 2, wc = wid & 3, fr = lane & 15, fq = lane >> 4;
    const int K = g.K, nt = K / BK;
    unsigned voffA[2], voffB[2];
#pragma unroll
    for (int i = 0; i < 2; ++i) { int R, C; stage_rc(tid * 16 + i * 8192, R, C); const int Rb = EpiT::PERM ? ((R & ~31) + perm32(R & 31)) : R;
        voffA[i] = (unsigned)(R * K + C) * 2u; voffB[i] = (unsigned)(Rb * K + C) * 2u; }
    const size_t kstep = (size_t)(BK * 2);
    const size_t hstep = (size_t)HALF * K * 2;
    const size_t tstep = 2 * hstep;
    const unsigned ldsw = (unsigned)wid * 1024u;
    const int aoff = lds_byte(wr * 64 + fr, fq * 8), boff = lds_byte(wc * 32 + fr, fq * 8);
#define PG8_SA(b, h) (((b) * 2 + (h)) * HTB)
#define PG8_SB(b, h) ((4 + (b) * 2 + (h)) * HTB)
#define PG8_STAGE(bufoff, gbase, voff) do { _Pragma("unroll") for (int _i = 0; _i < 2; ++_i) \
        __builtin_amdgcn_global_load_lds((const unsigned*)((const char*)(gbase) + (voff)[_i]), (PG8_LAS unsigned*)(lds + (bufoff) + ldsw + _i * 8192), 16, 0, 0); } while (0)
#define PG8_LDA(dst, b, h) do { _Pragma("unroll") for (int m = 0; m < 4; ++m) _Pragma("unroll") for (int k = 0; k < 2; ++k) dst[m][k] = *(const PG8_LAS bf16x8*)(lds + PG8_SA(b, h) + aoff + m * 2048 + k * 1024); } while (0)
#define PG8_LDB(dst, b, h) do { _Pragma("unroll") for (int n = 0; n < 2; ++n) _Pragma("unroll") for (int k = 0; k < 2; ++k) dst[n][k] = *(const PG8_LAS bf16x8*)(lds + PG8_SB(b, h) + boff + n * 2048 + k * 1024); } while (0)
#define PG8_MMA(ai, bj, At, Bt) do { __builtin_amdgcn_s_setprio(1); _Pragma("unroll") for (int m = 0; m < 4; ++m) _Pragma("unroll") for (int n = 0; n < 2; ++n) _Pragma("unroll") for (int k = 0; k < 2; ++k) \
        acc[ai][bj][m][n] = __builtin_amdgcn_mfma_f32_16x16x32_bf16(Bt[n][k], At[m][k], acc[ai][bj][m][n], 0, 0, 0); __builtin_amdgcn_s_setprio(0); } while (0)
#define PG8_WAIT_V(n) asm volatile("s_waitcnt vmcnt(" #n ")" ::: "memory")
#define PG8_WAIT_L(n) asm volatile("s_waitcnt lgkmcnt(" #n ")" ::: "memory")
#define PG8_BAR __builtin_amdgcn_s_barrier()
#define PG8_SCHED __builtin_amdgcn_sched_barrier(0)
    Unit cur, nxt; int ui = 0;
    if (!S.next(0, cur)) return;
    f32x4 acc[2][2][4][2];
#pragma unroll
    for (int a = 0; a < 2; ++a)
#pragma unroll
        for (int b = 0; b < 2; ++b)
#pragma unroll
            for (int m = 0; m < 4; ++m)
#pragma unroll
                for (int n = 0; n < 2; ++n) acc[a][b][m][n] = (f32x4){0.f, 0.f, 0.f, 0.f};
    bf16x8 At[4][2], B0[2][2], B1[2][2];
    const char* cA = (const char*)g.A + (size_t)cur.pm * tstep + (size_t)cur.br * g.abr; const char* cB = (const char*)g.Bt + (size_t)cur.pn * tstep + (size_t)cur.br * g.bbr;
    if constexpr (SP2) {
        PG8_STAGE(PG8_SB(0, 0), cB, voffB); PG8_STAGE(PG8_SB(0, 1), cB + hstep, voffB); PG8_STAGE(PG8_SA(0, 0), cA, voffA); PG8_STAGE(PG8_SA(0, 1), cA + hstep, voffA);
        if (wr == 1) PG8_BAR;
        PG8_WAIT_V(2); PG8_BAR;
        PG8_STAGE(PG8_SB(1, 0), cB + kstep, voffB); PG8_STAGE(PG8_SA(1, 0), cA + kstep, voffA); PG8_STAGE(PG8_SB(1, 1), cB + hstep + kstep, voffB);
        PG8_WAIT_V(6); PG8_BAR;
    } else {
        PG8_STAGE(PG8_SB(0, 0), cB, voffB); PG8_STAGE(PG8_SA(0, 0), cA, voffA); PG8_STAGE(PG8_SB(0, 1), cB + hstep, voffB); PG8_STAGE(PG8_SA(0, 1), cA + hstep, voffA);
        if (wr == 1) PG8_BAR;
        PG8_WAIT_V(4); PG8_BAR;
        PG8_STAGE(PG8_SB(1, 0), cB + kstep, voffB); PG8_STAGE(PG8_SA(1, 0), cA + kstep, voffA); PG8_STAGE(PG8_SB(1, 1), cB + hstep + kstep, voffB);
        PG8_WAIT_V(6); PG8_BAR;
    }
    for (;;) {
        const bool has_next = S.next(ui + 1, nxt);
        const char* nA = has_next ? (const char*)g.A + (size_t)nxt.pm * tstep + (size_t)nxt.br * g.abr : cA;
        const char* nB = has_next ? (const char*)g.Bt + (size_t)nxt.pn * tstep + (size_t)nxt.br * g.bbr : cB;
        for (int t = 0; t < nt; t += 2) {
            const bool last = (t == nt - 2);
            const char* a1 = cA + (size_t)(t + 1) * kstep;
            const char* a2 = last ? nA : cA + (size_t)(t + 2) * kstep; const char* b2 = last ? nB : cB + (size_t)(t + 2) * kstep;
            const char* a3 = a2 + kstep; const char* b3 = b2 + kstep;
            if constexpr (SP2) {
            PG8_LDB(B0, 0, 0); PG8_LDB(B1, 0, 1); PG8_SCHED; PG8_LDA(At, 0, 0); PG8_STAGE(PG8_SA(1, 1), a1 + hstep, voffA);
            PG8_WAIT_V(8); PG8_WAIT_L(0); PG8_BAR; PG8_MMA(0, 0, At, B0); PG8_MMA(0, 1, At, B1); PG8_BAR; PG8_SCHED;
            PG8_LDA(At, 0, 1); PG8_STAGE(PG8_SB(0, 0), b2, voffB); PG8_STAGE(PG8_SB(0, 1), b2 + hstep, voffB); PG8_STAGE(PG8_SA(0, 0), a2, voffA);
            PG8_WAIT_V(8); PG8_WAIT_L(0); PG8_BAR; PG8_MMA(1, 0, At, B0); PG8_MMA(1, 1, At, B1); PG8_BAR; PG8_SCHED;
            PG8_LDB(B0, 1, 0); PG8_LDB(B1, 1, 1); PG8_SCHED; PG8_LDA(At, 1, 0); PG8_STAGE(PG8_SA(0, 1), a2 + hstep, voffA);
            PG8_WAIT_V(8); PG8_WAIT_L(0); PG8_BAR; PG8_MMA(0, 0, At, B0); PG8_MMA(0, 1, At, B1); PG8_BAR; PG8_SCHED;
            PG8_LDA(At, 1, 1); PG8_STAGE(PG8_SB(1, 0), b3, voffB); PG8_STAGE(PG8_SB(1, 1), b3 + hstep, voffB); PG8_STAGE(PG8_SA(1, 0), a3, voffA);
            PG8_WAIT_V(8); PG8_WAIT_L(0); PG8_BAR; PG8_MMA(1, 0, At, B0); PG8_MMA(1, 1, At, B1); PG8_BAR; PG8_SCHED;
            } else {
            PG8_LDB(B0, 0, 0); PG8_SCHED; PG8_LDA(At, 0, 0); PG8_STAGE(PG8_SA(1, 1), a1 + hstep, voffA);
            PG8_WAIT_L(8); PG8_BAR; PG8_WAIT_L(0); PG8_MMA(0, 0, At, B0); PG8_BAR; PG8_SCHED;
            PG8_LDB(B1, 0, 1); PG8_STAGE(PG8_SB(0, 0), b2, voffB);
            PG8_BAR; PG8_WAIT_L(0); PG8_MMA(0, 1, At, B1); PG8_BAR;
            PG8_LDA(At, 0, 1); PG8_STAGE(PG8_SA(0, 0), a2, voffA);
            PG8_BAR; PG8_WAIT_L(0); PG8_MMA(1, 0, At, B0); PG8_BAR; PG8_SCHED;
            PG8_STAGE(PG8_SB(0, 1), b2 + hstep, voffB);
            PG8_WAIT_V(6); PG8_BAR; PG8_MMA(1, 1, At, B1); PG8_BAR;
            PG8_LDB(B0, 1, 0); PG8_SCHED; PG8_LDA(At, 1, 0); PG8_STAGE(PG8_SA(0, 1), a2 + hstep, voffA);
            PG8_WAIT_L(8); PG8_BAR; PG8_WAIT_L(0); PG8_MMA(0, 0, At, B0); PG8_BAR; PG8_SCHED;
            PG8_LDB(B1, 1, 1); PG8_STAGE(PG8_SB(1, 0), b3, voffB);
            PG8_BAR; PG8_WAIT_L(0); PG8_MMA(0, 1, At, B1); PG8_BAR;
            PG8_LDA(At, 1, 1); PG8_STAGE(PG8_SA(1, 0), a3, voffA);
            PG8_BAR; PG8_WAIT_L(0); PG8_MMA(1, 0, At, B0); PG8_BAR; PG8_SCHED;
            PG8_STAGE(PG8_SB(1, 1), b3 + hstep, voffB);
            PG8_WAIT_V(6); PG8_BAR; PG8_MMA(1, 1, At, B1); PG8_BAR;
            }
        }
        if constexpr (ALIGN_EPI) { if (wr == 0) PG8_BAR; }
        E(acc, cur, wr, wc, fr, fq);
        if (!has_next) break;
#pragma unroll
        for (int a = 0; a < 2; ++a)
#pragma unroll
            for (int b = 0; b < 2; ++b)
#pragma unroll
                for (int m = 0; m < 4; ++m)
#pragma unroll
                    for (int n = 0; n < 2; ++n) acc[a][b][m][n] = (f32x4){0.f, 0.f, 0.f, 0.f};
        cur = nxt; cA = nA; cB = nB; ++ui;
        if constexpr (ALIGN_EPI) { if (wr == 1) PG8_BAR; }
    }
    PG8_WAIT_V(0);
    if constexpr (!ALIGN_EPI) { if (wr == 0) PG8_BAR; }
    PG8_BAR;
#undef PG8_SA
#undef PG8_SB
#undef PG8_STAGE
#undef PG8_LDA
#undef PG8_LDB
#undef PG8_MMA
#undef PG8_WAIT_V
#undef PG8_WAIT_L
#undef PG8_BAR
#undef PG8_SCHED
}
}

struct Args { const float* in[22]; float* out; unsigned char* ws; };

__device__ __forceinline__ void transpose_item(const float* W, int ldw, int col_off, int K, int N, bf16_t* WT, LAS float* scr, int item, int lane) {
    const int nblk = N / 64, kb = item / nblk, nb = item % nblk, k0 = 64 * kb, n0 = 64 * nb;
    const int r = lane >> 4, c4 = lane & 15;
    f32x4 v[16];
#pragma unroll
    for (int i = 0; i < 16; ++i) v[i] = *(const f32x4*)(W + (size_t)(k0 + 4 * i + r) * ldw + col_off + n0 + 4 * c4);
#pragma unroll
    for (int i = 0; i < 16; ++i) { LAS float* d = scr + (4 * i + r) * 65 + 4 * c4; d[0] = v[i].x; d[1] = v[i].y; d[2] = v[i].z; d[3] = v[i].w; }
    asm volatile("s_waitcnt lgkmcnt(0)" ::: "memory");
    const int c = lane & 7;
#pragma unroll
    for (int j = 0; j < 8; ++j) { const int n = (lane >> 3) + 8 * j; const LAS float* s = scr + (8 * c) * 65 + n;
        u32x4 o; o.x = cvt_pk_bf16(s[0 * 65], s[1 * 65]); o.y = cvt_pk_bf16(s[2 * 65], s[3 * 65]); o.z = cvt_pk_bf16(s[4 * 65], s[5 * 65]); o.w = cvt_pk_bf16(s[6 * 65], s[7 * 65]);
        *(u32x4*)(WT + (size_t)(n0 + n) * K + k0 + 8 * c) = o; }
    asm volatile("s_waitcnt lgkmcnt(0)" ::: "memory");
}

__device__ __forceinline__ void s5_tables(LAS unsigned char* lds, const Args& a, int l, int g, int qt, int tid) {
    LAS f32x2* AP = (LAS f32x2*)lds;
    LAS f32x2* BB = AP + 65 * 64;
    LAS f32x2* CC = BB + 64 * 16;
    const int lg = l * 32 + g;
    const float* are = a.in[4] + lg * 64; const float* aim = a.in[5] + lg * 64;
    const float dt = expf(a.in[6][lg]);
    unsigned char* tab = a.ws + WS_S5 + (size_t)l * S5_LAYER;
    for (int idx = tid; idx < 65 * 64; idx += 512) {
        const int d = idx >> 6, p = idx & 63;
        const float lr = fminf(are[p], -1e-4f), li = aim[p];
        const float mag = expf(lr * dt * (float)d);
        double rev = (double)li * (double)dt * (double)d * 0.15915494309189535;
        rev -= floor(rev); if (rev > 0.5) rev -= 1.0;
        const float th = (float)(rev * 6.283185307179586);
        AP[idx] = (f32x2){mag * cosf(th), mag * sinf(th)};
    }
    for (int idx = tid; idx < 1024; idx += 512) CC[idx] = (f32x2){a.in[9][(size_t)lg * 1024 + idx], a.in[10][(size_t)lg * 1024 + idx]};
    for (int idx = tid; idx < 1024; idx += 512) {
        const int p = idx >> 4;
        const float lr = fminf(are[p], -1e-4f), li = aim[p];
        double rev = (double)li * (double)dt * 0.15915494309189535;
        rev -= floor(rev); if (rev > 0.5) rev -= 1.0;
        const float th = (float)(rev * 6.283185307179586);
        const float em1 = expm1f(lr * dt), c = cosf(th), s = sinf(th), sh = sinf(0.5f * th);
        const float nr = em1 * c - 2.f * sh * sh, ni = (1.f + em1) * s;
        const float den = 1.f / (lr * lr + li * li);
        const float qr = (nr * lr + ni * li) * den, qi = (ni * lr - nr * li) * den;
        const float br = a.in[7][(size_t)lg * 1024 + idx], bi = a.in[8][(size_t)lg * 1024 + idx];
        BB[idx] = (f32x2){qr * br - qi * bi, qr * bi + qi * br};
    }
    __syncthreads();
    bf16_t* kt = (bf16_t*)(tab + S5_KT) + (size_t)g * (65 * 256);
    if (tid < 256) { const int s = qt * 256 + tid;
        const int d = s >> 4, h = s & 15;
        float acc[16];
#pragma unroll
        for (int i = 0; i < 16; ++i) acc[i] = 0.f;
        for (int p = 0; p < 64; ++p) {
            const f32x2 cc = CC[h * 64 + p], ap = AP[d * 64 + p];
            const float cr = cc.x * ap.x - cc.y * ap.y, ci = cc.x * ap.y + cc.y * ap.x;
#pragma unroll
            for (int i = 0; i < 16; ++i) { const f32x2 bb = BB[p * 16 + i]; acc[i] += cr * bb.x - ci * bb.y; }
        }
        if (d == 0) { const float dsk = a.in[11][lg * 16 + h];
#pragma unroll
            for (int i = 0; i < 16; ++i) if (i == h) acc[i] += dsk; }
        u32x4 o0, o1;
        o0.x = cvt_pk_bf16(acc[0], acc[1]); o0.y = cvt_pk_bf16(acc[2], acc[3]); o0.z = cvt_pk_bf16(acc[4], acc[5]); o0.w = cvt_pk_bf16(acc[6], acc[7]);
        o1.x = cvt_pk_bf16(acc[8], acc[9]); o1.y = cvt_pk_bf16(acc[10], acc[11]); o1.z = cvt_pk_bf16(acc[12], acc[13]); o1.w = cvt_pk_bf16(acc[14], acc[15]);
        bf16_t* dst = kt + (size_t)(63 - d) * 256 + h * 8;
        *(u32x4*)dst = o0; *(u32x4*)(dst + 128) = o1;
    }
    if (qt == 0 && tid >= 256 && tid < 288) ((u32x4*)(kt + 64 * 256))[tid - 256] = (u32x4){0u, 0u, 0u, 0u};
    bf16_t* we = (bf16_t*)(tab + S5_WE) + (size_t)g * 128 * 1024;
    for (int idx = qt * 4096 + tid; idx < (qt + 1) * 4096; idx += 512) {
        const int half = idx & 1, j = (idx >> 1) & 63, row = idx >> 7, p = row & 63, im = row >> 6;
        const f32x2 ap = AP[(63 - j) * 64 + p];
        float v[8];
#pragma unroll
        for (int i = 0; i < 8; ++i) { const f32x2 bb = BB[p * 16 + 8 * half + i]; v[i] = im ? (ap.x * bb.y + ap.y * bb.x) : (ap.x * bb.x - ap.y * bb.y); }
        u32x4 o; o.x = cvt_pk_bf16(v[0], v[1]); o.y = cvt_pk_bf16(v[2], v[3]); o.z = cvt_pk_bf16(v[4], v[5]); o.w = cvt_pk_bf16(v[6], v[7]);
        *(u32x4*)(we + (size_t)row * 1024 + j * 16 + 8 * half) = o;
    }
    bf16_t* wc = (bf16_t*)(tab + S5_WC) + (size_t)g * 1024 * 128;
    for (int idx = qt * 4096 + tid; idx < (qt + 1) * 4096; idx += 512) {
        const int kgp = idx & 15, rowi = idx >> 4, t = rowi >> 4, h = rowi & 15, im = kgp >> 3, p0 = (kgp & 7) * 8;
        float v[8];
#pragma unroll
        for (int i = 0; i < 8; ++i) { const f32x2 cc = CC[h * 64 + p0 + i], ap = AP[(t + 1) * 64 + p0 + i];
            v[i] = im ? -(cc.x * ap.y + cc.y * ap.x) : (cc.x * ap.x - cc.y * ap.y); }
        u32x4 o; o.x = cvt_pk_bf16(v[0], v[1]); o.y = cvt_pk_bf16(v[2], v[3]); o.z = cvt_pk_bf16(v[4], v[5]); o.w = cvt_pk_bf16(v[6], v[7]);
        *(u32x4*)(wc + (size_t)rowi * 128 + kgp * 8) = o;
    }
    if (qt == 1 && tid < 64) {
        ((f32x2*)(tab + S5_A64))[g * 64 + tid] = AP[64 * 64 + tid];
        const int k = tid & 15, kg = tid >> 4; const float* wg = a.in[12] + (size_t)lg * 256;
        u32x4 o; o.x = cvt_pk_bf16(wg[(4 * kg + 0) * 16 + k], wg[(4 * kg + 1) * 16 + k]); o.y = cvt_pk_bf16(wg[(4 * kg + 2) * 16 + k], wg[(4 * kg + 3) * 16 + k]); o.z = 0u; o.w = 0u;
        ((u32x4*)(tab + S5_GLU))[g * 64 + tid] = o;
    }
    __syncthreads();
}

struct NormArgs { const float* resid; const bf16_t* add; const float* g_add; float* xout; const float* g_xn; bf16_t* xn; const float* wf; const float* bfh; float* logf; };
__device__ __forceinline__ void norm_phase(LAS unsigned char* lds, const NormArgs n, int gw, int ngw, int lane, int tid) {
    if (n.wf) {
        for (int i = tid; i < 2048; i += 512) { const int d = i >> 1, hh = i & 1; const f32x4 v = *(const f32x4*)(n.wf + (size_t)d * INW + 4 * hh);
            const int k = 4 * (d >> 8) + (d & 3), ln = (d >> 2) & 63;
            *(LAS f32x4*)(lds + ((k * 2 + hh) * 64 + ln) * 16) = v; }
        __syncthreads();
    }
    f32x4 ga[4], gx[4];
#pragma unroll
    for (int j = 0; j < 4; ++j) { ga[j] = n.add ? *(const f32x4*)(n.g_add + 4 * lane + 256 * j) : (f32x4){0.f, 0.f, 0.f, 0.f}; gx[j] = n.xn ? *(const f32x4*)(n.g_xn + 4 * lane + 256 * j) : (f32x4){0.f, 0.f, 0.f, 0.f}; }
    for (int rbase = gw; rbase < M; rbase += 2 * ngw) {
        f32x4 v[2][4]; f32x4 av[2][4];
#pragma unroll
        for (int rr = 0; rr < 2; ++rr) { const size_t row = (size_t)rbase + (size_t)rr * ngw;
#pragma unroll
            for (int j = 0; j < 4; ++j) v[rr][j] = *(const f32x4*)(n.resid + row * DM + 4 * lane + 256 * j);
            if (n.add) {
#pragma unroll
                for (int j = 0; j < 4; ++j) { const u32x2 u = *(const u32x2*)(n.add + row * DM + 4 * lane + 256 * j); av[rr][j] = (f32x4){bf_lo(u.x), bf_hi(u.x), bf_lo(u.y), bf_hi(u.y)}; }
            }
        }
#pragma unroll
        for (int rr = 0; rr < 2; ++rr) { const size_t row = (size_t)rbase + (size_t)rr * ngw;
            if (n.add) {
                float ss = 0.f;
#pragma unroll
                for (int j = 0; j < 4; ++j) ss += (av[rr][j].x * av[rr][j].x + av[rr][j].y * av[rr][j].y) + (av[rr][j].z * av[rr][j].z + av[rr][j].w * av[rr][j].w);
                const float rs = rsqrtf(wave_sum(ss) * (1.f / DM) + EPS);
#pragma unroll
                for (int j = 0; j < 4; ++j) v[rr][j] = v[rr][j] + av[rr][j] * rs * ga[j];
            }
            if (n.xout) {
#pragma unroll
                for (int j = 0; j < 4; ++j) *(f32x4*)(n.xout + row * DM + 4 * lane + 256 * j) = v[rr][j];
            }
            if (n.xn) {
                float ss = 0.f;
#pragma unroll
                for (int j = 0; j < 4; ++j) ss += (v[rr][j].x * v[rr][j].x + v[rr][j].y * v[rr][j].y) + (v[rr][j].z * v[rr][j].z + v[rr][j].w * v[rr][j].w);
                const float rs = rsqrtf(wave_sum(ss) * (1.f / DM) + EPS);
                f32x4 hn[4];
#pragma unroll
                for (int j = 0; j < 4; ++j) { hn[j] = v[rr][j] * rs * gx[j]; u32x2 o; o.x = cvt_pk_bf16(hn[j].x, hn[j].y); o.y = cvt_pk_bf16(hn[j].z, hn[j].w);
                    *(u32x2*)(n.xn + row * DM + 4 * lane + 256 * j) = o; }
                if (n.wf) {
                    f32x4 f0 = (f32x4){0.f, 0.f, 0.f, 0.f}, f1 = f0;
#pragma unroll
                    for (int j = 0; j < 4; ++j)
#pragma unroll
                        for (int i = 0; i < 4; ++i) { const LAS unsigned char* wp = lds + (((4 * j + i) * 2) * 64 + lane) * 16;
                            const f32x4 w0 = *(const LAS f32x4*)wp, w1 = *(const LAS f32x4*)(wp + 1024); f0 = f0 + w0 * hn[j][i]; f1 = f1 + w1 * hn[j][i]; }
                    float z = 0.f;
#pragma unroll
                    for (int hh = 0; hh < 4; ++hh) { const float s0 = wave_sum(f0[hh]), s1 = wave_sum(f1[hh]); if (lane == hh) z = s0; if (lane == hh + 4) z = s1; }
                    if (lane < 8) { z += n.bfh[lane]; n.logf[row * 8 + lane] = fminf(z, 0.f) - log1pf(expf(-fabsf(z))); }
                }
            }
        }
    }
}

__device__ __forceinline__ void cum_scan(LAS unsigned char* lds, const float* logf, float* cum, int bh, int tid, int lane, int w) {
    LAS float* ws = (LAS float*)lds;
    const int b = bh >> 3, h = bh & 7;
    float v[8]; float run = 0.f;
#pragma unroll
    for (int i = 0; i < 8; ++i) { run += logf[((size_t)b * SEQ + 8 * tid + i) * 8 + h]; v[i] = run; }
    float inc = run;
#pragma unroll
    for (int o = 1; o < 64; o <<= 1) { const float t = __int_as_float(__builtin_amdgcn_ds_bpermute((lane - o) << 2, __float_as_int(inc))); if (lane >= o) inc += t; }
    if (lane == 63) ws[w] = inc;
    __syncthreads();
    float base = inc - run;
    for (int i = 0; i < w; ++i) base += ws[i];
#pragma unroll
    for (int i = 0; i < 8; ++i) cum[(size_t)bh * SEQ + 8 * tid + i] = (base + v[i]) * LOG2E;
    __syncthreads();
}

#define MFMA16(a, b, c) __builtin_amdgcn_mfma_f32_16x16x32_bf16((a), (b), (c), 0, 0, 0)
#define MFMA32(a, b, c) __builtin_amdgcn_mfma_f32_32x32x16_bf16((a), (b), (c), 0, 0, 0)
__device__ __forceinline__ bf16x8 ldg16(const void* ubase, unsigned off) { return *(const bf16x8*)((const char*)ubase + off); }
__device__ __forceinline__ void s5_unit(LAS unsigned char* lds, const bf16_t* P, const unsigned char* tab, bf16_t* Ya, const int b, const int g, int tid, int lane, int w) {
    LAS unsigned char* KT = lds; LAS float* EL = (LAS float*)(lds + 33280); LAS unsigned char* SPT = lds + 66560;
    const unsigned char* ktab = tab + S5_KT + (size_t)g * KT_BYTES;
    const int n = lane & 15, kg = lane >> 4, ntile = w & 3, wh = w >> 2;
    const bf16_t* WEu = (const bf16_t*)(tab + S5_WE) + (size_t)g * 128 * 1024 + (size_t)(64 * wh) * 1024;
    const bf16_t* WCu = (const bf16_t*)(tab + S5_WC) + (size_t)g * 1024 * 128 + (size_t)(wh * 16) * 128;
    const bf16_t* Uu = P + ((size_t)b * SEQ + (size_t)(16 * ntile) * 64) * NA + 16 * g;
    const unsigned uoff = (unsigned)((n * 64 + (kg >> 1)) * NA + 8 * (kg & 1)) * 2u;
    const unsigned weoff = (unsigned)(n * 1024 + 8 * kg) * 2u;
    const unsigned wcoff = (unsigned)(n * 128 + 8 * kg) * 2u;
    for (int i = tid; i < KT_BYTES / 16; i += 512) *(LAS u32x4*)(KT + i * 16) = *(const u32x4*)(ktab + i * 16);
    {
        f32x4 e[4];
#pragma unroll
        for (int mt = 0; mt < 4; ++mt) e[mt] = (f32x4){0.f, 0.f, 0.f, 0.f};
        bf16x8 eb[4], ea[4][4];
#define S5_ELD(ks) do { eb[(ks) & 3] = ldg16(Uu + (size_t)(2 * (ks)) * NA, uoff); _Pragma("unroll") for (int _m = 0; _m < 4; ++_m) ea[(ks) & 3][_m] = ldg16(WEu + (size_t)(16 * _m) * 1024 + 32 * (ks), weoff); } while (0)
        S5_ELD(0); S5_ELD(1); S5_ELD(2);
        __builtin_amdgcn_sched_barrier(0);
#pragma unroll
        for (int ks = 0; ks < 32; ++ks) {
            if (ks + 3 < 32) S5_ELD(ks + 3);
#pragma unroll
            for (int mt = 0; mt < 4; ++mt) e[mt] = MFMA16(ea[ks & 3][mt], eb[ks & 3], e[mt]);
            __builtin_amdgcn_sched_barrier(0);
        }
#undef S5_ELD
#pragma unroll
        for (int mt = 0; mt < 4; ++mt)
#pragma unroll
            for (int i = 0; i < 4; ++i) EL[(64 * wh + 16 * mt + 4 * kg + i) * 65 + 16 * ntile + n] = e[mt][i];
    }
    __syncthreads();
    {
        const int p = tid & 63, seg = tid >> 6;
        const f32x2 a1 = ((const f32x2*)(tab + S5_A64))[g * 64 + p];
        float lr[8], li[8]; float sr = 0.f, si = 0.f;
#pragma unroll
        for (int j = 0; j < 8; ++j) { const float er = EL[p * 65 + 8 * seg + j], ei = EL[(64 + p) * 65 + 8 * seg + j];
            const float nr = a1.x * sr - a1.y * si + er, ni = a1.x * si + a1.y * sr + ei; sr = nr; si = ni; lr[j] = sr; li[j] = si; }
        LAS f32x2* TT = (LAS f32x2*)(lds + 66560 + 17408);
        TT[seg * 64 + p] = (f32x2){sr, si};
        f32x2 a2 = {a1.x * a1.x - a1.y * a1.y, 2.f * a1.x * a1.y}; f32x2 a4 = {a2.x * a2.x - a2.y * a2.y, 2.f * a2.x * a2.y}; const f32x2 a8 = {a4.x * a4.x - a4.y * a4.y, 2.f * a4.x * a4.y};
        __syncthreads();
        float cr = 0.f, ci = 0.f;
        for (int s2 = 0; s2 < seg; ++s2) { const f32x2 t = TT[s2 * 64 + p]; const float nr = a8.x * cr - a8.y * ci + t.x, ni = a8.x * ci + a8.y * cr + t.y; cr = nr; ci = ni; }
        float pr = cr, pi = ci, wr_ = cr, wi_ = ci;
#pragma unroll
        for (int j = 0; j < 8; ++j) {
            *(LAS bf16_t*)(SPT + (8 * seg + j) * 272 + 2 * p) = (bf16_t)(cvt_pk_bf16(pr, 0.f) & 0xffffu);
            *(LAS bf16_t*)(SPT + (8 * seg + j) * 272 + 2 * (64 + p)) = (bf16_t)(cvt_pk_bf16(pi, 0.f) & 0xffffu);
            const float nr = a1.x * wr_ - a1.y * wi_, ni = a1.x * wi_ + a1.y * wr_; wr_ = nr; wi_ = ni;
            pr = lr[j] + wr_; pi = li[j] + wi_;
        }
    }
    __syncthreads();
    const LAS unsigned char* klow = KT + (1 - wh + (lane >> 5)) * 512 + ((lane >> 4) & 1) * 256 + (lane & 15) * 16;
    const LAS unsigned char* spb = SPT + (16 * ntile + n) * 272 + 16 * kg;
    const bf16x8 aglu = *(const bf16x8*)(tab + S5_GLU + (size_t)(g * 64 + lane) * 16);
    const unsigned yoff = (unsigned)(n * 64 * YW + 4 * kg) * 2u;
#pragma unroll 1
    for (int pass = 0; pass < 2; ++pass) {
        f32x4 acc[16];
#pragma unroll
        for (int i = 0; i < 16; ++i) acc[i] = (f32x4){0.f, 0.f, 0.f, 0.f};
        bf16x8 bq[4], ca[2][4], bt[8], bu[8];
        const bf16_t* Up = Uu + (size_t)(32 * pass) * NA;
        const bf16_t* WCp = WCu + (size_t)(32 * pass) * 2048;
#define S5_LDC(st, slot) do { _Pragma("unroll") for (int _q = 0; _q < 4; ++_q) ca[slot][_q] = ldg16(WCp + (size_t)(2 * (4 * ((st) & 3) + _q)) * 2048 + 32 * ((st) >> 2), wcoff); } while (0)
#pragma unroll
        for (int jj = 0; jj < 8; ++jj) bt[jj] = ldg16(Up + (size_t)(2 * jj) * NA, uoff);
        S5_LDC(0, 0); S5_LDC(1, 1);
        if (pass == 1) {
            bq[0] = ldg16(Uu, uoff); bq[1] = ldg16(Uu + (size_t)2 * NA, uoff); bq[2] = ldg16(Uu + (size_t)4 * NA, uoff);
            __builtin_amdgcn_sched_barrier(0);
#pragma unroll
            for (int jj = 0; jj < 16; ++jj) {
                if (jj + 3 < 16) bq[(jj + 3) & 3] = ldg16(Uu + (size_t)(2 * (jj + 3)) * NA, uoff);
#pragma unroll
                for (int ii = 0; ii < 16; ++ii) { const bf16x8 af = *(const LAS bf16x8*)(klow + (30 - 2 * (ii - jj)) * 512); acc[ii] = MFMA16(af, bq[jj & 3], acc[ii]); }
                __builtin_amdgcn_sched_barrier(0);
            }
        }
        __builtin_amdgcn_sched_barrier(0);
#pragma unroll
        for (int jj = 0; jj < 16; ++jj) {
            const bf16x8 cb = *(const LAS bf16x8*)(spb + 64 * (jj >> 2));
            if (jj < 8) bu[jj] = ldg16(Up + (size_t)(2 * (jj + 8)) * NA, uoff);
#pragma unroll
            for (int ii = 0; ii < 16; ++ii) if (ii >= jj) { const bf16x8 af = *(const LAS bf16x8*)(klow + (62 - 2 * (ii - jj)) * 512); acc[ii] = MFMA16(af, (jj < 8 ? bt[jj & 7] : bu[jj & 7]), acc[ii]); }
#pragma unroll
            for (int q = 0; q < 4; ++q) acc[4 * (jj & 3) + q] = MFMA16(ca[jj & 1][q], cb, acc[4 * (jj & 3) + q]);
            __builtin_amdgcn_sched_barrier(0);
            if (jj + 2 < 16) S5_LDC(jj + 2, jj & 1);
            __builtin_amdgcn_sched_barrier(0);
        }
#undef S5_LDC
        bf16_t* Yu = Ya + ((size_t)b * SEQ + (size_t)(16 * ntile) * 64 + wh + 32 * pass) * YW + 16 * g;
#pragma unroll
        for (int ii = 0; ii < 16; ++ii) {
            f32x4 y;
#pragma unroll
            for (int k = 0; k < 4; ++k) y[k] = gelu_tanh(acc[ii][k]);
            u32x4 bp; bp.x = cvt_pk_bf16(y[0], y[1]); bp.y = cvt_pk_bf16(y[2], y[3]); bp.z = 0u; bp.w = 0u;
            const f32x4 z = MFMA16(aglu, __builtin_bit_cast(bf16x8, bp), ((f32x4){0.f, 0.f, 0.f, 0.f}));
            u32x2 o; o.x = cvt_pk_bf16(y[0] * sigmoid_f(z[0]), y[1] * sigmoid_f(z[1])); o.y = cvt_pk_bf16(y[2] * sigmoid_f(z[2]), y[3] * sigmoid_f(z[3]));
            *(u32x2*)((char*)(Yu + (size_t)(2 * ii) * YW) + yoff) = o;
        }
    }
    __syncthreads();
}

constexpr int AT_KS = 0, AT_VT = 9216, AT_VP = 192, AT_BS = 9216 + 64 * AT_VP, AT_BUF = AT_BS + 256;
__device__ __forceinline__ int crow(int r, int hi) { return (r & 3) + 8 * (r >> 2) + 4 * hi; }
__device__ __forceinline__ void attn_unit(LAS unsigned char* lds, const bf16_t* P, const float* cum, bf16_t* Yc, const int b, const int h, const int qb, int tid, int lane, int w) {
    const int r32 = lane & 31, hi = lane >> 5;
    const size_t row0 = (size_t)b * SEQ;
    const int q0 = qb * 256, qrow = q0 + 32 * w + r32;
    bf16x8 qf[4];
    { const bf16_t* qp = P + (row0 + qrow) * NA + COL_Q + 64 * h + 8 * hi;
#pragma unroll
      for (int s = 0; s < 4; ++s) qf[s] = *(const bf16x8*)(qp + 16 * s); }
    const float* cumbh = cum + (size_t)(b * 8 + h) * SEQ;
    const float ref = cumbh[q0];
    const int vlane = (4 * hi + ((lane & 15) >> 2)) * AT_VP + 32 * ((lane >> 4) & 1) + 8 * (lane & 3);
    const int skey = tid >> 3, spc = tid & 7;
    const bf16_t* kgp = P + (row0 + skey) * NA + COL_K + 64 * h + 8 * spc;
    const int NT = 4 * qb + 4;
    u32x4 kreg = *(const u32x4*)kgp, vreg = *(const u32x4*)(kgp + (COL_V - COL_K)); float breg = 0.f; if (tid < 64) breg = ref - cumbh[tid];
#define AT_WRITE(bufp) do { LAS unsigned char* _b = (bufp); *(LAS u32x4*)(_b + AT_KS + skey * 144 + 16 * spc) = kreg; \
        *(LAS u32x4*)(_b + AT_VT + skey * AT_VP + 16 * spc) = vreg; \
        if (tid < 64) *(LAS float*)(_b + AT_BS + 4 * tid) = breg; } while (0)
    AT_WRITE(lds);
    __syncthreads();
    float mrun = -1e30f, lrun = 0.f; f32x16 o0, o1;
#pragma unroll
    for (int r = 0; r < 16; ++r) { o0[r] = 0.f; o1[r] = 0.f; }
    for (int kt = 0; kt < NT; ++kt) {
        const int cur = kt & 1; const bool more = (kt + 1 < NT);
        if (more) { const bf16_t* kp = kgp + (size_t)(kt + 1) * 64 * NA; kreg = *(const u32x4*)kp; vreg = *(const u32x4*)(kp + (COL_V - COL_K)); if (tid < 64) breg = ref - cumbh[64 * (kt + 1) + tid]; }
        if (64 * kt <= q0 + 32 * w + 31) {
            const LAS unsigned char* Kb = lds + cur * AT_BUF + AT_KS; const LAS unsigned char* Vb = lds + cur * AT_BUF + AT_VT; const LAS unsigned char* Bb = lds + cur * AT_BUF + AT_BS;
            f32x16 p[2];
#pragma unroll
            for (int rb = 0; rb < 2; ++rb) {
                f32x16 c;
#pragma unroll
                for (int g4 = 0; g4 < 4; ++g4) { const f32x4 bv = *(const LAS f32x4*)(Bb + (32 * rb + 8 * g4 + 4 * hi) * 4); c[4 * g4 + 0] = bv.x; c[4 * g4 + 1] = bv.y; c[4 * g4 + 2] = bv.z; c[4 * g4 + 3] = bv.w; }
#pragma unroll
                for (int s = 0; s < 4; ++s) { const bf16x8 af = *(const LAS bf16x8*)(Kb + (32 * rb + r32) * 144 + 32 * s + 16 * hi); c = MFMA32(af, qf[s], c); }
                p[rb] = c;
            }
            if (64 * kt + 63 > q0 + 32 * w) {
#pragma unroll
                for (int rb = 0; rb < 2; ++rb)
#pragma unroll
                    for (int r = 0; r < 16; ++r) { const int key = 64 * kt + 32 * rb + crow(r, hi); if (key > qrow) p[rb][r] = -1e30f; }
            }
            float mt = p[0][0];
#pragma unroll
            for (int r = 1; r < 16; ++r) mt = fmaxf(mt, p[0][r]);
#pragma unroll
            for (int r = 0; r < 16; ++r) mt = fmaxf(mt, p[1][r]);
            mt = half_max(mt);
            const float mnew = fmaxf(mrun, mt), alpha = fast_exp2(mrun - mnew);
            mrun = mnew;
            float ls = 0.f;
#pragma unroll
            for (int rb = 0; rb < 2; ++rb)
#pragma unroll
                for (int r = 0; r < 16; ++r) { p[rb][r] = fast_exp2(p[rb][r] - mnew); ls += p[rb][r]; }
            lrun = lrun * alpha + ls;
#pragma unroll
            for (int r = 0; r < 16; ++r) { o0[r] *= alpha; o1[r] *= alpha; }
            bf16x8 pf[4];
#pragma unroll
            for (int s = 0; s < 4; ++s) { const int rb = s >> 1, r0 = 8 * (s & 1); u32x4 pk; pk.x = cvt_pk_bf16(p[rb][r0 + 0], p[rb][r0 + 1]); pk.y = cvt_pk_bf16(p[rb][r0 + 2], p[rb][r0 + 3]);
                pk.z = cvt_pk_bf16(p[rb][r0 + 4], p[rb][r0 + 5]); pk.w = cvt_pk_bf16(p[rb][r0 + 6], p[rb][r0 + 7]); pf[s] = __builtin_bit_cast(bf16x8, pk); }
#pragma unroll
            for (int s = 0; s < 4; ++s) {
                typedef short v4i16_t __attribute__((ext_vector_type(4)));
                const LAS unsigned char* vp = Vb + vlane + 16 * s * AT_VP;
                { const s16x4 lo = __builtin_bit_cast(s16x4, __builtin_amdgcn_ds_read_tr16_b64_v4i16((LAS v4i16_t*)(vp))), hh = __builtin_bit_cast(s16x4, __builtin_amdgcn_ds_read_tr16_b64_v4i16((LAS v4i16_t*)(vp + 8 * AT_VP)));
                  const bf16x8 af = __builtin_shufflevector(lo, hh, 0, 1, 2, 3, 4, 5, 6, 7); o0 = MFMA32(af, pf[s], o0); }
                { const s16x4 lo = __builtin_bit_cast(s16x4, __builtin_amdgcn_ds_read_tr16_b64_v4i16((LAS v4i16_t*)(vp + 64))), hh = __builtin_bit_cast(s16x4, __builtin_amdgcn_ds_read_tr16_b64_v4i16((LAS v4i16_t*)(vp + 64 + 8 * AT_VP)));
                  const bf16x8 af = __builtin_shufflevector(lo, hh, 0, 1, 2, 3, 4, 5, 6, 7); o1 = MFMA32(af, pf[s], o1); }
            }
        }
        if (more) AT_WRITE(lds + (cur ^ 1) * AT_BUF);
        __syncthreads();
    }
#undef AT_WRITE
    const float ltot = half_sum(lrun);
    const float inv = 1.0f / ltot;
    bf16_t* op = Yc + (row0 + qrow) * YW + 64 * h + 4 * hi;
#pragma unroll
    for (int g4 = 0; g4 < 4; ++g4) {
        u32x2 a, c2;
        a.x = cvt_pk_bf16(o0[4 * g4 + 0] * inv, o0[4 * g4 + 1] * inv); a.y = cvt_pk_bf16(o0[4 * g4 + 2] * inv, o0[4 * g4 + 3] * inv);
        c2.x = cvt_pk_bf16(o1[4 * g4 + 0] * inv, o1[4 * g4 + 1] * inv); c2.y = cvt_pk_bf16(o1[4 * g4 + 2] * inv, o1[4 * g4 + 3] * inv);
        *(u32x2*)(op + 8 * g4) = a; *(u32x2*)(op + 32 + 8 * g4) = c2;
    }
}

__device__ __forceinline__ u32x4 conv_item(const bf16_t* P, const float* cw, int item) {
    const int token = item >> 6, c0 = (item & 63) * 8, t = token & (SEQ - 1);
    float acc[8];
#pragma unroll
    for (int i = 0; i < 8; ++i) acc[i] = 0.f;
    u32x4 xc[3], cc[3];
#pragma unroll
    for (int tap = 0; tap < 3; ++tap) {
        const bool ok = (t - 2 + tap >= 0);
        const bf16_t* rp = P + (size_t)(ok ? token - 2 + tap : token) * NA + c0;
        xc[tap] = *(const u32x4*)(rp + COL_XC); cc[tap] = *(const u32x4*)(rp + COL_CC);
        if (!ok) { xc[tap] = (u32x4){0u, 0u, 0u, 0u}; }
    }
    const u32x4 bc = *(const u32x4*)(P + (size_t)token * NA + COL_BC + c0);
#pragma unroll
    for (int tap = 0; tap < 3; ++tap) {
        const f32x4 w0 = *(const f32x4*)(cw + tap * 512 + c0), w1 = *(const f32x4*)(cw + tap * 512 + c0 + 4);
        const u32x4 x = xc[tap], c = cc[tap];
        acc[0] += w0.x * bf_lo(x.x) * bf_lo(c.x); acc[1] += w0.y * bf_hi(x.x) * bf_hi(c.x); acc[2] += w0.z * bf_lo(x.y) * bf_lo(c.y); acc[3] += w0.w * bf_hi(x.y) * bf_hi(c.y);
        acc[4] += w1.x * bf_lo(x.z) * bf_lo(c.z); acc[5] += w1.y * bf_hi(x.z) * bf_hi(c.z); acc[6] += w1.z * bf_lo(x.w) * bf_lo(c.w); acc[7] += w1.w * bf_hi(x.w) * bf_hi(c.w);
    }
    u32x4 o; o.x = cvt_pk_bf16(acc[0] * bf_lo(bc.x), acc[1] * bf_hi(bc.x)); o.y = cvt_pk_bf16(acc[2] * bf_lo(bc.y), acc[3] * bf_hi(bc.y));
    o.z = cvt_pk_bf16(acc[4] * bf_lo(bc.z), acc[5] * bf_hi(bc.z)); o.w = cvt_pk_bf16(acc[6] * bf_lo(bc.w), acc[7] * bf_hi(bc.w));
    return o;
}
__device__ __forceinline__ void conv_phase(const bf16_t* P, const float* cw, bf16_t* Yb, int gtid, int ngt) {
    for (int item = gtid; item < M * 64; item += 4 * ngt) {
        u32x4 o[4];
#pragma unroll
        for (int q = 0; q < 4; ++q) o[q] = conv_item(P, cw, item + q * ngt);
#pragma unroll
        for (int q = 0; q < 4; ++q) { const int it = item + q * ngt; *(u32x4*)(Yb + (size_t)(it >> 6) * YW + (it & 63) * 8) = o[q]; }
    }
}

#define XB_TMO      128
#define XB_XCNT(j)  (256  + 64 * (j))
#define XB_XSUB(j)  (1280 + 64 * (j))
#define XB_XGEN(j)  (2304 + 64 * (j))
#define XB_TOP      3328
#define XB_TOPGEN   3392
#define XCD_BAR_WORDS 3456
#define XB_SPIN_CAP (1u << 18)
__device__ __forceinline__ unsigned xb_ld(unsigned* p)              { return __hip_atomic_load(p, __ATOMIC_RELAXED, __HIP_MEMORY_SCOPE_AGENT); }
__device__ __forceinline__ unsigned xb_add(unsigned* p, unsigned v) { return __hip_atomic_fetch_add(p, v, __ATOMIC_RELAXED, __HIP_MEMORY_SCOPE_AGENT); }
__device__ __forceinline__ unsigned xb_xcc_id() { return (unsigned)__builtin_amdgcn_s_getreg((3 << 11) | 20) & 0xFu; }
#define XB_SPIN(cond, bar) do { unsigned _sp = 0; while (cond) { __builtin_amdgcn_s_sleep(1); \
    if ((++_sp & 255u) == 0u) { if (xb_ld(&(bar)[XB_TMO])) break; if (_sp > XB_SPIN_CAP) { atomicAdd(&(bar)[XB_TMO], 1u); break; } } } } while (0)
struct XcdBarrier { unsigned* bar; unsigned x; volatile LAS unsigned* st; };
__device__ __forceinline__ XcdBarrier xcd_barrier_post(unsigned* bar, volatile LAS unsigned* st) {
    XcdBarrier b; b.bar = bar; b.x = xb_xcc_id(); b.st = st;
    if (threadIdx.x == 0) (void)xb_add(&bar[XB_XCNT(b.x)], 1u);
    return b;
}
__device__ __forceinline__ void xcd_barrier_complete(unsigned* bar, unsigned x, unsigned& nloc, unsigned& nx) {
    const unsigned G = gridDim.x * gridDim.y * gridDim.z;
    unsigned sum, cnt, mine, sp = 0u;
    for (;;) {
        sum = 0u; cnt = 0u; mine = 0u;
#pragma unroll
        for (unsigned j = 0; j < 16; ++j) { const unsigned c = xb_ld(&bar[XB_XCNT(j)]); sum += c; cnt += (c > 0u) ? 1u : 0u; mine = (j == x) ? c : mine; }
        if (sum == G) break;
        __builtin_amdgcn_s_sleep(1);
        if ((++sp & 255u) == 0u) { if (xb_ld(&bar[XB_TMO])) break; if (sp > XB_SPIN_CAP) { atomicAdd(&bar[XB_TMO], 1u); break; } }
    }
    nloc = mine > 0u ? mine : 1u; nx = cnt > 0u ? cnt : 1u;
}
__device__ __forceinline__ void xcd_barrier(const XcdBarrier& b) {
    asm volatile("s_waitcnt vmcnt(0) lgkmcnt(0)" ::: "memory");
    __syncthreads();
    if (threadIdx.x == 0) {
        unsigned* bar = b.bar;
        __builtin_amdgcn_s_waitcnt(0);
        unsigned nloc = b.st[0], nx = b.st[1];
        if (nloc == 0u) { xcd_barrier_complete(bar, b.x, nloc, nx); b.st[0] = nloc; b.st[1] = nx; }
        const unsigned old = xb_add(&bar[XB_XSUB(b.x)], 1u);
        const unsigned gen = old / nloc;
        if (old + 1u == (gen + 1u) * nloc) {
            __builtin_amdgcn_fence(__ATOMIC_RELEASE, "agent");
            asm volatile("s_waitcnt vmcnt(0)" ::: "memory");
            const unsigned og = xb_add(&bar[XB_TOP], 1u);
            const unsigned tg = og / nx;
            if (og + 1u == (tg + 1u) * nx) xb_add(&bar[XB_TOPGEN], 1u);
            else XB_SPIN(xb_ld(&bar[XB_TOPGEN]) == tg, bar);
            __builtin_amdgcn_fence(__ATOMIC_ACQUIRE, "agent");
            xb_add(&bar[XB_XGEN(b.x)], 1u);
            asm volatile("s_waitcnt vmcnt(0)" ::: "memory");
        } else {
            XB_SPIN(xb_ld(&bar[XB_XGEN(b.x)]) == gen, bar);
            __builtin_amdgcn_fence(__ATOMIC_ACQUIRE, "agent");
            asm volatile("s_waitcnt vmcnt(0)" ::: "memory");
        }
    }
    __syncthreads();
}
__device__ __forceinline__ void cg_barrier(cg::grid_group& grid) {
    asm volatile("s_waitcnt vmcnt(0) lgkmcnt(0)" ::: "memory");
    __syncthreads();
    grid.sync();
    if (threadIdx.x == 0) { __builtin_amdgcn_fence(__ATOMIC_ACQUIRE, "agent"); asm volatile("s_waitcnt vmcnt(0)" ::: "memory"); }
    __syncthreads();
}
#define grid_barrier(g_) xcd_barrier(xbar)

#ifndef DIAG_STAGE
#define DIAG_STAGE 0
#endif
__device__ __forceinline__ void diag_dump(float* out, const bf16_t* src, int ld, int ncols) {
    for (size_t i = (size_t)blockIdx.x * 512 + threadIdx.x; i < (size_t)M * DM; i += (size_t)gridDim.x * 512) {
        const size_t row = i >> 10; const int c = (int)(i & 1023); float v = 0.f;
        for (int cc = c; cc < ncols; cc += 1024) v += bf_lo((unsigned)src[row * ld + cc]);
        out[i] = v;
    }
}
#define DIAG(k, src, ld, ncols) do { if (DIAG_STAGE == (k)) { grid_barrier(grid); diag_dump(A_->out, (src), (ld), (ncols)); return; } } while (0)

typedef const __attribute__((address_space(4))) Args* KArgP;
__device__ __forceinline__ KArgP launder_args(KArgP p) { asm volatile("" : "+s"(p)); return p; }
#define A_ (launder_args(argp))
__global__ void __launch_bounds__(512, 2) fwd_kernel(Args a) {
    KArgP argp = (KArgP)__builtin_amdgcn_kernarg_segment_ptr(); (void)a;
    extern __shared__ __attribute__((aligned(16))) unsigned char lds_raw[];
    LAS unsigned char* lds = (LAS unsigned char*)lds_raw;
    cg::grid_group grid = cg::this_grid();
    volatile LAS unsigned* xst = (volatile LAS unsigned*)((LAS unsigned char*)lds_raw + LDS_BYTES - 64);
    if (threadIdx.x == 0) { xst[0] = 0u; xst[1] = 0u; }
    __syncthreads();
    const XcdBarrier xbar = xcd_barrier_post((unsigned*)(A_->ws + 16384), xst);
    const int G = gridDim.x, bid = blockIdx.x, ngw = G * 8;
#define FRESH() const int tid = launder_i(threadIdx.x), lane = tid & 63, w = __builtin_amdgcn_readfirstlane(tid >> 6), gw = bid * 8 + w; (void)lane; (void)gw
    unsigned char* ws = A_->ws;
    bf16_t* XN = (bf16_t*)(ws + WS_XN); bf16_t* PR = (bf16_t*)(ws + WS_P); bf16_t* Y = (bf16_t*)(ws + WS_Y);
    float* LOGF = (float*)(ws + WS_LOGF); float* CUM = (float*)(ws + WS_CUM);

    {
        FRESH();
#ifndef NO_TAB
        for (int u = bid; u < 256; u += G) s5_tables(lds, a, u >> 7, (u >> 2) & 31, u & 3, tid);
#endif
        LAS float* scr = (LAS float*)(lds + w * 16640);
        constexpr int I_A = 16 * 56, I_G = 16 * 48, I_B = 8 * 16, I_O = 16 * 16, I_1 = 16 * 64, I_2 = 64 * 16, I_L = I_A + I_G + 3 * I_B + I_O + I_1 + I_2;
        for (int it = gw; it < 2 * I_L; it += ngw) {
            const int l = it / I_L; int r = it - l * I_L;
            unsigned char* wl = ws + WS_W + (size_t)l * W_LAYER;
            const float* win = A_->in[2] + (size_t)l * DM * INW;
            if (r < I_A) { transpose_item(win, INW, 0, DM, NA, (bf16_t*)(wl + W_INA), scr, r, lane); continue; } r -= I_A;
            if (r < I_G) { transpose_item(win, INW, COL_G, DM, NG, (bf16_t*)(wl + W_G), scr, r, lane); continue; } r -= I_G;
            if (r < 3 * I_B) { const int br = r / I_B; transpose_item(A_->in[15] + (size_t)l * 1536 * DM + (size_t)br * 512 * DM, DM, 0, 512, DM, (bf16_t*)(wl + W_BR) + (size_t)br * DM * 512, scr, r - br * I_B, lane); continue; } r -= 3 * I_B;
            if (r < I_O) { transpose_item(A_->in[16] + (size_t)l * DM * DM, DM, 0, DM, DM, (bf16_t*)(wl + W_OUT), scr, r, lane); continue; } r -= I_O;
            if (r < I_1) { transpose_item(A_->in[19] + (size_t)l * DM * FF, FF, 0, DM, FF, (bf16_t*)(wl + W_1), scr, r, lane); continue; } r -= I_1;
            transpose_item(A_->in[20] + (size_t)l * FF * DM, DM, 0, FF, DM, (bf16_t*)(wl + W_2), scr, r, lane);
        }
        __syncthreads();
        NormArgs n{A_->in[0], nullptr, nullptr, nullptr, A_->in[1], XN, A_->in[2] + COL_F, A_->in[14], LOGF};
        norm_phase(lds, n, gw, ngw, lane, tid);
    }
    cg_barrier(grid);

    DIAG(1, XN, DM, DM);
#pragma unroll 1
    for (int l = 0; l < DEPTH; ++l) {
        unsigned char* wl = ws + WS_W + (size_t)l * W_LAYER;
        const unsigned char* s5tab = ws + WS_S5 + (size_t)l * S5_LAYER;
        const float* xin = (l == 0) ? A_->in[0] : A_->out;

        { FRESH(); for (int bh = bid; bh < 64; bh += G) cum_scan(lds, LOGF, CUM, bh, tid, lane, w); }
        {
            pg8::Gemm g{XN, (const bf16_t*)(wl + W_INA), M, NA, DM, 0, 0}; pg8::StaticOrder S; S.init(M, NA, G, bid, 1);
            pg8::Epi<pg8::EPI_PROJ> E{PR, NA, nullptr, nullptr};
#if (PHMASK >> 0) & 1
            pg8::gemm_phase<pg8::Epi<pg8::EPI_PROJ>, pg8::StaticOrder, true, true>(lds, g, S, E);
#endif
        }
        grid_barrier(grid);

        DIAG(2, PR, NA, NA);
#ifndef NO_S5
        { FRESH(); for (int v = bid; v < 256; v += G) s5_unit(lds, PR, s5tab, Y, v >> 5, v & 31, tid, lane, w); }
#endif
#ifndef NO_ATTN
        for (int v = bid; v < 256; v += G) {
            FRESH(); const int bh = v >> 2, s = v & 3;
#pragma unroll 1
            for (int k = 0; k < 4; ++k) { const int qb = (k == 0) ? 15 - s : (k == 1) ? s : (k == 2) ? 11 - s : s + 4;
                attn_unit(lds, PR, CUM, Y + 2 * (size_t)M * YW, bh >> 3, bh & 7, qb, tid, lane, w); }
        }
#endif
        { FRESH(); conv_phase(PR, A_->in[13] + (size_t)l * 3 * 512, Y + (size_t)M * YW, bid * 512 + tid, G * 512); }
        grid_barrier(grid);

        if (DIAG_STAGE == 3) { grid_barrier(grid); for (size_t i = (size_t)blockIdx.x * 512 + threadIdx.x; i < (size_t)M * DM; i += (size_t)gridDim.x * 512) { const size_t row = i >> 10; const int c = (int)(i & 511); A_->out[i] = bf_lo((unsigned)Y[row * YW + c]) + bf_lo((unsigned)Y[(size_t)M * YW + row * YW + c]) + bf_lo((unsigned)Y[2 * (size_t)M * YW + row * YW + c]); } return; }
        DIAG(31, Y + (size_t)M * YW, YW, YW); DIAG(32, Y + 2 * (size_t)M * YW, YW, YW);
        {
            pg8::Gemm g{XN, (const bf16_t*)(wl + W_G), M, NG, DM, 0, 0}; pg8::StaticOrder S; S.init(M, NG, G, bid, 1);
            pg8::Epi<pg8::EPI_GATE> E{PR, NG, A_->in[3] + (size_t)l * NG, nullptr};
#if (PHMASK >> 1) & 1
            pg8::gemm_phase<pg8::Epi<pg8::EPI_GATE>, pg8::StaticOrder, true, true>(lds, g, S, E);
#endif
        }
        grid_barrier(grid);

        DIAG(4, PR, NG, NG);
        {
            pg8::Gemm g{Y, (const bf16_t*)(wl + W_BR), M, DM, 512, (size_t)M * YW * 2, (size_t)DM * 512 * 2}; pg8::StaticOrder S; S.init(M, DM, G, bid, 3);
            pg8::Epi<pg8::EPI_BRANCH> E{XN, DM, nullptr, PR};
#if (PHMASK >> 2) & 1
            pg8::gemm_phase<pg8::Epi<pg8::EPI_BRANCH>, pg8::StaticOrder, true, true>(lds, g, S, E);
#endif
        }
        grid_barrier(grid);

        DIAG(5, XN, DM, DM);
        {
            pg8::Gemm g{XN, (const bf16_t*)(wl + W_OUT), M, DM, DM, 0, 0}; pg8::StaticOrder S; S.init(M, DM, G, bid, 1);
            pg8::Epi<pg8::EPI_PLAIN> E{PR, DM, nullptr, nullptr};
#if (PHMASK >> 3) & 1
            pg8::gemm_phase<pg8::Epi<pg8::EPI_PLAIN>, pg8::StaticOrder, true, true>(lds, g, S, E);
#endif
        }
        grid_barrier(grid);

        DIAG(6, PR, DM, DM);
        {
            FRESH(); NormArgs n{xin, PR, A_->in[17] + (size_t)l * DM, A_->out, A_->in[18] + (size_t)l * DM, XN, nullptr, nullptr, nullptr};
            norm_phase(lds, n, gw, ngw, lane, tid);
        }
        grid_barrier(grid);

        DIAG(7, XN, DM, DM);
        {
            pg8::Gemm g{XN, (const bf16_t*)(wl + W_1), M, FF, DM, 0, 0}; pg8::StaticOrder S; S.init(M, FF, G, bid, 1);
            pg8::Epi<pg8::EPI_RELU2> E{PR, FF, nullptr, nullptr};
#if (PHMASK >> 4) & 1
            pg8::gemm_phase<pg8::Epi<pg8::EPI_RELU2>, pg8::StaticOrder, true, true>(lds, g, S, E);
#endif
        }
        grid_barrier(grid);

        DIAG(8, PR, FF, FF);
        {
            pg8::Gemm g{PR, (const bf16_t*)(wl + W_2), M, DM, FF, 0, 0}; pg8::StaticOrder S; S.init(M, DM, G, bid, 1);
            pg8::Epi<pg8::EPI_PLAIN> E{XN, DM, nullptr, nullptr};
#if (PHMASK >> 5) & 1
            pg8::gemm_phase<pg8::Epi<pg8::EPI_PLAIN>, pg8::StaticOrder, true, true>(lds, g, S, E);
#endif
        }
        grid_barrier(grid);

        DIAG(9, XN, DM, DM);
        if (l + 1 < DEPTH) {
            FRESH(); NormArgs n{A_->out, XN, A_->in[21] + (size_t)l * DM, A_->out, A_->in[1] + (size_t)(l + 1) * DM, XN, A_->in[2] + (size_t)(l + 1) * DM * INW + COL_F, A_->in[14] + (l + 1) * 8, LOGF};
            norm_phase(lds, n, gw, ngw, lane, tid);
            grid_barrier(grid);
        } else {
            FRESH(); NormArgs n{A_->out, XN, A_->in[21] + (size_t)l * DM, A_->out, nullptr, nullptr, nullptr, nullptr, nullptr};
            norm_phase(lds, n, gw, ngw, lane, tid);
        }
    }
}

extern "C" void kernel_launch(void* const* d_in, const int* in_sizes, int n_in, void* d_out, int out_size, void* d_ws, size_t ws_size, hipStream_t stream) {
    static int grid = 0;
    if (grid == 0) {
        if (n_in != 22 || in_sizes[0] != M * DM || out_size != M * DM || ws_size < WS_END) { fprintf(stderr, "kernel_launch: unexpected shapes (n_in %d, in0 %d, out %d, ws %zu)\n", n_in, n_in > 0 ? in_sizes[0] : -1, out_size, ws_size); grid = -1; return; }
        int dev = 0, cus = 0, per_cu = 0;
        (void)hipGetDevice(&dev);
        (void)hipDeviceGetAttribute(&cus, hipDeviceAttributeMultiprocessorCount, dev);
        if (hipFuncSetAttribute((const void*)fwd_kernel, hipFuncAttributeMaxDynamicSharedMemorySize, LDS_BYTES) != hipSuccess) fprintf(stderr, "kernel_launch: hipFuncSetAttribute failed\n");
        if (hipOccupancyMaxActiveBlocksPerMultiprocessor(&per_cu, (const void*)fwd_kernel, 512, LDS_BYTES) != hipSuccess || per_cu < 1) { fprintf(stderr, "kernel_launch: occupancy query gave %d\n", per_cu); per_cu = 1; }
        (void)hipGetLastError();
        grid = cus * per_cu; if (grid > 256) grid = 256; if (grid < 1) grid = 256;
    }
    if (grid < 0) return;
    (void)hipMemsetAsync(d_ws, 0, 65536, stream);
    Args a{};
    for (int i = 0; i < 22; ++i) a.in[i] = (const float*)d_in[i];
    a.out = (float*)d_out; a.ws = (unsigned char*)d_ws;
    void* args[] = {&a};
    hipError_t e = hipLaunchCooperativeKernel((const void*)fwd_kernel, dim3(grid), dim3(512), args, LDS_BYTES, stream);
    if (e != hipSuccess) fprintf(stderr, "kernel_launch: cooperative launch failed: %s (grid %d)\n", hipGetErrorString(e), grid);
}
```

```cpp
#include <hip/hip_runtime.h>
#include <hip/hip_cooperative_groups.h>
#include <cstdio>
#include <cstdint>
namespace cg = cooperative_groups;

#define DIAG_STAGE 0
#ifndef PHMASK
#define PHMASK 0xff
#endif

#define LAS __attribute__((address_space(3)))
typedef unsigned short bf16_t;
typedef short bf16x8 __attribute__((ext_vector_type(8)));
typedef short s16x4 __attribute__((ext_vector_type(4)));
typedef float f32x2 __attribute__((ext_vector_type(2)));
typedef float f32x4 __attribute__((ext_vector_type(4)));
typedef float f32x16 __attribute__((ext_vector_type(16)));
typedef unsigned u32x2 __attribute__((ext_vector_type(2)));
typedef unsigned u32x4 __attribute__((ext_vector_type(4)));

constexpr int BATCH = 8, SEQ = 4096, DM = 1024, M = BATCH * SEQ, DEPTH = 2;
constexpr int INW = 6664, NA = 3584, NG = 3072, FF = 4096, YW = 512;
constexpr int COL_XC = 512, COL_BC = 1024, COL_CC = 1536, COL_Q = 2048, COL_K = 2560, COL_V = 3072, COL_F = 3584, COL_G = 3592;
constexpr float EPS = 1e-6f;
constexpr float LOG2E = 1.4426950408889634f;
constexpr float C2 = 0.125f * LOG2E;

constexpr size_t MiB = 1u << 20;
constexpr size_t WS_W = 1 * MiB, W_LAYER = 34 * MiB;
constexpr size_t W_INA = 0, W_G = 7 * MiB, W_BR = 13 * MiB, W_OUT = 16 * MiB, W_1 = 18 * MiB, W_2 = 26 * MiB;
constexpr size_t WS_S5 = 69 * MiB, S5_LAYER = 17 * MiB + 512 * 1024;
constexpr size_t S5_KT = 0, S5_WE = MiB + 256 * 1024, S5_WC = S5_WE + 8 * MiB, S5_A64 = S5_WC + 8 * MiB, S5_GLU = S5_A64 + 64 * 1024;
constexpr size_t WS_LOGF = 104 * MiB, WS_CUM = 105 * MiB, WS_XN = 106 * MiB, WS_P = 170 * MiB, WS_Y = 394 * MiB, WS_END = 490 * MiB;
constexpr int KT_BYTES = 65 * 512;

constexpr int LDS_BYTES = 147456;

typedef __bf16 bf16x2_t __attribute__((ext_vector_type(2)));
__device__ __forceinline__ unsigned cvt_pk_bf16(float lo, float hi) { const f32x2 v = {lo, hi}; const bf16x2_t b = __builtin_convertvector(v, bf16x2_t); return __builtin_bit_cast(unsigned, b); }
__device__ __forceinline__ float bf_lo(unsigned u) { return __uint_as_float(u << 16); }
__device__ __forceinline__ float bf_hi(unsigned u) { return __uint_as_float(u & 0xffff0000u); }
template <int O> __device__ __forceinline__ float swz_xor(float v) { return __int_as_float(__builtin_amdgcn_ds_swizzle(__float_as_int(v), (O << 10) | 0x1f)); }
__device__ __forceinline__ float half_sum(float v) { auto rr = __builtin_amdgcn_permlane32_swap(__float_as_uint(v), __float_as_uint(v), false, false); return __uint_as_float(rr[0]) + __uint_as_float(rr[1]); }
__device__ __forceinline__ float half_max(float v) { auto rr = __builtin_amdgcn_permlane32_swap(__float_as_uint(v), __float_as_uint(v), false, false); return fmaxf(__uint_as_float(rr[0]), __uint_as_float(rr[1])); }
__device__ __forceinline__ float wave_sum(float v) {
    v += swz_xor<1>(v); v += swz_xor<2>(v); v += swz_xor<4>(v); v += swz_xor<8>(v); v += swz_xor<16>(v);
    return half_sum(v);
}
__device__ __forceinline__ int launder_i(int x) { asm volatile("" : "+v"(x)); return x; }
__device__ __forceinline__ float fast_exp2(float x) { return __builtin_amdgcn_exp2f(x); }
__device__ __forceinline__ float fast_rcp(float x) { return __builtin_amdgcn_rcpf(x); }
__device__ __forceinline__ float sigmoid_f(float z) { return fast_rcp(1.0f + fast_exp2(-LOG2E * z)); }
__device__ __forceinline__ float gelu_tanh(float y) { const float t = y + 0.044715f * y * y * y; return y * fast_rcp(1.0f + fast_exp2(-2.302208198f * t)); }

namespace pg8 {
#define PG8_LAS __attribute__((address_space(3)))
constexpr int BM = 256, BK = 64, HALF = 128, HTB = HALF * BK * 2, STAGE_BYTES = 8 * HTB, NXCD = 8, WGM = 8;

__host__ __device__ __forceinline__ int lds_byte(int r, int c) { const int st = (r >> 4) * 2 + (c >> 5), rr = r & 15, cc = c & 31, ob = rr * 64 + cc * 2; return st * 1024 + (ob ^ (((ob >> 9) & 1) << 5)); }
__host__ __device__ __forceinline__ void stage_rc(int b, int& R, int& C) { const int st = b / 1024, sb = b % 1024, swz = sb ^ (((sb >> 9) & 1) << 5); R = (st >> 1) * 16 + swz / 64; C = (st & 1) * 32 + (swz % 64) / 2; }
__host__ __device__ __forceinline__ int perm32(int rho) { const int n = rho >> 4, i = rho & 15; return 8 * (i >> 2) + 4 * n + (i & 3); }

struct Unit { int pm, pn, br; };
struct Gemm { const bf16_t* A; const bf16_t* Bt; int M, N, K; size_t abr, bbr; };

struct StaticOrder {
    int nM, nN, nwg, G, c, nbr;
    __device__ void init(int M_, int N_, int G_, int c_, int nbr_) { nM = M_ / BM; nN = N_ / BM; nwg = nM * nN; G = G_; c = c_; nbr = nbr_; }
    __device__ bool next(int i, Unit& u) const {
        const int it = i / nbr; u.br = i - it * nbr;
        const long L = (long)it * G + c; if (L >= nwg) return false;
        int wgid = (int)L; { const int q = nwg / NXCD, r = nwg % NXCD, xcd = wgid % NXCD, off = wgid / NXCD; wgid = (xcd < r ? xcd * (q + 1) : r * (q + 1) + (xcd - r) * q) + off; }
        const int nig = WGM * nN, gid = wgid / nig, fm = gid * WGM, gsz = (nM - fm) < WGM ? (nM - fm) : WGM;
        u.pm = fm + ((wgid % nig) % gsz); u.pn = (wgid % nig) / gsz; return true;
    }
};

enum { EPI_PROJ = 0, EPI_GATE = 1, EPI_RELU2 = 2, EPI_BRANCH = 3, EPI_PLAIN = 4 };
template <int MODE> struct Epi {
    static constexpr bool PERM = true;
    bf16_t* O; int ldc; const float* bias; const bf16_t* G;
    __device__ __forceinline__ void operator()(const f32x4 (&acc)[2][2][4][2], const Unit& u, int wr, int wc, int fr, int fq) const {
        const int row0 = u.pm * BM + wr * 64 + fr; const int col0 = u.pn * BM + wc * 32 + 8 * fq;
        float sc = 1.f; if (MODE == EPI_PROJ) { if (u.pn >= COL_Q / 256 && u.pn < COL_K / 256) sc = C2; }
        f32x4 bv[2][2];
        if (MODE == EPI_GATE) {
#pragma unroll
            for (int bj = 0; bj < 2; ++bj)
#pragma unroll
                for (int n = 0; n < 2; ++n) bv[bj][n] = *(const f32x4*)(bias + col0 + bj * HALF + 4 * n);
        }
        if (MODE == EPI_BRANCH) {
#pragma unroll
            for (int ai = 0; ai < 2; ++ai) {
                u32x2 gt[4][2]; u32x4 pv[4][2];
#pragma unroll
                for (int m = 0; m < 4; ++m)
#pragma unroll
                    for (int bj = 0; bj < 2; ++bj) {
                        const size_t row = (size_t)(row0 + ai * HALF + m * 16);
                        gt[m][bj] = *(const u32x2*)((const unsigned char*)G + row * NG + (size_t)u.br * DM + col0 + bj * HALF);
                        pv[m][bj] = (u.br > 0) ? *(const u32x4*)(O + row * ldc + col0 + bj * HALF) : (u32x4){0u, 0u, 0u, 0u};
                    }
                __builtin_amdgcn_sched_barrier(0);
#pragma unroll
                for (int m = 0; m < 4; ++m)
#pragma unroll
                    for (int bj = 0; bj < 2; ++bj) {
                        const size_t row = (size_t)(row0 + ai * HALF + m * 16);
                        f32x4 v0 = acc[ai][bj][m][0], v1 = acc[ai][bj][m][1];
                        const u32x2 g8 = gt[m][bj]; const u32x4 p4 = pv[m][bj];
                        v0 = v0 * (1.f / 255.f); v1 = v1 * (1.f / 255.f);
                        v0[0] = v0[0] * (float)(g8.x & 0xffu) + bf_lo(p4.x); v0[1] = v0[1] * (float)((g8.x >> 8) & 0xffu) + bf_hi(p4.x); v0[2] = v0[2] * (float)((g8.x >> 16) & 0xffu) + bf_lo(p4.y); v0[3] = v0[3] * (float)(g8.x >> 24) + bf_hi(p4.y);
                        v1[0] = v1[0] * (float)(g8.y & 0xffu) + bf_lo(p4.z); v1[1] = v1[1] * (float)((g8.y >> 8) & 0xffu) + bf_hi(p4.z); v1[2] = v1[2] * (float)((g8.y >> 16) & 0xffu) + bf_lo(p4.w); v1[3] = v1[3] * (float)(g8.y >> 24) + bf_hi(p4.w);
                        u32x4 wv; wv.x = cvt_pk_bf16(v0[0], v0[1]); wv.y = cvt_pk_bf16(v0[2], v0[3]); wv.z = cvt_pk_bf16(v1[0], v1[1]); wv.w = cvt_pk_bf16(v1[2], v1[3]);
                        *(u32x4*)(O + row * ldc + col0 + bj * HALF) = wv;
                    }
                __builtin_amdgcn_sched_barrier(0);
            }
            return;
        }
#pragma unroll
        for (int ai = 0; ai < 2; ++ai)
#pragma unroll
            for (int m = 0; m < 4; ++m) {
                const size_t row = (size_t)(row0 + ai * HALF + m * 16);
                bf16_t* rowp = O + row * ldc + col0;
#pragma unroll
                for (int bj = 0; bj < 2; ++bj) {
                    f32x4 v0 = acc[ai][bj][m][0], v1 = acc[ai][bj][m][1];
                    if (MODE == EPI_PROJ) { v0 = v0 * sc; v1 = v1 * sc; }
                    if (MODE == EPI_GATE) {
                        v0 = v0 + bv[bj][0]; v1 = v1 + bv[bj][1];
                        u32x2 w8; w8.x = 0u; w8.y = 0u;
#pragma unroll
                        for (int i = 0; i < 4; ++i) { w8.x |= (unsigned)(sigmoid_f(v0[i]) * 255.f + 0.5f) << (8 * i); w8.y |= (unsigned)(sigmoid_f(v1[i]) * 255.f + 0.5f) << (8 * i); }
                        *(u32x2*)((unsigned char*)O + row * ldc + col0 + bj * HALF) = w8;
                        continue;
                    }
                    if (MODE == EPI_RELU2) {
#pragma unroll
                        for (int i = 0; i < 4; ++i) { const float a = fmaxf(v0[i], 0.f), b = fmaxf(v1[i], 0.f); v0[i] = a * a; v1[i] = b * b; }
                    }
                    if (MODE == EPI_BRANCH) {
                        const u32x4 gt = *(const u32x4*)(G + row * NG + (size_t)u.br * DM + col0 + bj * HALF);
                        v0[0] *= bf_lo(gt.x); v0[1] *= bf_hi(gt.x); v0[2] *= bf_lo(gt.y); v0[3] *= bf_hi(gt.y);
                        v1[0] *= bf_lo(gt.z); v1[1] *= bf_hi(gt.z); v1[2] *= bf_lo(gt.w); v1[3] *= bf_hi(gt.w);
                        if (u.br > 0) {
                            const u32x4 pv = *(const u32x4*)(rowp + bj * HALF);
                            v0[0] += bf_lo(pv.x); v0[1] += bf_hi(pv.x); v0[2] += bf_lo(pv.y); v0[3] += bf_hi(pv.y);
                            v1[0] += bf_lo(pv.z); v1[1] += bf_hi(pv.z); v1[2] += bf_lo(pv.w); v1[3] += bf_hi(pv.w);
                        }
                    }
                    u32x4 w; w.x = cvt_pk_bf16(v0[0], v0[1]); w.y = cvt_pk_bf16(v0[2], v0[3]); w.z = cvt_pk_bf16(v1[0], v1[1]); w.w = cvt_pk_bf16(v1[2], v1[3]);
                    *(u32x4*)(rowp + bj * HALF) = w;
                }
            }
    }
};

template <class EpiT, class Sched, bool ALIGN_EPI, bool SP2>
__device__ __forceinline__ void gemm_phase(PG8_LAS unsigned char* lds, const Gemm g, const Sched& S, const EpiT& E) {
    const int tid = launder_i(threadIdx.x), wid = __builtin_amdgcn_readfirstlane(tid >> 6), lane = tid & 63, wr = wid >> 2, wc = wid & 3, fr = lane & 15, fq = lane >> 4;
    const int K = g.K, nt = K / BK;
    unsigned voffA[2], voffB[2];
#pragma unroll
    for (int i = 0; i < 2; ++i) { int R, C; stage_rc(tid * 16 + i * 8192, R, C); const int Rb = EpiT::PERM ? ((R & ~31) + perm32(R & 31)) : R;
        voffA[i] = (unsigned)(R * K + C) * 2u; voffB[i] = (unsigned)(Rb * K + C) * 2u; }
    const size_t kstep = (size_t)(BK * 2);
    const size_t hstep = (size_t)HALF * K * 2;
    const size_t tstep = 2 * hstep;
    const unsigned ldsw = (unsigned)wid * 1024u;
    const int aoff = lds_byte(wr * 64 + fr, fq * 8), boff = lds_byte(wc * 32 + fr, fq * 8);
#define PG8_SA(b, h) (((b) * 2 + (h)) * HTB)
#define PG8_SB(b, h) ((4 + (b) * 2 + (h)) * HTB)
#define PG8_STAGE(bufoff, gbase, voff) do { _Pragma("unroll") for (int _i = 0; _i < 2; ++_i) \
        __builtin_amdgcn_global_load_lds((const unsigned*)((const char*)(gbase) + (voff)[_i]), (PG8_LAS unsigned*)(lds + (bufoff) + ldsw + _i * 8192), 16, 0, 0); } while (0)
#define PG8_LDA(dst, b, h) do { _Pragma("unroll") for (int m = 0; m < 4; ++m) _Pragma("unroll") for (int k = 0; k < 2; ++k) dst[m][k] = *(const PG8_LAS bf16x8*)(lds + PG8_SA(b, h) + aoff + m * 2048 + k * 1024); } while (0)
#define PG8_LDB(dst, b, h) do { _Pragma("unroll") for (int n = 0; n < 2; ++n) _Pragma("unroll") for (int k = 0; k < 2; ++k) dst[n][k] = *(const PG8_LAS bf16x8*)(lds + PG8_SB(b, h) + boff + n * 2048 + k * 1024); } while (0)
#define PG8_MMA(ai, bj, At, Bt) do { __builtin_amdgcn_s_setprio(1); _Pragma("unroll") for (int m = 0; m < 4; ++m) _Pragma("unroll") for (int n = 0; n < 2; ++n) _Pragma("unroll") for (int k = 0; k < 2; ++k) \
        acc[ai][bj][m][n] = __builtin_amdgcn_mfma_f32_16x16x32_bf16(Bt[n][k], At[m][k], acc[ai][bj][m][n], 0, 0, 0); __builtin_amdgcn_s_setprio(0); } while (0)
#define PG8_WAIT_V(n) asm volatile("s_waitcnt vmcnt(" #n ")" ::: "memory")
#define PG8_WAIT_L(n) asm volatile("s_waitcnt lgkmcnt(" #n ")" ::: "memory")
#define PG8_BAR __builtin_amdgcn_s_barrier()
#define PG8_SCHED __builtin_amdgcn_sched_barrier(0)
    Unit cur, nxt; int ui = 0;
    if (!S.next(0, cur)) return;
    f32x4 acc[2][2][4][2];
#pragma unroll
    for (int a = 0; a < 2; ++a)
#pragma unroll
        for (int b = 0; b < 2; ++b)
#pragma unroll
            for (int m = 0; m < 4; ++m)
#pragma unroll
                for (int n = 0; n < 2; ++n) acc[a][b][m][n] = (f32x4){0.f, 0.f, 0.f, 0.f};
    bf16x8 At[4][2], B0[2][2], B1[2][2];
    const char* cA = (const char*)g.A + (size_t)cur.pm * tstep + (size_t)cur.br * g.abr; const char* cB = (const char*)g.Bt + (size_t)cur.pn * tstep + (size_t)cur.br * g.bbr;
    if constexpr (SP2) {
        PG8_STAGE(PG8_SB(0, 0), cB, voffB); PG8_STAGE(PG8_SB(0, 1), cB + hstep, voffB); PG8_STAGE(PG8_SA(0, 0), cA, voffA); PG8_STAGE(PG8_SA(0, 1), cA + hstep, voffA);
        if (wr == 1) PG8_BAR;
        PG8_WAIT_V(2); PG8_BAR;
        PG8_STAGE(PG8_SB(1, 0), cB + kstep, voffB); PG8_STAGE(PG8_SA(1, 0), cA + kstep, voffA); PG8_STAGE(PG8_SB(1, 1), cB + hstep + kstep, voffB);
        PG8_WAIT_V(6); PG8_BAR;
    } else {
        PG8_STAGE(PG8_SB(0, 0), cB, voffB); PG8_STAGE(PG8_SA(0, 0), cA, voffA); PG8_STAGE(PG8_SB(0, 1), cB + hstep, voffB); PG8_STAGE(PG8_SA(0, 1), cA + hstep, voffA);
        if (wr == 1) PG8_BAR;
        PG8_WAIT_V(4); PG8_BAR;
        PG8_STAGE(PG8_SB(1, 0), cB + kstep, voffB); PG8_STAGE(PG8_SA(1, 0), cA + kstep, voffA); PG8_STAGE(PG8_SB(1, 1), cB + hstep + kstep, voffB);
        PG8_WAIT_V(6); PG8_BAR;
    }
    for (;;) {
        const bool has_next = S.next(ui + 1, nxt);
        const char* nA = has_next ? (const char*)g.A + (size_t)nxt.pm * tstep + (size_t)nxt.br * g.abr : cA;
        const char* nB = has_next ? (const char*)g.Bt + (size_t)nxt.pn * tstep + (size_t)nxt.br * g.bbr : cB;
        for (int t = 0; t < nt; t += 2) {
            const bool last = (t == nt - 2);
            const char* a1 = cA + (size_t)(t + 1) * kstep;
            const char* a2 = last ? nA : cA + (size_t)(t + 2) * kstep; const char* b2 = last ? nB : cB + (size_t)(t + 2) * kstep;
            const char* a3 = a2 + kstep; const char* b3 = b2 + kstep;
            if constexpr (SP2) {
            PG8_LDB(B0, 0, 0); PG8_LDB(B1, 0, 1); PG8_SCHED; PG8_LDA(At, 0, 0); PG8_STAGE(PG8_SA(1, 1), a1 + hstep, voffA);
            PG8_WAIT_V(8); PG8_WAIT_L(0); PG8_BAR; PG8_MMA(0, 0, At, B0); PG8_MMA(0, 1, At, B1); PG8_BAR; PG8_SCHED;
            PG8_LDA(At, 0, 1); PG8_STAGE(PG8_SB(0, 0), b2, voffB); PG8_STAGE(PG8_SB(0, 1), b2 + hstep, voffB); PG8_STAGE(PG8_SA(0, 0), a2, voffA);
            PG8_WAIT_V(8); PG8_WAIT_L(0); PG8_BAR; PG8_MMA(1, 0, At, B0); PG8_MMA(1, 1, At, B1); PG8_BAR; PG8_SCHED;
            PG8_LDB(B0, 1, 0); PG8_LDB(B1, 1, 1); PG8_SCHED; PG8_LDA(At, 1, 0); PG8_STAGE(PG8_SA(0, 1), a2 + hstep, voffA);
            PG8_WAIT_V(8); PG8_WAIT_L(0); PG8_BAR; PG8_MMA(0, 0, At, B0); PG8_MMA(0, 1, At, B1); PG8_BAR; PG8_SCHED;
            PG8_LDA(At, 1, 1); PG8_STAGE(PG8_SB(1, 0), b3, voffB); PG8_STAGE(PG8_SB(1, 1), b3 + hstep, voffB); PG8_STAGE(PG8_SA(1, 0), a3, voffA);
            PG8_WAIT_V(8); PG8_WAIT_L(0); PG8_BAR; PG8_MMA(1, 0, At, B0); PG8_MMA(1, 1, At, B1); PG8_BAR; PG8_SCHED;
            } else {
            PG8_LDB(B0, 0, 0); PG8_SCHED; PG8_LDA(At, 0, 0); PG8_STAGE(PG8_SA(1, 1), a1 + hstep, voffA);
            PG8_WAIT_L(8); PG8_BAR; PG8_WAIT_L(0); PG8_MMA(0, 0, At, B0); PG8_BAR; PG8_SCHED;
            PG8_LDB(B1, 0, 1); PG8_STAGE(PG8_SB(0, 0), b2, voffB);
            PG8_BAR; PG8_WAIT_L(0); PG8_MMA(0, 1, At, B1); PG8_BAR;
            PG8_LDA(At, 0, 1); PG8_STAGE(PG8_SA(0, 0), a2, voffA);
            PG8_BAR; PG8_WAIT_L(0); PG8_MMA(1, 0, At, B0); PG8_BAR; PG8_SCHED;
            PG8_STAGE(PG8_SB(0, 1), b2 + hstep, voffB);
            PG8_WAIT_V(6); PG8_BAR; PG8_MMA(1, 1, At, B1); PG8_BAR;
            PG8_LDB(B0, 1, 0); PG8_SCHED; PG8_LDA(At, 1, 0); PG8_STAGE(PG8_SA(0, 1), a2 + hstep, voffA);
            PG8_WAIT_L(8); PG8_BAR; PG8_WAIT_L(0); PG8_MMA(0, 0, At, B0); PG8_BAR; PG8_SCHED;
            PG8_LDB(B1, 1, 1); PG8_STAGE(PG8_SB(1, 0), b3, voffB);
            PG8_BAR; PG8_WAIT_L(0); PG8_MMA(0, 1, At, B1); PG8_BAR;
            PG8_LDA(At, 1, 1); PG8_STAGE(PG8_SA(1, 0), a3, voffA);
            PG8_BAR; PG8_WAIT_L(0); PG8_MMA(1, 0, At, B0); PG8_BAR; PG8_SCHED;
            PG8_STAGE(PG8_SB(1, 1), b3 + hstep, voffB);
            PG8_WAIT_V(6); PG8_BAR; PG8_MMA(1, 1, At, B1); PG8_BAR;
            }
        }
        if constexpr (ALIGN_EPI) { if (wr == 0) PG8_BAR; }
        E(acc, cur, wr, wc, fr, fq);
        if (!has_next) break;
#pragma unroll
        for (int a = 0; a < 2; ++a)
#pragma unroll
            for (int b = 0; b < 2; ++b)
#pragma unroll
                for (int m = 0; m < 4; ++m)
#pragma unroll
                    for (int n = 0; n < 2; ++n) acc[a][b][m][n] = (f32x4){0.f, 0.f, 0.f, 0.f};
        cur = nxt; cA = nA; cB = nB; ++ui;
        if constexpr (ALIGN_EPI) { if (wr == 1) PG8_BAR; }
    }
    PG8_WAIT_V(0);
    if constexpr (!ALIGN_EPI) { if (wr == 0) PG8_BAR; }
    PG8_BAR;
#undef PG8_SA
#undef PG8_SB
#undef PG8_STAGE
#undef PG8_LDA
#undef PG8_LDB
#undef PG8_MMA
#undef PG8_WAIT_V
#undef PG8_WAIT_L
#undef PG8_BAR
#undef PG8_SCHED
}
}

struct Args { const float* in[22]; float* out; unsigned char* ws; };

__device__ __forceinline__ void transpose_item(const float* W, int ldw, int col_off, int K, int N, bf16_t* WT, LAS float* scr, int item, int lane) {
    const int nblk = N / 64, kb = item / nblk, nb = item % nblk, k0 = 64 * kb, n0 = 64 * nb;
    const int r = lane >> 4, c4 = lane & 15;
    f32x4 v[16];
#pragma unroll
    for (int i = 0; i < 16; ++i) v[i] = *(const f32x4*)(W + (size_t)(k0 + 4 * i + r) * ldw + col_off + n0 + 4 * c4);
#pragma unroll
    for (int i = 0; i < 16; ++i) { LAS float* d = scr + (4 * i + r) * 65 + 4 * c4; d[0] = v[i].x; d[1] = v[i].y; d[2] = v[i].z; d[3] = v[i].w; }
    asm volatile("s_waitcnt lgkmcnt(0)" ::: "memory");
    const int c = lane & 7;
#pragma unroll
    for (int j = 0; j < 8; ++j) { const int n = (lane >> 3) + 8 * j; const LAS float* s = scr + (8 * c) * 65 + n;
        u32x4 o; o.x = cvt_pk_bf16(s[0 * 65], s[1 * 65]); o.y = cvt_pk_bf16(s[2 * 65], s[3 * 65]); o.z = cvt_pk_bf16(s[4 * 65], s[5 * 65]); o.w = cvt_pk_bf16(s[6 * 65], s[7 * 65]);
        *(u32x4*)(WT + (size_t)(n0 + n) * K + k0 + 8 * c) = o; }
    asm volatile("s_waitcnt lgkmcnt(0)" ::: "memory");
}

__device__ __forceinline__ void s5_tables(LAS unsigned char* lds, const Args& a, int l, int g, int qt, int tid) {
    LAS f32x2* AP = (LAS f32x2*)lds;
    LAS f32x2* BB = AP + 65 * 64;
    LAS f32x2* CC = BB + 64 * 16;
    const int lg = l * 32 + g;
    const float* are = a.in[4] + lg * 64; const float* aim = a.in[5] + lg * 64;
    const float dt = expf(a.in[6][lg]);
    unsigned char* tab = a.ws + WS_S5 + (size_t)l * S5_LAYER;
    for (int idx = tid; idx < 65 * 64; idx += 512) {
        const int d = idx >> 6, p = idx & 63;
        const float lr = fminf(are[p], -1e-4f), li = aim[p];
        const float mag = expf(lr * dt * (float)d);
        double rev = (double)li * (double)dt * (double)d * 0.15915494309189535;
        rev -= floor(rev); if (rev > 0.5) rev -= 1.0;
        const float th = (float)(rev * 6.283185307179586);
        AP[idx] = (f32x2){mag * cosf(th), mag * sinf(th)};
    }
    for (int idx = tid; idx < 1024; idx += 512) CC[idx] = (f32x2){a.in[9][(size_t)lg * 1024 + idx], a.in[10][(size_t)lg * 1024 + idx]};
    for (int idx = tid; idx < 1024; idx += 512) {
        const int p = idx >> 4;
        const float lr = fminf(are[p], -1e-4f), li = aim[p];
        double rev = (double)li * (double)dt * 0.15915494309189535;
        rev -= floor(rev); if (rev > 0.5) rev -= 1.0;
        const float th = (float)(rev * 6.283185307179586);
        const float em1 = expm1f(lr * dt), c = cosf(th), s = sinf(th), sh = sinf(0.5f * th);
        const float nr = em1 * c - 2.f * sh * sh, ni = (1.f + em1) * s;
        const float den = 1.f / (lr * lr + li * li);
        const float qr = (nr * lr + ni * li) * den, qi = (ni * lr - nr * li) * den;
        const float br = a.in[7][(size_t)lg * 1024 + idx], bi = a.in[8][(size_t)lg * 1024 + idx];
        BB[idx] = (f32x2){qr * br - qi * bi, qr * bi + qi * br};
    }
    __syncthreads();
    bf16_t* kt = (bf16_t*)(tab + S5_KT) + (size_t)g * (65 * 256);
    if (tid < 256) { const int s = qt * 256 + tid;
        const int d = s >> 4, h = s & 15;
        float acc[16];
#pragma unroll
        for (int i = 0; i < 16; ++i) acc[i] = 0.f;
        for (int p = 0; p < 64; ++p) {
            const f32x2 cc = CC[h * 64 + p], ap = AP[d * 64 + p];
            const float cr = cc.x * ap.x - cc.y * ap.y, ci = cc.x * ap.y + cc.y * ap.x;
#pragma unroll
            for (int i = 0; i < 16; ++i) { const f32x2 bb = BB[p * 16 + i]; acc[i] += cr * bb.x - ci * bb.y; }
        }
        if (d == 0) { const float dsk = a.in[11][lg * 16 + h];
#pragma unroll
            for (int i = 0; i < 16; ++i) if (i == h) acc[i] += dsk; }
        u32x4 o0, o1;
        o0.x = cvt_pk_bf16(acc[0], acc[1]); o0.y = cvt_pk_bf16(acc[2], acc[3]); o0.z = cvt_pk_bf16(acc[4], acc[5]); o0.w = cvt_pk_bf16(acc[6], acc[7]);
        o1.x = cvt_pk_bf16(acc[8], acc[9]); o1.y = cvt_pk_bf16(acc[10], acc[11]); o1.z = cvt_pk_bf16(acc[12], acc[13]); o1.w = cvt_pk_bf16(acc[14], acc[15]);
        bf16_t* dst = kt + (size_t)(63 - d) * 256 + h * 8;
        *(u32x4*)dst = o0; *(u32x4*)(dst + 128) = o1;
    }
    if (qt == 0 && tid >= 256 && tid < 288) ((u32x4*)(kt + 64 * 256))[tid - 256] = (u32x4){0u, 0u, 0u, 0u};
    bf16_t* we = (bf16_t*)(tab + S5_WE) + (size_t)g * 128 * 1024;
    for (int idx = qt * 4096 + tid; idx < (qt + 1) * 4096; idx += 512) {
        const int half = idx & 1, j = (idx >> 1) & 63, row = idx >> 7, p = row & 63, im = row >> 6;
        const f32x2 ap = AP[(63 - j) * 64 + p];
        float v[8];
#pragma unroll
        for (int i = 0; i < 8; ++i) { const f32x2 bb = BB[p * 16 + 8 * half + i]; v[i] = im ? (ap.x * bb.y + ap.y * bb.x) : (ap.x * bb.x - ap.y * bb.y); }
        u32x4 o; o.x = cvt_pk_bf16(v[0], v[1]); o.y = cvt_pk_bf16(v[2], v[3]); o.z = cvt_pk_bf16(v[4], v[5]); o.w = cvt_pk_bf16(v[6], v[7]);
        *(u32x4*)(we + (size_t)row * 1024 + j * 16 + 8 * half) = o;
    }
    bf16_t* wc = (bf16_t*)(tab + S5_WC) + (size_t)g * 1024 * 128;
    for (int idx = qt * 4096 + tid; idx < (qt + 1) * 4096; idx += 512) {
        const int kgp = idx & 15, rowi = idx >> 4, t = rowi >> 4, h = rowi & 15, im = kgp >> 3, p0 = (kgp & 7) * 8;
        float v[8];
#pragma unroll
        for (int i = 0; i < 8; ++i) { const f32x2 cc = CC[h * 64 + p0 + i], ap = AP[(t + 1) * 64 + p0 + i];
            v[i] = im ? -(cc.x * ap.y + cc.y * ap.x) : (cc.x * ap.x - cc.y * ap.y); }
        u32x4 o; o.x = cvt_pk_bf16(v[0], v[1]); o.y = cvt_pk_bf16(v[2], v[3]); o.z = cvt_pk_bf16(v[4], v[5]); o.w = cvt_pk_bf16(v[6], v[7]);
        *(u32x4*)(wc + (size_t)rowi * 128 + kgp * 8) = o;
    }
    if (qt == 1 && tid < 64) {
        ((f32x2*)(tab + S5_A64))[g * 64 + tid] = AP[64 * 64 + tid];
        const int k = tid & 15, kg = tid >> 4; const float* wg = a.in[12] + (size_t)lg * 256;
        u32x4 o; o.x = cvt_pk_bf16(wg[(4 * kg + 0) * 16 + k], wg[(4 * kg + 1) * 16 + k]); o.y = cvt_pk_bf16(wg[(4 * kg + 2) * 16 + k], wg[(4 * kg + 3) * 16 + k]); o.z = 0u; o.w = 0u;
        ((u32x4*)(tab + S5_GLU))[g * 64 + tid] = o;
    }
    __syncthreads();
}

struct NormArgs { const float* resid; const bf16_t* add; const float* g_add; float* xout; const float* g_xn; bf16_t* xn; const float* wf; const float* bfh; float* logf; };
__device__ __forceinline__ void norm_phase(LAS unsigned char* lds, const NormArgs n, int gw, int ngw, int lane, int tid) {
    if (n.wf) {
        for (int i = tid; i < 2048; i += 512) { const int d = i >> 1, hh = i & 1; const f32x4 v = *(const f32x4*)(n.wf + (size_t)d * INW + 4 * hh);
            const int k = 4 * (d >> 8) + (d & 3), ln = (d >> 2) & 63;
            *(LAS f32x4*)(lds + ((k * 2 + hh) * 64 + ln) * 16) = v; }
        __syncthreads();
    }
    f32x4 ga[4], gx[4];
#pragma unroll
    for (int j = 0; j < 4; ++j) { ga[j] = n.add ? *(const f32x4*)(n.g_add + 4 * lane + 256 * j) : (f32x4){0.f, 0.f, 0.f, 0.f}; gx[j] = n.xn ? *(const f32x4*)(n.g_xn + 4 * lane + 256 * j) : (f32x4){0.f, 0.f, 0.f, 0.f}; }
    for (int rbase = gw; rbase < M; rbase += 2 * ngw) {
        f32x4 v[2][4]; f32x4 av[2][4];
#pragma unroll
        for (int rr = 0; rr < 2; ++rr) { const size_t row = (size_t)rbase + (size_t)rr * ngw;
#pragma unroll
            for (int j = 0; j < 4; ++j) v[rr][j] = *(const f32x4*)(n.resid + row * DM + 4 * lane + 256 * j);
            if (n.add) {
#pragma unroll
                for (int j = 0; j < 4; ++j) { const u32x2 u = *(const u32x2*)(n.add + row * DM + 4 * lane + 256 * j); av[rr][j] = (f32x4){bf_lo(u.x), bf_hi(u.x), bf_lo(u.y), bf_hi(u.y)}; }
            }
        }
#pragma unroll
        for (int rr = 0; rr < 2; ++rr) { const size_t row = (size_t)rbase + (size_t)rr * ngw;
            if (n.add) {
                float ss = 0.f;
#pragma unroll
                for (int j = 0; j < 4; ++j) ss += (av[rr][j].x * av[rr][j].x + av[rr][j].y * av[rr][j].y) + (av[rr][j].z * av[rr][j].z + av[rr][j].w * av[rr][j].w);
                const float rs = rsqrtf(wave_sum(ss) * (1.f / DM) + EPS);
#pragma unroll
                for (int j = 0; j < 4; ++j) v[rr][j] = v[rr][j] + av[rr][j] * rs * ga[j];
            }
            if (n.xout) {
#pragma unroll
                for (int j = 0; j < 4; ++j) *(f32x4*)(n.xout + row * DM + 4 * lane + 256 * j) = v[rr][j];
            }
            if (n.xn) {
                float ss = 0.f;
#pragma unroll
                for (int j = 0; j < 4; ++j) ss += (v[rr][j].x * v[rr][j].x + v[rr][j].y * v[rr][j].y) + (v[rr][j].z * v[rr][j].z + v[rr][j].w * v[rr][j].w);
                const float rs = rsqrtf(wave_sum(ss) * (1.f / DM) + EPS);
                f32x4 hn[4];
#pragma unroll
                for (int j = 0; j < 4; ++j) { hn[j] = v[rr][j] * rs * gx[j]; u32x2 o; o.x = cvt_pk_bf16(hn[j].x, hn[j].y); o.y = cvt_pk_bf16(hn[j].z, hn[j].w);
                    *(u32x2*)(n.xn + row * DM + 4 * lane + 256 * j) = o; }
                if (n.wf) {
                    f32x4 f0 = (f32x4){0.f, 0.f, 0.f, 0.f}, f1 = f0;
#pragma unroll
                    for (int j = 0; j < 4; ++j)
#pragma unroll
                        for (int i = 0; i < 4; ++i) { const LAS unsigned char* wp = lds + (((4 * j + i) * 2) * 64 + lane) * 16;
                            const f32x4 w0 = *(const LAS f32x4*)wp, w1 = *(const LAS f32x4*)(wp + 1024); f0 = f0 + w0 * hn[j][i]; f1 = f1 + w1 * hn[j][i]; }
                    float z = 0.f;
#pragma unroll
                    for (int hh = 0; hh < 4; ++hh) { const float s0 = wave_sum(f0[hh]), s1 = wave_sum(f1[hh]); if (lane == hh) z = s0; if (lane == hh + 4) z = s1; }
                    if (lane < 8) { z += n.bfh[lane]; n.logf[row * 8 + lane] = fminf(z, 0.f) - log1pf(expf(-fabsf(z))); }
                }
            }
        }
    }
}

__device__ __forceinline__ void cum_scan(LAS unsigned char* lds, const float* logf, float* cum, int bh, int tid, int lane, int w) {
    LAS float* ws = (LAS float*)lds;
    const int b = bh >> 3, h = bh & 7;
    float v[8]; float run = 0.f;
#pragma unroll
    for (int i = 0; i < 8; ++i) { run += logf[((size_t)b * SEQ + 8 * tid + i) * 8 + h]; v[i] = run; }
    float inc = run;
#pragma unroll
    for (int o = 1; o < 64; o <<= 1) { const float t = __int_as_float(__builtin_amdgcn_ds_bpermute((lane - o) << 2, __float_as_int(inc))); if (lane >= o) inc += t; }
    if (lane == 63) ws[w] = inc;
    __syncthreads();
    float base = inc - run;
    for (int i = 0; i < w; ++i) base += ws[i];
#pragma unroll
    for (int i = 0; i < 8; ++i) cum[(size_t)bh * SEQ + 8 * tid + i] = (base + v[i]) * LOG2E;
    __syncthreads();
}

#define MFMA16(a, b, c) __builtin_amdgcn_mfma_f32_16x16x32_bf16((a), (b), (c), 0, 0, 0)
#define MFMA32(a, b, c) __builtin_amdgcn_mfma_f32_32x32x16_bf16((a), (b), (c), 0, 0, 0)
__device__ __forceinline__ bf16x8 ldg16(const void* ubase, unsigned off) { return *(const bf16x8*)((const char*)ubase + off); }
__device__ __forceinline__ void s5_unit(LAS unsigned char* lds, const bf16_t* P, const unsigned char* tab, bf16_t* Ya, const int b, const int g, int tid, int lane, int w) {
    LAS unsigned char* KT = lds; LAS float* EL = (LAS float*)(lds + 33280); LAS unsigned char* SPT = lds + 66560;
    const unsigned char* ktab = tab + S5_KT + (size_t)g * KT_BYTES;
    const int n = lane & 15, kg = lane >> 4, ntile = w & 3, wh = w >> 2;
    const bf16_t* WEu = (const bf16_t*)(tab + S5_WE) + (size_t)g * 128 * 1024 + (size_t)(64 * wh) * 1024;
    const bf16_t* WCu = (const bf16_t*)(tab + S5_WC) + (size_t)g * 1024 * 128 + (size_t)(wh * 16) * 128;
    const bf16_t* Uu = P + ((size_t)b * SEQ + (size_t)(16 * ntile) * 64) * NA + 16 * g;
    const unsigned uoff = (unsigned)((n * 64 + (kg >> 1)) * NA + 8 * (kg & 1)) * 2u;
    const unsigned weoff = (unsigned)(n * 1024 + 8 * kg) * 2u;
    const unsigned wcoff = (unsigned)(n * 128 + 8 * kg) * 2u;
    for (int i = tid; i < KT_BYTES / 16; i += 512) *(LAS u32x4*)(KT + i * 16) = *(const u32x4*)(ktab + i * 16);
    {
        f32x4 e[4];
#pragma unroll
        for (int mt = 0; mt < 4; ++mt) e[mt] = (f32x4){0.f, 0.f, 0.f, 0.f};
        bf16x8 eb[4], ea[4][4];
#define S5_ELD(ks) do { eb[(ks) & 3] = ldg16(Uu + (size_t)(2 * (ks)) * NA, uoff); _Pragma("unroll") for (int _m = 0; _m < 4; ++_m) ea[(ks) & 3][_m] = ldg16(WEu + (size_t)(16 * _m) * 1024 + 32 * (ks), weoff); } while (0)
        S5_ELD(0); S5_ELD(1); S5_ELD(2);
        __builtin_amdgcn_sched_barrier(0);
#pragma unroll
        for (int ks = 0; ks < 32; ++ks) {
            if (ks + 3 < 32) S5_ELD(ks + 3);
#pragma unroll
            for (int mt = 0; mt < 4; ++mt) e[mt] = MFMA16(ea[ks & 3][mt], eb[ks & 3], e[mt]);
            __builtin_amdgcn_sched_barrier(0);
        }
#undef S5_ELD
#pragma unroll
        for (int mt = 0; mt < 4; ++mt)
#pragma unroll
            for (int i = 0; i < 4; ++i) EL[(64 * wh + 16 * mt + 4 * kg + i) * 65 + 16 * ntile + n] = e[mt][i];
    }
    __syncthreads();
    {
        const int p = tid & 63, seg = tid >> 6;
        const f32x2 a1 = ((const f32x2*)(tab + S5_A64))[g * 64 + p];
        float lr[8], li[8]; float sr = 0.f, si = 0.f;
#pragma unroll
        for (int j = 0; j < 8; ++j) { const float er = EL[p * 65 + 8 * seg + j], ei = EL[(64 + p) * 65 + 8 * seg + j];
            const float nr = a1.x * sr - a1.y * si + er, ni = a1.x * si + a1.y * sr + ei; sr = nr; si = ni; lr[j] = sr; li[j] = si; }
        LAS f32x2* TT = (LAS f32x2*)(lds + 66560 + 17408);
        TT[seg * 64 + p] = (f32x2){sr, si};
        f32x2 a2 = {a1.x * a1.x - a1.y * a1.y, 2.f * a1.x * a1.y}; f32x2 a4 = {a2.x * a2.x - a2.y * a2.y, 2.f * a2.x * a2.y}; const f32x2 a8 = {a4.x * a4.x - a4.y * a4.y, 2.f * a4.x * a4.y};
        __syncthreads();
        float cr = 0.f, ci = 0.f;
        for (int s2 = 0; s2 < seg; ++s2) { const f32x2 t = TT[s2 * 64 + p]; const float nr = a8.x * cr - a8.y * ci + t.x, ni = a8.x * ci + a8.y * cr + t.y; cr = nr; ci = ni; }
        float pr = cr, pi = ci, wr_ = cr, wi_ = ci;
#pragma unroll
        for (int j = 0; j < 8; ++j) {
            *(LAS bf16_t*)(SPT + (8 * seg + j) * 272 + 2 * p) = (bf16_t)(cvt_pk_bf16(pr, 0.f) & 0xffffu);
            *(LAS bf16_t*)(SPT + (8 * seg + j) * 272 + 2 * (64 + p)) = (bf16_t)(cvt_pk_bf16(pi, 0.f) & 0xffffu);
            const float nr = a1.x * wr_ - a1.y * wi_, ni = a1.x * wi_ + a1.y * wr_; wr_ = nr; wi_ = ni;
            pr = lr[j] + wr_; pi = li[j] + wi_;
        }
    }
    __syncthreads();
    const LAS unsigned char* klow = KT + (1 - wh + (lane >> 5)) * 512 + ((lane >> 4) & 1) * 256 + (lane & 15) * 16;
    const LAS unsigned char* spb = SPT + (16 * ntile + n) * 272 + 16 * kg;
    const bf16x8 aglu = *(const bf16x8*)(tab + S5_GLU + (size_t)(g * 64 + lane) * 16);
    const unsigned yoff = (unsigned)(n * 64 * YW + 4 * kg) * 2u;
#pragma unroll 1
    for (int pass = 0; pass < 2; ++pass) {
        f32x4 acc[16];
#pragma unroll
        for (int i = 0; i < 16; ++i) acc[i] = (f32x4){0.f, 0.f, 0.f, 0.f};
        bf16x8 bq[4], ca[2][4], bt[8], bu[8];
        const bf16_t* Up = Uu + (size_t)(32 * pass) * NA;
        const bf16_t* WCp = WCu + (size_t)(32 * pass) * 2048;
#define S5_LDC(st, slot) do { _Pragma("unroll") for (int _q = 0; _q < 4; ++_q) ca[slot][_q] = ldg16(WCp + (size_t)(2 * (4 * ((st) & 3) + _q)) * 2048 + 32 * ((st) >> 2), wcoff); } while (0)
#pragma unroll
        for (int jj = 0; jj < 8; ++jj) bt[jj] = ldg16(Up + (size_t)(2 * jj) * NA, uoff);
        S5_LDC(0, 0); S5_LDC(1, 1);
        if (pass == 1) {
            bq[0] = ldg16(Uu, uoff); bq[1] = ldg16(Uu + (size_t)2 * NA, uoff); bq[2] = ldg16(Uu + (size_t)4 * NA, uoff);
            __builtin_amdgcn_sched_barrier(0);
#pragma unroll
            for (int jj = 0; jj < 16; ++jj) {
                if (jj + 3 < 16) bq[(jj + 3) & 3] = ldg16(Uu + (size_t)(2 * (jj + 3)) * NA, uoff);
#pragma unroll
                for (int ii = 0; ii < 16; ++ii) { const bf16x8 af = *(const LAS bf16x8*)(klow + (30 - 2 * (ii - jj)) * 512); acc[ii] = MFMA16(af, bq[jj & 3], acc[ii]); }
                __builtin_amdgcn_sched_barrier(0);
            }
        }
        __builtin_amdgcn_sched_barrier(0);
#pragma unroll
        for (int jj = 0; jj < 16; ++jj) {
            const bf16x8 cb = *(const LAS bf16x8*)(spb + 64 * (jj >> 2));
            if (jj < 8) bu[jj] = ldg16(Up + (size_t)(2 * (jj + 8)) * NA, uoff);
#pragma unroll
            for (int ii = 0; ii < 16; ++ii) if (ii >= jj) { const bf16x8 af = *(const LAS bf16x8*)(klow + (62 - 2 * (ii - jj)) * 512); acc[ii] = MFMA16(af, (jj < 8 ? bt[jj & 7] : bu[jj & 7]), acc[ii]); }
#pragma unroll
            for (int q = 0; q < 4; ++q) acc[4 * (jj & 3) + q] = MFMA16(ca[jj & 1][q], cb, acc[4 * (jj & 3) + q]);
            __builtin_amdgcn_sched_barrier(0);
            if (jj + 2 < 16) S5_LDC(jj + 2, jj & 1);
            __builtin_amdgcn_sched_barrier(0);
        }
#undef S5_LDC
        bf16_t* Yu = Ya + ((size_t)b * SEQ + (size_t)(16 * ntile) * 64 + wh + 32 * pass) * YW + 16 * g;
#pragma unroll
        for (int ii = 0; ii < 16; ++ii) {
            f32x4 y;
#pragma unroll
            for (int k = 0; k < 4; ++k) y[k] = gelu_tanh(acc[ii][k]);
            u32x4 bp; bp.x = cvt_pk_bf16(y[0], y[1]); bp.y = cvt_pk_bf16(y[2], y[3]); bp.z = 0u; bp.w = 0u;
            const f32x4 z = MFMA16(aglu, __builtin_bit_cast(bf16x8, bp), ((f32x4){0.f, 0.f, 0.f, 0.f}));
            u32x2 o; o.x = cvt_pk_bf16(y[0] * sigmoid_f(z[0]), y[1] * sigmoid_f(z[1])); o.y = cvt_pk_bf16(y[2] * sigmoid_f(z[2]), y[3] * sigmoid_f(z[3]));
            *(u32x2*)((char*)(Yu + (size_t)(2 * ii) * YW) + yoff) = o;
        }
    }
    __syncthreads();
}

constexpr int AT_KS = 0, AT_VT = 9216, AT_VP = 192, AT_BS = 9216 + 64 * AT_VP, AT_BUF = AT_BS + 256;
__device__ __forceinline__ int crow(int r, int hi) { return (r & 3) + 8 * (r >> 2) + 4 * hi; }
__device__ __forceinline__ void attn_unit(LAS unsigned char* lds, const bf16_t* P, const float* cum, bf16_t* Yc, const int b, const int h, const int qb, int tid, int lane, int w) {
    const int r32 = lane & 31, hi = lane >> 5;
    const size_t row0 = (size_t)b * SEQ;
    const int q0 = qb * 256, qrow = q0 + 32 * w + r32;
    bf16x8 qf[4];
    { const bf16_t* qp = P + (row0 + qrow) * NA + COL_Q + 64 * h + 8 * hi;
#pragma unroll
      for (int s = 0; s < 4; ++s) qf[s] = *(const bf16x8*)(qp + 16 * s); }
    const float* cumbh = cum + (size_t)(b * 8 + h) * SEQ;
    const float ref = cumbh[q0];
    const int vlane = (4 * hi + ((lane & 15) >> 2)) * AT_VP + 32 * ((lane >> 4) & 1) + 8 * (lane & 3);
    const int skey = tid >> 3, spc = tid & 7;
    const bf16_t* kgp = P + (row0 + skey) * NA + COL_K + 64 * h + 8 * spc;
    const int NT = 4 * qb + 4;
    u32x4 kreg = *(const u32x4*)kgp, vreg = *(const u32x4*)(kgp + (COL_V - COL_K)); float breg = 0.f; if (tid < 64) breg = ref - cumbh[tid];
#define AT_WRITE(bufp) do { LAS unsigned char* _b = (bufp); *(LAS u32x4*)(_b + AT_KS + skey * 144 + 16 * spc) = kreg; \
        *(LAS u32x4*)(_b + AT_VT + skey * AT_VP + 16 * spc) = vreg; \
        if (tid < 64) *(LAS float*)(_b + AT_BS + 4 * tid) = breg; } while (0)
    AT_WRITE(lds);
    __syncthreads();
    float mrun = -1e30f, lrun = 0.f; f32x16 o0, o1;
#pragma unroll
    for (int r = 0; r < 16; ++r) { o0[r] = 0.f; o1[r] = 0.f; }
    for (int kt = 0; kt < NT; ++kt) {
        const int cur = kt & 1; const bool more = (kt + 1 < NT);
        if (more) { const bf16_t* kp = kgp + (size_t)(kt + 1) * 64 * NA; kreg = *(const u32x4*)kp; vreg = *(const u32x4*)(kp + (COL_V - COL_K)); if (tid < 64) breg = ref - cumbh[64 * (kt + 1) + tid]; }
        if (64 * kt <= q0 + 32 * w + 31) {
            const LAS unsigned char* Kb = lds + cur * AT_BUF + AT_KS; const LAS unsigned char* Vb = lds + cur * AT_BUF + AT_VT; const LAS unsigned char* Bb = lds + cur * AT_BUF + AT_BS;
            f32x16 p[2];
#pragma unroll
            for (int rb = 0; rb < 2; ++rb) {
                f32x16 c;
#pragma unroll
                for (int g4 = 0; g4 < 4; ++g4) { const f32x4 bv = *(const LAS f32x4*)(Bb + (32 * rb + 8 * g4 + 4 * hi) * 4); c[4 * g4 + 0] = bv.x; c[4 * g4 + 1] = bv.y; c[4 * g4 + 2] = bv.z; c[4 * g4 + 3] = bv.w; }
#pragma unroll
                for (int s = 0; s < 4; ++s) { const bf16x8 af = *(const LAS bf16x8*)(Kb + (32 * rb + r32) * 144 + 32 * s + 16 * hi); c = MFMA32(af, qf[s], c); }
                p[rb] = c;
            }
            if (64 * kt + 63 > q0 + 32 * w) {
#pragma unroll
                for (int rb = 0; rb < 2; ++rb)
#pragma unroll
                    for (int r = 0; r < 16; ++r) { const int key = 64 * kt + 32 * rb + crow(r, hi); if (key > qrow) p[rb][r] = -1e30f; }
            }
            float mt = p[0][0];
#pragma unroll
            for (int r = 1; r < 16; ++r) mt = fmaxf(mt, p[0][r]);
#pragma unroll
            for (int r = 0; r < 16; ++r) mt = fmaxf(mt, p[1][r]);
            mt = half_max(mt);
            const float mnew = fmaxf(mrun, mt), alpha = fast_exp2(mrun - mnew);
            mrun = mnew;
            float ls = 0.f;
#pragma unroll
            for (int rb = 0; rb < 2; ++rb)
#pragma unroll
                for (int r = 0; r < 16; ++r) { p[rb][r] = fast_exp2(p[rb][r] - mnew); ls += p[rb][r]; }
            lrun = lrun * alpha + ls;
#pragma unroll
            for (int r = 0; r < 16; ++r) { o0[r] *= alpha; o1[r] *= alpha; }
            bf16x8 pf[4];
#pragma unroll
            for (int s = 0; s < 4; ++s) { const int rb = s >> 1, r0 = 8 * (s & 1); u32x4 pk; pk.x = cvt_pk_bf16(p[rb][r0 + 0], p[rb][r0 + 1]); pk.y = cvt_pk_bf16(p[rb][r0 + 2], p[rb][r0 + 3]);
                pk.z = cvt_pk_bf16(p[rb][r0 + 4], p[rb][r0 + 5]); pk.w = cvt_pk_bf16(p[rb][r0 + 6], p[rb][r0 + 7]); pf[s] = __builtin_bit_cast(bf16x8, pk); }
#pragma unroll
            for (int s = 0; s < 4; ++s) {
                typedef short v4i16_t __attribute__((ext_vector_type(4)));
                const LAS unsigned char* vp = Vb + vlane + 16 * s * AT_VP;
                { const s16x4 lo = __builtin_bit_cast(s16x4, __builtin_amdgcn_ds_read_tr16_b64_v4i16((LAS v4i16_t*)(vp))), hh = __builtin_bit_cast(s16x4, __builtin_amdgcn_ds_read_tr16_b64_v4i16((LAS v4i16_t*)(vp + 8 * AT_VP)));
                  const bf16x8 af = __builtin_shufflevector(lo, hh, 0, 1, 2, 3, 4, 5, 6, 7); o0 = MFMA32(af, pf[s], o0); }
                { const s16x4 lo = __builtin_bit_cast(s16x4, __builtin_amdgcn_ds_read_tr16_b64_v4i16((LAS v4i16_t*)(vp + 64))), hh = __builtin_bit_cast(s16x4, __builtin_amdgcn_ds_read_tr16_b64_v4i16((LAS v4i16_t*)(vp + 64 + 8 * AT_VP)));
                  const bf16x8 af = __builtin_shufflevector(lo, hh, 0, 1, 2, 3, 4, 5, 6, 7); o1 = MFMA32(af, pf[s], o1); }
            }
        }
        if (more) AT_WRITE(lds + (cur ^ 1) * AT_BUF);
        __syncthreads();
    }
#undef AT_WRITE
    const float ltot = half_sum(lrun);
    const float inv = 1.0f / ltot;
    bf16_t* op = Yc + (row0 + qrow) * YW + 64 * h + 4 * hi;
#pragma unroll
    for (int g4 = 0; g4 < 4; ++g4) {
        u32x2 a, c2;
        a.x = cvt_pk_bf16(o0[4 * g4 + 0] * inv, o0[4 * g4 + 1] * inv); a.y = cvt_pk_bf16(o0[4 * g4 + 2] * inv, o0[4 * g4 + 3] * inv);
        c2.x = cvt_pk_bf16(o1[4 * g4 + 0] * inv, o1[4 * g4 + 1] * inv); c2.y = cvt_pk_bf16(o1[4 * g4 + 2] * inv, o1[4 * g4 + 3] * inv);
        *(u32x2*)(op + 8 * g4) = a; *(u32x2*)(op + 32 + 8 * g4) = c2;
    }
}

__device__ __forceinline__ u32x4 conv_item(const bf16_t* P, const float* cw, int item) {
    const int token = item >> 6, c0 = (item & 63) * 8, t = token & (SEQ - 1);
    float acc[8];
#pragma unroll
    for (int i = 0; i < 8; ++i) acc[i] = 0.f;
    u32x4 xc[3], cc[3];
#pragma unroll
    for (int tap = 0; tap < 3; ++tap) {
        const bool ok = (t - 2 + tap >= 0);
        const bf16_t* rp = P + (size_t)(ok ? token - 2 + tap : token) * NA + c0;
        xc[tap] = *(const u32x4*)(rp + COL_XC); cc[tap] = *(const u32x4*)(rp + COL_CC);
        if (!ok) { xc[tap] = (u32x4){0u, 0u, 0u, 0u}; }
    }
    const u32x4 bc = *(const u32x4*)(P + (size_t)token * NA + COL_BC + c0);
#pragma unroll
    for (int tap = 0; tap < 3; ++tap) {
        const f32x4 w0 = *(const f32x4*)(cw + tap * 512 + c0), w1 = *(const f32x4*)(cw + tap * 512 + c0 + 4);
        const u32x4 x = xc[tap], c = cc[tap];
        acc[0] += w0.x * bf_lo(x.x) * bf_lo(c.x); acc[1] += w0.y * bf_hi(x.x) * bf_hi(c.x); acc[2] += w0.z * bf_lo(x.y) * bf_lo(c.y); acc[3] += w0.w * bf_hi(x.y) * bf_hi(c.y);
        acc[4] += w1.x * bf_lo(x.z) * bf_lo(c.z); acc[5] += w1.y * bf_hi(x.z) * bf_hi(c.z); acc[6] += w1.z * bf_lo(x.w) * bf_lo(c.w); acc[7] += w1.w * bf_hi(x.w) * bf_hi(c.w);
    }
    u32x4 o; o.x = cvt_pk_bf16(acc[0] * bf_lo(bc.x), acc[1] * bf_hi(bc.x)); o.y = cvt_pk_bf16(acc[2] * bf_lo(bc.y), acc[3] * bf_hi(bc.y));
    o.z = cvt_pk_bf16(acc[4] * bf_lo(bc.z), acc[5] * bf_hi(bc.z)); o.w = cvt_pk_bf16(acc[6] * bf_lo(bc.w), acc[7] * bf_hi(bc.w));
    return o;
}
__device__ __forceinline__ void conv_phase(const bf16_t* P, const float* cw, bf16_t* Yb, int gtid, int ngt) {
    for (int item = gtid; item < M * 64; item += 4 * ngt) {
        u32x4 o[4];
#pragma unroll
        for (int q = 0; q < 4; ++q) o[q] = conv_item(P, cw, item + q * ngt);
#pragma unroll
        for (int q = 0; q < 4; ++q) { const int it = item + q * ngt; *(u32x4*)(Yb + (size_t)(it >> 6) * YW + (it & 63) * 8) = o[q]; }
    }
}

#define XB_TMO      128
#define XB_XCNT(j)  (256  + 64 * (j))
#define XB_XSUB(j)  (1280 + 64 * (j))
#define XB_XGEN(j)  (2304 + 64 * (j))
#define XB_TOP      3328
#define XB_TOPGEN   3392
#define XCD_BAR_WORDS 3456
#define XB_SPIN_CAP (1u << 18)
__device__ __forceinline__ unsigned xb_ld(unsigned* p)              { return __hip_atomic_load(p, __ATOMIC_RELAXED, __HIP_MEMORY_SCOPE_AGENT); }
__device__ __forceinline__ unsigned xb_add(unsigned* p, unsigned v) { return __hip_atomic_fetch_add(p, v, __ATOMIC_RELAXED, __HIP_MEMORY_SCOPE_AGENT); }
__device__ __forceinline__ unsigned xb_xcc_id() { return (unsigned)__builtin_amdgcn_s_getreg((3 << 11) | 20) & 0xFu; }
#define XB_SPIN(cond, bar) do { unsigned _sp = 0; while (cond) { __builtin_amdgcn_s_sleep(1); \
    if ((++_sp & 255u) == 0u) { if (xb_ld(&(bar)[XB_TMO])) break; if (_sp > XB_SPIN_CAP) { atomicAdd(&(bar)[XB_TMO], 1u); break; } } } } while (0)
struct XcdBarrier { unsigned* bar; unsigned x; volatile LAS unsigned* st; };
__device__ __forceinline__ XcdBarrier xcd_barrier_post(unsigned* bar, volatile LAS unsigned* st) {
    XcdBarrier b; b.bar = bar; b.x = xb_xcc_id(); b.st = st;
    if (threadIdx.x == 0) (void)xb_add(&bar[XB_XCNT(b.x)], 1u);
    return b;
}
__device__ __forceinline__ void xcd_barrier_complete(unsigned* bar, unsigned x, unsigned& nloc, unsigned& nx) {
    const unsigned G = gridDim.x * gridDim.y * gridDim.z;
    unsigned sum, cnt, mine, sp = 0u;
    for (;;) {
        sum = 0u; cnt = 0u; mine = 0u;
#pragma unroll
        for (unsigned j = 0; j < 16; ++j) { const unsigned c = xb_ld(&bar[XB_XCNT(j)]); sum += c; cnt += (c > 0u) ? 1u : 0u; mine = (j == x) ? c : mine; }
        if (sum == G) break;
        __builtin_amdgcn_s_sleep(1);
        if ((++sp & 255u) == 0u) { if (xb_ld(&bar[XB_TMO])) break; if (sp > XB_SPIN_CAP) { atomicAdd(&bar[XB_TMO], 1u); break; } }
    }
    nloc = mine > 0u ? mine : 1u; nx = cnt > 0u ? cnt : 1u;
}
__device__ __forceinline__ void xcd_barrier(const XcdBarrier& b) {
    asm volatile("s_waitcnt vmcnt(0) lgkmcnt(0)" ::: "memory");
    __syncthreads();
    if (threadIdx.x == 0) {
        unsigned* bar = b.bar; unsigned bx = b.x;
        asm volatile("" : "+s"(bar), "+s"(bx));
        __builtin_amdgcn_s_waitcnt(0);
        unsigned nloc = b.st[0], nx = b.st[1];
        if (nloc == 0u) { xcd_barrier_complete(bar, bx, nloc, nx); b.st[0] = nloc; b.st[1] = nx; }
        const unsigned old = xb_add(&bar[XB_XSUB(bx)], 1u);
        const unsigned gen = old / nloc;
        if (old + 1u == (gen + 1u) * nloc) {
            __builtin_amdgcn_fence(__ATOMIC_RELEASE, "agent");
            asm volatile("s_waitcnt vmcnt(0)" ::: "memory");
            const unsigned og = xb_add(&bar[XB_TOP], 1u);
            const unsigned tg = og / nx;
            if (og + 1u == (tg + 1u) * nx) xb_add(&bar[XB_TOPGEN], 1u);
            else XB_SPIN(xb_ld(&bar[XB_TOPGEN]) == tg, bar);
            __builtin_amdgcn_fence(__ATOMIC_ACQUIRE, "agent");
            xb_add(&bar[XB_XGEN(bx)], 1u);
            asm volatile("s_waitcnt vmcnt(0)" ::: "memory");
        } else {
            XB_SPIN(xb_ld(&bar[XB_XGEN(bx)]) == gen, bar);
            __builtin_amdgcn_fence(__ATOMIC_ACQUIRE, "agent");
            asm volatile("s_waitcnt vmcnt(0)" ::: "memory");
        }
    }
    __syncthreads();
}
__device__ __forceinline__ void cg_barrier(cg::grid_group& grid) {
    asm volatile("s_waitcnt vmcnt(0) lgkmcnt(0)" ::: "memory");
    __syncthreads();
    grid.sync();
    if (threadIdx.x == 0) { __builtin_amdgcn_fence(__ATOMIC_ACQUIRE, "agent"); asm volatile("s_waitcnt vmcnt(0)" ::: "memory"); }
    __syncthreads();
}
#define grid_barrier(g_) xcd_barrier(xbar)

#ifndef DIAG_STAGE
#define DIAG_STAGE 0
#endif
__device__ __forceinline__ void diag_dump(float* out, const bf16_t* src, int ld, int ncols) {
    for (size_t i = (size_t)blockIdx.x * 512 + threadIdx.x; i < (size_t)M * DM; i += (size_t)gridDim.x * 512) {
        const size_t row = i >> 10; const int c = (int)(i & 1023); float v = 0.f;
        for (int cc = c; cc < ncols; cc += 1024) v += bf_lo((unsigned)src[row * ld + cc]);
        out[i] = v;
    }
}
#define DIAG(k, src, ld, ncols) do { if (DIAG_STAGE == (k)) { grid_barrier(grid); diag_dump(A_->out, (src), (ld), (ncols)); return; } } while (0)

typedef const __attribute__((address_space(4))) Args* KArgP;
__device__ __forceinline__ KArgP launder_args(KArgP p) { asm volatile("" : "+s"(p)); return p; }
#define A_ (launder_args(argp))
__global__ void __launch_bounds__(512, 2) fwd_kernel(Args a) {
    KArgP argp = (KArgP)__builtin_amdgcn_kernarg_segment_ptr(); (void)a;
    extern __shared__ __attribute__((aligned(16))) unsigned char lds_raw[];
    LAS unsigned char* lds = (LAS unsigned char*)lds_raw;
    cg::grid_group grid = cg::this_grid();
    if (gridDim.z == 12345u) grid.sync();
    volatile LAS unsigned* xst = (volatile LAS unsigned*)((LAS unsigned char*)lds_raw + LDS_BYTES - 64);
    if (threadIdx.x == 0) { xst[0] = 0u; xst[1] = 0u; }
    __syncthreads();
    const XcdBarrier xbar = xcd_barrier_post((unsigned*)(A_->ws + 16384), xst);
    const int G = gridDim.x, bid = blockIdx.x, ngw = G * 8;
#define FRESH() const int tid = launder_i(threadIdx.x), lane = tid & 63, w = __builtin_amdgcn_readfirstlane(tid >> 6), gw = bid * 8 + w; (void)lane; (void)gw
    unsigned char* ws = A_->ws;
    bf16_t* XN = (bf16_t*)(ws + WS_XN); bf16_t* PR = (bf16_t*)(ws + WS_P); bf16_t* Y = (bf16_t*)(ws + WS_Y);
    float* LOGF = (float*)(ws + WS_LOGF); float* CUM = (float*)(ws + WS_CUM);

    {
        FRESH();
#ifndef NO_TAB
        for (int u = bid; u < 256; u += G) s5_tables(lds, a, u >> 7, (u >> 2) & 31, u & 3, tid);
#endif
        LAS float* scr = (LAS float*)(lds + w * 16640);
        constexpr int I_A = 16 * 56, I_G = 16 * 48, I_B = 8 * 16, I_O = 16 * 16, I_1 = 16 * 64, I_2 = 64 * 16, I_L = I_A + I_G + 3 * I_B + I_O + I_1 + I_2;
        for (int it = gw; it < 2 * I_L; it += ngw) {
            const int l = it / I_L; int r = it - l * I_L;
            unsigned char* wl = ws + WS_W + (size_t)l * W_LAYER;
            const float* win = A_->in[2] + (size_t)l * DM * INW;
            if (r < I_A) { transpose_item(win, INW, 0, DM, NA, (bf16_t*)(wl + W_INA), scr, r, lane); continue; } r -= I_A;
            if (r < I_G) { transpose_item(win, INW, COL_G, DM, NG, (bf16_t*)(wl + W_G), scr, r, lane); continue; } r -= I_G;
            if (r < 3 * I_B) { const int br = r / I_B; transpose_item(A_->in[15] + (size_t)l * 1536 * DM + (size_t)br * 512 * DM, DM, 0, 512, DM, (bf16_t*)(wl + W_BR) + (size_t)br * DM * 512, scr, r - br * I_B, lane); continue; } r -= 3 * I_B;
            if (r < I_O) { transpose_item(A_->in[16] + (size_t)l * DM * DM, DM, 0, DM, DM, (bf16_t*)(wl + W_OUT), scr, r, lane); continue; } r -= I_O;
            if (r < I_1) { transpose_item(A_->in[19] + (size_t)l * DM * FF, FF, 0, DM, FF, (bf16_t*)(wl + W_1), scr, r, lane); continue; } r -= I_1;
            transpose_item(A_->in[20] + (size_t)l * FF * DM, DM, 0, FF, DM, (bf16_t*)(wl + W_2), scr, r, lane);
        }
        __syncthreads();
        NormArgs n{A_->in[0], nullptr, nullptr, nullptr, A_->in[1], XN, A_->in[2] + COL_F, A_->in[14], LOGF};
        norm_phase(lds, n, gw, ngw, lane, tid);
    }
    xcd_barrier(xbar);

    DIAG(1, XN, DM, DM);
#pragma unroll 1
    for (int l = 0; l < DEPTH; ++l) {
        unsigned char* wl = ws + WS_W + (size_t)l * W_LAYER;
        const unsigned char* s5tab = ws + WS_S5 + (size_t)l * S5_LAYER;
        const float* xin = (l == 0) ? A_->in[0] : A_->out;

        { FRESH(); for (int bh = bid; bh < 64; bh += G) cum_scan(lds, LOGF, CUM, bh, tid, lane, w); }
        {
            pg8::Gemm g{XN, (const bf16_t*)(wl + W_INA), M, NA, DM, 0, 0}; pg8::StaticOrder S; S.init(M, NA, G, bid, 1);
            pg8::Epi<pg8::EPI_PROJ> E{PR, NA, nullptr, nullptr};
#if (PHMASK >> 0) & 1
            pg8::gemm_phase<pg8::Epi<pg8::EPI_PROJ>, pg8::StaticOrder, true, true>(lds, g, S, E);
#endif
        }
        grid_barrier(grid);

        DIAG(2, PR, NA, NA);
#ifndef NO_S5
        { FRESH(); for (int v = bid; v < 256; v += G) s5_unit(lds, PR, s5tab, Y, v >> 5, v & 31, tid, lane, w); }
#endif
#ifndef NO_ATTN
        for (int v = bid; v < 256; v += G) {
            FRESH(); const int bh = v >> 2, s = v & 3;
#pragma unroll 1
            for (int k = 0; k < 4; ++k) { const int qb = (k == 0) ? 15 - s : (k == 1) ? s : (k == 2) ? 11 - s : s + 4;
                attn_unit(lds, PR, CUM, Y + 2 * (size_t)M * YW, bh >> 3, bh & 7, qb, tid, lane, w); }
        }
#endif
        { FRESH(); conv_phase(PR, A_->in[13] + (size_t)l * 3 * 512, Y + (size_t)M * YW, bid * 512 + tid, G * 512); }
        grid_barrier(grid);

        if (DIAG_STAGE == 3) { grid_barrier(grid); for (size_t i = (size_t)blockIdx.x * 512 + threadIdx.x; i < (size_t)M * DM; i += (size_t)gridDim.x * 512) { const size_t row = i >> 10; const int c = (int)(i & 511); A_->out[i] = bf_lo((unsigned)Y[row * YW + c]) + bf_lo((unsigned)Y[(size_t)M * YW + row * YW + c]) + bf_lo((unsigned)Y[2 * (size_t)M * YW + row * YW + c]); } return; }
        DIAG(31, Y + (size_t)M * YW, YW, YW); DIAG(32, Y + 2 * (size_t)M * YW, YW, YW);
        {
            pg8::Gemm g{XN, (const bf16_t*)(wl + W_G), M, NG, DM, 0, 0}; pg8::StaticOrder S; S.init(M, NG, G, bid, 1);
            pg8::Epi<pg8::EPI_GATE> E{PR, NG, A_->in[3] + (size_t)l * NG, nullptr};
#if (PHMASK >> 1) & 1
            pg8::gemm_phase<pg8::Epi<pg8::EPI_GATE>, pg8::StaticOrder, true, true>(lds, g, S, E);
#endif
        }
        grid_barrier(grid);

        DIAG(4, PR, NG, NG);
        {
            pg8::Gemm g{Y, (const bf16_t*)(wl + W_BR), M, DM, 512, (size_t)M * YW * 2, (size_t)DM * 512 * 2}; pg8::StaticOrder S; S.init(M, DM, G, bid, 3);
            pg8::Epi<pg8::EPI_BRANCH> E{XN, DM, nullptr, PR};
#if (PHMASK >> 2) & 1
            pg8::gemm_phase<pg8::Epi<pg8::EPI_BRANCH>, pg8::StaticOrder, true, true>(lds, g, S, E);
#endif
        }
        grid_barrier(grid);

        DIAG(5, XN, DM, DM);
        {
            pg8::Gemm g{XN, (const bf16_t*)(wl + W_OUT), M, DM, DM, 0, 0}; pg8::StaticOrder S; S.init(M, DM, G, bid, 1);
            pg8::Epi<pg8::EPI_PLAIN> E{PR, DM, nullptr, nullptr};
#if (PHMASK >> 3) & 1
            pg8::gemm_phase<pg8::Epi<pg8::EPI_PLAIN>, pg8::StaticOrder, true, true>(lds, g, S, E);
#endif
        }
        grid_barrier(grid);

        DIAG(6, PR, DM, DM);
        {
            FRESH(); NormArgs n{xin, PR, A_->in[17] + (size_t)l * DM, A_->out, A_->in[18] + (size_t)l * DM, XN, nullptr, nullptr, nullptr};
            norm_phase(lds, n, gw, ngw, lane, tid);
        }
        grid_barrier(grid);

        DIAG(7, XN, DM, DM);
        {
            pg8::Gemm g{XN, (const bf16_t*)(wl + W_1), M, FF, DM, 0, 0}; pg8::StaticOrder S; S.init(M, FF, G, bid, 1);
            pg8::Epi<pg8::EPI_RELU2> E{PR, FF, nullptr, nullptr};
#if (PHMASK >> 4) & 1
            pg8::gemm_phase<pg8::Epi<pg8::EPI_RELU2>, pg8::StaticOrder, true, true>(lds, g, S, E);
#endif
        }
        grid_barrier(grid);

        DIAG(8, PR, FF, FF);
        {
            pg8::Gemm g{PR, (const bf16_t*)(wl + W_2), M, DM, FF, 0, 0}; pg8::StaticOrder S; S.init(M, DM, G, bid, 1);
            pg8::Epi<pg8::EPI_PLAIN> E{XN, DM, nullptr, nullptr};
#if (PHMASK >> 5) & 1
            pg8::gemm_phase<pg8::Epi<pg8::EPI_PLAIN>, pg8::StaticOrder, true, true>(lds, g, S, E);
#endif
        }
        grid_barrier(grid);

        DIAG(9, XN, DM, DM);
        if (l + 1 < DEPTH) {
            FRESH(); NormArgs n{A_->out, XN, A_->in[21] + (size_t)l * DM, A_->out, A_->in[1] + (size_t)(l + 1) * DM, XN, A_->in[2] + (size_t)(l + 1) * DM * INW + COL_F, A_->in[14] + (l + 1) * 8, LOGF};
            norm_phase(lds, n, gw, ngw, lane, tid);
            grid_barrier(grid);
        } else {
            FRESH(); NormArgs n{A_->out, XN, A_->in[21] + (size_t)l * DM, A_->out, nullptr, nullptr, nullptr, nullptr, nullptr};
            norm_phase(lds, n, gw, ngw, lane, tid);
        }
    }
}

extern "C" void kernel_launch(void* const* d_in, const int* in_sizes, int n_in, void* d_out, int out_size, void* d_ws, size_t ws_size, hipStream_t stream) {
    static int grid = 0;
    if (grid == 0) {
        if (n_in != 22 || in_sizes[0] != M * DM || out_size != M * DM || ws_size < WS_END) { fprintf(stderr, "kernel_launch: unexpected shapes (n_in %d, in0 %d, out %d, ws %zu)\n", n_in, n_in > 0 ? in_sizes[0] : -1, out_size, ws_size); grid = -1; return; }
        int dev = 0, cus = 0, per_cu = 0;
        (void)hipGetDevice(&dev);
        (void)hipDeviceGetAttribute(&cus, hipDeviceAttributeMultiprocessorCount, dev);
        if (hipFuncSetAttribute((const void*)fwd_kernel, hipFuncAttributeMaxDynamicSharedMemorySize, LDS_BYTES) != hipSuccess) fprintf(stderr, "kernel_launch: hipFuncSetAttribute failed\n");
        if (hipOccupancyMaxActiveBlocksPerMultiprocessor(&per_cu, (const void*)fwd_kernel, 512, LDS_BYTES) != hipSuccess || per_cu < 1) { fprintf(stderr, "kernel_launch: occupancy query gave %d\n", per_cu); per_cu = 1; }
        (void)hipGetLastError();
        grid = cus * per_cu; if (grid > 256) grid = 256; if (grid < 1) grid = 256;
    }
    if (grid < 0) return;
    (void)hipMemsetAsync(d_ws, 0, 65536, stream);
    Args a{};
    for (int i = 0; i < 22; ++i) a.in[i] = (const float*)d_in[i];
    a.out = (float*)d_out; a.ws = (unsigned char*)d_ws;
    void* args[] = {&a};
    hipError_t e = hipLaunchCooperativeKernel((const void*)fwd_kernel, dim3(grid), dim3(512), args, LDS_BYTES, stream);
    if (e != hipSuccess) fprintf(stderr, "kernel_launch: cooperative launch failed: %s (grid %d)\n", hipGetErrorString(e), grid);
}
```

```cpp
#include <hip/hip_runtime.h>
#include <hip/hip_cooperative_groups.h>
#include <cstdio>
#include <cstdint>
namespace cg = cooperative_groups;

#define DIAG_STAGE 0
#ifndef PHMASK
#define PHMASK 0xff
#endif

#define LAS __attribute__((address_space(3)))
typedef unsigned short bf16_t;
typedef short bf16x8 __attribute__((ext_vector_type(8)));
typedef short s16x4 __attribute__((ext_vector_type(4)));
typedef float f32x2 __attribute__((ext_vector_type(2)));
typedef float f32x4 __attribute__((ext_vector_type(4)));
typedef float f32x16 __attribute__((ext_vector_type(16)));
typedef unsigned u32x2 __attribute__((ext_vector_type(2)));
typedef unsigned u32x4 __attribute__((ext_vector_type(4)));

constexpr int BATCH = 8, SEQ = 4096, DM = 1024, M = BATCH * SEQ, DEPTH = 2;
constexpr int INW = 6664, NA = 3584, NG = 3072, FF = 4096, YW = 512;
constexpr int COL_XC = 512, COL_BC = 1024, COL_CC = 1536, COL_Q = 2048, COL_K = 2560, COL_V = 3072, COL_F = 3584, COL_G = 3592;
constexpr float EPS = 1e-6f;
constexpr float LOG2E = 1.4426950408889634f;
constexpr float C2 = 0.125f * LOG2E;

constexpr size_t MiB = 1u << 20;
constexpr size_t WS_W = 1 * MiB, W_LAYER = 34 * MiB;
constexpr size_t W_INA = 0, W_G = 7 * MiB, W_BR = 13 * MiB, W_OUT = 16 * MiB, W_1 = 18 * MiB, W_2 = 26 * MiB;
constexpr size_t WS_S5 = 69 * MiB, S5_LAYER = 17 * MiB + 512 * 1024;
constexpr size_t S5_KT = 0, S5_WE = MiB + 256 * 1024, S5_WC = S5_WE + 8 * MiB, S5_A64 = S5_WC + 8 * MiB, S5_GLU = S5_A64 + 64 * 1024;
constexpr size_t WS_LOGF = 104 * MiB, WS_CUM = 105 * MiB, WS_XN = 106 * MiB, WS_P = 170 * MiB, WS_Y = 394 * MiB, WS_END = 490 * MiB;
constexpr int KT_BYTES = 65 * 512;

constexpr int LDS_BYTES = 147456;

typedef __bf16 bf16x2_t __attribute__((ext_vector_type(2)));
__device__ __forceinline__ unsigned cvt_pk_bf16(float lo, float hi) { const f32x2 v = {lo, hi}; const bf16x2_t b = __builtin_convertvector(v, bf16x2_t); return __builtin_bit_cast(unsigned, b); }
__device__ __forceinline__ float bf_lo(unsigned u) { return __uint_as_float(u << 16); }
__device__ __forceinline__ float bf_hi(unsigned u) { return __uint_as_float(u & 0xffff0000u); }
template <int O> __device__ __forceinline__ float swz_xor(float v) { return __int_as_float(__builtin_amdgcn_ds_swizzle(__float_as_int(v), (O << 10) | 0x1f)); }
__device__ __forceinline__ float half_sum(float v) { auto rr = __builtin_amdgcn_permlane32_swap(__float_as_uint(v), __float_as_uint(v), false, false); return __uint_as_float(rr[0]) + __uint_as_float(rr[1]); }
__device__ __forceinline__ float half_max(float v) { auto rr = __builtin_amdgcn_permlane32_swap(__float_as_uint(v), __float_as_uint(v), false, false); return fmaxf(__uint_as_float(rr[0]), __uint_as_float(rr[1])); }
__device__ __forceinline__ float wave_sum(float v) {
    v += swz_xor<1>(v); v += swz_xor<2>(v); v += swz_xor<4>(v); v += swz_xor<8>(v); v += swz_xor<16>(v);
    return half_sum(v);
}
__device__ __forceinline__ int launder_i(int x) { asm volatile("" : "+v"(x)); return x; }
__device__ __forceinline__ float fast_exp2(float x) { return __builtin_amdgcn_exp2f(x); }
__device__ __forceinline__ float fast_rcp(float x) { return __builtin_amdgcn_rcpf(x); }
__device__ __forceinline__ float sigmoid_f(float z) { return fast_rcp(1.0f + fast_exp2(-LOG2E * z)); }
__device__ __forceinline__ float gelu_tanh(float y) { const float t = y + 0.044715f * y * y * y; return y * fast_rcp(1.0f + fast_exp2(-2.302208198f * t)); }

namespace pg8 {
#define PG8_LAS __attribute__((address_space(3)))
constexpr int BM = 256, BK = 64, HALF = 128, HTB = HALF * BK * 2, STAGE_BYTES = 8 * HTB, NXCD = 8, WGM = 8;

__host__ __device__ __forceinline__ int lds_byte(int r, int c) { const int st = (r >> 4) * 2 + (c >> 5), rr = r & 15, cc = c & 31, ob = rr * 64 + cc * 2; return st * 1024 + (ob ^ (((ob >> 9) & 1) << 5)); }
__host__ __device__ __forceinline__ void stage_rc(int b, int& R, int& C) { const int st = b / 1024, sb = b % 1024, swz = sb ^ (((sb >> 9) & 1) << 5); R = (st >> 1) * 16 + swz / 64; C = (st & 1) * 32 + (swz % 64) / 2; }
__host__ __device__ __forceinline__ int perm32(int rho) { const int n = rho >> 4, i = rho & 15; return 8 * (i >> 2) + 4 * n + (i & 3); }

struct Unit { int pm, pn, br; };
struct Gemm { const bf16_t* A; const bf16_t* Bt; int M, N, K; size_t abr, bbr; };

struct StaticOrder {
    int nM, nN, nwg, G, c, nbr;
    __device__ void init(int M_, int N_, int G_, int c_, int nbr_) { nM = M_ / BM; nN = N_ / BM; nwg = nM * nN; G = G_; c = c_; nbr = nbr_; }
    __device__ bool next(int i, Unit& u) const {
        const int it = i / nbr; u.br = i - it * nbr;
        const long L = (long)it * G + c; if (L >= nwg) return false;
        int wgid = (int)L; { const int q = nwg / NXCD, r = nwg % NXCD, xcd = wgid % NXCD, off = wgid / NXCD; wgid = (xcd < r ? xcd * (q + 1) : r * (q + 1) + (xcd - r) * q) + off; }
        const int nig = WGM * nN, gid = wgid / nig, fm = gid * WGM, gsz = (nM - fm) < WGM ? (nM - fm) : WGM;
        u.pm = fm + ((wgid % nig) % gsz); u.pn = (wgid % nig) / gsz; return true;
    }
};

enum { EPI_PROJ = 0, EPI_GATE = 1, EPI_RELU2 = 2, EPI_BRANCH = 3, EPI_PLAIN = 4 };
template <int MODE> struct Epi {
    static constexpr bool PERM = true;
    bf16_t* O; int ldc; const float* bias; const bf16_t* G;
    __device__ __forceinline__ void operator()(const f32x4 (&acc)[2][2][4][2], const Unit& u, int wr, int wc, int fr, int fq) const {
        const int row0 = u.pm * BM + wr * 64 + fr; const int col0 = u.pn * BM + wc * 32 + 8 * fq;
        float sc = 1.f; if (MODE == EPI_PROJ) { if (u.pn >= COL_Q / 256 && u.pn < COL_K / 256) sc = C2; }
        f32x4 bv[2][2];
        if (MODE == EPI_GATE) {
#pragma unroll
            for (int bj = 0; bj < 2; ++bj)
#pragma unroll
                for (int n = 0; n < 2; ++n) bv[bj][n] = *(const f32x4*)(bias + col0 + bj * HALF + 4 * n);
        }
        if (MODE == EPI_BRANCH) {
#pragma unroll
            for (int ai = 0; ai < 2; ++ai) {
                u32x2 gt[4][2]; u32x4 pv[4][2];
#pragma unroll
                for (int m = 0; m < 4; ++m)
#pragma unroll
                    for (int bj = 0; bj < 2; ++bj) {
                        const size_t row = (size_t)(row0 + ai * HALF + m * 16);
                        gt[m][bj] = *(const u32x2*)((const unsigned char*)G + row * NG + (size_t)u.br * DM + col0 + bj * HALF);
                        pv[m][bj] = (u.br > 0) ? *(const u32x4*)(O + row * ldc + col0 + bj * HALF) : (u32x4){0u, 0u, 0u, 0u};
                    }
                __builtin_amdgcn_sched_barrier(0);
#pragma unroll
                for (int m = 0; m < 4; ++m)
#pragma unroll
                    for (int bj = 0; bj < 2; ++bj) {
                        const size_t row = (size_t)(row0 + ai * HALF + m * 16);
                        f32x4 v0 = acc[ai][bj][m][0], v1 = acc[ai][bj][m][1];
                        const u32x2 g8 = gt[m][bj]; const u32x4 p4 = pv[m][bj];
                        v0 = v0 * (1.f / 255.f); v1 = v1 * (1.f / 255.f);
                        v0[0] = v0[0] * (float)(g8.x & 0xffu) + bf_lo(p4.x); v0[1] = v0[1] * (float)((g8.x >> 8) & 0xffu) + bf_hi(p4.x); v0[2] = v0[2] * (float)((g8.x >> 16) & 0xffu) + bf_lo(p4.y); v0[3] = v0[3] * (float)(g8.x >> 24) + bf_hi(p4.y);
                        v1[0] = v1[0] * (float)(g8.y & 0xffu) + bf_lo(p4.z); v1[1] = v1[1] * (float)((g8.y >> 8) & 0xffu) + bf_hi(p4.z); v1[2] = v1[2] * (float)((g8.y >> 16) & 0xffu) + bf_lo(p4.w); v1[3] = v1[3] * (float)(g8.y >> 24) + bf_hi(p4.w);
                        u32x4 wv; wv.x = cvt_pk_bf16(v0[0], v0[1]); wv.y = cvt_pk_bf16(v0[2], v0[3]); wv.z = cvt_pk_bf16(v1[0], v1[1]); wv.w = cvt_pk_bf16(v1[2], v1[3]);
                        *(u32x4*)(O + row * ldc + col0 + bj * HALF) = wv;
                    }
                __builtin_amdgcn_sched_barrier(0);
            }
            return;
        }
#pragma unroll
        for (int ai = 0; ai < 2; ++ai)
#pragma unroll
            for (int m = 0; m < 4; ++m) {
                const size_t row = (size_t)(row0 + ai * HALF + m * 16);
                bf16_t* rowp = O + row * ldc + col0;
#pragma unroll
                for (int bj = 0; bj < 2; ++bj) {
                    f32x4 v0 = acc[ai][bj][m][0], v1 = acc[ai][bj][m][1];
                    if (MODE == EPI_PROJ) { v0 = v0 * sc; v1 = v1 * sc; }
                    if (MODE == EPI_GATE) {
                        v0 = v0 + bv[bj][0]; v1 = v1 + bv[bj][1];
                        u32x2 w8; w8.x = 0u; w8.y = 0u;
#pragma unroll
                        for (int i = 0; i < 4; ++i) { w8.x |= (unsigned)(sigmoid_f(v0[i]) * 255.f + 0.5f) << (8 * i); w8.y |= (unsigned)(sigmoid_f(v1[i]) * 255.f + 0.5f) << (8 * i); }
                        *(u32x2*)((unsigned char*)O + row * ldc + col0 + bj * HALF) = w8;
                        continue;
                    }
                    if (MODE == EPI_RELU2) {
#pragma unroll
                        for (int i = 0; i < 4; ++i) { const float a = fmaxf(v0[i], 0.f), b = fmaxf(v1[i], 0.f); v0[i] = a * a; v1[i] = b * b; }
                    }
                    if (MODE == EPI_BRANCH) {
                        const u32x4 gt = *(const u32x4*)(G + row * NG + (size_t)u.br * DM + col0 + bj * HALF);
                        v0[0] *= bf_lo(gt.x); v0[1] *= bf_hi(gt.x); v0[2] *= bf_lo(gt.y); v0[3] *= bf_hi(gt.y);
                        v1[0] *= bf_lo(gt.z); v1[1] *= bf_hi(gt.z); v1[2] *= bf_lo(gt.w); v1[3] *= bf_hi(gt.w);
                        if (u.br > 0) {
                            const u32x4 pv = *(const u32x4*)(rowp + bj * HALF);
                            v0[0] += bf_lo(pv.x); v0[1] += bf_hi(pv.x); v0[2] += bf_lo(pv.y); v0[3] += bf_hi(pv.y);
                            v1[0] += bf_lo(pv.z); v1[1] += bf_hi(pv.z); v1[2] += bf_lo(pv.w); v1[3] += bf_hi(pv.w);
                        }
                    }
                    u32x4 w; w.x = cvt_pk_bf16(v0[0], v0[1]); w.y = cvt_pk_bf16(v0[2], v0[3]); w.z = cvt_pk_bf16(v1[0], v1[1]); w.w = cvt_pk_bf16(v1[2], v1[3]);
                    *(u32x4*)(rowp + bj * HALF) = w;
                }
            }
    }
};

template <class EpiT, class Sched, bool ALIGN_EPI, bool SP2>
__device__ __forceinline__ void gemm_phase(PG8_LAS unsigned char* lds, const Gemm g, const Sched& S, const EpiT& E) {
    const int tid = launder_i(threadIdx.x), wid = __builtin_amdgcn_readfirstlane(tid >> 6), lane = tid & 63, wr = wid >> 2, wc = wid & 3, fr = lane & 15, fq = lane >> 4;
    const int K = g.K, nt = K / BK;
    unsigned voffA[2], voffB[2];
#pragma unroll
    for (int i = 0; i < 2; ++i) { int R, C; stage_rc(tid * 16 + i * 8192, R, C); const int Rb = EpiT::PERM ? ((R & ~31) + perm32(R & 31)) : R;
        voffA[i] = (unsigned)(R * K + C) * 2u; voffB[i] = (unsigned)(Rb * K + C) * 2u; }
    const size_t kstep = (size_t)(BK * 2);
    const size_t hstep = (size_t)HALF * K * 2;
    const size_t tstep = 2 * hstep;
    const unsigned ldsw = (unsigned)wid * 1024u;
    const int aoff = lds_byte(wr * 64 + fr, fq * 8), boff = lds_byte(wc * 32 + fr, fq * 8);
#define PG8_SA(b, h) (((b) * 2 + (h)) * HTB)
#define PG8_SB(b, h) ((4 + (b) * 2 + (h)) * HTB)
#define PG8_STAGE(bufoff, gbase, voff) do { _Pragma("unroll") for (int _i = 0; _i < 2; ++_i) \
        __builtin_amdgcn_global_load_lds((const unsigned*)((const char*)(gbase) + (voff)[_i]), (PG8_LAS unsigned*)(lds + (bufoff) + ldsw + _i * 8192), 16, 0, 0); } while (0)
#define PG8_LDA(dst, b, h) do { _Pragma("unroll") for (int m = 0; m < 4; ++m) _Pragma("unroll") for (int k = 0; k < 2; ++k) dst[m][k] = *(const PG8_LAS bf16x8*)(lds + PG8_SA(b, h) + aoff + m * 2048 + k * 1024); } while (0)
#define PG8_LDB(dst, b, h) do { _Pragma("unroll") for (int n = 0; n < 2; ++n) _Pragma("unroll") for (int k = 0; k < 2; ++k) dst[n][k] = *(const PG8_LAS bf16x8*)(lds + PG8_SB(b, h) + boff + n * 2048 + k * 1024); } while (0)
#define PG8_MMA(ai, bj, At, Bt) do { __builtin_amdgcn_s_setprio(1); _Pragma("unroll") for (int m = 0; m < 4; ++m) _Pragma("unroll") for (int n = 0; n < 2; ++n) _Pragma("unroll") for (int k = 0; k < 2; ++k) \
        acc[ai][bj][m][n] = __builtin_amdgcn_mfma_f32_16x16x32_bf16(Bt[n][k], At[m][k], acc[ai][bj][m][n], 0, 0, 0); __builtin_amdgcn_s_setprio(0); } while (0)
#define PG8_WAIT_V(n) asm volatile("s_waitcnt vmcnt(" #n ")" ::: "memory")
#define PG8_WAIT_L(n) asm volatile("s_waitcnt lgkmcnt(" #n ")" ::: "memory")
#define PG8_BAR __builtin_amdgcn_s_barrier()
#define PG8_SCHED __builtin_amdgcn_sched_barrier(0)
    Unit cur, nxt; int ui = 0;
    if (!S.next(0, cur)) return;
    f32x4 acc[2][2][4][2];
#pragma unroll
    for (int a = 0; a < 2; ++a)
#pragma unroll
        for (int b = 0; b < 2; ++b)
#pragma unroll
            for (int m = 0; m < 4; ++m)
#pragma unroll
                for (int n = 0; n < 2; ++n) acc[a][b][m][n] = (f32x4){0.f, 0.f, 0.f, 0.f};
    bf16x8 At[4][2], B0[2][2], B1[2][2];
    const char* cA = (const char*)g.A + (size_t)cur.pm * tstep + (size_t)cur.br * g.abr; const char* cB = (const char*)g.Bt + (size_t)cur.pn * tstep + (size_t)cur.br * g.bbr;
    if constexpr (SP2) {
        PG8_STAGE(PG8_SB(0, 0), cB, voffB); PG8_STAGE(PG8_SB(0, 1), cB + hstep, voffB); PG8_STAGE(PG8_SA(0, 0), cA, voffA); PG8_STAGE(PG8_SA(0, 1), cA + hstep, voffA);
        if (wr == 1) PG8_BAR;
        PG8_WAIT_V(2); PG8_BAR;
        PG8_STAGE(PG8_SB(1, 0), cB + kstep, voffB); PG8_STAGE(PG8_SA(1, 0), cA + kstep, voffA); PG8_STAGE(PG8_SB(1, 1), cB + hstep + kstep, voffB);
        PG8_WAIT_V(6); PG8_BAR;
    } else {
        PG8_STAGE(PG8_SB(0, 0), cB, voffB); PG8_STAGE(PG8_SA(0, 0), cA, voffA); PG8_STAGE(PG8_SB(0, 1), cB + hstep, voffB); PG8_STAGE(PG8_SA(0, 1), cA + hstep, voffA);
        if (wr == 1) PG8_BAR;
        PG8_WAIT_V(4); PG8_BAR;
        PG8_STAGE(PG8_SB(1, 0), cB + kstep, voffB); PG8_STAGE(PG8_SA(1, 0), cA + kstep, voffA); PG8_STAGE(PG8_SB(1, 1), cB + hstep + kstep, voffB);
        PG8_WAIT_V(6); PG8_BAR;
    }
    for (;;) {
        const bool has_next = S.next(ui + 1, nxt);
        const char* nA = has_next ? (const char*)g.A + (size_t)nxt.pm * tstep + (size_t)nxt.br * g.abr : cA;
        const char* nB = has_next ? (const char*)g.Bt + (size_t)nxt.pn * tstep + (size_t)nxt.br * g.bbr : cB;
        for (int t = 0; t < nt; t += 2) {
            const bool last = (t == nt - 2);
            const char* a1 = cA + (size_t)(t + 1) * kstep;
            const char* a2 = last ? nA : cA + (size_t)(t + 2) * kstep; const char* b2 = last ? nB : cB + (size_t)(t + 2) * kstep;
            const char* a3 = a2 + kstep; const char* b3 = b2 + kstep;
            if constexpr (SP2) {
            PG8_LDB(B0, 0, 0); PG8_LDB(B1, 0, 1); PG8_SCHED; PG8_LDA(At, 0, 0); PG8_STAGE(PG8_SA(1, 1), a1 + hstep, voffA);
            PG8_WAIT_V(8); PG8_WAIT_L(0); PG8_BAR; PG8_MMA(0, 0, At, B0); PG8_MMA(0, 1, At, B1); PG8_BAR; PG8_SCHED;
            PG8_LDA(At, 0, 1); PG8_STAGE(PG8_SB(0, 0), b2, voffB); PG8_STAGE(PG8_SB(0, 1), b2 + hstep, voffB); PG8_STAGE(PG8_SA(0, 0), a2, voffA);
            PG8_WAIT_V(8); PG8_WAIT_L(0); PG8_BAR; PG8_MMA(1, 0, At, B0); PG8_MMA(1, 1, At, B1); PG8_BAR; PG8_SCHED;
            PG8_LDB(B0, 1, 0); PG8_LDB(B1, 1, 1); PG8_SCHED; PG8_LDA(At, 1, 0); PG8_STAGE(PG8_SA(0, 1), a2 + hstep, voffA);
            PG8_WAIT_V(8); PG8_WAIT_L(0); PG8_BAR; PG8_MMA(0, 0, At, B0); PG8_MMA(0, 1, At, B1); PG8_BAR; PG8_SCHED;
            PG8_LDA(At, 1, 1); PG8_STAGE(PG8_SB(1, 0), b3, voffB); PG8_STAGE(PG8_SB(1, 1), b3 + hstep, voffB); PG8_STAGE(PG8_SA(1, 0), a3, voffA);
            PG8_WAIT_V(8); PG8_WAIT_L(0); PG8_BAR; PG8_MMA(1, 0, At, B0); PG8_MMA(1, 1, At, B1); PG8_BAR; PG8_SCHED;
            } else {
            PG8_LDB(B0, 0, 0); PG8_SCHED; PG8_LDA(At, 0, 0); PG8_STAGE(PG8_SA(1, 1), a1 + hstep, voffA);
            PG8_WAIT_L(8); PG8_BAR; PG8_WAIT_L(0); PG8_MMA(0, 0, At, B0); PG8_BAR; PG8_SCHED;
            PG8_LDB(B1, 0, 1); PG8_STAGE(PG8_SB(0, 0), b2, voffB);
            PG8_BAR; PG8_WAIT_L(0); PG8_MMA(0, 1, At, B1); PG8_BAR;
            PG8_LDA(At, 0, 1); PG8_STAGE(PG8_SA(0, 0), a2, voffA);
            PG8_BAR; PG8_WAIT_L(0); PG8_MMA(1, 0, At, B0); PG8_BAR; PG8_SCHED;
            PG8_STAGE(PG8_SB(0, 1), b2 + hstep, voffB);
            PG8_WAIT_V(6); PG8_BAR; PG8_MMA(1, 1, At, B1); PG8_BAR;
            PG8_LDB(B0, 1, 0); PG8_SCHED; PG8_LDA(At, 1, 0); PG8_STAGE(PG8_SA(0, 1), a2 + hstep, voffA);
            PG8_WAIT_L(8); PG8_BAR; PG8_WAIT_L(0); PG8_MMA(0, 0, At, B0); PG8_BAR; PG8_SCHED;
            PG8_LDB(B1, 1, 1); PG8_STAGE(PG8_SB(1, 0), b3, voffB);
            PG8_BAR; PG8_WAIT_L(0); PG8_MMA(0, 1, At, B1); PG8_BAR;
            PG8_LDA(At, 1, 1); PG8_STAGE(PG8_SA(1, 0), a3, voffA);
            PG8_BAR; PG8_WAIT_L(0); PG8_MMA(1, 0, At, B0); PG8_BAR; PG8_SCHED;
            PG8_STAGE(PG8_SB(1, 1), b3 + hstep, voffB);
            PG8_WAIT_V(6); PG8_BAR; PG8_MMA(1, 1, At, B1); PG8_BAR;
            }
        }
        if constexpr (ALIGN_EPI) { if (wr == 0) PG8_BAR; }
        E(acc, cur, wr, wc, fr, fq);
        if (!has_next) break;
#pragma unroll
        for (int a = 0; a < 2; ++a)
#pragma unroll
            for (int b = 0; b < 2; ++b)
#pragma unroll
                for (int m = 0; m < 4; ++m)
#pragma unroll
                    for (int n = 0; n < 2; ++n) acc[a][b][m][n] = (f32x4){0.f, 0.f, 0.f, 0.f};
        cur = nxt; cA = nA; cB = nB; ++ui;
        if constexpr (ALIGN_EPI) { if (wr == 1) PG8_BAR; }
    }
    PG8_WAIT_V(0);
    if constexpr (!ALIGN_EPI) { if (wr == 0) PG8_BAR; }
    PG8_BAR;
#undef PG8_SA
#undef PG8_SB
#undef PG8_STAGE
#undef PG8_LDA
#undef PG8_LDB
#undef PG8_MMA
#undef PG8_WAIT_V
#undef PG8_WAIT_L
#undef PG8_BAR
#undef PG8_SCHED
}
}

struct Args { const float* in[22]; float* out; unsigned char* ws; };

__device__ __forceinline__ void transpose_item(const float* W, int ldw, int col_off, int K, int N, bf16_t* WT, LAS float* scr, int item, int lane) {
    const int nblk = N / 64, kb = item / nblk, nb = item % nblk, k0 = 64 * kb, n0 = 64 * nb;
    const int r = lane >> 4, c4 = lane & 15;
    f32x4 v[16];
#pragma unroll
    for (int i = 0; i < 16; ++i) v[i] = *(const f32x4*)(W + (size_t)(k0 + 4 * i + r) * ldw + col_off + n0 + 4 * c4);
#pragma unroll
    for (int i = 0; i < 16; ++i) { LAS float* d = scr + (4 * i + r) * 65 + 4 * c4; d[0] = v[i].x; d[1] = v[i].y; d[2] = v[i].z; d[3] = v[i].w; }
    asm volatile("s_waitcnt lgkmcnt(0)" ::: "memory");
    const int c = lane & 7;
#pragma unroll
    for (int j = 0; j < 8; ++j) { const int n = (lane >> 3) + 8 * j; const LAS float* s = scr + (8 * c) * 65 + n;
        u32x4 o; o.x = cvt_pk_bf16(s[0 * 65], s[1 * 65]); o.y = cvt_pk_bf16(s[2 * 65], s[3 * 65]); o.z = cvt_pk_bf16(s[4 * 65], s[5 * 65]); o.w = cvt_pk_bf16(s[6 * 65], s[7 * 65]);
        *(u32x4*)(WT + (size_t)(n0 + n) * K + k0 + 8 * c) = o; }
    asm volatile("s_waitcnt lgkmcnt(0)" ::: "memory");
}

__device__ __forceinline__ void s5_tables(LAS unsigned char* lds, const Args& a, int l, int g, int qt, int tid) {
    LAS f32x2* AP = (LAS f32x2*)lds;
    LAS f32x2* BB = AP + 65 * 64;
    LAS f32x2* CC = BB + 64 * 16;
    const int lg = l * 32 + g;
    const float* are = a.in[4] + lg * 64; const float* aim = a.in[5] + lg * 64;
    const float dt = expf(a.in[6][lg]);
    unsigned char* tab = a.ws + WS_S5 + (size_t)l * S5_LAYER;
    for (int idx = tid; idx < 65 * 64; idx += 512) {
        const int d = idx >> 6, p = idx & 63;
        const float lr = fminf(are[p], -1e-4f), li = aim[p];
        const float mag = expf(lr * dt * (float)d);
        double rev = (double)li * (double)dt * (double)d * 0.15915494309189535;
        rev -= floor(rev); if (rev > 0.5) rev -= 1.0;
        const float th = (float)(rev * 6.283185307179586);
        AP[idx] = (f32x2){mag * cosf(th), mag * sinf(th)};
    }
    for (int idx = tid; idx < 1024; idx += 512) CC[idx] = (f32x2){a.in[9][(size_t)lg * 1024 + idx], a.in[10][(size_t)lg * 1024 + idx]};
    for (int idx = tid; idx < 1024; idx += 512) {
        const int p = idx >> 4;
        const float lr = fminf(are[p], -1e-4f), li = aim[p];
        double rev = (double)li * (double)dt * 0.15915494309189535;
        rev -= floor(rev); if (rev > 0.5) rev -= 1.0;
        const float th = (float)(rev * 6.283185307179586);
        const float em1 = expm1f(lr * dt), c = cosf(th), s = sinf(th), sh = sinf(0.5f * th);
        const float nr = em1 * c - 2.f * sh * sh, ni = (1.f + em1) * s;
        const float den = 1.f / (lr * lr + li * li);
        const float qr = (nr * lr + ni * li) * den, qi = (ni * lr - nr * li) * den;
        const float br = a.in[7][(size_t)lg * 1024 + idx], bi = a.in[8][(size_t)lg * 1024 + idx];
        BB[idx] = (f32x2){qr * br - qi * bi, qr * bi + qi * br};
    }
    __syncthreads();
    bf16_t* kt = (bf16_t*)(tab + S5_KT) + (size_t)g * (65 * 256);
    if (tid < 256) { const int s = qt * 256 + tid;
        const int d = s >> 4, h = s & 15;
        float acc[16];
#pragma unroll
        for (int i = 0; i < 16; ++i) acc[i] = 0.f;
        for (int p = 0; p < 64; ++p) {
            const f32x2 cc = CC[h * 64 + p], ap = AP[d * 64 + p];
            const float cr = cc.x * ap.x - cc.y * ap.y, ci = cc.x * ap.y + cc.y * ap.x;
#pragma unroll
            for (int i = 0; i < 16; ++i) { const f32x2 bb = BB[p * 16 + i]; acc[i] += cr * bb.x - ci * bb.y; }
        }
        if (d == 0) { const float dsk = a.in[11][lg * 16 + h];
#pragma unroll
            for (int i = 0; i < 16; ++i) if (i == h) acc[i] += dsk; }
        u32x4 o0, o1;
        o0.x = cvt_pk_bf16(acc[0], acc[1]); o0.y = cvt_pk_bf16(acc[2], acc[3]); o0.z = cvt_pk_bf16(acc[4], acc[5]); o0.w = cvt_pk_bf16(acc[6], acc[7]);
        o1.x = cvt_pk_bf16(acc[8], acc[9]); o1.y = cvt_pk_bf16(acc[10], acc[11]); o1.z = cvt_pk_bf16(acc[12], acc[13]); o1.w = cvt_pk_bf16(acc[14], acc[15]);
        bf16_t* dst = kt + (size_t)(63 - d) * 256 + h * 8;
        *(u32x4*)dst = o0; *(u32x4*)(dst + 128) = o1;
    }
    if (qt == 0 && tid >= 256 && tid < 288) ((u32x4*)(kt + 64 * 256))[tid - 256] = (u32x4){0u, 0u, 0u, 0u};
    bf16_t* we = (bf16_t*)(tab + S5_WE) + (size_t)g * 128 * 1024;
    for (int idx = qt * 4096 + tid; idx < (qt + 1) * 4096; idx += 512) {
        const int half = idx & 1, j = (idx >> 1) & 63, row = idx >> 7, p = row & 63, im = row >> 6;
        const f32x2 ap = AP[(63 - j) * 64 + p];
        float v[8];
#pragma unroll
        for (int i = 0; i < 8; ++i) { const f32x2 bb = BB[p * 16 + 8 * half + i]; v[i] = im ? (ap.x * bb.y + ap.y * bb.x) : (ap.x * bb.x - ap.y * bb.y); }
        u32x4 o; o.x = cvt_pk_bf16(v[0], v[1]); o.y = cvt_pk_bf16(v[2], v[3]); o.z = cvt_pk_bf16(v[4], v[5]); o.w = cvt_pk_bf16(v[6], v[7]);
        *(u32x4*)(we + (size_t)row * 1024 + j * 16 + 8 * half) = o;
    }
    bf16_t* wc = (bf16_t*)(tab + S5_WC) + (size_t)g * 1024 * 128;
    for (int idx = qt * 4096 + tid; idx < (qt + 1) * 4096; idx += 512) {
        const int kgp = idx & 15, rowi = idx >> 4, t = rowi >> 4, h = rowi & 15, im = kgp >> 3, p0 = (kgp & 7) * 8;
        float v[8];
#pragma unroll
        for (int i = 0; i < 8; ++i) { const f32x2 cc = CC[h * 64 + p0 + i], ap = AP[(t + 1) * 64 + p0 + i];
            v[i] = im ? -(cc.x * ap.y + cc.y * ap.x) : (cc.x * ap.x - cc.y * ap.y); }
        u32x4 o; o.x = cvt_pk_bf16(v[0], v[1]); o.y = cvt_pk_bf16(v[2], v[3]); o.z = cvt_pk_bf16(v[4], v[5]); o.w = cvt_pk_bf16(v[6], v[7]);
        *(u32x4*)(wc + (size_t)rowi * 128 + kgp * 8) = o;
    }
    if (qt == 1 && tid < 64) {
        ((f32x2*)(tab + S5_A64))[g * 64 + tid] = AP[64 * 64 + tid];
        const int k = tid & 15, kg = tid >> 4; const float* wg = a.in[12] + (size_t)lg * 256;
        u32x4 o; o.x = cvt_pk_bf16(wg[(4 * kg + 0) * 16 + k], wg[(4 * kg + 1) * 16 + k]); o.y = cvt_pk_bf16(wg[(4 * kg + 2) * 16 + k], wg[(4 * kg + 3) * 16 + k]); o.z = 0u; o.w = 0u;
        ((u32x4*)(tab + S5_GLU))[g * 64 + tid] = o;
    }
    __syncthreads();
}

struct NormArgs { const float* resid; const bf16_t* add; const float* g_add; float* xout; const float* g_xn; bf16_t* xn; const float* wf; const float* bfh; float* logf; };
__device__ __forceinline__ void norm_phase(LAS unsigned char* lds, const NormArgs n, int gw, int ngw, int lane, int tid) {
    if (n.wf) {
        for (int i = tid; i < 2048; i += 512) { const int d = i >> 1, hh = i & 1; const f32x4 v = *(const f32x4*)(n.wf + (size_t)d * INW + 4 * hh);
            const int k = 4 * (d >> 8) + (d & 3), ln = (d >> 2) & 63;
            *(LAS f32x4*)(lds + ((k * 2 + hh) * 64 + ln) * 16) = v; }
        __syncthreads();
    }
    f32x4 ga[4], gx[4];
#pragma unroll
    for (int j = 0; j < 4; ++j) { ga[j] = n.add ? *(const f32x4*)(n.g_add + 4 * lane + 256 * j) : (f32x4){0.f, 0.f, 0.f, 0.f}; gx[j] = n.xn ? *(const f32x4*)(n.g_xn + 4 * lane + 256 * j) : (f32x4){0.f, 0.f, 0.f, 0.f}; }
    for (int rbase = gw; rbase < M; rbase += 2 * ngw) {
        f32x4 v[2][4]; f32x4 av[2][4];
#pragma unroll
        for (int rr = 0; rr < 2; ++rr) { const size_t row = (size_t)rbase + (size_t)rr * ngw;
#pragma unroll
            for (int j = 0; j < 4; ++j) v[rr][j] = *(const f32x4*)(n.resid + row * DM + 4 * lane + 256 * j);
            if (n.add) {
#pragma unroll
                for (int j = 0; j < 4; ++j) { const u32x2 u = *(const u32x2*)(n.add + row * DM + 4 * lane + 256 * j); av[rr][j] = (f32x4){bf_lo(u.x), bf_hi(u.x), bf_lo(u.y), bf_hi(u.y)}; }
            }
        }
#pragma unroll
        for (int rr = 0; rr < 2; ++rr) { const size_t row = (size_t)rbase + (size_t)rr * ngw;
            if (n.add) {
                float ss = 0.f;
#pragma unroll
                for (int j = 0; j < 4; ++j) ss += (av[rr][j].x * av[rr][j].x + av[rr][j].y * av[rr][j].y) + (av[rr][j].z * av[rr][j].z + av[rr][j].w * av[rr][j].w);
                const float rs = rsqrtf(wave_sum(ss) * (1.f / DM) + EPS);
#pragma unroll
                for (int j = 0; j < 4; ++j) v[rr][j] = v[rr][j] + av[rr][j] * rs * ga[j];
            }
            if (n.xout) {
#pragma unroll
                for (int j = 0; j < 4; ++j) *(f32x4*)(n.xout + row * DM + 4 * lane + 256 * j) = v[rr][j];
            }
            if (n.xn) {
                float ss = 0.f;
#pragma unroll
                for (int j = 0; j < 4; ++j) ss += (v[rr][j].x * v[rr][j].x + v[rr][j].y * v[rr][j].y) + (v[rr][j].z * v[rr][j].z + v[rr][j].w * v[rr][j].w);
                const float rs = rsqrtf(wave_sum(ss) * (1.f / DM) + EPS);
                f32x4 hn[4];
#pragma unroll
                for (int j = 0; j < 4; ++j) { hn[j] = v[rr][j] * rs * gx[j]; u32x2 o; o.x = cvt_pk_bf16(hn[j].x, hn[j].y); o.y = cvt_pk_bf16(hn[j].z, hn[j].w);
                    *(u32x2*)(n.xn + row * DM + 4 * lane + 256 * j) = o; }
                if (n.wf) {
                    f32x4 f0 = (f32x4){0.f, 0.f, 0.f, 0.f}, f1 = f0;
#pragma unroll
                    for (int j = 0; j < 4; ++j)
#pragma unroll
                        for (int i = 0; i < 4; ++i) { const LAS unsigned char* wp = lds + (((4 * j + i) * 2) * 64 + lane) * 16;
                            const f32x4 w0 = *(const LAS f32x4*)wp, w1 = *(const LAS f32x4*)(wp + 1024); f0 = f0 + w0 * hn[j][i]; f1 = f1 + w1 * hn[j][i]; }
                    float z = 0.f;
#pragma unroll
                    for (int hh = 0; hh < 4; ++hh) { const float s0 = wave_sum(f0[hh]), s1 = wave_sum(f1[hh]); if (lane == hh) z = s0; if (lane == hh + 4) z = s1; }
                    if (lane < 8) { z += n.bfh[lane]; n.logf[row * 8 + lane] = fminf(z, 0.f) - log1pf(expf(-fabsf(z))); }
                }
            }
        }
    }
}

__device__ __forceinline__ void cum_scan(LAS unsigned char* lds, const float* logf, float* cum, int bh, int tid, int lane, int w) {
    LAS float* ws = (LAS float*)lds;
    const int b = bh >> 3, h = bh & 7;
    float v[8]; float run = 0.f;
#pragma unroll
    for (int i = 0; i < 8; ++i) { run += logf[((size_t)b * SEQ + 8 * tid + i) * 8 + h]; v[i] = run; }
    float inc = run;
#pragma unroll
    for (int o = 1; o < 64; o <<= 1) { const float t = __int_as_float(__builtin_amdgcn_ds_bpermute((lane - o) << 2, __float_as_int(inc))); if (lane >= o) inc += t; }
    if (lane == 63) ws[w] = inc;
    __syncthreads();
    float base = inc - run;
    for (int i = 0; i < w; ++i) base += ws[i];
#pragma unroll
    for (int i = 0; i < 8; ++i) cum[(size_t)bh * SEQ + 8 * tid + i] = (base + v[i]) * LOG2E;
    __syncthreads();
}

#define MFMA16(a, b, c) __builtin_amdgcn_mfma_f32_16x16x32_bf16((a), (b), (c), 0, 0, 0)
#define MFMA32(a, b, c) __builtin_amdgcn_mfma_f32_32x32x16_bf16((a), (b), (c), 0, 0, 0)
__device__ __forceinline__ bf16x8 ldg16(const void* ubase, unsigned off) { return *(const bf16x8*)((const char*)ubase + off); }
__device__ __forceinline__ void s5_unit(LAS unsigned char* lds, const bf16_t* P, const unsigned char* tab, bf16_t* Ya, const int b, const int g, int tid, int lane, int w) {
    LAS unsigned char* KT = lds; LAS float* EL = (LAS float*)(lds + 33280); LAS unsigned char* SPT = lds + 66560;
    const unsigned char* ktab = tab + S5_KT + (size_t)g * KT_BYTES;
    const int n = lane & 15, kg = lane >> 4, ntile = w & 3, wh = w >> 2;
    const bf16_t* WEu = (const bf16_t*)(tab + S5_WE) + (size_t)g * 128 * 1024 + (size_t)(64 * wh) * 1024;
    const bf16_t* WCu = (const bf16_t*)(tab + S5_WC) + (size_t)g * 1024 * 128 + (size_t)(wh * 16) * 128;
    const bf16_t* Uu = P + ((size_t)b * SEQ + (size_t)(16 * ntile) * 64) * NA + 16 * g;
    const unsigned uoff = (unsigned)((n * 64 + (kg >> 1)) * NA + 8 * (kg & 1)) * 2u;
    const unsigned weoff = (unsigned)(n * 1024 + 8 * kg) * 2u;
    const unsigned wcoff = (unsigned)(n * 128 + 8 * kg) * 2u;
    for (int i = tid; i < KT_BYTES / 16; i += 512) *(LAS u32x4*)(KT + i * 16) = *(const u32x4*)(ktab + i * 16);
    {
        f32x4 e[4];
#pragma unroll
        for (int mt = 0; mt < 4; ++mt) e[mt] = (f32x4){0.f, 0.f, 0.f, 0.f};
        bf16x8 eb[4], ea[4][4];
#define S5_ELD(ks) do { eb[(ks) & 3] = ldg16(Uu + (size_t)(2 * (ks)) * NA, uoff); _Pragma("unroll") for (int _m = 0; _m < 4; ++_m) ea[(ks) & 3][_m] = ldg16(WEu + (size_t)(16 * _m) * 1024 + 32 * (ks), weoff); } while (0)
        S5_ELD(0); S5_ELD(1); S5_ELD(2);
        __builtin_amdgcn_sched_barrier(0);
#pragma unroll
        for (int ks = 0; ks < 32; ++ks) {
            if (ks + 3 < 32) S5_ELD(ks + 3);
#pragma unroll
            for (int mt = 0; mt < 4; ++mt) e[mt] = MFMA16(ea[ks & 3][mt], eb[ks & 3], e[mt]);
            __builtin_amdgcn_sched_barrier(0);
        }
#undef S5_ELD
#pragma unroll
        for (int mt = 0; mt < 4; ++mt)
#pragma unroll
            for (int i = 0; i < 4; ++i) EL[(64 * wh + 16 * mt + 4 * kg + i) * 65 + 16 * ntile + n] = e[mt][i];
    }
    __syncthreads();
    {
        const int p = tid & 63, seg = tid >> 6;
        const f32x2 a1 = ((const f32x2*)(tab + S5_A64))[g * 64 + p];
        float lr[8], li[8]; float sr = 0.f, si = 0.f;
#pragma unroll
        for (int j = 0; j < 8; ++j) { const float er = EL[p * 65 + 8 * seg + j], ei = EL[(64 + p) * 65 + 8 * seg + j];
            const float nr = a1.x * sr - a1.y * si + er, ni = a1.x * si + a1.y * sr + ei; sr = nr; si = ni; lr[j] = sr; li[j] = si; }
        LAS f32x2* TT = (LAS f32x2*)(lds + 66560 + 17408);
        TT[seg * 64 + p] = (f32x2){sr, si};
        f32x2 a2 = {a1.x * a1.x - a1.y * a1.y, 2.f * a1.x * a1.y}; f32x2 a4 = {a2.x * a2.x - a2.y * a2.y, 2.f * a2.x * a2.y}; const f32x2 a8 = {a4.x * a4.x - a4.y * a4.y, 2.f * a4.x * a4.y};
        __syncthreads();
        float cr = 0.f, ci = 0.f;
        for (int s2 = 0; s2 < seg; ++s2) { const f32x2 t = TT[s2 * 64 + p]; const float nr = a8.x * cr - a8.y * ci + t.x, ni = a8.x * ci + a8.y * cr + t.y; cr = nr; ci = ni; }
        float pr = cr, pi = ci, wr_ = cr, wi_ = ci;
#pragma unroll
        for (int j = 0; j < 8; ++j) {
            *(LAS bf16_t*)(SPT + (8 * seg + j) * 272 + 2 * p) = (bf16_t)(cvt_pk_bf16(pr, 0.f) & 0xffffu);
            *(LAS bf16_t*)(SPT + (8 * seg + j) * 272 + 2 * (64 + p)) = (bf16_t)(cvt_pk_bf16(pi, 0.f) & 0xffffu);
            const float nr = a1.x * wr_ - a1.y * wi_, ni = a1.x * wi_ + a1.y * wr_; wr_ = nr; wi_ = ni;
            pr = lr[j] + wr_; pi = li[j] + wi_;
        }
    }
    __syncthreads();
    const LAS unsigned char* klow = KT + (1 - wh + (lane >> 5)) * 512 + ((lane >> 4) & 1) * 256 + (lane & 15) * 16;
    const LAS unsigned char* spb = SPT + (16 * ntile + n) * 272 + 16 * kg;
    const bf16x8 aglu = *(const bf16x8*)(tab + S5_GLU + (size_t)(g * 64 + lane) * 16);
    const unsigned yoff = (unsigned)(n * 64 * YW + 4 * kg) * 2u;
#pragma unroll 1
    for (int pass = 0; pass < 2; ++pass) {
        f32x4 acc[16];
#pragma unroll
        for (int i = 0; i < 16; ++i) acc[i] = (f32x4){0.f, 0.f, 0.f, 0.f};
        bf16x8 bq[4], ca[2][4], bt[8], bu[8];
        const bf16_t* Up = Uu + (size_t)(32 * pass) * NA;
        const bf16_t* WCp = WCu + (size_t)(32 * pass) * 2048;
#define S5_LDC(st, slot) do { _Pragma("unroll") for (int _q = 0; _q < 4; ++_q) ca[slot][_q] = ldg16(WCp + (size_t)(2 * (4 * ((st) & 3) + _q)) * 2048 + 32 * ((st) >> 2), wcoff); } while (0)
#pragma unroll
        for (int jj = 0; jj < 8; ++jj) bt[jj] = ldg16(Up + (size_t)(2 * jj) * NA, uoff);
        S5_LDC(0, 0); S5_LDC(1, 1);
        if (pass == 1) {
            bq[0] = ldg16(Uu, uoff); bq[1] = ldg16(Uu + (size_t)2 * NA, uoff); bq[2] = ldg16(Uu + (size_t)4 * NA, uoff);
            __builtin_amdgcn_sched_barrier(0);
#pragma unroll
            for (int jj = 0; jj < 16; ++jj) {
                if (jj + 3 < 16) bq[(jj + 3) & 3] = ldg16(Uu + (size_t)(2 * (jj + 3)) * NA, uoff);
#pragma unroll
                for (int ii = 0; ii < 16; ++ii) { const bf16x8 af = *(const LAS bf16x8*)(klow + (30 - 2 * (ii - jj)) * 512); acc[ii] = MFMA16(af, bq[jj & 3], acc[ii]); }
                __builtin_amdgcn_sched_barrier(0);
            }
        }
        __builtin_amdgcn_sched_barrier(0);
#pragma unroll
        for (int jj = 0; jj < 16; ++jj) {
            const bf16x8 cb = *(const LAS bf16x8*)(spb + 64 * (jj >> 2));
            if (jj < 8) bu[jj] = ldg16(Up + (size_t)(2 * (jj + 8)) * NA, uoff);
#pragma unroll
            for (int ii = 0; ii < 16; ++ii) if (ii >= jj) { const bf16x8 af = *(const LAS bf16x8*)(klow + (62 - 2 * (ii - jj)) * 512); acc[ii] = MFMA16(af, (jj < 8 ? bt[jj & 7] : bu[jj & 7]), acc[ii]); }
#pragma unroll
            for (int q = 0; q < 4; ++q) acc[4 * (jj & 3) + q] = MFMA16(ca[jj & 1][q], cb, acc[4 * (jj & 3) + q]);
            __builtin_amdgcn_sched_barrier(0);
            if (jj + 2 < 16) S5_LDC(jj + 2, jj & 1);
            __builtin_amdgcn_sched_barrier(0);
        }
#undef S5_LDC
        bf16_t* Yu = Ya + ((size_t)b * SEQ + (size_t)(16 * ntile) * 64 + wh + 32 * pass) * YW + 16 * g;
#pragma unroll
        for (int ii = 0; ii < 16; ++ii) {
            f32x4 y;
#pragma unroll
            for (int k = 0; k < 4; ++k) y[k] = gelu_tanh(acc[ii][k]);
            u32x4 bp; bp.x = cvt_pk_bf16(y[0], y[1]); bp.y = cvt_pk_bf16(y[2], y[3]); bp.z = 0u; bp.w = 0u;
            const f32x4 z = MFMA16(aglu, __builtin_bit_cast(bf16x8, bp), ((f32x4){0.f, 0.f, 0.f, 0.f}));
            u32x2 o; o.x = cvt_pk_bf16(y[0] * sigmoid_f(z[0]), y[1] * sigmoid_f(z[1])); o.y = cvt_pk_bf16(y[2] * sigmoid_f(z[2]), y[3] * sigmoid_f(z[3]));
            *(u32x2*)((char*)(Yu + (size_t)(2 * ii) * YW) + yoff) = o;
        }
    }
    __syncthreads();
}

constexpr int AT_KS = 0, AT_VT = 9216, AT_VP = 192, AT_BS = 9216 + 64 * AT_VP, AT_BUF = AT_BS + 256;
__device__ __forceinline__ int crow(int r, int hi) { return (r & 3) + 8 * (r >> 2) + 4 * hi; }
__device__ __forceinline__ void attn_unit(LAS unsigned char* lds, const bf16_t* P, const float* cum, bf16_t* Yc, const int b, const int h, const int qb, int tid, int lane, int w) {
    const int r32 = lane & 31, hi = lane >> 5;
    const size_t row0 = (size_t)b * SEQ;
    const int q0 = qb * 256, qrow = q0 + 32 * w + r32;
    bf16x8 qf[4];
    { const bf16_t* qp = P + (row0 + qrow) * NA + COL_Q + 64 * h + 8 * hi;
#pragma unroll
      for (int s = 0; s < 4; ++s) qf[s] = *(const bf16x8*)(qp + 16 * s); }
    const float* cumbh = cum + (size_t)(b * 8 + h) * SEQ;
    const float ref = cumbh[q0];
    const int vlane = (4 * hi + ((lane & 15) >> 2)) * AT_VP + 32 * ((lane >> 4) & 1) + 8 * (lane & 3);
    const int skey = tid >> 3, spc = tid & 7;
    const bf16_t* kgp = P + (row0 + skey) * NA + COL_K + 64 * h + 8 * spc;
    const int NT = 4 * qb + 4;
    u32x4 kreg = *(const u32x4*)kgp, vreg = *(const u32x4*)(kgp + (COL_V - COL_K)); float breg = 0.f; if (tid < 64) breg = ref - cumbh[tid];
#define AT_WRITE(bufp) do { LAS unsigned char* _b = (bufp); *(LAS u32x4*)(_b + AT_KS + skey * 144 + 16 * spc) = kreg; \
        *(LAS u32x4*)(_b + AT_VT + skey * AT_VP + 16 * spc) = vreg; \
        if (tid < 64) *(LAS float*)(_b + AT_BS + 4 * tid) = breg; } while (0)
    AT_WRITE(lds);
    __syncthreads();
    float mrun = -1e30f, lrun = 0.f; f32x16 o0, o1;
#pragma unroll
    for (int r = 0; r < 16; ++r) { o0[r] = 0.f; o1[r] = 0.f; }
    for (int kt = 0; kt < NT; ++kt) {
        const int cur = kt & 1; const bool more = (kt + 1 < NT);
        if (more) { const bf16_t* kp = kgp + (size_t)(kt + 1) * 64 * NA; kreg = *(const u32x4*)kp; vreg = *(const u32x4*)(kp + (COL_V - COL_K)); if (tid < 64) breg = ref - cumbh[64 * (kt + 1) + tid]; }
        if (64 * kt <= q0 + 32 * w + 31) {
            const LAS unsigned char* Kb = lds + cur * AT_BUF + AT_KS; const LAS unsigned char* Vb = lds + cur * AT_BUF + AT_VT; const LAS unsigned char* Bb = lds + cur * AT_BUF + AT_BS;
            f32x16 p[2];
#pragma unroll
            for (int rb = 0; rb < 2; ++rb) {
                f32x16 c;
#pragma unroll
                for (int g4 = 0; g4 < 4; ++g4) { const f32x4 bv = *(const LAS f32x4*)(Bb + (32 * rb + 8 * g4 + 4 * hi) * 4); c[4 * g4 + 0] = bv.x; c[4 * g4 + 1] = bv.y; c[4 * g4 + 2] = bv.z; c[4 * g4 + 3] = bv.w; }
#pragma unroll
                for (int s = 0; s < 4; ++s) { const bf16x8 af = *(const LAS bf16x8*)(Kb + (32 * rb + r32) * 144 + 32 * s + 16 * hi); c = MFMA32(af, qf[s], c); }
                p[rb] = c;
            }
            if (64 * kt + 63 > q0 + 32 * w) {
#pragma unroll
                for (int rb = 0; rb < 2; ++rb)
#pragma unroll
                    for (int r = 0; r < 16; ++r) { const int key = 64 * kt + 32 * rb + crow(r, hi); if (key > qrow) p[rb][r] = -1e30f; }
            }
            float mt = p[0][0];
#pragma unroll
            for (int r = 1; r < 16; ++r) mt = fmaxf(mt, p[0][r]);
#pragma unroll
            for (int r = 0; r < 16; ++r) mt = fmaxf(mt, p[1][r]);
            mt = half_max(mt);
            const float mnew = fmaxf(mrun, mt), alpha = fast_exp2(mrun - mnew);
            mrun = mnew;
            float ls = 0.f;
#pragma unroll
            for (int rb = 0; rb < 2; ++rb)
#pragma unroll
                for (int r = 0; r < 16; ++r) { p[rb][r] = fast_exp2(p[rb][r] - mnew); ls += p[rb][r]; }
            lrun = lrun * alpha + ls;
#pragma unroll
            for (int r = 0; r < 16; ++r) { o0[r] *= alpha; o1[r] *= alpha; }
            bf16x8 pf[4];
#pragma unroll
            for (int s = 0; s < 4; ++s) { const int rb = s >> 1, r0 = 8 * (s & 1); u32x4 pk; pk.x = cvt_pk_bf16(p[rb][r0 + 0], p[rb][r0 + 1]); pk.y = cvt_pk_bf16(p[rb][r0 + 2], p[rb][r0 + 3]);
                pk.z = cvt_pk_bf16(p[rb][r0 + 4], p[rb][r0 + 5]); pk.w = cvt_pk_bf16(p[rb][r0 + 6], p[rb][r0 + 7]); pf[s] = __builtin_bit_cast(bf16x8, pk); }
#pragma unroll
            for (int s = 0; s < 4; ++s) {
                typedef short v4i16_t __attribute__((ext_vector_type(4)));
                const LAS unsigned char* vp = Vb + vlane + 16 * s * AT_VP;
                { const s16x4 lo = __builtin_bit_cast(s16x4, __builtin_amdgcn_ds_read_tr16_b64_v4i16((LAS v4i16_t*)(vp))), hh = __builtin_bit_cast(s16x4, __builtin_amdgcn_ds_read_tr16_b64_v4i16((LAS v4i16_t*)(vp + 8 * AT_VP)));
                  const bf16x8 af = __builtin_shufflevector(lo, hh, 0, 1, 2, 3, 4, 5, 6, 7); o0 = MFMA32(af, pf[s], o0); }
                { const s16x4 lo = __builtin_bit_cast(s16x4, __builtin_amdgcn_ds_read_tr16_b64_v4i16((LAS v4i16_t*)(vp + 64))), hh = __builtin_bit_cast(s16x4, __builtin_amdgcn_ds_read_tr16_b64_v4i16((LAS v4i16_t*)(vp + 64 + 8 * AT_VP)));
                  const bf16x8 af = __builtin_shufflevector(lo, hh, 0, 1, 2, 3, 4, 5, 6, 7); o1 = MFMA32(af, pf[s], o1); }
            }
        }
        if (more) AT_WRITE(lds + (cur ^ 1) * AT_BUF);
        __syncthreads();
    }
#undef AT_WRITE
    const float ltot = half_sum(lrun);
    const float inv = 1.0f / ltot;
    bf16_t* op = Yc + (row0 + qrow) * YW + 64 * h + 4 * hi;
#pragma unroll
    for (int g4 = 0; g4 < 4; ++g4) {
        u32x2 a, c2;
        a.x = cvt_pk_bf16(o0[4 * g4 + 0] * inv, o0[4 * g4 + 1] * inv); a.y = cvt_pk_bf16(o0[4 * g4 + 2] * inv, o0[4 * g4 + 3] * inv);
        c2.x = cvt_pk_bf16(o1[4 * g4 + 0] * inv, o1[4 * g4 + 1] * inv); c2.y = cvt_pk_bf16(o1[4 * g4 + 2] * inv, o1[4 * g4 + 3] * inv);
        *(u32x2*)(op + 8 * g4) = a; *(u32x2*)(op + 32 + 8 * g4) = c2;
    }
}

__device__ __forceinline__ u32x4 conv_item(const bf16_t* P, const float* cw, int item) {
    const int token = item >> 6, c0 = (item & 63) * 8, t = token & (SEQ - 1);
    float acc[8];
#pragma unroll
    for (int i = 0; i < 8; ++i) acc[i] = 0.f;
    u32x4 xc[3], cc[3];
#pragma unroll
    for (int tap = 0; tap < 3; ++tap) {
        const bool ok = (t - 2 + tap >= 0);
        const bf16_t* rp = P + (size_t)(ok ? token - 2 + tap : token) * NA + c0;
        xc[tap] = *(const u32x4*)(rp + COL_XC); cc[tap] = *(const u32x4*)(rp + COL_CC);
        if (!ok) { xc[tap] = (u32x4){0u, 0u, 0u, 0u}; }
    }
    const u32x4 bc = *(const u32x4*)(P + (size_t)token * NA + COL_BC + c0);
#pragma unroll
    for (int tap = 0; tap < 3; ++tap) {
        const f32x4 w0 = *(const f32x4*)(cw + tap * 512 + c0), w1 = *(const f32x4*)(cw + tap * 512 + c0 + 4);
        const u32x4 x = xc[tap], c = cc[tap];
        acc[0] += w0.x * bf_lo(x.x) * bf_lo(c.x); acc[1] += w0.y * bf_hi(x.x) * bf_hi(c.x); acc[2] += w0.z * bf_lo(x.y) * bf_lo(c.y); acc[3] += w0.w * bf_hi(x.y) * bf_hi(c.y);
        acc[4] += w1.x * bf_lo(x.z) * bf_lo(c.z); acc[5] += w1.y * bf_hi(x.z) * bf_hi(c.z); acc[6] += w1.z * bf_lo(x.w) * bf_lo(c.w); acc[7] += w1.w * bf_hi(x.w) * bf_hi(c.w);
    }
    u32x4 o; o.x = cvt_pk_bf16(acc[0] * bf_lo(bc.x), acc[1] * bf_hi(bc.x)); o.y = cvt_pk_bf16(acc[2] * bf_lo(bc.y), acc[3] * bf_hi(bc.y));
    o.z = cvt_pk_bf16(acc[4] * bf_lo(bc.z), acc[5] * bf_hi(bc.z)); o.w = cvt_pk_bf16(acc[6] * bf_lo(bc.w), acc[7] * bf_hi(bc.w));
    return o;
}
__device__ __forceinline__ void conv_phase(const bf16_t* P, const float* cw, bf16_t* Yb, int gtid, int ngt) {
    for (int item = gtid; item < M * 64; item += 4 * ngt) {
        u32x4 o[4];
#pragma unroll
        for (int q = 0; q < 4; ++q) o[q] = conv_item(P, cw, item + q * ngt);
#pragma unroll
        for (int q = 0; q < 4; ++q) { const int it = item + q * ngt; *(u32x4*)(Yb + (size_t)(it >> 6) * YW + (it & 63) * 8) = o[q]; }
    }
}

#define XB_TMO      128
#define XB_XCNT(j)  (256  + 64 * (j))
#define XB_XSUB(j)  (1280 + 64 * (j))
#define XB_XGEN(j)  (2304 + 64 * (j))
#define XB_TOP      3328
#define XB_TOPGEN   3392
#define XCD_BAR_WORDS 3456
#define XB_SPIN_CAP (1u << 18)
__device__ __forceinline__ unsigned xb_ld(unsigned* p)              { return __hip_atomic_load(p, __ATOMIC_RELAXED, __HIP_MEMORY_SCOPE_AGENT); }
__device__ __forceinline__ unsigned xb_add(unsigned* p, unsigned v) { return __hip_atomic_fetch_add(p, v, __ATOMIC_RELAXED, __HIP_MEMORY_SCOPE_AGENT); }
__device__ __forceinline__ unsigned xb_xcc_id() { return (unsigned)__builtin_amdgcn_s_getreg((3 << 11) | 20) & 0xFu; }
#define XB_SPIN(cond, bar) do { unsigned _sp = 0; while (cond) { __builtin_amdgcn_s_sleep(1); \
    if ((++_sp & 255u) == 0u) { if (xb_ld(&(bar)[XB_TMO])) break; if (_sp > XB_SPIN_CAP) { atomicAdd(&(bar)[XB_TMO], 1u); break; } } } } while (0)
struct XcdBarrier { unsigned* bar; unsigned x; volatile LAS unsigned* st; };
__device__ __forceinline__ XcdBarrier xcd_barrier_post(unsigned* bar, volatile LAS unsigned* st) {
    XcdBarrier b; b.bar = bar; b.x = xb_xcc_id(); b.st = st;
    if (threadIdx.x == 0) (void)xb_add(&bar[XB_XCNT(b.x)], 1u);
    return b;
}
__device__ __forceinline__ void xcd_barrier_complete(unsigned* bar, unsigned x, unsigned& nloc, unsigned& nx) {
    const unsigned G = gridDim.x * gridDim.y * gridDim.z;
    unsigned sum, cnt, mine, sp = 0u;
    for (;;) {
        sum = 0u; cnt = 0u; mine = 0u;
#pragma unroll
        for (unsigned j = 0; j < 16; ++j) { const unsigned c = xb_ld(&bar[XB_XCNT(j)]); sum += c; cnt += (c > 0u) ? 1u : 0u; mine = (j == x) ? c : mine; }
        if (sum == G) break;
        __builtin_amdgcn_s_sleep(1);
        if ((++sp & 255u) == 0u) { if (xb_ld(&bar[XB_TMO])) break; if (sp > XB_SPIN_CAP) { atomicAdd(&bar[XB_TMO], 1u); break; } }
    }
    nloc = mine > 0u ? mine : 1u; nx = cnt > 0u ? cnt : 1u;
}
__device__ __forceinline__ void xcd_barrier(const XcdBarrier& b) {
    asm volatile("s_waitcnt vmcnt(0) lgkmcnt(0)" ::: "memory");
    __syncthreads();
    if (threadIdx.x == 0) {
        unsigned* bar = b.bar; unsigned bx = b.x;
        asm volatile("" : "+s"(bar), "+s"(bx));
        __builtin_amdgcn_s_waitcnt(0);
        unsigned nloc = b.st[0], nx = b.st[1];
        if (nloc == 0u) { xcd_barrier_complete(bar, bx, nloc, nx); b.st[0] = nloc; b.st[1] = nx; }
        const unsigned old = xb_add(&bar[XB_XSUB(bx)], 1u);
        const unsigned gen = old / nloc;
        if (old + 1u == (gen + 1u) * nloc) {
            __builtin_amdgcn_fence(__ATOMIC_RELEASE, "agent");
            asm volatile("s_waitcnt vmcnt(0)" ::: "memory");
            const unsigned og = xb_add(&bar[XB_TOP], 1u);
            const unsigned tg = og / nx;
            if (og + 1u == (tg + 1u) * nx) xb_add(&bar[XB_TOPGEN], 1u);
            else XB_SPIN(xb_ld(&bar[XB_TOPGEN]) == tg, bar);
            __builtin_amdgcn_fence(__ATOMIC_ACQUIRE, "agent");
            xb_add(&bar[XB_XGEN(bx)], 1u);
            asm volatile("s_waitcnt vmcnt(0)" ::: "memory");
        } else {
            XB_SPIN(xb_ld(&bar[XB_XGEN(bx)]) == gen, bar);
            __builtin_amdgcn_fence(__ATOMIC_ACQUIRE, "agent");
            asm volatile("s_waitcnt vmcnt(0)" ::: "memory");
        }
    }
    __syncthreads();
}
__device__ __forceinline__ void cg_barrier(cg::grid_group& grid) {
    asm volatile("s_waitcnt vmcnt(0) lgkmcnt(0)" ::: "memory");
    __syncthreads();
    grid.sync();
    if (threadIdx.x == 0) { __builtin_amdgcn_fence(__ATOMIC_ACQUIRE, "agent"); asm volatile("s_waitcnt vmcnt(0)" ::: "memory"); }
    __syncthreads();
}
#define grid_barrier(g_) xcd_barrier(xbar)

#ifndef DIAG_STAGE
#define DIAG_STAGE 0
#endif
__device__ __forceinline__ void diag_dump(float* out, const bf16_t* src, int ld, int ncols) {
    for (size_t i = (size_t)blockIdx.x * 512 + threadIdx.x; i < (size_t)M * DM; i += (size_t)gridDim.x * 512) {
        const size_t row = i >> 10; const int c = (int)(i & 1023); float v = 0.f;
        for (int cc = c; cc < ncols; cc += 1024) v += bf_lo((unsigned)src[row * ld + cc]);
        out[i] = v;
    }
}
#define DIAG(k, src, ld, ncols) do { if (DIAG_STAGE == (k)) { grid_barrier(grid); diag_dump(A_->out, (src), (ld), (ncols)); return; } } while (0)

typedef const __attribute__((address_space(4))) Args* KArgP;
__device__ __forceinline__ KArgP launder_args(KArgP p) { asm volatile("" : "+s"(p)); return p; }
#define A_ (launder_args(argp))
__global__ void __launch_bounds__(512, 2) fwd_kernel(Args a) {
    KArgP argp = (KArgP)__builtin_amdgcn_kernarg_segment_ptr(); (void)a;
    extern __shared__ __attribute__((aligned(16))) unsigned char lds_raw[];
    LAS unsigned char* lds = (LAS unsigned char*)lds_raw;
    cg::grid_group grid = cg::this_grid();
    if (gridDim.z == 12345u) grid.sync();
    volatile LAS unsigned* xst = (volatile LAS unsigned*)((LAS unsigned char*)lds_raw + LDS_BYTES - 64);
    if (threadIdx.x == 0) { xst[0] = 0u; xst[1] = 0u; }
    __syncthreads();
    const XcdBarrier xbar = xcd_barrier_post((unsigned*)(A_->ws + 16384), xst);
    const int G = gridDim.x, bid = blockIdx.x, ngw = G * 8;
#define FRESH() const int tid = launder_i(threadIdx.x), lane = tid & 63, w = __builtin_amdgcn_readfirstlane(tid >> 6), gw = bid * 8 + w; (void)lane; (void)gw
    unsigned char* ws = A_->ws;
    bf16_t* XN = (bf16_t*)(ws + WS_XN); bf16_t* PR = (bf16_t*)(ws + WS_P); bf16_t* Y = (bf16_t*)(ws + WS_Y);
    float* LOGF = (float*)(ws + WS_LOGF); float* CUM = (float*)(ws + WS_CUM);

    {
        FRESH();
#ifndef NO_TAB
        for (int u = bid; u < 256; u += G) s5_tables(lds, a, u >> 7, (u >> 2) & 31, u & 3, tid);
#endif
        LAS float* scr = (LAS float*)(lds + w * 16640);
        constexpr int I_A = 16 * 56, I_G = 16 * 48, I_B = 8 * 16, I_O = 16 * 16, I_1 = 16 * 64, I_2 = 64 * 16, I_L = I_A + I_G + 3 * I_B + I_O + I_1 + I_2;
        for (int it = gw; it < 2 * I_L; it += ngw) {
            const int l = it / I_L; int r = it - l * I_L;
            unsigned char* wl = ws + WS_W + (size_t)l * W_LAYER;
            const float* win = A_->in[2] + (size_t)l * DM * INW;
            if (r < I_A) { transpose_item(win, INW, 0, DM, NA, (bf16_t*)(wl + W_INA), scr, r, lane); continue; } r -= I_A;
            if (r < I_G) { transpose_item(win, INW, COL_G, DM, NG, (bf16_t*)(wl + W_G), scr, r, lane); continue; } r -= I_G;
            if (r < 3 * I_B) { const int br = r / I_B; transpose_item(A_->in[15] + (size_t)l * 1536 * DM + (size_t)br * 512 * DM, DM, 0, 512, DM, (bf16_t*)(wl + W_BR) + (size_t)br * DM * 512, scr, r - br * I_B, lane); continue; } r -= 3 * I_B;
            if (r < I_O) { transpose_item(A_->in[16] + (size_t)l * DM * DM, DM, 0, DM, DM, (bf16_t*)(wl + W_OUT), scr, r, lane); continue; } r -= I_O;
            if (r < I_1) { transpose_item(A_->in[19] + (size_t)l * DM * FF, FF, 0, DM, FF, (bf16_t*)(wl + W_1), scr, r, lane); continue; } r -= I_1;
            transpose_item(A_->in[20] + (size_t)l * FF * DM, DM, 0, FF, DM, (bf16_t*)(wl + W_2), scr, r, lane);
        }
        __syncthreads();
        NormArgs n{A_->in[0], nullptr, nullptr, nullptr, A_->in[1], XN, A_->in[2] + COL_F, A_->in[14], LOGF};
        norm_phase(lds, n, gw, ngw, lane, tid);
    }
    xcd_barrier(xbar);

    DIAG(1, XN, DM, DM);
#pragma unroll 1
    for (int l = 0; l < DEPTH; ++l) {
        unsigned char* wl = ws + WS_W + (size_t)l * W_LAYER;
        const unsigned char* s5tab = ws + WS_S5 + (size_t)l * S5_LAYER;
        const float* xin = (l == 0) ? A_->in[0] : A_->out;

        { FRESH(); for (int bh = bid; bh < 64; bh += G) cum_scan(lds, LOGF, CUM, bh, tid, lane, w); }
        {
            pg8::Gemm g{XN, (const bf16_t*)(wl + W_INA), M, NA, DM, 0, 0}; pg8::StaticOrder S; S.init(M, NA, G, bid, 1);
            pg8::Epi<pg8::EPI_PROJ> E{PR, NA, nullptr, nullptr};
#if (PHMASK >> 0) & 1
            pg8::gemm_phase<pg8::Epi<pg8::EPI_PROJ>, pg8::StaticOrder, true, true>(lds, g, S, E);
#endif
        }
        grid_barrier(grid);

        DIAG(2, PR, NA, NA);
        if ((bid >> 3) & 1) {
        for (int v = bid; v < 256; v += G) {
            FRESH(); const int bh = v >> 2, s = v & 3;
#pragma unroll 1
            for (int k = 0; k < 4; ++k) { const int qb = (k == 0) ? 15 - s : (k == 1) ? s : (k == 2) ? 11 - s : s + 4;
                attn_unit(lds, PR, CUM, Y + 2 * (size_t)M * YW, bh >> 3, bh & 7, qb, tid, lane, w); }
        }
        { FRESH(); for (int v = bid; v < 256; v += G) s5_unit(lds, PR, s5tab, Y, v >> 5, v & 31, tid, lane, w); }
        } else {
        { FRESH(); for (int v = bid; v < 256; v += G) s5_unit(lds, PR, s5tab, Y, v >> 5, v & 31, tid, lane, w); }
        for (int v = bid; v < 256; v += G) {
            FRESH(); const int bh = v >> 2, s = v & 3;
#pragma unroll 1
            for (int k = 0; k < 4; ++k) { const int qb = (k == 0) ? 15 - s : (k == 1) ? s : (k == 2) ? 11 - s : s + 4;
                attn_unit(lds, PR, CUM, Y + 2 * (size_t)M * YW, bh >> 3, bh & 7, qb, tid, lane, w); }
        }
        }
        { FRESH(); conv_phase(PR, A_->in[13] + (size_t)l * 3 * 512, Y + (size_t)M * YW, bid * 512 + tid, G * 512); }
        grid_barrier(grid);

        if (DIAG_STAGE == 3) { grid_barrier(grid); for (size_t i = (size_t)blockIdx.x * 512 + threadIdx.x; i < (size_t)M * DM; i += (size_t)gridDim.x * 512) { const size_t row = i >> 10; const int c = (int)(i & 511); A_->out[i] = bf_lo((unsigned)Y[row * YW + c]) + bf_lo((unsigned)Y[(size_t)M * YW + row * YW + c]) + bf_lo((unsigned)Y[2 * (size_t)M * YW + row * YW + c]); } return; }
        DIAG(31, Y + (size_t)M * YW, YW, YW); DIAG(32, Y + 2 * (size_t)M * YW, YW, YW);
        {
            pg8::Gemm g{XN, (const bf16_t*)(wl + W_G), M, NG, DM, 0, 0}; pg8::StaticOrder S; S.init(M, NG, G, bid, 1);
            pg8::Epi<pg8::EPI_GATE> E{PR, NG, A_->in[3] + (size_t)l * NG, nullptr};
#if (PHMASK >> 1) & 1
            pg8::gemm_phase<pg8::Epi<pg8::EPI_GATE>, pg8::StaticOrder, true, true>(lds, g, S, E);
#endif
        }
        grid_barrier(grid);

        DIAG(4, PR, NG, NG);
        {
            pg8::Gemm g{Y, (const bf16_t*)(wl + W_BR), M, DM, 512, (size_t)M * YW * 2, (size_t)DM * 512 * 2}; pg8::StaticOrder S; S.init(M, DM, G, bid, 3);
            pg8::Epi<pg8::EPI_BRANCH> E{XN, DM, nullptr, PR};
#if (PHMASK >> 2) & 1
            pg8::gemm_phase<pg8::Epi<pg8::EPI_BRANCH>, pg8::StaticOrder, true, true>(lds, g, S, E);
#endif
        }
        grid_barrier(grid);

        DIAG(5, XN, DM, DM);
        {
            pg8::Gemm g{XN, (const bf16_t*)(wl + W_OUT), M, DM, DM, 0, 0}; pg8::StaticOrder S; S.init(M, DM, G, bid, 1);
            pg8::Epi<pg8::EPI_PLAIN> E{PR, DM, nullptr, nullptr};
#if (PHMASK >> 3) & 1
            pg8::gemm_phase<pg8::Epi<pg8::EPI_PLAIN>, pg8::StaticOrder, true, true>(lds, g, S, E);
#endif
        }
        grid_barrier(grid);

        DIAG(6, PR, DM, DM);
        {
            FRESH(); NormArgs n{xin, PR, A_->in[17] + (size_t)l * DM, A_->out, A_->in[18] + (size_t)l * DM, XN, nullptr, nullptr, nullptr};
            norm_phase(lds, n, gw, ngw, lane, tid);
        }
        grid_barrier(grid);

        DIAG(7, XN, DM, DM);
        {
            pg8::Gemm g{XN, (const bf16_t*)(wl + W_1), M, FF, DM, 0, 0}; pg8::StaticOrder S; S.init(M, FF, G, bid, 1);
            pg8::Epi<pg8::EPI_RELU2> E{PR, FF, nullptr, nullptr};
#if (PHMASK >> 4) & 1
            pg8::gemm_phase<pg8::Epi<pg8::EPI_RELU2>, pg8::StaticOrder, true, true>(lds, g, S, E);
#endif
        }
        grid_barrier(grid);

        DIAG(8, PR, FF, FF);
        {
            pg8::Gemm g{PR, (const bf16_t*)(wl + W_2), M, DM, FF, 0, 0}; pg8::StaticOrder S; S.init(M, DM, G, bid, 1);
            pg8::Epi<pg8::EPI_PLAIN> E{XN, DM, nullptr, nullptr};
#if (PHMASK >> 5) & 1
            pg8::gemm_phase<pg8::Epi<pg8::EPI_PLAIN>, pg8::StaticOrder, true, true>(lds, g, S, E);
#endif
        }
        grid_barrier(grid);

        DIAG(9, XN, DM, DM);
        if (l + 1 < DEPTH) {
            FRESH(); NormArgs n{A_->out, XN, A_->in[21] + (size_t)l * DM, A_->out, A_->in[1] + (size_t)(l + 1) * DM, XN, A_->in[2] + (size_t)(l + 1) * DM * INW + COL_F, A_->in[14] + (l + 1) * 8, LOGF};
            norm_phase(lds, n, gw, ngw, lane, tid);
            grid_barrier(grid);
        } else {
            FRESH(); NormArgs n{A_->out, XN, A_->in[21] + (size_t)l * DM, A_->out, nullptr, nullptr, nullptr, nullptr, nullptr};
            norm_phase(lds, n, gw, ngw, lane, tid);
        }
    }
}

extern "C" void kernel_launch(void* const* d_in, const int* in_sizes, int n_in, void* d_out, int out_size, void* d_ws, size_t ws_size, hipStream_t stream) {
    static int grid = 0;
    if (grid == 0) {
        if (n_in != 22 || in_sizes[0] != M * DM || out_size != M * DM || ws_size < WS_END) { fprintf(stderr, "kernel_launch: unexpected shapes (n_in %d, in0 %d, out %d, ws %zu)\n", n_in, n_in > 0 ? in_sizes[0] : -1, out_size, ws_size); grid = -1; return; }
        int dev = 0, cus = 0, per_cu = 0;
        (void)hipGetDevice(&dev);
        (void)hipDeviceGetAttribute(&cus, hipDeviceAttributeMultiprocessorCount, dev);
        if (hipFuncSetAttribute((const void*)fwd_kernel, hipFuncAttributeMaxDynamicSharedMemorySize, LDS_BYTES) != hipSuccess) fprintf(stderr, "kernel_launch: hipFuncSetAttribute failed\n");
        if (hipOccupancyMaxActiveBlocksPerMultiprocessor(&per_cu, (const void*)fwd_kernel, 512, LDS_BYTES) != hipSuccess || per_cu < 1) { fprintf(stderr, "kernel_launch: occupancy query gave %d\n", per_cu); per_cu = 1; }
        (void)hipGetLastError();
        grid = cus * per_cu; if (grid > 256) grid = 256; if (grid < 1) grid = 256;
    }
    if (grid < 0) return;
    (void)hipMemsetAsync(d_ws, 0, 65536, stream);
    Args a{};
    for (int i = 0; i < 22; ++i) a.in[i] = (const float*)d_in[i];
    a.out = (float*)d_out; a.ws = (unsigned char*)d_ws;
    void* args[] = {&a};
    hipError_t e = hipLaunchCooperativeKernel((const void*)fwd_kernel, dim3(grid), dim3(512), args, LDS_BYTES, stream);
    if (e != hipSuccess) fprintf(stderr, "kernel_launch: cooperative launch failed: %s (grid %d)\n", hipGetErrorString(e), grid);
}
```

```cpp
#include <hip/hip_runtime.h>
#include <hip/hip_cooperative_groups.h>
#include <cstdio>
#include <cstdint>
namespace cg = cooperative_groups;

#define DIAG_STAGE 0
#ifndef PHMASK
#define PHMASK 0xff
#endif

#define LAS __attribute__((address_space(3)))
typedef unsigned short bf16_t;
typedef short bf16x8 __attribute__((ext_vector_type(8)));
typedef short s16x4 __attribute__((ext_vector_type(4)));
typedef float f32x2 __attribute__((ext_vector_type(2)));
typedef float f32x4 __attribute__((ext_vector_type(4)));
typedef float f32x16 __attribute__((ext_vector_type(16)));
typedef unsigned u32x2 __attribute__((ext_vector_type(2)));
typedef unsigned u32x4 __attribute__((ext_vector_type(4)));

constexpr int BATCH = 8, SEQ = 4096, DM = 1024, M = BATCH * SEQ, DEPTH = 2;
constexpr int INW = 6664, NA = 3584, NG = 3072, FF = 4096, YW = 512;
constexpr int COL_XC = 512, COL_BC = 1024, COL_CC = 1536, COL_Q = 2048, COL_K = 2560, COL_V = 3072, COL_F = 3584, COL_G = 3592;
constexpr float EPS = 1e-6f;
constexpr float LOG2E = 1.4426950408889634f;
constexpr float C2 = 0.125f * LOG2E;

constexpr size_t MiB = 1u << 20;
constexpr size_t WS_W = 1 * MiB, W_LAYER = 34 * MiB;
constexpr size_t W_INA = 0, W_G = 7 * MiB, W_BR = 13 * MiB, W_OUT = 16 * MiB, W_1 = 18 * MiB, W_2 = 26 * MiB;
constexpr size_t WS_S5 = 69 * MiB, S5_LAYER = 17 * MiB + 512 * 1024;
constexpr size_t S5_KT = 0, S5_WE = MiB + 256 * 1024, S5_WC = S5_WE + 8 * MiB, S5_A64 = S5_WC + 8 * MiB, S5_GLU = S5_A64 + 64 * 1024;
constexpr size_t WS_LOGF = 104 * MiB, WS_CUM = 105 * MiB, WS_XN = 106 * MiB, WS_P = 170 * MiB, WS_Y = 394 * MiB, WS_END = 490 * MiB;
constexpr int KT_BYTES = 65 * 512;

constexpr int LDS_BYTES = 147456;

typedef __bf16 bf16x2_t __attribute__((ext_vector_type(2)));
__device__ __forceinline__ unsigned cvt_pk_bf16(float lo, float hi) { const f32x2 v = {lo, hi}; const bf16x2_t b = __builtin_convertvector(v, bf16x2_t); return __builtin_bit_cast(unsigned, b); }
__device__ __forceinline__ float bf_lo(unsigned u) { return __uint_as_float(u << 16); }
__device__ __forceinline__ float bf_hi(unsigned u) { return __uint_as_float(u & 0xffff0000u); }
template <int O> __device__ __forceinline__ float swz_xor(float v) { return __int_as_float(__builtin_amdgcn_ds_swizzle(__float_as_int(v), (O << 10) | 0x1f)); }
__device__ __forceinline__ float half_sum(float v) { auto rr = __builtin_amdgcn_permlane32_swap(__float_as_uint(v), __float_as_uint(v), false, false); return __uint_as_float(rr[0]) + __uint_as_float(rr[1]); }
__device__ __forceinline__ float half_max(float v) { auto rr = __builtin_amdgcn_permlane32_swap(__float_as_uint(v), __float_as_uint(v), false, false); return fmaxf(__uint_as_float(rr[0]), __uint_as_float(rr[1])); }
__device__ __forceinline__ float wave_sum(float v) {
    v += swz_xor<1>(v); v += swz_xor<2>(v); v += swz_xor<4>(v); v += swz_xor<8>(v); v += swz_xor<16>(v);
    return half_sum(v);
}
__device__ __forceinline__ int launder_i(int x) { asm volatile("" : "+v"(x)); return x; }
__device__ __forceinline__ float fast_exp2(float x) { return __builtin_amdgcn_exp2f(x); }
__device__ __forceinline__ float fast_rcp(float x) { return __builtin_amdgcn_rcpf(x); }
__device__ __forceinline__ float sigmoid_f(float z) { return fast_rcp(1.0f + fast_exp2(-LOG2E * z)); }
__device__ __forceinline__ float gelu_tanh(float y) { const float t = y + 0.044715f * y * y * y; return y * fast_rcp(1.0f + fast_exp2(-2.302208198f * t)); }

namespace pg8 {
#define PG8_LAS __attribute__((address_space(3)))
constexpr int BM = 256, BK = 64, HALF = 128, HTB = HALF * BK * 2, STAGE_BYTES = 8 * HTB, NXCD = 8, WGM = 8;

__host__ __device__ __forceinline__ int lds_byte(int r, int c) { const int st = (r >> 4) * 2 + (c >> 5), rr = r & 15, cc = c & 31, ob = rr * 64 + cc * 2; return st * 1024 + (ob ^ (((ob >> 9) & 1) << 5)); }
__host__ __device__ __forceinline__ void stage_rc(int b, int& R, int& C) { const int st = b / 1024, sb = b % 1024, swz = sb ^ (((sb >> 9) & 1) << 5); R = (st >> 1) * 16 + swz / 64; C = (st & 1) * 32 + (swz % 64) / 2; }
__host__ __device__ __forceinline__ int perm32(int rho) { const int n = rho >> 4, i = rho & 15; return 8 * (i >> 2) + 4 * n + (i & 3); }

struct Unit { int pm, pn, br; };
struct Gemm { const bf16_t* A; const bf16_t* Bt; int M, N, K; size_t abr, bbr; };

struct StaticOrder {
    int nM, nN, nwg, G, c, nbr;
    __device__ void init(int M_, int N_, int G_, int c_, int nbr_) { nM = M_ / BM; nN = N_ / BM; nwg = nM * nN; G = G_; c = c_; nbr = nbr_; }
    __device__ bool next(int i, Unit& u) const {
        const int it = i / nbr; u.br = i - it * nbr;
        const long L = (long)it * G + c; if (L >= nwg) return false;
        int wgid = (int)L; { const int q = nwg / NXCD, r = nwg % NXCD, xcd = wgid % NXCD, off = wgid / NXCD; wgid = (xcd < r ? xcd * (q + 1) : r * (q + 1) + (xcd - r) * q) + off; }
        const int nig = WGM * nN, gid = wgid / nig, fm = gid * WGM, gsz = (nM - fm) < WGM ? (nM - fm) : WGM;
        u.pm = fm + ((wgid % nig) % gsz); u.pn = (wgid % nig) / gsz; return true;
    }
};

enum { EPI_PROJ = 0, EPI_GATE = 1, EPI_RELU2 = 2, EPI_BRANCH = 3, EPI_PLAIN = 4 };
template <int MODE> struct Epi {
    static constexpr bool PERM = true;
    bf16_t* O; int ldc; const float* bias; const bf16_t* G;
    __device__ __forceinline__ void operator()(const f32x4 (&acc)[2][2][4][2], const Unit& u, int wr, int wc, int fr, int fq) const {
        const int row0 = u.pm * BM + wr * 64 + fr; const int col0 = u.pn * BM + wc * 32 + 8 * fq;
        float sc = 1.f; if (MODE == EPI_PROJ) { if (u.pn >= COL_Q / 256 && u.pn < COL_K / 256) sc = C2; }
        f32x4 bv[2][2];
        if (MODE == EPI_GATE) {
#pragma unroll
            for (int bj = 0; bj < 2; ++bj)
#pragma unroll
                for (int n = 0; n < 2; ++n) bv[bj][n] = *(const f32x4*)(bias + col0 + bj * HALF + 4 * n);
        }
        if (MODE == EPI_BRANCH) {
#pragma unroll
            for (int ai = 0; ai < 2; ++ai) {
                u32x2 gt[4][2]; u32x4 pv[4][2];
#pragma unroll
                for (int m = 0; m < 4; ++m)
#pragma unroll
                    for (int bj = 0; bj < 2; ++bj) {
                        const size_t row = (size_t)(row0 + ai * HALF + m * 16);
                        gt[m][bj] = *(const u32x2*)((const unsigned char*)G + row * NG + (size_t)u.br * DM + col0 + bj * HALF);
                        pv[m][bj] = (u.br > 0) ? *(const u32x4*)(O + row * ldc + col0 + bj * HALF) : (u32x4){0u, 0u, 0u, 0u};
                    }
                __builtin_amdgcn_sched_barrier(0);
#pragma unroll
                for (int m = 0; m < 4; ++m)
#pragma unroll
                    for (int bj = 0; bj < 2; ++bj) {
                        const size_t row = (size_t)(row0 + ai * HALF + m * 16);
                        f32x4 v0 = acc[ai][bj][m][0], v1 = acc[ai][bj][m][1];
                        const u32x2 g8 = gt[m][bj]; const u32x4 p4 = pv[m][bj];
                        v0 = v0 * (1.f / 255.f); v1 = v1 * (1.f / 255.f);
                        v0[0] = v0[0] * (float)(g8.x & 0xffu) + bf_lo(p4.x); v0[1] = v0[1] * (float)((g8.x >> 8) & 0xffu) + bf_hi(p4.x); v0[2] = v0[2] * (float)((g8.x >> 16) & 0xffu) + bf_lo(p4.y); v0[3] = v0[3] * (float)(g8.x >> 24) + bf_hi(p4.y);
                        v1[0] = v1[0] * (float)(g8.y & 0xffu) + bf_lo(p4.z); v1[1] = v1[1] * (float)((g8.y >> 8) & 0xffu) + bf_hi(p4.z); v1[2] = v1[2] * (float)((g8.y >> 16) & 0xffu) + bf_lo(p4.w); v1[3] = v1[3] * (float)(g8.y >> 24) + bf_hi(p4.w);
                        u32x4 wv; wv.x = cvt_pk_bf16(v0[0], v0[1]); wv.y = cvt_pk_bf16(v0[2], v0[3]); wv.z = cvt_pk_bf16(v1[0], v1[1]); wv.w = cvt_pk_bf16(v1[2], v1[3]);
                        *(u32x4*)(O + row * ldc + col0 + bj * HALF) = wv;
                    }
                __builtin_amdgcn_sched_barrier(0);
            }
            return;
        }
#pragma unroll
        for (int ai = 0; ai < 2; ++ai)
#pragma unroll
            for (int m = 0; m < 4; ++m) {
                const size_t row = (size_t)(row0 + ai * HALF + m * 16);
                bf16_t* rowp = O + row * ldc + col0;
#pragma unroll
                for (int bj = 0; bj < 2; ++bj) {
                    f32x4 v0 = acc[ai][bj][m][0], v1 = acc[ai][bj][m][1];
                    if (MODE == EPI_PROJ) { v0 = v0 * sc; v1 = v1 * sc; }
                    if (MODE == EPI_GATE) {
                        v0 = v0 + bv[bj][0]; v1 = v1 + bv[bj][1];
                        u32x2 w8; w8.x = 0u; w8.y = 0u;
#pragma unroll
                        for (int i = 0; i < 4; ++i) { w8.x |= (unsigned)(sigmoid_f(v0[i]) * 255.f + 0.5f) << (8 * i); w8.y |= (unsigned)(sigmoid_f(v1[i]) * 255.f + 0.5f) << (8 * i); }
                        *(u32x2*)((unsigned char*)O + row * ldc + col0 + bj * HALF) = w8;
                        continue;
                    }
                    if (MODE == EPI_RELU2) {
#pragma unroll
                        for (int i = 0; i < 4; ++i) { const float a = fmaxf(v0[i], 0.f), b = fmaxf(v1[i], 0.f); v0[i] = a * a; v1[i] = b * b; }
                    }
                    if (MODE == EPI_BRANCH) {
                        const u32x4 gt = *(const u32x4*)(G + row * NG + (size_t)u.br * DM + col0 + bj * HALF);
                        v0[0] *= bf_lo(gt.x); v0[1] *= bf_hi(gt.x); v0[2] *= bf_lo(gt.y); v0[3] *= bf_hi(gt.y);
                        v1[0] *= bf_lo(gt.z); v1[1] *= bf_hi(gt.z); v1[2] *= bf_lo(gt.w); v1[3] *= bf_hi(gt.w);
                        if (u.br > 0) {
                            const u32x4 pv = *(const u32x4*)(rowp + bj * HALF);
                            v0[0] += bf_lo(pv.x); v0[1] += bf_hi(pv.x); v0[2] += bf_lo(pv.y); v0[3] += bf_hi(pv.y);
                            v1[0] += bf_lo(pv.z); v1[1] += bf_hi(pv.z); v1[2] += bf_lo(pv.w); v1[3] += bf_hi(pv.w);
                        }
                    }
                    u32x4 w; w.x = cvt_pk_bf16(v0[0], v0[1]); w.y = cvt_pk_bf16(v0[2], v0[3]); w.z = cvt_pk_bf16(v1[0], v1[1]); w.w = cvt_pk_bf16(v1[2], v1[3]);
                    *(u32x4*)(rowp + bj * HALF) = w;
                }
            }
    }
};

template <class EpiT, class Sched, bool ALIGN_EPI, bool SP2>
__device__ __forceinline__ void gemm_phase(PG8_LAS unsigned char* lds, const Gemm g, const Sched& S, const EpiT& E) {
    const int tid = launder_i(threadIdx.x), wid = __builtin_amdgcn_readfirstlane(tid >> 6), lane = tid & 63, wr = wid >> 2, wc = wid & 3, fr = lane & 15, fq = lane >> 4;
    const int K = g.K, nt = K / BK;
    unsigned voffA[2], voffB[2];
#pragma unroll
    for (int i = 0; i < 2; ++i) { int R, C; stage_rc(tid * 16 + i * 8192, R, C); const int Rb = EpiT::PERM ? ((R & ~31) + perm32(R & 31)) : R;
        voffA[i] = (unsigned)(R * K + C) * 2u; voffB[i] = (unsigned)(Rb * K + C) * 2u; }
    const size_t kstep = (size_t)(BK * 2);
    const size_t hstep = (size_t)HALF * K * 2;
    const size_t tstep = 2 * hstep;
    const unsigned ldsw = (unsigned)wid * 1024u;
    const int aoff = lds_byte(wr * 64 + fr, fq * 8), boff = lds_byte(wc * 32 + fr, fq * 8);
#define PG8_SA(b, h) (((b) * 2 + (h)) * HTB)
#define PG8_SB(b, h) ((4 + (b) * 2 + (h)) * HTB)
#define PG8_STAGE(bufoff, gbase, voff) do { _Pragma("unroll") for (int _i = 0; _i < 2; ++_i) \
        __builtin_amdgcn_global_load_lds((const unsigned*)((const char*)(gbase) + (voff)[_i]), (PG8_LAS unsigned*)(lds + (bufoff) + ldsw + _i * 8192), 16, 0, 0); } while (0)
#define PG8_LDA(dst, b, h) do { _Pragma("unroll") for (int m = 0; m < 4; ++m) _Pragma("unroll") for (int k = 0; k < 2; ++k) dst[m][k] = *(const PG8_LAS bf16x8*)(lds + PG8_SA(b, h) + aoff + m * 2048 + k * 1024); } while (0)
#define PG8_LDB(dst, b, h) do { _Pragma("unroll") for (int n = 0; n < 2; ++n) _Pragma("unroll") for (int k = 0; k < 2; ++k) dst[n][k] = *(const PG8_LAS bf16x8*)(lds + PG8_SB(b, h) + boff + n * 2048 + k * 1024); } while (0)
#define PG8_MMA(ai, bj, At, Bt) do { __builtin_amdgcn_s_setprio(1); _Pragma("unroll") for (int m = 0; m < 4; ++m) _Pragma("unroll") for (int n = 0; n < 2; ++n) _Pragma("unroll") for (int k = 0; k < 2; ++k) \
        acc[ai][bj][m][n] = __builtin_amdgcn_mfma_f32_16x16x32_bf16(Bt[n][k], At[m][k], acc[ai][bj][m][n], 0, 0, 0); __builtin_amdgcn_s_setprio(0); } while (0)
#define PG8_WAIT_V(n) asm volatile("s_waitcnt vmcnt(" #n ")" ::: "memory")
#define PG8_WAIT_L(n) asm volatile("s_waitcnt lgkmcnt(" #n ")" ::: "memory")
#define PG8_BAR __builtin_amdgcn_s_barrier()
#define PG8_SCHED __builtin_amdgcn_sched_barrier(0)
    Unit cur, nxt; int ui = 0;
    if (!S.next(0, cur)) return;
    f32x4 acc[2][2][4][2];
#pragma unroll
    for (int a = 0; a < 2; ++a)
#pragma unroll
        for (int b = 0; b < 2; ++b)
#pragma unroll
            for (int m = 0; m < 4; ++m)
#pragma unroll
                for (int n = 0; n < 2; ++n) acc[a][b][m][n] = (f32x4){0.f, 0.f, 0.f, 0.f};
    bf16x8 At[4][2], B0[2][2], B1[2][2];
    const char* cA = (const char*)g.A + (size_t)cur.pm * tstep + (size_t)cur.br * g.abr; const char* cB = (const char*)g.Bt + (size_t)cur.pn * tstep + (size_t)cur.br * g.bbr;
    if constexpr (SP2) {
        PG8_STAGE(PG8_SB(0, 0), cB, voffB); PG8_STAGE(PG8_SB(0, 1), cB + hstep, voffB); PG8_STAGE(PG8_SA(0, 0), cA, voffA); PG8_STAGE(PG8_SA(0, 1), cA + hstep, voffA);
        if (wr == 1) PG8_BAR;
        PG8_WAIT_V(2); PG8_BAR;
        PG8_STAGE(PG8_SB(1, 0), cB + kstep, voffB); PG8_STAGE(PG8_SA(1, 0), cA + kstep, voffA); PG8_STAGE(PG8_SB(1, 1), cB + hstep + kstep, voffB);
        PG8_WAIT_V(6); PG8_BAR;
    } else {
        PG8_STAGE(PG8_SB(0, 0), cB, voffB); PG8_STAGE(PG8_SA(0, 0), cA, voffA); PG8_STAGE(PG8_SB(0, 1), cB + hstep, voffB); PG8_STAGE(PG8_SA(0, 1), cA + hstep, voffA);
        if (wr == 1) PG8_BAR;
        PG8_WAIT_V(4); PG8_BAR;
        PG8_STAGE(PG8_SB(1, 0), cB + kstep, voffB); PG8_STAGE(PG8_SA(1, 0), cA + kstep, voffA); PG8_STAGE(PG8_SB(1, 1), cB + hstep + kstep, voffB);
        PG8_WAIT_V(6); PG8_BAR;
    }
    for (;;) {
        const bool has_next = S.next(ui + 1, nxt);
        const char* nA = has_next ? (const char*)g.A + (size_t)nxt.pm * tstep + (size_t)nxt.br * g.abr : cA;
        const char* nB = has_next ? (const char*)g.Bt + (size_t)nxt.pn * tstep + (size_t)nxt.br * g.bbr : cB;
        for (int t = 0; t < nt; t += 2) {
            const bool last = (t == nt - 2);
            const char* a1 = cA + (size_t)(t + 1) * kstep;
            const char* a2 = last ? nA : cA + (size_t)(t + 2) * kstep; const char* b2 = last ? nB : cB + (size_t)(t + 2) * kstep;
            const char* a3 = a2 + kstep; const char* b3 = b2 + kstep;
            if constexpr (SP2) {
            PG8_LDB(B0, 0, 0); PG8_LDB(B1, 0, 1); PG8_SCHED; PG8_LDA(At, 0, 0); PG8_STAGE(PG8_SA(1, 1), a1 + hstep, voffA);
            PG8_WAIT_V(8); PG8_WAIT_L(0); PG8_BAR; PG8_MMA(0, 0, At, B0); PG8_MMA(0, 1, At, B1); PG8_BAR; PG8_SCHED;
            PG8_LDA(At, 0, 1); PG8_STAGE(PG8_SB(0, 0), b2, voffB); PG8_STAGE(PG8_SB(0, 1), b2 + hstep, voffB); PG8_STAGE(PG8_SA(0, 0), a2, voffA);
            PG8_WAIT_V(8); PG8_WAIT_L(0); PG8_BAR; PG8_MMA(1, 0, At, B0); PG8_MMA(1, 1, At, B1); PG8_BAR; PG8_SCHED;
            PG8_LDB(B0, 1, 0); PG8_LDB(B1, 1, 1); PG8_SCHED; PG8_LDA(At, 1, 0); PG8_STAGE(PG8_SA(0, 1), a2 + hstep, voffA);
            PG8_WAIT_V(8); PG8_WAIT_L(0); PG8_BAR; PG8_MMA(0, 0, At, B0); PG8_MMA(0, 1, At, B1); PG8_BAR; PG8_SCHED;
            PG8_LDA(At, 1, 1); PG8_STAGE(PG8_SB(1, 0), b3, voffB); PG8_STAGE(PG8_SB(1, 1), b3 + hstep, voffB); PG8_STAGE(PG8_SA(1, 0), a3, voffA);
            PG8_WAIT_V(8); PG8_WAIT_L(0); PG8_BAR; PG8_MMA(1, 0, At, B0); PG8_MMA(1, 1, At, B1); PG8_BAR; PG8_SCHED;
            } else {
            PG8_LDB(B0, 0, 0); PG8_SCHED; PG8_LDA(At, 0, 0); PG8_STAGE(PG8_SA(1, 1), a1 + hstep, voffA);
            PG8_WAIT_L(8); PG8_BAR; PG8_WAIT_L(0); PG8_MMA(0, 0, At, B0); PG8_BAR; PG8_SCHED;
            PG8_LDB(B1, 0, 1); PG8_STAGE(PG8_SB(0, 0), b2, voffB);
            PG8_BAR; PG8_WAIT_L(0); PG8_MMA(0, 1, At, B1); PG8_BAR;
            PG8_LDA(At, 0, 1); PG8_STAGE(PG8_SA(0, 0), a2, voffA);
            PG8_BAR; PG8_WAIT_L(0); PG8_MMA(1, 0, At, B0); PG8_BAR; PG8_SCHED;
            PG8_STAGE(PG8_SB(0, 1), b2 + hstep, voffB);
            PG8_WAIT_V(6); PG8_BAR; PG8_MMA(1, 1, At, B1); PG8_BAR;
            PG8_LDB(B0, 1, 0); PG8_SCHED; PG8_LDA(At, 1, 0); PG8_STAGE(PG8_SA(0, 1), a2 + hstep, voffA);
            PG8_WAIT_L(8); PG8_BAR; PG8_WAIT_L(0); PG8_MMA(0, 0, At, B0); PG8_BAR; PG8_SCHED;
            PG8_LDB(B1, 1, 1); PG8_STAGE(PG8_SB(1, 0), b3, voffB);
            PG8_BAR; PG8_WAIT_L(0); PG8_MMA(0, 1, At, B1); PG8_BAR;
            PG8_LDA(At, 1, 1); PG8_STAGE(PG8_SA(1, 0), a3, voffA);
            PG8_BAR; PG8_WAIT_L(0); PG8_MMA(1, 0, At, B0); PG8_BAR; PG8_SCHED;
            PG8_STAGE(PG8_SB(1, 1), b3 + hstep, voffB);
            PG8_WAIT_V(6); PG8_BAR; PG8_MMA(1, 1, At, B1); PG8_BAR;
            }
        }
        if constexpr (ALIGN_EPI) { if (wr == 0) PG8_BAR; }
        E(acc, cur, wr, wc, fr, fq);
        if (!has_next) break;
#pragma unroll
        for (int a = 0; a < 2; ++a)
#pragma unroll
            for (int b = 0; b < 2; ++b)
#pragma unroll
                for (int m = 0; m < 4; ++m)
#pragma unroll
                    for (int n = 0; n < 2; ++n) acc[a][b][m][n] = (f32x4){0.f, 0.f, 0.f, 0.f};
        cur = nxt; cA = nA; cB = nB; ++ui;
        if constexpr (ALIGN_EPI) { if (wr == 1) PG8_BAR; }
    }
    PG8_WAIT_V(0);
    if constexpr (!ALIGN_EPI) { if (wr == 0) PG8_BAR; }
    PG8_BAR;
#undef PG8_SA
#undef PG8_SB
#undef PG8_STAGE
#undef PG8_LDA
#undef PG8_LDB
#undef PG8_MMA
#undef PG8_WAIT_V
#undef PG8_WAIT_L
#undef PG8_BAR
#undef PG8_SCHED
}
}

struct Args { const float* in[22]; float* out; unsigned char* ws; };

__device__ __forceinline__ void transpose_item(const float* W, int ldw, int col_off, int K, int N, bf16_t* WT, LAS float* scr, int item, int lane) {
    const int nblk = N / 64, kb = item / nblk, nb = item % nblk, k0 = 64 * kb, n0 = 64 * nb;
    const int r = lane >> 4, c4 = lane & 15;
    f32x4 v[16];
#pragma unroll
    for (int i = 0; i < 16; ++i) v[i] = *(const f32x4*)(W + (size_t)(k0 + 4 * i + r) * ldw + col_off + n0 + 4 * c4);
#pragma unroll
    for (int i = 0; i < 16; ++i) { LAS float* d = scr + (4 * i + r) * 65 + 4 * c4; d[0] = v[i].x; d[1] = v[i].y; d[2] = v[i].z; d[3] = v[i].w; }
    asm volatile("s_waitcnt lgkmcnt(0)" ::: "memory");
    const int c = lane & 7;
#pragma unroll
    for (int j = 0; j < 8; ++j) { const int n = (lane >> 3) + 8 * j; const LAS float* s = scr + (8 * c) * 65 + n;
        u32x4 o; o.x = cvt_pk_bf16(s[0 * 65], s[1 * 65]); o.y = cvt_pk_bf16(s[2 * 65], s[3 * 65]); o.z = cvt_pk_bf16(s[4 * 65], s[5 * 65]); o.w = cvt_pk_bf16(s[6 * 65], s[7 * 65]);
        *(u32x4*)(WT + (size_t)(n0 + n) * K + k0 + 8 * c) = o; }
    asm volatile("s_waitcnt lgkmcnt(0)" ::: "memory");
}

__device__ __forceinline__ void s5_tables(LAS unsigned char* lds, const Args& a, int l, int g, int qt, int tid) {
    LAS f32x2* AP = (LAS f32x2*)lds;
    LAS f32x2* BB = AP + 65 * 64;
    LAS f32x2* CC = BB + 64 * 16;
    const int lg = l * 32 + g;
    const float* are = a.in[4] + lg * 64; const float* aim = a.in[5] + lg * 64;
    const float dt = expf(a.in[6][lg]);
    unsigned char* tab = a.ws + WS_S5 + (size_t)l * S5_LAYER;
    for (int idx = tid; idx < 65 * 64; idx += 512) {
        const int d = idx >> 6, p = idx & 63;
        const float lr = fminf(are[p], -1e-4f), li = aim[p];
        const float mag = expf(lr * dt * (float)d);
        double rev = (double)li * (double)dt * (double)d * 0.15915494309189535;
        rev -= floor(rev); if (rev > 0.5) rev -= 1.0;
        const float th = (float)(rev * 6.283185307179586);
        AP[idx] = (f32x2){mag * cosf(th), mag * sinf(th)};
    }
    for (int idx = tid; idx < 1024; idx += 512) CC[idx] = (f32x2){a.in[9][(size_t)lg * 1024 + idx], a.in[10][(size_t)lg * 1024 + idx]};
    for (int idx = tid; idx < 1024; idx += 512) {
        const int p = idx >> 4;
        const float lr = fminf(are[p], -1e-4f), li = aim[p];
        double rev = (double)li * (double)dt * 0.15915494309189535;
        rev -= floor(rev); if (rev > 0.5) rev -= 1.0;
        const float th = (float)(rev * 6.283185307179586);
        const float em1 = expm1f(lr * dt), c = cosf(th), s = sinf(th), sh = sinf(0.5f * th);
        const float nr = em1 * c - 2.f * sh * sh, ni = (1.f + em1) * s;
        const float den = 1.f / (lr * lr + li * li);
        const float qr = (nr * lr + ni * li) * den, qi = (ni * lr - nr * li) * den;
        const float br = a.in[7][(size_t)lg * 1024 + idx], bi = a.in[8][(size_t)lg * 1024 + idx];
        BB[idx] = (f32x2){qr * br - qi * bi, qr * bi + qi * br};
    }
    __syncthreads();
    bf16_t* kt = (bf16_t*)(tab + S5_KT) + (size_t)g * (65 * 256);
    if (tid < 256) { const int s = qt * 256 + tid;
        const int d = s >> 4, h = s & 15;
        float acc[16];
#pragma unroll
        for (int i = 0; i < 16; ++i) acc[i] = 0.f;
        for (int p = 0; p < 64; ++p) {
            const f32x2 cc = CC[h * 64 + p], ap = AP[d * 64 + p];
            const float cr = cc.x * ap.x - cc.y * ap.y, ci = cc.x * ap.y + cc.y * ap.x;
#pragma unroll
            for (int i = 0; i < 16; ++i) { const f32x2 bb = BB[p * 16 + i]; acc[i] += cr * bb.x - ci * bb.y; }
        }
        if (d == 0) { const float dsk = a.in[11][lg * 16 + h];
#pragma unroll
            for (int i = 0; i < 16; ++i) if (i == h) acc[i] += dsk; }
        u32x4 o0, o1;
        o0.x = cvt_pk_bf16(acc[0], acc[1]); o0.y = cvt_pk_bf16(acc[2], acc[3]); o0.z = cvt_pk_bf16(acc[4], acc[5]); o0.w = cvt_pk_bf16(acc[6], acc[7]);
        o1.x = cvt_pk_bf16(acc[8], acc[9]); o1.y = cvt_pk_bf16(acc[10], acc[11]); o1.z = cvt_pk_bf16(acc[12], acc[13]); o1.w = cvt_pk_bf16(acc[14], acc[15]);
        bf16_t* dst = kt + (size_t)(63 - d) * 256 + h * 8;
        *(u32x4*)dst = o0; *(u32x4*)(dst + 128) = o1;
    }
    if (qt == 0 && tid >= 256 && tid < 288) ((u32x4*)(kt + 64 * 256))[tid - 256] = (u32x4){0u, 0u, 0u, 0u};
    bf16_t* we = (bf16_t*)(tab + S5_WE) + (size_t)g * 128 * 1024;
    for (int idx = qt * 4096 + tid; idx < (qt + 1) * 4096; idx += 512) {
        const int half = idx & 1, j = (idx >> 1) & 63, row = idx >> 7, p = row & 63, im = row >> 6;
        const f32x2 ap = AP[(63 - j) * 64 + p];
        float v[8];
#pragma unroll
        for (int i = 0; i < 8; ++i) { const f32x2 bb = BB[p * 16 + 8 * half + i]; v[i] = im ? (ap.x * bb.y + ap.y * bb.x) : (ap.x * bb.x - ap.y * bb.y); }
        u32x4 o; o.x = cvt_pk_bf16(v[0], v[1]); o.y = cvt_pk_bf16(v[2], v[3]); o.z = cvt_pk_bf16(v[4], v[5]); o.w = cvt_pk_bf16(v[6], v[7]);
        *(u32x4*)(we + (size_t)row * 1024 + j * 16 + 8 * half) = o;
    }
    bf16_t* wc = (bf16_t*)(tab + S5_WC) + (size_t)g * 1024 * 128;
    for (int idx = qt * 4096 + tid; idx < (qt + 1) * 4096; idx += 512) {
        const int kgp = idx & 15, rowi = idx >> 4, t = rowi >> 4, h = rowi & 15, im = kgp >> 3, p0 = (kgp & 7) * 8;
        float v[8];
#pragma unroll
        for (int i = 0; i < 8; ++i) { const f32x2 cc = CC[h * 64 + p0 + i], ap = AP[(t + 1) * 64 + p0 + i];
            v[i] = im ? -(cc.x * ap.y + cc.y * ap.x) : (cc.x * ap.x - cc.y * ap.y); }
        u32x4 o; o.x = cvt_pk_bf16(v[0], v[1]); o.y = cvt_pk_bf16(v[2], v[3]); o.z = cvt_pk_bf16(v[4], v[5]); o.w = cvt_pk_bf16(v[6], v[7]);
        *(u32x4*)(wc + (size_t)rowi * 128 + kgp * 8) = o;
    }
    if (qt == 1 && tid < 64) {
        ((f32x2*)(tab + S5_A64))[g * 64 + tid] = AP[64 * 64 + tid];
        const int k = tid & 15, kg = tid >> 4; const float* wg = a.in[12] + (size_t)lg * 256;
        u32x4 o; o.x = cvt_pk_bf16(wg[(4 * kg + 0) * 16 + k], wg[(4 * kg + 1) * 16 + k]); o.y = cvt_pk_bf16(wg[(4 * kg + 2) * 16 + k], wg[(4 * kg + 3) * 16 + k]); o.z = 0u; o.w = 0u;
        ((u32x4*)(tab + S5_GLU))[g * 64 + tid] = o;
    }
    __syncthreads();
}

struct NormArgs { const float* resid; const bf16_t* add; const float* g_add; float* xout; const float* g_xn; bf16_t* xn; const float* wf; const float* bfh; float* logf; };
__device__ __forceinline__ void norm_phase(LAS unsigned char* lds, const NormArgs n, int gw, int ngw, int lane, int tid) {
    if (n.wf) {
        for (int i = tid; i < 2048; i += 512) { const int d = i >> 1, hh = i & 1; const f32x4 v = *(const f32x4*)(n.wf + (size_t)d * INW + 4 * hh);
            const int k = 4 * (d >> 8) + (d & 3), ln = (d >> 2) & 63;
            *(LAS f32x4*)(lds + ((k * 2 + hh) * 64 + ln) * 16) = v; }
        __syncthreads();
    }
    f32x4 ga[4], gx[4];
#pragma unroll
    for (int j = 0; j < 4; ++j) { ga[j] = n.add ? *(const f32x4*)(n.g_add + 4 * lane + 256 * j) : (f32x4){0.f, 0.f, 0.f, 0.f}; gx[j] = n.xn ? *(const f32x4*)(n.g_xn + 4 * lane + 256 * j) : (f32x4){0.f, 0.f, 0.f, 0.f}; }
    for (int rbase = gw; rbase < M; rbase += 2 * ngw) {
        f32x4 v[2][4]; f32x4 av[2][4];
#pragma unroll
        for (int rr = 0; rr < 2; ++rr) { const size_t row = (size_t)rbase + (size_t)rr * ngw;
#pragma unroll
            for (int j = 0; j < 4; ++j) v[rr][j] = *(const f32x4*)(n.resid + row * DM + 4 * lane + 256 * j);
            if (n.add) {
#pragma unroll
                for (int j = 0; j < 4; ++j) { const u32x2 u = *(const u32x2*)(n.add + row * DM + 4 * lane + 256 * j); av[rr][j] = (f32x4){bf_lo(u.x), bf_hi(u.x), bf_lo(u.y), bf_hi(u.y)}; }
            }
        }
#pragma unroll
        for (int rr = 0; rr < 2; ++rr) { const size_t row = (size_t)rbase + (size_t)rr * ngw;
            if (n.add) {
                float ss = 0.f;
#pragma unroll
                for (int j = 0; j < 4; ++j) ss += (av[rr][j].x * av[rr][j].x + av[rr][j].y * av[rr][j].y) + (av[rr][j].z * av[rr][j].z + av[rr][j].w * av[rr][j].w);
                const float rs = rsqrtf(wave_sum(ss) * (1.f / DM) + EPS);
#pragma unroll
                for (int j = 0; j < 4; ++j) v[rr][j] = v[rr][j] + av[rr][j] * rs * ga[j];
            }
            if (n.xout) {
#pragma unroll
                for (int j = 0; j < 4; ++j) *(f32x4*)(n.xout + row * DM + 4 * lane + 256 * j) = v[rr][j];
            }
            if (n.xn) {
                float ss = 0.f;
#pragma unroll
                for (int j = 0; j < 4; ++j) ss += (v[rr][j].x * v[rr][j].x + v[rr][j].y * v[rr][j].y) + (v[rr][j].z * v[rr][j].z + v[rr][j].w * v[rr][j].w);
                const float rs = rsqrtf(wave_sum(ss) * (1.f / DM) + EPS);
                f32x4 hn[4];
#pragma unroll
                for (int j = 0; j < 4; ++j) { hn[j] = v[rr][j] * rs * gx[j]; u32x2 o; o.x = cvt_pk_bf16(hn[j].x, hn[j].y); o.y = cvt_pk_bf16(hn[j].z, hn[j].w);
                    *(u32x2*)(n.xn + row * DM + 4 * lane + 256 * j) = o; }
                if (n.wf) {
                    f32x4 f0 = (f32x4){0.f, 0.f, 0.f, 0.f}, f1 = f0;
#pragma unroll
                    for (int j = 0; j < 4; ++j)
#pragma unroll
                        for (int i = 0; i < 4; ++i) { const LAS unsigned char* wp = lds + (((4 * j + i) * 2) * 64 + lane) * 16;
                            const f32x4 w0 = *(const LAS f32x4*)wp, w1 = *(const LAS f32x4*)(wp + 1024); f0 = f0 + w0 * hn[j][i]; f1 = f1 + w1 * hn[j][i]; }
                    float z = 0.f;
#pragma unroll
                    for (int hh = 0; hh < 4; ++hh) { const float s0 = wave_sum(f0[hh]), s1 = wave_sum(f1[hh]); if (lane == hh) z = s0; if (lane == hh + 4) z = s1; }
                    if (lane < 8) { z += n.bfh[lane]; n.logf[row * 8 + lane] = fminf(z, 0.f) - log1pf(expf(-fabsf(z))); }
                }
            }
        }
    }
}

__device__ __forceinline__ void cum_scan(LAS unsigned char* lds, const float* logf, float* cum, int bh, int tid, int lane, int w) {
    LAS float* ws = (LAS float*)lds;
    const int b = bh >> 3, h = bh & 7;
    float v[8]; float run = 0.f;
#pragma unroll
    for (int i = 0; i < 8; ++i) { run += logf[((size_t)b * SEQ + 8 * tid + i) * 8 + h]; v[i] = run; }
    float inc = run;
#pragma unroll
    for (int o = 1; o < 64; o <<= 1) { const float t = __int_as_float(__builtin_amdgcn_ds_bpermute((lane - o) << 2, __float_as_int(inc))); if (lane >= o) inc += t; }
    if (lane == 63) ws[w] = inc;
    __syncthreads();
    float base = inc - run;
    for (int i = 0; i < w; ++i) base += ws[i];
#pragma unroll
    for (int i = 0; i < 8; ++i) cum[(size_t)bh * SEQ + 8 * tid + i] = (base + v[i]) * LOG2E;
    __syncthreads();
}

#define MFMA16(a, b, c) __builtin_amdgcn_mfma_f32_16x16x32_bf16((a), (b), (c), 0, 0, 0)
#define MFMA32(a, b, c) __builtin_amdgcn_mfma_f32_32x32x16_bf16((a), (b), (c), 0, 0, 0)
__device__ __forceinline__ bf16x8 ldg16(const void* ubase, unsigned off) { return *(const bf16x8*)((const char*)ubase + off); }
__device__ __forceinline__ void s5_unit(LAS unsigned char* lds, const bf16_t* P, const unsigned char* tab, bf16_t* Ya, const int b, const int g, int tid, int lane, int w) {
    LAS unsigned char* KT = lds; LAS float* EL = (LAS float*)(lds + 33280); LAS unsigned char* SPT = lds + 66560;
    const unsigned char* ktab = tab + S5_KT + (size_t)g * KT_BYTES;
    const int n = lane & 15, kg = lane >> 4, ntile = w & 3, wh = w >> 2;
    const bf16_t* WEu = (const bf16_t*)(tab + S5_WE) + (size_t)g * 128 * 1024 + (size_t)(64 * wh) * 1024;
    const bf16_t* WCu = (const bf16_t*)(tab + S5_WC) + (size_t)g * 1024 * 128 + (size_t)(wh * 16) * 128;
    const bf16_t* Uu = P + ((size_t)b * SEQ + (size_t)(16 * ntile) * 64) * NA + 16 * g;
    const unsigned uoff = (unsigned)((n * 64 + (kg >> 1)) * NA + 8 * (kg & 1)) * 2u;
    const unsigned weoff = (unsigned)(n * 1024 + 8 * kg) * 2u;
    const unsigned wcoff = (unsigned)(n * 128 + 8 * kg) * 2u;
    for (int i = tid; i < KT_BYTES / 16; i += 512) *(LAS u32x4*)(KT + i * 16) = *(const u32x4*)(ktab + i * 16);
    {
        f32x4 e[4];
#pragma unroll
        for (int mt = 0; mt < 4; ++mt) e[mt] = (f32x4){0.f, 0.f, 0.f, 0.f};
        bf16x8 eb[4], ea[4][4];
#define S5_ELD(ks) do { eb[(ks) & 3] = ldg16(Uu + (size_t)(2 * (ks)) * NA, uoff); _Pragma("unroll") for (int _m = 0; _m < 4; ++_m) ea[(ks) & 3][_m] = ldg16(WEu + (size_t)(16 * _m) * 1024 + 32 * (ks), weoff); } while (0)
        S5_ELD(0); S5_ELD(1); S5_ELD(2);
        __builtin_amdgcn_sched_barrier(0);
#pragma unroll
        for (int ks = 0; ks < 32; ++ks) {
            if (ks + 3 < 32) S5_ELD(ks + 3);
#pragma unroll
            for (int mt = 0; mt < 4; ++mt) e[mt] = MFMA16(ea[ks & 3][mt], eb[ks & 3], e[mt]);
            __builtin_amdgcn_sched_barrier(0);
        }
#undef S5_ELD
#pragma unroll
        for (int mt = 0; mt < 4; ++mt)
#pragma unroll
            for (int i = 0; i < 4; ++i) EL[(64 * wh + 16 * mt + 4 * kg + i) * 65 + 16 * ntile + n] = e[mt][i];
    }
    __syncthreads();
    {
        const int p = tid & 63, seg = tid >> 6;
        const f32x2 a1 = ((const f32x2*)(tab + S5_A64))[g * 64 + p];
        float lr[8], li[8]; float sr = 0.f, si = 0.f;
#pragma unroll
        for (int j = 0; j < 8; ++j) { const float er = EL[p * 65 + 8 * seg + j], ei = EL[(64 + p) * 65 + 8 * seg + j];
            const float nr = a1.x * sr - a1.y * si + er, ni = a1.x * si + a1.y * sr + ei; sr = nr; si = ni; lr[j] = sr; li[j] = si; }
        LAS f32x2* TT = (LAS f32x2*)(lds + 66560 + 17408);
        TT[seg * 64 + p] = (f32x2){sr, si};
        f32x2 a2 = {a1.x * a1.x - a1.y * a1.y, 2.f * a1.x * a1.y}; f32x2 a4 = {a2.x * a2.x - a2.y * a2.y, 2.f * a2.x * a2.y}; const f32x2 a8 = {a4.x * a4.x - a4.y * a4.y, 2.f * a4.x * a4.y};
        __syncthreads();
        float cr = 0.f, ci = 0.f;
        for (int s2 = 0; s2 < seg; ++s2) { const f32x2 t = TT[s2 * 64 + p]; const float nr = a8.x * cr - a8.y * ci + t.x, ni = a8.x * ci + a8.y * cr + t.y; cr = nr; ci = ni; }
        float pr = cr, pi = ci, wr_ = cr, wi_ = ci;
#pragma unroll
        for (int j = 0; j < 8; ++j) {
            *(LAS bf16_t*)(SPT + (8 * seg + j) * 272 + 2 * p) = (bf16_t)(cvt_pk_bf16(pr, 0.f) & 0xffffu);
            *(LAS bf16_t*)(SPT + (8 * seg + j) * 272 + 2 * (64 + p)) = (bf16_t)(cvt_pk_bf16(pi, 0.f) & 0xffffu);
            const float nr = a1.x * wr_ - a1.y * wi_, ni = a1.x * wi_ + a1.y * wr_; wr_ = nr; wi_ = ni;
            pr = lr[j] + wr_; pi = li[j] + wi_;
        }
    }
    __syncthreads();
    const LAS unsigned char* klow = KT + (1 - wh + (lane >> 5)) * 512 + ((lane >> 4) & 1) * 256 + (lane & 15) * 16;
    const LAS unsigned char* spb = SPT + (16 * ntile + n) * 272 + 16 * kg;
    const bf16x8 aglu = *(const bf16x8*)(tab + S5_GLU + (size_t)(g * 64 + lane) * 16);
    const unsigned yoff = (unsigned)(n * 64 * YW + 4 * kg) * 2u;
#pragma unroll 1
    for (int pass = 0; pass < 2; ++pass) {
        f32x4 acc[16];
#pragma unroll
        for (int i = 0; i < 16; ++i) acc[i] = (f32x4){0.f, 0.f, 0.f, 0.f};
        bf16x8 bq[4], ca[2][4], bt[8], bu[8];
        const bf16_t* Up = Uu + (size_t)(32 * pass) * NA;
        const bf16_t* WCp = WCu + (size_t)(32 * pass) * 2048;
#define S5_LDC(st, slot) do { _Pragma("unroll") for (int _q = 0; _q < 4; ++_q) ca[slot][_q] = ldg16(WCp + (size_t)(2 * (4 * ((st) & 3) + _q)) * 2048 + 32 * ((st) >> 2), wcoff); } while (0)
#pragma unroll
        for (int jj = 0; jj < 8; ++jj) bt[jj] = ldg16(Up + (size_t)(2 * jj) * NA, uoff);
        S5_LDC(0, 0); S5_LDC(1, 1);
        if (pass == 1) {
            bq[0] = ldg16(Uu, uoff); bq[1] = ldg16(Uu + (size_t)2 * NA, uoff); bq[2] = ldg16(Uu + (size_t)4 * NA, uoff);
            __builtin_amdgcn_sched_barrier(0);
#pragma unroll
            for (int jj = 0; jj < 16; ++jj) {
                if (jj + 3 < 16) bq[(jj + 3) & 3] = ldg16(Uu + (size_t)(2 * (jj + 3)) * NA, uoff);
#pragma unroll
                for (int ii = 0; ii < 16; ++ii) { const bf16x8 af = *(const LAS bf16x8*)(klow + (30 - 2 * (ii - jj)) * 512); acc[ii] = MFMA16(af, bq[jj & 3], acc[ii]); }
                __builtin_amdgcn_sched_barrier(0);
            }
        }
        __builtin_amdgcn_sched_barrier(0);
#pragma unroll
        for (int jj = 0; jj < 16; ++jj) {
            const bf16x8 cb = *(const LAS bf16x8*)(spb + 64 * (jj >> 2));
            if (jj < 8) bu[jj] = ldg16(Up + (size_t)(2 * (jj + 8)) * NA, uoff);
#pragma unroll
            for (int ii = 0; ii < 16; ++ii) if (ii >= jj) { const bf16x8 af = *(const LAS bf16x8*)(klow + (62 - 2 * (ii - jj)) * 512); acc[ii] = MFMA16(af, (jj < 8 ? bt[jj & 7] : bu[jj & 7]), acc[ii]); }
#pragma unroll
            for (int q = 0; q < 4; ++q) acc[4 * (jj & 3) + q] = MFMA16(ca[jj & 1][q], cb, acc[4 * (jj & 3) + q]);
            __builtin_amdgcn_sched_barrier(0);
            if (jj + 2 < 16) S5_LDC(jj + 2, jj & 1);
            __builtin_amdgcn_sched_barrier(0);
        }
#undef S5_LDC
        bf16_t* Yu = Ya + ((size_t)b * SEQ + (size_t)(16 * ntile) * 64 + wh + 32 * pass) * YW + 16 * g;
#pragma unroll
        for (int ii = 0; ii < 16; ++ii) {
            f32x4 y;
#pragma unroll
            for (int k = 0; k < 4; ++k) y[k] = gelu_tanh(acc[ii][k]);
            u32x4 bp; bp.x = cvt_pk_bf16(y[0], y[1]); bp.y = cvt_pk_bf16(y[2], y[3]); bp.z = 0u; bp.w = 0u;
            const f32x4 z = MFMA16(aglu, __builtin_bit_cast(bf16x8, bp), ((f32x4){0.f, 0.f, 0.f, 0.f}));
            u32x2 o; o.x = cvt_pk_bf16(y[0] * sigmoid_f(z[0]), y[1] * sigmoid_f(z[1])); o.y = cvt_pk_bf16(y[2] * sigmoid_f(z[2]), y[3] * sigmoid_f(z[3]));
            *(u32x2*)((char*)(Yu + (size_t)(2 * ii) * YW) + yoff) = o;
        }
    }
    __syncthreads();
}

constexpr int AT_KS = 0, AT_VT = 9216, AT_VP = 192, AT_BS = 9216 + 64 * AT_VP, AT_BUF = AT_BS + 256;
__device__ __forceinline__ int crow(int r, int hi) { return (r & 3) + 8 * (r >> 2) + 4 * hi; }
__device__ __forceinline__ void attn_unit(LAS unsigned char* lds, const bf16_t* P, const float* cum, bf16_t* Yc, const int b, const int h, const int qb, int tid, int lane, int w) {
    const int r32 = lane & 31, hi = lane >> 5;
    const size_t row0 = (size_t)b * SEQ;
    const int q0 = qb * 256, qrow = q0 + 32 * w + r32;
    bf16x8 qf[4];
    { const bf16_t* qp = P + (row0 + qrow) * NA + COL_Q + 64 * h + 8 * hi;
#pragma unroll
      for (int s = 0; s < 4; ++s) qf[s] = *(const bf16x8*)(qp + 16 * s); }
    const float* cumbh = cum + (size_t)(b * 8 + h) * SEQ;
    const float ref = cumbh[q0];
    const int vlane = (4 * hi + ((lane & 15) >> 2)) * AT_VP + 32 * ((lane >> 4) & 1) + 8 * (lane & 3);
    const int skey = tid >> 3, spc = tid & 7;
    const bf16_t* kgp = P + (row0 + skey) * NA + COL_K + 64 * h + 8 * spc;
    const int NT = 4 * qb + 4;
    u32x4 kreg = *(const u32x4*)kgp, vreg = *(const u32x4*)(kgp + (COL_V - COL_K)); float breg = 0.f; if (tid < 64) breg = ref - cumbh[tid];
#define AT_WRITE(bufp) do { LAS unsigned char* _b = (bufp); *(LAS u32x4*)(_b + AT_KS + skey * 144 + 16 * spc) = kreg; \
        *(LAS u32x4*)(_b + AT_VT + skey * AT_VP + 16 * spc) = vreg; \
        if (tid < 64) *(LAS float*)(_b + AT_BS + 4 * tid) = breg; } while (0)
    AT_WRITE(lds);
    __syncthreads();
    float mrun = -1e30f, lrun = 0.f; f32x16 o0, o1;
#pragma unroll
    for (int r = 0; r < 16; ++r) { o0[r] = 0.f; o1[r] = 0.f; }
    for (int kt = 0; kt < NT; ++kt) {
        const int cur = kt & 1; const bool more = (kt + 1 < NT);
        if (more) { const bf16_t* kp = kgp + (size_t)(kt + 1) * 64 * NA; kreg = *(const u32x4*)kp; vreg = *(const u32x4*)(kp + (COL_V - COL_K)); if (tid < 64) breg = ref - cumbh[64 * (kt + 1) + tid]; }
        if (64 * kt <= q0 + 32 * w + 31) {
            const LAS unsigned char* Kb = lds + cur * AT_BUF + AT_KS; const LAS unsigned char* Vb = lds + cur * AT_BUF + AT_VT; const LAS unsigned char* Bb = lds + cur * AT_BUF + AT_BS;
            f32x16 p[2];
#pragma unroll
            for (int rb = 0; rb < 2; ++rb) {
                f32x16 c;
#pragma unroll
                for (int g4 = 0; g4 < 4; ++g4) { const f32x4 bv = *(const LAS f32x4*)(Bb + (32 * rb + 8 * g4 + 4 * hi) * 4); c[4 * g4 + 0] = bv.x; c[4 * g4 + 1] = bv.y; c[4 * g4 + 2] = bv.z; c[4 * g4 + 3] = bv.w; }
#pragma unroll
                for (int s = 0; s < 4; ++s) { const bf16x8 af = *(const LAS bf16x8*)(Kb + (32 * rb + r32) * 144 + 32 * s + 16 * hi); c = MFMA32(af, qf[s], c); }
                p[rb] = c;
            }
            if (64 * kt + 63 > q0 + 32 * w) {
#pragma unroll
                for (int rb = 0; rb < 2; ++rb)
#pragma unroll
                    for (int r = 0; r < 16; ++r) { const int key = 64 * kt + 32 * rb + crow(r, hi); if (key > qrow) p[rb][r] = -1e30f; }
            }
            float mt = p[0][0];
#pragma unroll
            for (int r = 1; r < 16; ++r) mt = fmaxf(mt, p[0][r]);
#pragma unroll
            for (int r = 0; r < 16; ++r) mt = fmaxf(mt, p[1][r]);
            mt = half_max(mt);
            const float mnew = fmaxf(mrun, mt), alpha = fast_exp2(mrun - mnew);
            mrun = mnew;
            float ls = 0.f;
#pragma unroll
            for (int rb = 0; rb < 2; ++rb)
#pragma unroll
                for (int r = 0; r < 16; ++r) { p[rb][r] = fast_exp2(p[rb][r] - mnew); ls += p[rb][r]; }
            lrun = lrun * alpha + ls;
#pragma unroll
            for (int r = 0; r < 16; ++r) { o0[r] *= alpha; o1[r] *= alpha; }
            bf16x8 pf[4];
#pragma unroll
            for (int s = 0; s < 4; ++s) { const int rb = s >> 1, r0 = 8 * (s & 1); u32x4 pk; pk.x = cvt_pk_bf16(p[rb][r0 + 0], p[rb][r0 + 1]); pk.y = cvt_pk_bf16(p[rb][r0 + 2], p[rb][r0 + 3]);
                pk.z = cvt_pk_bf16(p[rb][r0 + 4], p[rb][r0 + 5]); pk.w = cvt_pk_bf16(p[rb][r0 + 6], p[rb][r0 + 7]); pf[s] = __builtin_bit_cast(bf16x8, pk); }
#pragma unroll
            for (int s = 0; s < 4; ++s) {
                typedef short v4i16_t __attribute__((ext_vector_type(4)));
                const LAS unsigned char* vp = Vb + vlane + 16 * s * AT_VP;
                { const s16x4 lo = __builtin_bit_cast(s16x4, __builtin_amdgcn_ds_read_tr16_b64_v4i16((LAS v4i16_t*)(vp))), hh = __builtin_bit_cast(s16x4, __builtin_amdgcn_ds_read_tr16_b64_v4i16((LAS v4i16_t*)(vp + 8 * AT_VP)));
                  const bf16x8 af = __builtin_shufflevector(lo, hh, 0, 1, 2, 3, 4, 5, 6, 7); o0 = MFMA32(af, pf[s], o0); }
                { const s16x4 lo = __builtin_bit_cast(s16x4, __builtin_amdgcn_ds_read_tr16_b64_v4i16((LAS v4i16_t*)(vp + 64))), hh = __builtin_bit_cast(s16x4, __builtin_amdgcn_ds_read_tr16_b64_v4i16((LAS v4i16_t*)(vp + 64 + 8 * AT_VP)));
                  const bf16x8 af = __builtin_shufflevector(lo, hh, 0, 1, 2, 3, 4, 5, 6, 7); o1 = MFMA32(af, pf[s], o1); }
            }
        }
        if (more) AT_WRITE(lds + (cur ^ 1) * AT_BUF);
        __syncthreads();
    }
#undef AT_WRITE
    const float ltot = half_sum(lrun);
    const float inv = 1.0f / ltot;
    bf16_t* op = Yc + (row0 + qrow) * YW + 64 * h + 4 * hi;
#pragma unroll
    for (int g4 = 0; g4 < 4; ++g4) {
        u32x2 a, c2;
        a.x = cvt_pk_bf16(o0[4 * g4 + 0] * inv, o0[4 * g4 + 1] * inv); a.y = cvt_pk_bf16(o0[4 * g4 + 2] * inv, o0[4 * g4 + 3] * inv);
        c2.x = cvt_pk_bf16(o1[4 * g4 + 0] * inv, o1[4 * g4 + 1] * inv); c2.y = cvt_pk_bf16(o1[4 * g4 + 2] * inv, o1[4 * g4 + 3] * inv);
        *(u32x2*)(op + 8 * g4) = a; *(u32x2*)(op + 32 + 8 * g4) = c2;
    }
}

__device__ __forceinline__ u32x4 conv_item(const bf16_t* P, const float* cw, int item) {
    const int token = item >> 6, c0 = (item & 63) * 8, t = token & (SEQ - 1);
    float acc[8];
#pragma unroll
    for (int i = 0; i < 8; ++i) acc[i] = 0.f;
    u32x4 xc[3], cc[3];
#pragma unroll
    for (int tap = 0; tap < 3; ++tap) {
        const bool ok = (t - 2 + tap >= 0);
        const bf16_t* rp = P + (size_t)(ok ? token - 2 + tap : token) * NA + c0;
        xc[tap] = *(const u32x4*)(rp + COL_XC); cc[tap] = *(const u32x4*)(rp + COL_CC);
        if (!ok) { xc[tap] = (u32x4){0u, 0u, 0u, 0u}; }
    }
    const u32x4 bc = *(const u32x4*)(P + (size_t)token * NA + COL_BC + c0);
#pragma unroll
    for (int tap = 0; tap < 3; ++tap) {
        const f32x4 w0 = *(const f32x4*)(cw + tap * 512 + c0), w1 = *(const f32x4*)(cw + tap * 512 + c0 + 4);
        const u32x4 x = xc[tap], c = cc[tap];
        acc[0] += w0.x * bf_lo(x.x) * bf_lo(c.x); acc[1] += w0.y * bf_hi(x.x) * bf_hi(c.x); acc[2] += w0.z * bf_lo(x.y) * bf_lo(c.y); acc[3] += w0.w * bf_hi(x.y) * bf_hi(c.y);
        acc[4] += w1.x * bf_lo(x.z) * bf_lo(c.z); acc[5] += w1.y * bf_hi(x.z) * bf_hi(c.z); acc[6] += w1.z * bf_lo(x.w) * bf_lo(c.w); acc[7] += w1.w * bf_hi(x.w) * bf_hi(c.w);
    }
    u32x4 o; o.x = cvt_pk_bf16(acc[0] * bf_lo(bc.x), acc[1] * bf_hi(bc.x)); o.y = cvt_pk_bf16(acc[2] * bf_lo(bc.y), acc[3] * bf_hi(bc.y));
    o.z = cvt_pk_bf16(acc[4] * bf_lo(bc.z), acc[5] * bf_hi(bc.z)); o.w = cvt_pk_bf16(acc[6] * bf_lo(bc.w), acc[7] * bf_hi(bc.w));
    return o;
}
__device__ __forceinline__ void conv_phase(const bf16_t* P, const float* cw, bf16_t* Yb, int gtid, int ngt) {
    for (int item = gtid; item < M * 64; item += 4 * ngt) {
        u32x4 o[4];
#pragma unroll
        for (int q = 0; q < 4; ++q) o[q] = conv_item(P, cw, item + q * ngt);
#pragma unroll
        for (int q = 0; q < 4; ++q) { const int it = item + q * ngt; *(u32x4*)(Yb + (size_t)(it >> 6) * YW + (it & 63) * 8) = o[q]; }
    }
}

#define XB_TMO      128
#define XB_XCNT(j)  (256  + 64 * (j))
#define XB_XSUB(j)  (1280 + 64 * (j))
#define XB_XGEN(j)  (2304 + 64 * (j))
#define XB_TOP      3328
#define XB_TOPGEN   3392
#define XCD_BAR_WORDS 3456
#define XB_SPIN_CAP (1u << 18)
__device__ __forceinline__ unsigned xb_ld(unsigned* p)              { return __hip_atomic_load(p, __ATOMIC_RELAXED, __HIP_MEMORY_SCOPE_AGENT); }
__device__ __forceinline__ unsigned xb_add(unsigned* p, unsigned v) { return __hip_atomic_fetch_add(p, v, __ATOMIC_RELAXED, __HIP_MEMORY_SCOPE_AGENT); }
__device__ __forceinline__ unsigned xb_xcc_id() { return (unsigned)__builtin_amdgcn_s_getreg((3 << 11) | 20) & 0xFu; }
#define XB_SPIN(cond, bar) do { unsigned _sp = 0; while (cond) { __builtin_amdgcn_s_sleep(1); \
    if ((++_sp & 255u) == 0u) { if (xb_ld(&(bar)[XB_TMO])) break; if (_sp > XB_SPIN_CAP) { atomicAdd(&(bar)[XB_TMO], 1u); break; } } } } while (0)
struct XcdBarrier { unsigned* bar; unsigned x; volatile LAS unsigned* st; };
__device__ __forceinline__ XcdBarrier xcd_barrier_post(unsigned* bar, volatile LAS unsigned* st) {
    XcdBarrier b; b.bar = bar; b.x = xb_xcc_id(); b.st = st;
    if (threadIdx.x == 0) (void)xb_add(&bar[XB_XCNT(b.x)], 1u);
    return b;
}
__device__ __forceinline__ void xcd_barrier_complete(unsigned* bar, unsigned x, unsigned& nloc, unsigned& nx) {
    const unsigned G = gridDim.x * gridDim.y * gridDim.z;
    unsigned sum, cnt, mine, sp = 0u;
    for (;;) {
        sum = 0u; cnt = 0u; mine = 0u;
#pragma unroll
        for (unsigned j = 0; j < 16; ++j) { const unsigned c = xb_ld(&bar[XB_XCNT(j)]); sum += c; cnt += (c > 0u) ? 1u : 0u; mine = (j == x) ? c : mine; }
        if (sum == G) break;
        __builtin_amdgcn_s_sleep(1);
        if ((++sp & 255u) == 0u) { if (xb_ld(&bar[XB_TMO])) break; if (sp > XB_SPIN_CAP) { atomicAdd(&bar[XB_TMO], 1u); break; } }
    }
    nloc = mine > 0u ? mine : 1u; nx = cnt > 0u ? cnt : 1u;
}
__device__ __forceinline__ void xcd_barrier(const XcdBarrier& b) {
    asm volatile("s_waitcnt vmcnt(0) lgkmcnt(0)" ::: "memory");
    __syncthreads();
    if (threadIdx.x == 0) {
        unsigned* bar = b.bar; unsigned bx = b.x;
        asm volatile("" : "+s"(bar), "+s"(bx));
        __builtin_amdgcn_s_waitcnt(0);
        unsigned nloc = b.st[0], nx = b.st[1];
        if (nloc == 0u) { xcd_barrier_complete(bar, bx, nloc, nx); b.st[0] = nloc; b.st[1] = nx; }
        const unsigned old = xb_add(&bar[XB_XSUB(bx)], 1u);
        const unsigned gen = old / nloc;
        if (old + 1u == (gen + 1u) * nloc) {
            __builtin_amdgcn_fence(__ATOMIC_RELEASE, "agent");
            asm volatile("s_waitcnt vmcnt(0)" ::: "memory");
            const unsigned og = xb_add(&bar[XB_TOP], 1u);
            const unsigned tg = og / nx;
            if (og + 1u == (tg + 1u) * nx) xb_add(&bar[XB_TOPGEN], 1u);
            else XB_SPIN(xb_ld(&bar[XB_TOPGEN]) == tg, bar);
            __builtin_amdgcn_fence(__ATOMIC_ACQUIRE, "agent");
            xb_add(&bar[XB_XGEN(bx)], 1u);
            asm volatile("s_waitcnt vmcnt(0)" ::: "memory");
        } else {
            XB_SPIN(xb_ld(&bar[XB_XGEN(bx)]) == gen, bar);
            __builtin_amdgcn_fence(__ATOMIC_ACQUIRE, "agent");
            asm volatile("s_waitcnt vmcnt(0)" ::: "memory");
        }
    }
    __syncthreads();
}
__device__ __forceinline__ void cg_barrier(cg::grid_group& grid) {
    asm volatile("s_waitcnt vmcnt(0) lgkmcnt(0)" ::: "memory");
    __syncthreads();
    grid.sync();
    if (threadIdx.x == 0) { __builtin_amdgcn_fence(__ATOMIC_ACQUIRE, "agent"); asm volatile("s_waitcnt vmcnt(0)" ::: "memory"); }
    __syncthreads();
}
#define grid_barrier(g_) xcd_barrier(xbar)

#ifndef DIAG_STAGE
#define DIAG_STAGE 0
#endif
__device__ __forceinline__ void diag_dump(float* out, const bf16_t* src, int ld, int ncols) {
    for (size_t i = (size_t)blockIdx.x * 512 + threadIdx.x; i < (size_t)M * DM; i += (size_t)gridDim.x * 512) {
        const size_t row = i >> 10; const int c = (int)(i & 1023); float v = 0.f;
        for (int cc = c; cc < ncols; cc += 1024) v += bf_lo((unsigned)src[row * ld + cc]);
        out[i] = v;
    }
}
#define DIAG(k, src, ld, ncols) do { if (DIAG_STAGE == (k)) { grid_barrier(grid); diag_dump(A_->out, (src), (ld), (ncols)); return; } } while (0)

typedef const __attribute__((address_space(4))) Args* KArgP;
__device__ __forceinline__ KArgP launder_args(KArgP p) { asm volatile("" : "+s"(p)); return p; }
#define A_ (launder_args(argp))
__global__ void __launch_bounds__(512, 2) fwd_kernel(Args a) {
    KArgP argp = (KArgP)__builtin_amdgcn_kernarg_segment_ptr(); (void)a;
    extern __shared__ __attribute__((aligned(16))) unsigned char lds_raw[];
    LAS unsigned char* lds = (LAS unsigned char*)lds_raw;
    cg::grid_group grid = cg::this_grid();
    if (gridDim.z == 12345u) grid.sync();
    volatile LAS unsigned* xst = (volatile LAS unsigned*)((LAS unsigned char*)lds_raw + LDS_BYTES - 64);
    if (threadIdx.x == 0) { xst[0] = 0u; xst[1] = 0u; }
    __syncthreads();
    const XcdBarrier xbar = xcd_barrier_post((unsigned*)(A_->ws + 16384), xst);
    const int G = gridDim.x, bid = blockIdx.x, ngw = G * 8;
#define FRESH() const int tid = launder_i(threadIdx.x), lane = tid & 63, w = __builtin_amdgcn_readfirstlane(tid >> 6), gw = bid * 8 + w; (void)lane; (void)gw
    unsigned char* ws = A_->ws;
    bf16_t* XN = (bf16_t*)(ws + WS_XN); bf16_t* PR = (bf16_t*)(ws + WS_P); bf16_t* Y = (bf16_t*)(ws + WS_Y);
    float* LOGF = (float*)(ws + WS_LOGF); float* CUM = (float*)(ws + WS_CUM);

    {
        FRESH();
#ifndef NO_TAB
        for (int u = bid; u < 256; u += G) s5_tables(lds, a, u >> 7, (u >> 2) & 31, u & 3, tid);
#endif
        LAS float* scr = (LAS float*)(lds + w * 16640);
        constexpr int I_A = 16 * 56, I_G = 16 * 48, I_B = 8 * 16, I_O = 16 * 16, I_1 = 16 * 64, I_2 = 64 * 16, I_L = I_A + I_G + 3 * I_B + I_O + I_1 + I_2;
        for (int it = gw; it < 2 * I_L; it += ngw) {
            const int l = it / I_L; int r = it - l * I_L;
            unsigned char* wl = ws + WS_W + (size_t)l * W_LAYER;
            const float* win = A_->in[2] + (size_t)l * DM * INW;
            if (r < I_A) { transpose_item(win, INW, 0, DM, NA, (bf16_t*)(wl + W_INA), scr, r, lane); continue; } r -= I_A;
            if (r < I_G) { transpose_item(win, INW, COL_G, DM, NG, (bf16_t*)(wl + W_G), scr, r, lane); continue; } r -= I_G;
            if (r < 3 * I_B) { const int br = r / I_B; transpose_item(A_->in[15] + (size_t)l * 1536 * DM + (size_t)br * 512 * DM, DM, 0, 512, DM, (bf16_t*)(wl + W_BR) + (size_t)br * DM * 512, scr, r - br * I_B, lane); continue; } r -= 3 * I_B;
            if (r < I_O) { transpose_item(A_->in[16] + (size_t)l * DM * DM, DM, 0, DM, DM, (bf16_t*)(wl + W_OUT), scr, r, lane); continue; } r -= I_O;
            if (r < I_1) { transpose_item(A_->in[19] + (size_t)l * DM * FF, FF, 0, DM, FF, (bf16_t*)(wl + W_1), scr, r, lane); continue; } r -= I_1;
            transpose_item(A_->in[20] + (size_t)l * FF * DM, DM, 0, FF, DM, (bf16_t*)(wl + W_2), scr, r, lane);
        }
        __syncthreads();
        NormArgs n{A_->in[0], nullptr, nullptr, nullptr, A_->in[1], XN, A_->in[2] + COL_F, A_->in[14], LOGF};
        norm_phase(lds, n, gw, ngw, lane, tid);
    }
    xcd_barrier(xbar);

    DIAG(1, XN, DM, DM);
#pragma unroll 1
    for (int l = 0; l < DEPTH; ++l) {
        unsigned char* wl = ws + WS_W + (size_t)l * W_LAYER;
        const unsigned char* s5tab = ws + WS_S5 + (size_t)l * S5_LAYER;
        const float* xin = (l == 0) ? A_->in[0] : A_->out;

        { FRESH(); for (int bh = bid; bh < 64; bh += G) cum_scan(lds, LOGF, CUM, bh, tid, lane, w); }
        {
            pg8::Gemm g{XN, (const bf16_t*)(wl + W_INA), M, NA, DM, 0, 0}; pg8::StaticOrder S; S.init(M, NA, G, bid, 1);
            pg8::Epi<pg8::EPI_PROJ> E{PR, NA, nullptr, nullptr};
#if (PHMASK >> 0) & 1
            pg8::gemm_phase<pg8::Epi<pg8::EPI_PROJ>, pg8::StaticOrder, true, true>(lds, g, S, E);
#endif
        }
        grid_barrier(grid);

        DIAG(2, PR, NA, NA);
        if ((bid >> 3) & 1) {
        for (int v = bid; v < 256; v += G) {
            FRESH(); const int bh = v >> 2, s = v & 3;
#pragma unroll 1
            for (int k = 0; k < 4; ++k) { const int qb = (k == 0) ? 15 - s : (k == 1) ? s : (k == 2) ? 11 - s : s + 4;
                attn_unit(lds, PR, CUM, Y + 2 * (size_t)M * YW, bh >> 3, bh & 7, qb, tid, lane, w); }
        }
        { FRESH(); for (int v = bid; v < 256; v += G) s5_unit(lds, PR, s5tab, Y, v >> 5, 4 * (v & 7) + ((v >> 3) & 3), tid, lane, w);     }
        } else {
        { FRESH(); for (int v = bid; v < 256; v += G) s5_unit(lds, PR, s5tab, Y, v >> 5, 4 * (v & 7) + ((v >> 3) & 3), tid, lane, w);     }
        for (int v = bid; v < 256; v += G) {
            FRESH(); const int bh = v >> 2, s = v & 3;
#pragma unroll 1
            for (int k = 0; k < 4; ++k) { const int qb = (k == 0) ? 15 - s : (k == 1) ? s : (k == 2) ? 11 - s : s + 4;
                attn_unit(lds, PR, CUM, Y + 2 * (size_t)M * YW, bh >> 3, bh & 7, qb, tid, lane, w); }
        }
        }
        { FRESH(); conv_phase(PR, A_->in[13] + (size_t)l * 3 * 512, Y + (size_t)M * YW, bid * 512 + tid, G * 512); }
        grid_barrier(grid);

        if (DIAG_STAGE == 3) { grid_barrier(grid); for (size_t i = (size_t)blockIdx.x * 512 + threadIdx.x; i < (size_t)M * DM; i += (size_t)gridDim.x * 512) { const size_t row = i >> 10; const int c = (int)(i & 511); A_->out[i] = bf_lo((unsigned)Y[row * YW + c]) + bf_lo((unsigned)Y[(size_t)M * YW + row * YW + c]) + bf_lo((unsigned)Y[2 * (size_t)M * YW + row * YW + c]); } return; }
        DIAG(31, Y + (size_t)M * YW, YW, YW); DIAG(32, Y + 2 * (size_t)M * YW, YW, YW);
        {
            pg8::Gemm g{XN, (const bf16_t*)(wl + W_G), M, NG, DM, 0, 0}; pg8::StaticOrder S; S.init(M, NG, G, bid, 1);
            pg8::Epi<pg8::EPI_GATE> E{PR, NG, A_->in[3] + (size_t)l * NG, nullptr};
#if (PHMASK >> 1) & 1
            pg8::gemm_phase<pg8::Epi<pg8::EPI_GATE>, pg8::StaticOrder, true, true>(lds, g, S, E);
#endif
        }
        grid_barrier(grid);

        DIAG(4, PR, NG, NG);
        {
            pg8::Gemm g{Y, (const bf16_t*)(wl + W_BR), M, DM, 512, (size_t)M * YW * 2, (size_t)DM * 512 * 2}; pg8::StaticOrder S; S.init(M, DM, G, bid, 3);
            pg8::Epi<pg8::EPI_BRANCH> E{XN, DM, nullptr, PR};
#if (PHMASK >> 2) & 1
            pg8::gemm_phase<pg8::Epi<pg8::EPI_BRANCH>, pg8::StaticOrder, true, true>(lds, g, S, E);
#endif
        }
        grid_barrier(grid);

        DIAG(5, XN, DM, DM);
        {
            pg8::Gemm g{XN, (const bf16_t*)(wl + W_OUT), M, DM, DM, 0, 0}; pg8::StaticOrder S; S.init(M, DM, G, bid, 1);
            pg8::Epi<pg8::EPI_PLAIN> E{PR, DM, nullptr, nullptr};
#if (PHMASK >> 3) & 1
            pg8::gemm_phase<pg8::Epi<pg8::EPI_PLAIN>, pg8::StaticOrder, true, true>(lds, g, S, E);
#endif
        }
        grid_barrier(grid);

        DIAG(6, PR, DM, DM);
        {
            FRESH(); NormArgs n{xin, PR, A_->in[17] + (size_t)l * DM, A_->out, A_->in[18] + (size_t)l * DM, XN, nullptr, nullptr, nullptr};
            norm_phase(lds, n, gw, ngw, lane, tid);
        }
        grid_barrier(grid);

        DIAG(7, XN, DM, DM);
        {
            pg8::Gemm g{XN, (const bf16_t*)(wl + W_1), M, FF, DM, 0, 0}; pg8::StaticOrder S; S.init(M, FF, G, bid, 1);
            pg8::Epi<pg8::EPI_RELU2> E{PR, FF, nullptr, nullptr};
#if (PHMASK >> 4) & 1
            pg8::gemm_phase<pg8::Epi<pg8::EPI_RELU2>, pg8::StaticOrder, true, true>(lds, g, S, E);
#endif
        }
        grid_barrier(grid);

        DIAG(8, PR, FF, FF);
        {
            pg8::Gemm g{PR, (const bf16_t*)(wl + W_2), M, DM, FF, 0, 0}; pg8::StaticOrder S; S.init(M, DM, G, bid, 1);
            pg8::Epi<pg8::EPI_PLAIN> E{XN, DM, nullptr, nullptr};
#if (PHMASK >> 5) & 1
            pg8::gemm_phase<pg8::Epi<pg8::EPI_PLAIN>, pg8::StaticOrder, true, true>(lds, g, S, E);
#endif
        }
        grid_barrier(grid);

        DIAG(9, XN, DM, DM);
        if (l + 1 < DEPTH) {
            FRESH(); NormArgs n{A_->out, XN, A_->in[21] + (size_t)l * DM, A_->out, A_->in[1] + (size_t)(l + 1) * DM, XN, A_->in[2] + (size_t)(l + 1) * DM * INW + COL_F, A_->in[14] + (l + 1) * 8, LOGF};
            norm_phase(lds, n, gw, ngw, lane, tid);
            grid_barrier(grid);
        } else {
            FRESH(); NormArgs n{A_->out, XN, A_->in[21] + (size_t)l * DM, A_->out, nullptr, nullptr, nullptr, nullptr, nullptr};
            norm_phase(lds, n, gw, ngw, lane, tid);
        }
    }
}

extern "C" void kernel_launch(void* const* d_in, const int* in_sizes, int n_in, void* d_out, int out_size, void* d_ws, size_t ws_size, hipStream_t stream) {
    static int grid = 0;
    if (grid == 0) {
        if (n_in != 22 || in_sizes[0] != M * DM || out_size != M * DM || ws_size < WS_END) { fprintf(stderr, "kernel_launch: unexpected shapes (n_in %d, in0 %d, out %d, ws %zu)\n", n_in, n_in > 0 ? in_sizes[0] : -1, out_size, ws_size); grid = -1; return; }
        int dev = 0, cus = 0, per_cu = 0;
        (void)hipGetDevice(&dev);
        (void)hipDeviceGetAttribute(&cus, hipDeviceAttributeMultiprocessorCount, dev);
        if (hipFuncSetAttribute((const void*)fwd_kernel, hipFuncAttributeMaxDynamicSharedMemorySize, LDS_BYTES) != hipSuccess) fprintf(stderr, "kernel_launch: hipFuncSetAttribute failed\n");
        if (hipOccupancyMaxActiveBlocksPerMultiprocessor(&per_cu, (const void*)fwd_kernel, 512, LDS_BYTES) != hipSuccess || per_cu < 1) { fprintf(stderr, "kernel_launch: occupancy query gave %d\n", per_cu); per_cu = 1; }
        (void)hipGetLastError();
        grid = cus * per_cu; if (grid > 256) grid = 256; if (grid < 1) grid = 256;
    }
    if (grid < 0) return;
    (void)hipMemsetAsync(d_ws, 0, 65536, stream);
    Args a{};
    for (int i = 0; i < 22; ++i) a.in[i] = (const float*)d_in[i];
    a.out = (float*)d_out; a.ws = (unsigned char*)d_ws;
    void* args[] = {&a};
    hipError_t e = hipLaunchCooperativeKernel((const void*)fwd_kernel, dim3(grid), dim3(512), args, LDS_BYTES, stream);
    if (e != hipSuccess) fprintf(stderr, "kernel_launch: cooperative launch failed: %s (grid %d)\n", hipGetErrorString(e), grid);
}
```

```cpp
#include <hip/hip_runtime.h>
#include <hip/hip_cooperative_groups.h>
#include <cstdio>
#include <cstdint>
namespace cg = cooperative_groups;

#define DIAG_STAGE 0
#ifndef PHMASK
#define PHMASK 0xff
#endif

#define LAS __attribute__((address_space(3)))
typedef unsigned short bf16_t;
typedef short bf16x8 __attribute__((ext_vector_type(8)));
typedef short s16x4 __attribute__((ext_vector_type(4)));
typedef float f32x2 __attribute__((ext_vector_type(2)));
typedef float f32x4 __attribute__((ext_vector_type(4)));
typedef float f32x16 __attribute__((ext_vector_type(16)));
typedef unsigned u32x2 __attribute__((ext_vector_type(2)));
typedef unsigned u32x4 __attribute__((ext_vector_type(4)));

constexpr int BATCH = 8, SEQ = 4096, DM = 1024, M = BATCH * SEQ, DEPTH = 2;
constexpr int INW = 6664, NA = 3584, NG = 3072, FF = 4096, YW = 512;
constexpr int COL_XC = 512, COL_BC = 1024, COL_CC = 1536, COL_Q = 2048, COL_K = 2560, COL_V = 3072, COL_F = 3584, COL_G = 3592;
constexpr float EPS = 1e-6f;
constexpr float LOG2E = 1.4426950408889634f;
constexpr float C2 = 0.125f * LOG2E;

constexpr size_t MiB = 1u << 20;
constexpr size_t WS_W = 1 * MiB, W_LAYER = 34 * MiB;
constexpr size_t W_INA = 0, W_G = 7 * MiB, W_BR = 13 * MiB, W_OUT = 16 * MiB, W_1 = 18 * MiB, W_2 = 26 * MiB;
constexpr size_t WS_S5 = 69 * MiB, S5_LAYER = 17 * MiB + 512 * 1024;
constexpr size_t S5_KT = 0, S5_WE = MiB + 256 * 1024, S5_WC = S5_WE + 8 * MiB, S5_A64 = S5_WC + 8 * MiB, S5_GLU = S5_A64 + 64 * 1024;
constexpr size_t WS_LOGF = 104 * MiB, WS_CUM = 105 * MiB, WS_XN = 106 * MiB, WS_P = 170 * MiB, WS_Y = 394 * MiB, WS_END = 490 * MiB;
constexpr int KT_BYTES = 65 * 512;

constexpr int LDS_BYTES = 147456;

typedef __bf16 bf16x2_t __attribute__((ext_vector_type(2)));
__device__ __forceinline__ unsigned cvt_pk_bf16(float lo, float hi) { const f32x2 v = {lo, hi}; const bf16x2_t b = __builtin_convertvector(v, bf16x2_t); return __builtin_bit_cast(unsigned, b); }
__device__ __forceinline__ float bf_lo(unsigned u) { return __uint_as_float(u << 16); }
__device__ __forceinline__ float bf_hi(unsigned u) { return __uint_as_float(u & 0xffff0000u); }
template <int O> __device__ __forceinline__ float swz_xor(float v) { return __int_as_float(__builtin_amdgcn_ds_swizzle(__float_as_int(v), (O << 10) | 0x1f)); }
__device__ __forceinline__ float half_sum(float v) { auto rr = __builtin_amdgcn_permlane32_swap(__float_as_uint(v), __float_as_uint(v), false, false); return __uint_as_float(rr[0]) + __uint_as_float(rr[1]); }
__device__ __forceinline__ float half_max(float v) { auto rr = __builtin_amdgcn_permlane32_swap(__float_as_uint(v), __float_as_uint(v), false, false); return fmaxf(__uint_as_float(rr[0]), __uint_as_float(rr[1])); }
__device__ __forceinline__ float wave_sum(float v) {
    v += swz_xor<1>(v); v += swz_xor<2>(v); v += swz_xor<4>(v); v += swz_xor<8>(v); v += swz_xor<16>(v);
    return half_sum(v);
}
__device__ __forceinline__ int launder_i(int x) { asm volatile("" : "+v"(x)); return x; }
__device__ __forceinline__ float fast_exp2(float x) { return __builtin_amdgcn_exp2f(x); }
__device__ __forceinline__ float fast_rcp(float x) { return __builtin_amdgcn_rcpf(x); }
__device__ __forceinline__ float sigmoid_f(float z) { return fast_rcp(1.0f + fast_exp2(-LOG2E * z)); }
__device__ __forceinline__ float gelu_tanh(float y) { const float t = y + 0.044715f * y * y * y; return y * fast_rcp(1.0f + fast_exp2(-2.302208198f * t)); }

namespace pg8 {
#define PG8_LAS __attribute__((address_space(3)))
constexpr int BM = 256, BK = 64, HALF = 128, HTB = HALF * BK * 2, STAGE_BYTES = 8 * HTB, NXCD = 8, WGM = 8;

__host__ __device__ __forceinline__ int lds_byte(int r, int c) { const int st = (r >> 4) * 2 + (c >> 5), rr = r & 15, cc = c & 31, ob = rr * 64 + cc * 2; return st * 1024 + (ob ^ (((ob >> 9) & 1) << 5)); }
__host__ __device__ __forceinline__ void stage_rc(int b, int& R, int& C) { const int st = b / 1024, sb = b % 1024, swz = sb ^ (((sb >> 9) & 1) << 5); R = (st >> 1) * 16 + swz / 64; C = (st & 1) * 32 + (swz % 64) / 2; }
__host__ __device__ __forceinline__ int perm32(int rho) { const int n = rho >> 4, i = rho & 15; return 8 * (i >> 2) + 4 * n + (i & 3); }

struct Unit { int pm, pn, br; };
struct Gemm { const bf16_t* A; const bf16_t* Bt; int M, N, K; size_t abr, bbr; };

struct StaticOrder {
    int nM, nN, nwg, G, c, nbr;
    __device__ void init(int M_, int N_, int G_, int c_, int nbr_) { nM = M_ / BM; nN = N_ / BM; nwg = nM * nN; G = G_; c = c_; nbr = nbr_; }
    __device__ bool next(int i, Unit& u) const {
        const int it = i / nbr; u.br = i - it * nbr;
        const long L = (long)it * G + c; if (L >= nwg) return false;
        int wgid = (int)L; { const int q = nwg / NXCD, r = nwg % NXCD, xcd = wgid % NXCD, off = wgid / NXCD; wgid = (xcd < r ? xcd * (q + 1) : r * (q + 1) + (xcd - r) * q) + off; }
        const int nig = WGM * nN, gid = wgid / nig, fm = gid * WGM, gsz = (nM - fm) < WGM ? (nM - fm) : WGM;
        u.pm = fm + ((wgid % nig) % gsz); u.pn = (wgid % nig) / gsz; return true;
    }
};

enum { EPI_PROJ = 0, EPI_GATE = 1, EPI_RELU2 = 2, EPI_BRANCH = 3, EPI_PLAIN = 4 };
template <int MODE> struct Epi {
    static constexpr bool PERM = true;
    bf16_t* O; int ldc; const float* bias; const bf16_t* G;
    __device__ __forceinline__ void operator()(const f32x4 (&acc)[2][2][4][2], const Unit& u, int wr, int wc, int fr, int fq) const {
        const int row0 = u.pm * BM + wr * 64 + fr; const int col0 = u.pn * BM + wc * 32 + 8 * fq;
        float sc = 1.f; if (MODE == EPI_PROJ) { if (u.pn >= COL_Q / 256 && u.pn < COL_K / 256) sc = C2; }
        f32x4 bv[2][2];
        if (MODE == EPI_GATE) {
#pragma unroll
            for (int bj = 0; bj < 2; ++bj)
#pragma unroll
                for (int n = 0; n < 2; ++n) bv[bj][n] = *(const f32x4*)(bias + col0 + bj * HALF + 4 * n);
        }
        if (MODE == EPI_BRANCH) {
#pragma unroll
            for (int ai = 0; ai < 2; ++ai) {
                u32x2 gt[4][2]; u32x4 pv[4][2];
#pragma unroll
                for (int m = 0; m < 4; ++m)
#pragma unroll
                    for (int bj = 0; bj < 2; ++bj) {
                        const size_t row = (size_t)(row0 + ai * HALF + m * 16);
                        gt[m][bj] = *(const u32x2*)((const unsigned char*)G + row * NG + (size_t)u.br * DM + col0 + bj * HALF);
                        pv[m][bj] = (u.br > 0) ? *(const u32x4*)(O + row * ldc + col0 + bj * HALF) : (u32x4){0u, 0u, 0u, 0u};
                    }
                __builtin_amdgcn_sched_barrier(0);
#pragma unroll
                for (int m = 0; m < 4; ++m)
#pragma unroll
                    for (int bj = 0; bj < 2; ++bj) {
                        const size_t row = (size_t)(row0 + ai * HALF + m * 16);
                        f32x4 v0 = acc[ai][bj][m][0], v1 = acc[ai][bj][m][1];
                        const u32x2 g8 = gt[m][bj]; const u32x4 p4 = pv[m][bj];
                        v0 = v0 * (1.f / 255.f); v1 = v1 * (1.f / 255.f);
                        v0[0] = v0[0] * (float)(g8.x & 0xffu) + bf_lo(p4.x); v0[1] = v0[1] * (float)((g8.x >> 8) & 0xffu) + bf_hi(p4.x); v0[2] = v0[2] * (float)((g8.x >> 16) & 0xffu) + bf_lo(p4.y); v0[3] = v0[3] * (float)(g8.x >> 24) + bf_hi(p4.y);
                        v1[0] = v1[0] * (float)(g8.y & 0xffu) + bf_lo(p4.z); v1[1] = v1[1] * (float)((g8.y >> 8) & 0xffu) + bf_hi(p4.z); v1[2] = v1[2] * (float)((g8.y >> 16) & 0xffu) + bf_lo(p4.w); v1[3] = v1[3] * (float)(g8.y >> 24) + bf_hi(p4.w);
                        u32x4 wv; wv.x = cvt_pk_bf16(v0[0], v0[1]); wv.y = cvt_pk_bf16(v0[2], v0[3]); wv.z = cvt_pk_bf16(v1[0], v1[1]); wv.w = cvt_pk_bf16(v1[2], v1[3]);
                        *(u32x4*)(O + row * ldc + col0 + bj * HALF) = wv;
                    }
                __builtin_amdgcn_sched_barrier(0);
            }
            return;
        }
#pragma unroll
        for (int ai = 0; ai < 2; ++ai)
#pragma unroll
            for (int m = 0; m < 4; ++m) {
                const size_t row = (size_t)(row0 + ai * HALF + m * 16);
                bf16_t* rowp = O + row * ldc + col0;
#pragma unroll
                for (int bj = 0; bj < 2; ++bj) {
                    f32x4 v0 = acc[ai][bj][m][0], v1 = acc[ai][bj][m][1];
                    if (MODE == EPI_PROJ) { v0 = v0 * sc; v1 = v1 * sc; }
                    if (MODE == EPI_GATE) {
                        v0 = v0 + bv[bj][0]; v1 = v1 + bv[bj][1];
                        u32x2 w8; w8.x = 0u; w8.y = 0u;
#pragma unroll
                        for (int i = 0; i < 4; ++i) { w8.x |= (unsigned)(sigmoid_f(v0[i]) * 255.f + 0.5f) << (8 * i); w8.y |= (unsigned)(sigmoid_f(v1[i]) * 255.f + 0.5f) << (8 * i); }
                        *(u32x2*)((unsigned char*)O + row * ldc + col0 + bj * HALF) = w8;
                        continue;
                    }
                    if (MODE == EPI_RELU2) {
#pragma unroll
                        for (int i = 0; i < 4; ++i) { const float a = fmaxf(v0[i], 0.f), b = fmaxf(v1[i], 0.f); v0[i] = a * a; v1[i] = b * b; }
                    }
                    if (MODE == EPI_BRANCH) {
                        const u32x4 gt = *(const u32x4*)(G + row * NG + (size_t)u.br * DM + col0 + bj * HALF);
                        v0[0] *= bf_lo(gt.x); v0[1] *= bf_hi(gt.x); v0[2] *= bf_lo(gt.y); v0[3] *= bf_hi(gt.y);
                        v1[0] *= bf_lo(gt.z); v1[1] *= bf_hi(gt.z); v1[2] *= bf_lo(gt.w); v1[3] *= bf_hi(gt.w);
                        if (u.br > 0) {
                            const u32x4 pv = *(const u32x4*)(rowp + bj * HALF);
                            v0[0] += bf_lo(pv.x); v0[1] += bf_hi(pv.x); v0[2] += bf_lo(pv.y); v0[3] += bf_hi(pv.y);
                            v1[0] += bf_lo(pv.z); v1[1] += bf_hi(pv.z); v1[2] += bf_lo(pv.w); v1[3] += bf_hi(pv.w);
                        }
                    }
                    u32x4 w; w.x = cvt_pk_bf16(v0[0], v0[1]); w.y = cvt_pk_bf16(v0[2], v0[3]); w.z = cvt_pk_bf16(v1[0], v1[1]); w.w = cvt_pk_bf16(v1[2], v1[3]);
                    *(u32x4*)(rowp + bj * HALF) = w;
                }
            }
    }
};

template <class EpiT, class Sched, bool ALIGN_EPI, bool SP2>
__device__ __forceinline__ void gemm_phase(PG8_LAS unsigned char* lds, const Gemm g, const Sched& S, const EpiT& E) {
    const int tid = launder_i(threadIdx.x), wid = __builtin_amdgcn_readfirstlane(tid >> 6), lane = tid & 63, wr = wid >> 2, wc = wid & 3, fr = lane & 15, fq = lane >> 4;
    const int K = g.K, nt = K / BK;
    unsigned voffA[2], voffB[2];
#pragma unroll
    for (int i = 0; i < 2; ++i) { int R, C; stage_rc(tid * 16 + i * 8192, R, C); const int Rb = EpiT::PERM ? ((R & ~31) + perm32(R & 31)) : R;
        voffA[i] = (unsigned)(R * K + C) * 2u; voffB[i] = (unsigned)(Rb * K + C) * 2u; }
    const size_t kstep = (size_t)(BK * 2);
    const size_t hstep = (size_t)HALF * K * 2;
    const size_t tstep = 2 * hstep;
    const unsigned ldsw = (unsigned)wid * 1024u;
    const int aoff = lds_byte(wr * 64 + fr, fq * 8), boff = lds_byte(wc * 32 + fr, fq * 8);
#define PG8_SA(b, h) (((b) * 2 + (h)) * HTB)
#define PG8_SB(b, h) ((4 + (b) * 2 + (h)) * HTB)
#define PG8_STAGE(bufoff, gbase, voff) do { _Pragma("unroll") for (int _i = 0; _i < 2; ++_i) \
        __builtin_amdgcn_global_load_lds((const unsigned*)((const char*)(gbase) + (voff)[_i]), (PG8_LAS unsigned*)(lds + (bufoff) + ldsw + _i * 8192), 16, 0, 0); } while (0)
#define PG8_LDA(dst, b, h) do { _Pragma("unroll") for (int m = 0; m < 4; ++m) _Pragma("unroll") for (int k = 0; k < 2; ++k) dst[m][k] = *(const PG8_LAS bf16x8*)(lds + PG8_SA(b, h) + aoff + m * 2048 + k * 1024); } while (0)
#define PG8_LDB(dst, b, h) do { _Pragma("unroll") for (int n = 0; n < 2; ++n) _Pragma("unroll") for (int k = 0; k < 2; ++k) dst[n][k] = *(const PG8_LAS bf16x8*)(lds + PG8_SB(b, h) + boff + n * 2048 + k * 1024); } while (0)
#define PG8_MMA(ai, bj, At, Bt) do { __builtin_amdgcn_s_setprio(1); _Pragma("unroll") for (int m = 0; m < 4; ++m) _Pragma("unroll") for (int n = 0; n < 2; ++n) _Pragma("unroll") for (int k = 0; k < 2; ++k) \
        acc[ai][bj][m][n] = __builtin_amdgcn_mfma_f32_16x16x32_bf16(Bt[n][k], At[m][k], acc[ai][bj][m][n], 0, 0, 0); __builtin_amdgcn_s_setprio(0); } while (0)
#define PG8_WAIT_V(n) asm volatile("s_waitcnt vmcnt(" #n ")" ::: "memory")
#define PG8_WAIT_L(n) asm volatile("s_waitcnt lgkmcnt(" #n ")" ::: "memory")
#define PG8_BAR __builtin_amdgcn_s_barrier()
#define PG8_SCHED __builtin_amdgcn_sched_barrier(0)
    Unit cur, nxt; int ui = 0;
    if (!S.next(0, cur)) return;
    f32x4 acc[2][2][4][2];
#pragma unroll
    for (int a = 0; a < 2; ++a)
#pragma unroll
        for (int b = 0; b < 2; ++b)
#pragma unroll
            for (int m = 0; m < 4; ++m)
#pragma unroll
                for (int n = 0; n < 2; ++n) acc[a][b][m][n] = (f32x4){0.f, 0.f, 0.f, 0.f};
    bf16x8 At[4][2], B0[2][2], B1[2][2];
    const char* cA = (const char*)g.A + (size_t)cur.pm * tstep + (size_t)cur.br * g.abr; const char* cB = (const char*)g.Bt + (size_t)cur.pn * tstep + (size_t)cur.br * g.bbr;
    if constexpr (SP2) {
        PG8_STAGE(PG8_SB(0, 0), cB, voffB); PG8_STAGE(PG8_SB(0, 1), cB + hstep, voffB); PG8_STAGE(PG8_SA(0, 0), cA, voffA); PG8_STAGE(PG8_SA(0, 1), cA + hstep, voffA);
        if (wr == 1) PG8_BAR;
        PG8_WAIT_V(2); PG8_BAR;
        PG8_STAGE(PG8_SB(1, 0), cB + kstep, voffB); PG8_STAGE(PG8_SA(1, 0), cA + kstep, voffA); PG8_STAGE(PG8_SB(1, 1), cB + hstep + kstep, voffB);
        PG8_WAIT_V(6); PG8_BAR;
    } else {
        PG8_STAGE(PG8_SB(0, 0), cB, voffB); PG8_STAGE(PG8_SA(0, 0), cA, voffA); PG8_STAGE(PG8_SB(0, 1), cB + hstep, voffB); PG8_STAGE(PG8_SA(0, 1), cA + hstep, voffA);
        if (wr == 1) PG8_BAR;
        PG8_WAIT_V(4); PG8_BAR;
        PG8_STAGE(PG8_SB(1, 0), cB + kstep, voffB); PG8_STAGE(PG8_SA(1, 0), cA + kstep, voffA); PG8_STAGE(PG8_SB(1, 1), cB + hstep + kstep, voffB);
        PG8_WAIT_V(6); PG8_BAR;
    }
    for (;;) {
        const bool has_next = S.next(ui + 1, nxt);
        const char* nA = has_next ? (const char*)g.A + (size_t)nxt.pm * tstep + (size_t)nxt.br * g.abr : cA;
        const char* nB = has_next ? (const char*)g.Bt + (size_t)nxt.pn * tstep + (size_t)nxt.br * g.bbr : cB;
        for (int t = 0; t < nt; t += 2) {
            const bool last = (t == nt - 2);
            const char* a1 = cA + (size_t)(t + 1) * kstep;
            const char* a2 = last ? nA : cA + (size_t)(t + 2) * kstep; const char* b2 = last ? nB : cB + (size_t)(t + 2) * kstep;
            const char* a3 = a2 + kstep; const char* b3 = b2 + kstep;
            if constexpr (SP2) {
            PG8_LDB(B0, 0, 0); PG8_LDB(B1, 0, 1); PG8_SCHED; PG8_LDA(At, 0, 0); PG8_STAGE(PG8_SA(1, 1), a1 + hstep, voffA);
            PG8_WAIT_V(8); PG8_WAIT_L(0); PG8_BAR; PG8_MMA(0, 0, At, B0); PG8_MMA(0, 1, At, B1); PG8_BAR; PG8_SCHED;
            PG8_LDA(At, 0, 1); PG8_STAGE(PG8_SB(0, 0), b2, voffB); PG8_STAGE(PG8_SB(0, 1), b2 + hstep, voffB); PG8_STAGE(PG8_SA(0, 0), a2, voffA);
            PG8_WAIT_V(8); PG8_WAIT_L(0); PG8_BAR; PG8_MMA(1, 0, At, B0); PG8_MMA(1, 1, At, B1); PG8_BAR; PG8_SCHED;
            PG8_LDB(B0, 1, 0); PG8_LDB(B1, 1, 1); PG8_SCHED; PG8_LDA(At, 1, 0); PG8_STAGE(PG8_SA(0, 1), a2 + hstep, voffA);
            PG8_WAIT_V(8); PG8_WAIT_L(0); PG8_BAR; PG8_MMA(0, 0, At, B0); PG8_MMA(0, 1, At, B1); PG8_BAR; PG8_SCHED;
            PG8_LDA(At, 1, 1); PG8_STAGE(PG8_SB(1, 0), b3, voffB); PG8_STAGE(PG8_SB(1, 1), b3 + hstep, voffB); PG8_STAGE(PG8_SA(1, 0), a3, voffA);
            PG8_WAIT_V(8); PG8_WAIT_L(0); PG8_BAR; PG8_MMA(1, 0, At, B0); PG8_MMA(1, 1, At, B1); PG8_BAR; PG8_SCHED;
            } else {
            PG8_LDB(B0, 0, 0); PG8_SCHED; PG8_LDA(At, 0, 0); PG8_STAGE(PG8_SA(1, 1), a1 + hstep, voffA);
            PG8_WAIT_L(8); PG8_BAR; PG8_WAIT_L(0); PG8_MMA(0, 0, At, B0); PG8_BAR; PG8_SCHED;
            PG8_LDB(B1, 0, 1); PG8_STAGE(PG8_SB(0, 0), b2, voffB);
            PG8_BAR; PG8_WAIT_L(0); PG8_MMA(0, 1, At, B1); PG8_BAR;
            PG8_LDA(At, 0, 1); PG8_STAGE(PG8_SA(0, 0), a2, voffA);
            PG8_BAR; PG8_WAIT_L(0); PG8_MMA(1, 0, At, B0); PG8_BAR; PG8_SCHED;
            PG8_STAGE(PG8_SB(0, 1), b2 + hstep, voffB);
            PG8_WAIT_V(6); PG8_BAR; PG8_MMA(1, 1, At, B1); PG8_BAR;
            PG8_LDB(B0, 1, 0); PG8_SCHED; PG8_LDA(At, 1, 0); PG8_STAGE(PG8_SA(0, 1), a2 + hstep, voffA);
            PG8_WAIT_L(8); PG8_BAR; PG8_WAIT_L(0); PG8_MMA(0, 0, At, B0); PG8_BAR; PG8_SCHED;
            PG8_LDB(B1, 1, 1); PG8_STAGE(PG8_SB(1, 0), b3, voffB);
            PG8_BAR; PG8_WAIT_L(0); PG8_MMA(0, 1, At, B1); PG8_BAR;
            PG8_LDA(At, 1, 1); PG8_STAGE(PG8_SA(1, 0), a3, voffA);
            PG8_BAR; PG8_WAIT_L(0); PG8_MMA(1, 0, At, B0); PG8_BAR; PG8_SCHED;
            PG8_STAGE(PG8_SB(1, 1), b3 + hstep, voffB);
            PG8_WAIT_V(6); PG8_BAR; PG8_MMA(1, 1, At, B1); PG8_BAR;
            }
        }
        if constexpr (ALIGN_EPI) { if (wr == 0) PG8_BAR; }
        E(acc, cur, wr, wc, fr, fq);
        if (!has_next) break;
#pragma unroll
        for (int a = 0; a < 2; ++a)
#pragma unroll
            for (int b = 0; b < 2; ++b)
#pragma unroll
                for (int m = 0; m < 4; ++m)
#pragma unroll
                    for (int n = 0; n < 2; ++n) acc[a][b][m][n] = (f32x4){0.f, 0.f, 0.f, 0.f};
        cur = nxt; cA = nA; cB = nB; ++ui;
        if constexpr (ALIGN_EPI) { if (wr == 1) PG8_BAR; }
    }
    PG8_WAIT_V(0);
    if constexpr (!ALIGN_EPI) { if (wr == 0) PG8_BAR; }
    PG8_BAR;
#undef PG8_SA
#undef PG8_SB
#undef PG8_STAGE
#undef PG8_LDA
#undef PG8_LDB
#undef PG8_MMA
#undef PG8_WAIT_V
#undef PG8_WAIT_L
#undef PG8_BAR
#undef PG8_SCHED
}
}

struct Args { const float* in[22]; float* out; unsigned char* ws; };

__device__ __forceinline__ void transpose_item(const float* W, int ldw, int col_off, int K, int N, bf16_t* WT, LAS float* scr, int item, int lane) {
    const int nblk = N / 64, kb = item / nblk, nb = item % nblk, k0 = 64 * kb, n0 = 64 * nb;
    const int r = lane >> 4, c4 = lane & 15;
    f32x4 v[16];
#pragma unroll
    for (int i = 0; i < 16; ++i) v[i] = *(const f32x4*)(W + (size_t)(k0 + 4 * i + r) * ldw + col_off + n0 + 4 * c4);
#pragma unroll
    for (int i = 0; i < 16; ++i) { LAS float* d = scr + (4 * i + r) * 65 + 4 * c4; d[0] = v[i].x; d[1] = v[i].y; d[2] = v[i].z; d[3] = v[i].w; }
    asm volatile("s_waitcnt lgkmcnt(0)" ::: "memory");
    const int c = lane & 7;
#pragma unroll
    for (int j = 0; j < 8; ++j) { const int n = (lane >> 3) + 8 * j; const LAS float* s = scr + (8 * c) * 65 + n;
        u32x4 o; o.x = cvt_pk_bf16(s[0 * 65], s[1 * 65]); o.y = cvt_pk_bf16(s[2 * 65], s[3 * 65]); o.z = cvt_pk_bf16(s[4 * 65], s[5 * 65]); o.w = cvt_pk_bf16(s[6 * 65], s[7 * 65]);
        *(u32x4*)(WT + (size_t)(n0 + n) * K + k0 + 8 * c) = o; }
    asm volatile("s_waitcnt lgkmcnt(0)" ::: "memory");
}

__device__ __forceinline__ void s5_tables(LAS unsigned char* lds, const Args& a, int l, int g, int qt, int tid) {
    LAS f32x2* AP = (LAS f32x2*)lds;
    LAS f32x2* BB = AP + 65 * 64;
    LAS f32x2* CC = BB + 64 * 16;
    const int lg = l * 32 + g;
    const float* are = a.in[4] + lg * 64; const float* aim = a.in[5] + lg * 64;
    const float dt = expf(a.in[6][lg]);
    unsigned char* tab = a.ws + WS_S5 + (size_t)l * S5_LAYER;
    for (int idx = tid; idx < 65 * 64; idx += 512) {
        const int d = idx >> 6, p = idx & 63;
        const float lr = fminf(are[p], -1e-4f), li = aim[p];
        const float mag = expf(lr * dt * (float)d);
        double rev = (double)li * (double)dt * (double)d * 0.15915494309189535;
        rev -= floor(rev); if (rev > 0.5) rev -= 1.0;
        const float th = (float)(rev * 6.283185307179586);
        AP[idx] = (f32x2){mag * cosf(th), mag * sinf(th)};
    }
    for (int idx = tid; idx < 1024; idx += 512) CC[idx] = (f32x2){a.in[9][(size_t)lg * 1024 + idx], a.in[10][(size_t)lg * 1024 + idx]};
    for (int idx = tid; idx < 1024; idx += 512) {
        const int p = idx >> 4;
        const float lr = fminf(are[p], -1e-4f), li = aim[p];
        double rev = (double)li * (double)dt * 0.15915494309189535;
        rev -= floor(rev); if (rev > 0.5) rev -= 1.0;
        const float th = (float)(rev * 6.283185307179586);
        const float em1 = expm1f(lr * dt), c = cosf(th), s = sinf(th), sh = sinf(0.5f * th);
        const float nr = em1 * c - 2.f * sh * sh, ni = (1.f + em1) * s;
        const float den = 1.f / (lr * lr + li * li);
        const float qr = (nr * lr + ni * li) * den, qi = (ni * lr - nr * li) * den;
        const float br = a.in[7][(size_t)lg * 1024 + idx], bi = a.in[8][(size_t)lg * 1024 + idx];
        BB[idx] = (f32x2){qr * br - qi * bi, qr * bi + qi * br};
    }
    __syncthreads();
    bf16_t* kt = (bf16_t*)(tab + S5_KT) + (size_t)g * (65 * 256);
    if (tid < 256) { const int s = qt * 256 + tid;
        const int d = s >> 4, h = s & 15;
        float acc[16];
#pragma unroll
        for (int i = 0; i < 16; ++i) acc[i] = 0.f;
        for (int p = 0; p < 64; ++p) {
            const f32x2 cc = CC[h * 64 + p], ap = AP[d * 64 + p];
            const float cr = cc.x * ap.x - cc.y * ap.y, ci = cc.x * ap.y + cc.y * ap.x;
#pragma unroll
            for (int i = 0; i < 16; ++i) { const f32x2 bb = BB[p * 16 + i]; acc[i] += cr * bb.x - ci * bb.y; }
        }
        if (d == 0) { const float dsk = a.in[11][lg * 16 + h];
#pragma unroll
            for (int i = 0; i < 16; ++i) if (i == h) acc[i] += dsk; }
        u32x4 o0, o1;
        o0.x = cvt_pk_bf16(acc[0], acc[1]); o0.y = cvt_pk_bf16(acc[2], acc[3]); o0.z = cvt_pk_bf16(acc[4], acc[5]); o0.w = cvt_pk_bf16(acc[6], acc[7]);
        o1.x = cvt_pk_bf16(acc[8], acc[9]); o1.y = cvt_pk_bf16(acc[10], acc[11]); o1.z = cvt_pk_bf16(acc[12], acc[13]); o1.w = cvt_pk_bf16(acc[14], acc[15]);
        bf16_t* dst = kt + (size_t)(63 - d) * 256 + h * 8;
        *(u32x4*)dst = o0; *(u32x4*)(dst + 128) = o1;
    }
    if (qt == 0 && tid >= 256 && tid < 288) ((u32x4*)(kt + 64 * 256))[tid - 256] = (u32x4){0u, 0u, 0u, 0u};
    bf16_t* we = (bf16_t*)(tab + S5_WE) + (size_t)g * 128 * 1024;
    for (int idx = qt * 4096 + tid; idx < (qt + 1) * 4096; idx += 512) {
        const int half = idx & 1, j = (idx >> 1) & 63, row = idx >> 7, p = row & 63, im = row >> 6;
        const f32x2 ap = AP[(63 - j) * 64 + p];
        float v[8];
#pragma unroll
        for (int i = 0; i < 8; ++i) { const f32x2 bb = BB[p * 16 + 8 * half + i]; v[i] = im ? (ap.x * bb.y + ap.y * bb.x) : (ap.x * bb.x - ap.y * bb.y); }
        u32x4 o; o.x = cvt_pk_bf16(v[0], v[1]); o.y = cvt_pk_bf16(v[2], v[3]); o.z = cvt_pk_bf16(v[4], v[5]); o.w = cvt_pk_bf16(v[6], v[7]);
        *(u32x4*)(we + (size_t)row * 1024 + j * 16 + 8 * half) = o;
    }
    bf16_t* wc = (bf16_t*)(tab + S5_WC) + (size_t)g * 1024 * 128;
    for (int idx = qt * 4096 + tid; idx < (qt + 1) * 4096; idx += 512) {
        const int kgp = idx & 15, rowi = idx >> 4, t = rowi >> 4, h = rowi & 15, im = kgp >> 3, p0 = (kgp & 7) * 8;
        float v[8];
#pragma unroll
        for (int i = 0; i < 8; ++i) { const f32x2 cc = CC[h * 64 + p0 + i], ap = AP[(t + 1) * 64 + p0 + i];
            v[i] = im ? -(cc.x * ap.y + cc.y * ap.x) : (cc.x * ap.x - cc.y * ap.y); }
        u32x4 o; o.x = cvt_pk_bf16(v[0], v[1]); o.y = cvt_pk_bf16(v[2], v[3]); o.z = cvt_pk_bf16(v[4], v[5]); o.w = cvt_pk_bf16(v[6], v[7]);
        *(u32x4*)(wc + (size_t)rowi * 128 + kgp * 8) = o;
    }
    if (qt == 1 && tid < 64) {
        ((f32x2*)(tab + S5_A64))[g * 64 + tid] = AP[64 * 64 + tid];
        const int k = tid & 15, kg = tid >> 4; const float* wg = a.in[12] + (size_t)lg * 256;
        u32x4 o; o.x = cvt_pk_bf16(wg[(4 * kg + 0) * 16 + k], wg[(4 * kg + 1) * 16 + k]); o.y = cvt_pk_bf16(wg[(4 * kg + 2) * 16 + k], wg[(4 * kg + 3) * 16 + k]); o.z = 0u; o.w = 0u;
        ((u32x4*)(tab + S5_GLU))[g * 64 + tid] = o;
    }
    __syncthreads();
}

struct NormArgs { const float* resid; const bf16_t* add; const float* g_add; float* xout; const float* g_xn; bf16_t* xn; const float* wf; const float* bfh; float* logf; };
__device__ __forceinline__ void norm_phase(LAS unsigned char* lds, const NormArgs n, int gw, int ngw, int lane, int tid) {
    if (n.wf) {
        for (int i = tid; i < 2048; i += 512) { const int d = i >> 1, hh = i & 1; const f32x4 v = *(const f32x4*)(n.wf + (size_t)d * INW + 4 * hh);
            const int k = 4 * (d >> 8) + (d & 3), ln = (d >> 2) & 63;
            *(LAS f32x4*)(lds + ((k * 2 + hh) * 64 + ln) * 16) = v; }
        __syncthreads();
    }
    f32x4 ga[4], gx[4];
#pragma unroll
    for (int j = 0; j < 4; ++j) { ga[j] = n.add ? *(const f32x4*)(n.g_add + 4 * lane + 256 * j) : (f32x4){0.f, 0.f, 0.f, 0.f}; gx[j] = n.xn ? *(const f32x4*)(n.g_xn + 4 * lane + 256 * j) : (f32x4){0.f, 0.f, 0.f, 0.f}; }
    for (int rbase = gw; rbase < M; rbase += 2 * ngw) {
        f32x4 v[2][4]; f32x4 av[2][4];
#pragma unroll
        for (int rr = 0; rr < 2; ++rr) { const size_t row = (size_t)rbase + (size_t)rr * ngw;
#pragma unroll
            for (int j = 0; j < 4; ++j) v[rr][j] = *(const f32x4*)(n.resid + row * DM + 4 * lane + 256 * j);
            if (n.add) {
#pragma unroll
                for (int j = 0; j < 4; ++j) { const u32x2 u = *(const u32x2*)(n.add + row * DM + 4 * lane + 256 * j); av[rr][j] = (f32x4){bf_lo(u.x), bf_hi(u.x), bf_lo(u.y), bf_hi(u.y)}; }
            }
        }
#pragma unroll
        for (int rr = 0; rr < 2; ++rr) { const size_t row = (size_t)rbase + (size_t)rr * ngw;
            if (n.add) {
                float ss = 0.f;
#pragma unroll
                for (int j = 0; j < 4; ++j) ss += (av[rr][j].x * av[rr][j].x + av[rr][j].y * av[rr][j].y) + (av[rr][j].z * av[rr][j].z + av[rr][j].w * av[rr][j].w);
                const float rs = rsqrtf(wave_sum(ss) * (1.f / DM) + EPS);
#pragma unroll
                for (int j = 0; j < 4; ++j) v[rr][j] = v[rr][j] + av[rr][j] * rs * ga[j];
            }
            if (n.xout) {
#pragma unroll
                for (int j = 0; j < 4; ++j) *(f32x4*)(n.xout + row * DM + 4 * lane + 256 * j) = v[rr][j];
            }
            if (n.xn) {
                float ss = 0.f;
#pragma unroll
                for (int j = 0; j < 4; ++j) ss += (v[rr][j].x * v[rr][j].x + v[rr][j].y * v[rr][j].y) + (v[rr][j].z * v[rr][j].z + v[rr][j].w * v[rr][j].w);
                const float rs = rsqrtf(wave_sum(ss) * (1.f / DM) + EPS);
                f32x4 hn[4];
#pragma unroll
                for (int j = 0; j < 4; ++j) { hn[j] = v[rr][j] * rs * gx[j]; u32x2 o; o.x = cvt_pk_bf16(hn[j].x, hn[j].y); o.y = cvt_pk_bf16(hn[j].z, hn[j].w);
                    *(u32x2*)(n.xn + row * DM + 4 * lane + 256 * j) = o; }
                if (n.wf) {
                    f32x4 f0 = (f32x4){0.f, 0.f, 0.f, 0.f}, f1 = f0;
#pragma unroll
                    for (int j = 0; j < 4; ++j)
#pragma unroll
                        for (int i = 0; i < 4; ++i) { const LAS unsigned char* wp = lds + (((4 * j + i) * 2) * 64 + lane) * 16;
                            const f32x4 w0 = *(const LAS f32x4*)wp, w1 = *(const LAS f32x4*)(wp + 1024); f0 = f0 + w0 * hn[j][i]; f1 = f1 + w1 * hn[j][i]; }
                    float z = 0.f;
#pragma unroll
                    for (int hh = 0; hh < 4; ++hh) { const float s0 = wave_sum(f0[hh]), s1 = wave_sum(f1[hh]); if (lane == hh) z = s0; if (lane == hh + 4) z = s1; }
                    if (lane < 8) { z += n.bfh[lane]; n.logf[row * 8 + lane] = fminf(z, 0.f) - log1pf(expf(-fabsf(z))); }
                }
            }
        }
    }
}

__device__ __forceinline__ void cum_scan(LAS unsigned char* lds, const float* logf, float* cum, int bh, int tid, int lane, int w) {
    LAS float* ws = (LAS float*)lds;
    const int b = bh >> 3, h = bh & 7;
    float v[8]; float run = 0.f;
#pragma unroll
    for (int i = 0; i < 8; ++i) { run += logf[((size_t)b * SEQ + 8 * tid + i) * 8 + h]; v[i] = run; }
    float inc = run;
#pragma unroll
    for (int o = 1; o < 64; o <<= 1) { const float t = __int_as_float(__builtin_amdgcn_ds_bpermute((lane - o) << 2, __float_as_int(inc))); if (lane >= o) inc += t; }
    if (lane == 63) ws[w] = inc;
    __syncthreads();
    float base = inc - run;
    for (int i = 0; i < w; ++i) base += ws[i];
#pragma unroll
    for (int i = 0; i < 8; ++i) cum[(size_t)bh * SEQ + 8 * tid + i] = (base + v[i]) * LOG2E;
    __syncthreads();
}

#define MFMA16(a, b, c) __builtin_amdgcn_mfma_f32_16x16x32_bf16((a), (b), (c), 0, 0, 0)
#define MFMA32(a, b, c) __builtin_amdgcn_mfma_f32_32x32x16_bf16((a), (b), (c), 0, 0, 0)
__device__ __forceinline__ bf16x8 ldg16(const void* ubase, unsigned off) { return *(const bf16x8*)((const char*)ubase + off); }
__device__ __forceinline__ void s5_unit(LAS unsigned char* lds, const bf16_t* P, const unsigned char* tab, bf16_t* Ya, const int b, const int g, int tid, int lane, int w) {
    LAS unsigned char* KT = lds; LAS float* EL = (LAS float*)(lds + 33280); LAS unsigned char* SPT = lds + 66560;
    const unsigned char* ktab = tab + S5_KT + (size_t)g * KT_BYTES;
    const int n = lane & 15, kg = lane >> 4, ntile = w & 3, wh = w >> 2;
    const bf16_t* WEu = (const bf16_t*)(tab + S5_WE) + (size_t)g * 128 * 1024 + (size_t)(64 * wh) * 1024;
    const bf16_t* WCu = (const bf16_t*)(tab + S5_WC) + (size_t)g * 1024 * 128 + (size_t)(wh * 16) * 128;
    const bf16_t* Uu = P + ((size_t)b * SEQ + (size_t)(16 * ntile) * 64) * NA + 16 * g;
    const unsigned uoff = (unsigned)((n * 64 + (kg >> 1)) * NA + 8 * (kg & 1)) * 2u;
    const unsigned weoff = (unsigned)(n * 1024 + 8 * kg) * 2u;
    const unsigned wcoff = (unsigned)(n * 128 + 8 * kg) * 2u;
    for (int i = tid; i < KT_BYTES / 16; i += 512) *(LAS u32x4*)(KT + i * 16) = *(const u32x4*)(ktab + i * 16);
    {
        f32x4 e[4];
#pragma unroll
        for (int mt = 0; mt < 4; ++mt) e[mt] = (f32x4){0.f, 0.f, 0.f, 0.f};
        bf16x8 eb[4], ea[4][4];
#define S5_ELD(ks) do { eb[(ks) & 3] = ldg16(Uu + (size_t)(2 * (ks)) * NA, uoff); _Pragma("unroll") for (int _m = 0; _m < 4; ++_m) ea[(ks) & 3][_m] = ldg16(WEu + (size_t)(16 * _m) * 1024 + 32 * (ks), weoff); } while (0)
        S5_ELD(0); S5_ELD(1); S5_ELD(2);
        __builtin_amdgcn_sched_barrier(0);
#pragma unroll
        for (int ks = 0; ks < 32; ++ks) {
            if (ks + 3 < 32) S5_ELD(ks + 3);
#pragma unroll
            for (int mt = 0; mt < 4; ++mt) e[mt] = MFMA16(ea[ks & 3][mt], eb[ks & 3], e[mt]);
            __builtin_amdgcn_sched_barrier(0);
        }
#undef S5_ELD
#pragma unroll
        for (int mt = 0; mt < 4; ++mt)
#pragma unroll
            for (int i = 0; i < 4; ++i) EL[(64 * wh + 16 * mt + 4 * kg + i) * 65 + 16 * ntile + n] = e[mt][i];
    }
    __syncthreads();
    {
        const int p = tid & 63, seg = tid >> 6;
        const f32x2 a1 = ((const f32x2*)(tab + S5_A64))[g * 64 + p];
        float lr[8], li[8]; float sr = 0.f, si = 0.f;
#pragma unroll
        for (int j = 0; j < 8; ++j) { const float er = EL[p * 65 + 8 * seg + j], ei = EL[(64 + p) * 65 + 8 * seg + j];
            const float nr = a1.x * sr - a1.y * si + er, ni = a1.x * si + a1.y * sr + ei; sr = nr; si = ni; lr[j] = sr; li[j] = si; }
        LAS f32x2* TT = (LAS f32x2*)(lds + 66560 + 17408);
        TT[seg * 64 + p] = (f32x2){sr, si};
        f32x2 a2 = {a1.x * a1.x - a1.y * a1.y, 2.f * a1.x * a1.y}; f32x2 a4 = {a2.x * a2.x - a2.y * a2.y, 2.f * a2.x * a2.y}; const f32x2 a8 = {a4.x * a4.x - a4.y * a4.y, 2.f * a4.x * a4.y};
        __syncthreads();
        float cr = 0.f, ci = 0.f;
        for (int s2 = 0; s2 < seg; ++s2) { const f32x2 t = TT[s2 * 64 + p]; const float nr = a8.x * cr - a8.y * ci + t.x, ni = a8.x * ci + a8.y * cr + t.y; cr = nr; ci = ni; }
        float pr = cr, pi = ci, wr_ = cr, wi_ = ci;
#pragma unroll
        for (int j = 0; j < 8; ++j) {
            *(LAS bf16_t*)(SPT + (8 * seg + j) * 272 + 2 * p) = (bf16_t)(cvt_pk_bf16(pr, 0.f) & 0xffffu);
            *(LAS bf16_t*)(SPT + (8 * seg + j) * 272 + 2 * (64 + p)) = (bf16_t)(cvt_pk_bf16(pi, 0.f) & 0xffffu);
            const float nr = a1.x * wr_ - a1.y * wi_, ni = a1.x * wi_ + a1.y * wr_; wr_ = nr; wi_ = ni;
            pr = lr[j] + wr_; pi = li[j] + wi_;
        }
    }
    __syncthreads();
    const LAS unsigned char* klow = KT + (1 - wh + (lane >> 5)) * 512 + ((lane >> 4) & 1) * 256 + (lane & 15) * 16;
    const LAS unsigned char* spb = SPT + (16 * ntile + n) * 272 + 16 * kg;
    const bf16x8 aglu = *(const bf16x8*)(tab + S5_GLU + (size_t)(g * 64 + lane) * 16);
    const unsigned yoff = (unsigned)(n * 64 * YW + 4 * kg) * 2u;
#pragma unroll 1
    for (int pass = 0; pass < 2; ++pass) {
        f32x4 acc[16];
#pragma unroll
        for (int i = 0; i < 16; ++i) acc[i] = (f32x4){0.f, 0.f, 0.f, 0.f};
        bf16x8 bq[4], ca[2][4], bt[8], bu[8];
        const bf16_t* Up = Uu + (size_t)(32 * pass) * NA;
        const bf16_t* WCp = WCu + (size_t)(32 * pass) * 2048;
#define S5_LDC(st, slot) do { _Pragma("unroll") for (int _q = 0; _q < 4; ++_q) ca[slot][_q] = ldg16(WCp + (size_t)(2 * (4 * ((st) & 3) + _q)) * 2048 + 32 * ((st) >> 2), wcoff); } while (0)
#pragma unroll
        for (int jj = 0; jj < 8; ++jj) bt[jj] = ldg16(Up + (size_t)(2 * jj) * NA, uoff);
        S5_LDC(0, 0); S5_LDC(1, 1);
        if (pass == 1) {
            bq[0] = ldg16(Uu, uoff); bq[1] = ldg16(Uu + (size_t)2 * NA, uoff); bq[2] = ldg16(Uu + (size_t)4 * NA, uoff);
            __builtin_amdgcn_sched_barrier(0);
#pragma unroll
            for (int jj = 0; jj < 16; ++jj) {
                if (jj + 3 < 16) bq[(jj + 3) & 3] = ldg16(Uu + (size_t)(2 * (jj + 3)) * NA, uoff);
#pragma unroll
                for (int ii = 0; ii < 16; ++ii) { const bf16x8 af = *(const LAS bf16x8*)(klow + (30 - 2 * (ii - jj)) * 512); acc[ii] = MFMA16(af, bq[jj & 3], acc[ii]); }
                __builtin_amdgcn_sched_barrier(0);
            }
        }
        __builtin_amdgcn_sched_barrier(0);
#pragma unroll
        for (int jj = 0; jj < 16; ++jj) {
            const bf16x8 cb = *(const LAS bf16x8*)(spb + 64 * (jj >> 2));
            if (jj < 8) bu[jj] = ldg16(Up + (size_t)(2 * (jj + 8)) * NA, uoff);
#pragma unroll
            for (int ii = 0; ii < 16; ++ii) if (ii >= jj) { const bf16x8 af = *(const LAS bf16x8*)(klow + (62 - 2 * (ii - jj)) * 512); acc[ii] = MFMA16(af, (jj < 8 ? bt[jj & 7] : bu[jj & 7]), acc[ii]); }
#pragma unroll
            for (int q = 0; q < 4; ++q) acc[4 * (jj & 3) + q] = MFMA16(ca[jj & 1][q], cb, acc[4 * (jj & 3) + q]);
            __builtin_amdgcn_sched_barrier(0);
            if (jj + 2 < 16) S5_LDC(jj + 2, jj & 1);
            __builtin_amdgcn_sched_barrier(0);
        }
#undef S5_LDC
        bf16_t* Yu = Ya + ((size_t)b * SEQ + (size_t)(16 * ntile) * 64 + wh + 32 * pass) * YW + 16 * g;
#pragma unroll
        for (int ii = 0; ii < 16; ++ii) {
            f32x4 y;
#pragma unroll
            for (int k = 0; k < 4; ++k) y[k] = gelu_tanh(acc[ii][k]);
            u32x4 bp; bp.x = cvt_pk_bf16(y[0], y[1]); bp.y = cvt_pk_bf16(y[2], y[3]); bp.z = 0u; bp.w = 0u;
            const f32x4 z = MFMA16(aglu, __builtin_bit_cast(bf16x8, bp), ((f32x4){0.f, 0.f, 0.f, 0.f}));
            u32x2 o; o.x = cvt_pk_bf16(y[0] * sigmoid_f(z[0]), y[1] * sigmoid_f(z[1])); o.y = cvt_pk_bf16(y[2] * sigmoid_f(z[2]), y[3] * sigmoid_f(z[3]));
            *(u32x2*)((char*)(Yu + (size_t)(2 * ii) * YW) + yoff) = o;
        }
    }
    __syncthreads();
}

constexpr int AT_KS = 0, AT_VT = 9216, AT_VP = 192, AT_BS = 9216 + 64 * AT_VP, AT_BUF = AT_BS + 256;
__device__ __forceinline__ int crow(int r, int hi) { return (r & 3) + 8 * (r >> 2) + 4 * hi; }
__device__ __forceinline__ void attn_unit(LAS unsigned char* lds, const bf16_t* P, const float* cum, bf16_t* Yc, const int b, const int h, const int qb, int tid, int lane, int w) {
    const int r32 = lane & 31, hi = lane >> 5;
    const size_t row0 = (size_t)b * SEQ;
    const int q0 = qb * 256, qrow = q0 + 32 * w + r32;
    bf16x8 qf[4];
    { const bf16_t* qp = P + (row0 + qrow) * NA + COL_Q + 64 * h + 8 * hi;
#pragma unroll
      for (int s = 0; s < 4; ++s) qf[s] = *(const bf16x8*)(qp + 16 * s); }
    const float* cumbh = cum + (size_t)(b * 8 + h) * SEQ;
    const float ref = cumbh[q0];
    const int vlane = (4 * hi + ((lane & 15) >> 2)) * AT_VP + 32 * ((lane >> 4) & 1) + 8 * (lane & 3);
    const int skey = tid >> 3, spc = tid & 7;
    const bf16_t* kgp = P + (row0 + skey) * NA + COL_K + 64 * h + 8 * spc;
    const int NT = 4 * qb + 4;
    u32x4 kreg = *(const u32x4*)kgp, vreg = *(const u32x4*)(kgp + (COL_V - COL_K)); float breg = 0.f; if (tid < 64) breg = ref - cumbh[tid];
#define AT_WRITE(bufp) do { LAS unsigned char* _b = (bufp); *(LAS u32x4*)(_b + AT_KS + skey * 144 + 16 * spc) = kreg; \
        *(LAS u32x4*)(_b + AT_VT + skey * AT_VP + 16 * spc) = vreg; \
        if (tid < 64) *(LAS float*)(_b + AT_BS + 4 * tid) = breg; } while (0)
    AT_WRITE(lds);
    __syncthreads();
    float mrun = -1e30f, lrun = 0.f; f32x16 o0, o1;
#pragma unroll
    for (int r = 0; r < 16; ++r) { o0[r] = 0.f; o1[r] = 0.f; }
    for (int kt = 0; kt < NT; ++kt) {
        const int cur = kt & 1; const bool more = (kt + 1 < NT);
        if (more) { const bf16_t* kp = kgp + (size_t)(kt + 1) * 64 * NA; kreg = *(const u32x4*)kp; vreg = *(const u32x4*)(kp + (COL_V - COL_K)); if (tid < 64) breg = ref - cumbh[64 * (kt + 1) + tid]; }
        if (64 * kt <= q0 + 32 * w + 31) {
            const LAS unsigned char* Kb = lds + cur * AT_BUF + AT_KS; const LAS unsigned char* Vb = lds + cur * AT_BUF + AT_VT; const LAS unsigned char* Bb = lds + cur * AT_BUF + AT_BS;
            f32x16 p[2];
#pragma unroll
            for (int rb = 0; rb < 2; ++rb) {
                f32x16 c;
#pragma unroll
                for (int g4 = 0; g4 < 4; ++g4) { const f32x4 bv = *(const LAS f32x4*)(Bb + (32 * rb + 8 * g4 + 4 * hi) * 4); c[4 * g4 + 0] = bv.x; c[4 * g4 + 1] = bv.y; c[4 * g4 + 2] = bv.z; c[4 * g4 + 3] = bv.w; }
#pragma unroll
                for (int s = 0; s < 4; ++s) { const bf16x8 af = *(const LAS bf16x8*)(Kb + (32 * rb + r32) * 144 + 32 * s + 16 * hi); c = MFMA32(af, qf[s], c); }
                p[rb] = c;
            }
            if (64 * kt + 63 > q0 + 32 * w) {
#pragma unroll
                for (int rb = 0; rb < 2; ++rb)
#pragma unroll
                    for (int r = 0; r < 16; ++r) { const int key = 64 * kt + 32 * rb + crow(r, hi); if (key > qrow) p[rb][r] = -1e30f; }
            }
            float mt = p[0][0];
#pragma unroll
            for (int r = 1; r < 16; ++r) mt = fmaxf(mt, p[0][r]);
#pragma unroll
            for (int r = 0; r < 16; ++r) mt = fmaxf(mt, p[1][r]);
            mt = half_max(mt);
            const float mnew = fmaxf(mrun, mt), alpha = fast_exp2(mrun - mnew);
            mrun = mnew;
            float ls = 0.f;
#pragma unroll
            for (int rb = 0; rb < 2; ++rb)
#pragma unroll
                for (int r = 0; r < 16; ++r) { p[rb][r] = fast_exp2(p[rb][r] - mnew); ls += p[rb][r]; }
            lrun = lrun * alpha + ls;
#pragma unroll
            for (int r = 0; r < 16; ++r) { o0[r] *= alpha; o1[r] *= alpha; }
            bf16x8 pf[4];
#pragma unroll
            for (int s = 0; s < 4; ++s) { const int rb = s >> 1, r0 = 8 * (s & 1); u32x4 pk; pk.x = cvt_pk_bf16(p[rb][r0 + 0], p[rb][r0 + 1]); pk.y = cvt_pk_bf16(p[rb][r0 + 2], p[rb][r0 + 3]);
                pk.z = cvt_pk_bf16(p[rb][r0 + 4], p[rb][r0 + 5]); pk.w = cvt_pk_bf16(p[rb][r0 + 6], p[rb][r0 + 7]); pf[s] = __builtin_bit_cast(bf16x8, pk); }
#pragma unroll
            for (int s = 0; s < 4; ++s) {
                typedef short v4i16_t __attribute__((ext_vector_type(4)));
                const LAS unsigned char* vp = Vb + vlane + 16 * s * AT_VP;
                { const s16x4 lo = __builtin_bit_cast(s16x4, __builtin_amdgcn_ds_read_tr16_b64_v4i16((LAS v4i16_t*)(vp))), hh = __builtin_bit_cast(s16x4, __builtin_amdgcn_ds_read_tr16_b64_v4i16((LAS v4i16_t*)(vp + 8 * AT_VP)));
                  const bf16x8 af = __builtin_shufflevector(lo, hh, 0, 1, 2, 3, 4, 5, 6, 7); o0 = MFMA32(af, pf[s], o0); }
                { const s16x4 lo = __builtin_bit_cast(s16x4, __builtin_amdgcn_ds_read_tr16_b64_v4i16((LAS v4i16_t*)(vp + 64))), hh = __builtin_bit_cast(s16x4, __builtin_amdgcn_ds_read_tr16_b64_v4i16((LAS v4i16_t*)(vp + 64 + 8 * AT_VP)));
                  const bf16x8 af = __builtin_shufflevector(lo, hh, 0, 1, 2, 3, 4, 5, 6, 7); o1 = MFMA32(af, pf[s], o1); }
            }
        }
        if (more) AT_WRITE(lds + (cur ^ 1) * AT_BUF);
        __syncthreads();
    }
#undef AT_WRITE
    const float ltot = half_sum(lrun);
    const float inv = 1.0f / ltot;
    bf16_t* op = Yc + (row0 + qrow) * YW + 64 * h + 4 * hi;
#pragma unroll
    for (int g4 = 0; g4 < 4; ++g4) {
        u32x2 a, c2;
        a.x = cvt_pk_bf16(o0[4 * g4 + 0] * inv, o0[4 * g4 + 1] * inv); a.y = cvt_pk_bf16(o0[4 * g4 + 2] * inv, o0[4 * g4 + 3] * inv);
        c2.x = cvt_pk_bf16(o1[4 * g4 + 0] * inv, o1[4 * g4 + 1] * inv); c2.y = cvt_pk_bf16(o1[4 * g4 + 2] * inv, o1[4 * g4 + 3] * inv);
        *(u32x2*)(op + 8 * g4) = a; *(u32x2*)(op + 32 + 8 * g4) = c2;
    }
}

__device__ __forceinline__ u32x4 conv_item(const bf16_t* P, const float* cw, int item) {
    const int token = item >> 6, c0 = (item & 63) * 8, t = token & (SEQ - 1);
    float acc[8];
#pragma unroll
    for (int i = 0; i < 8; ++i) acc[i] = 0.f;
    u32x4 xc[3], cc[3];
#pragma unroll
    for (int tap = 0; tap < 3; ++tap) {
        const bool ok = (t - 2 + tap >= 0);
        const bf16_t* rp = P + (size_t)(ok ? token - 2 + tap : token) * NA + c0;
        xc[tap] = *(const u32x4*)(rp + COL_XC); cc[tap] = *(const u32x4*)(rp + COL_CC);
        if (!ok) { xc[tap] = (u32x4){0u, 0u, 0u, 0u}; }
    }
    const u32x4 bc = *(const u32x4*)(P + (size_t)token * NA + COL_BC + c0);
#pragma unroll
    for (int tap = 0; tap < 3; ++tap) {
        const f32x4 w0 = *(const f32x4*)(cw + tap * 512 + c0), w1 = *(const f32x4*)(cw + tap * 512 + c0 + 4);
        const u32x4 x = xc[tap], c = cc[tap];
        acc[0] += w0.x * bf_lo(x.x) * bf_lo(c.x); acc[1] += w0.y * bf_hi(x.x) * bf_hi(c.x); acc[2] += w0.z * bf_lo(x.y) * bf_lo(c.y); acc[3] += w0.w * bf_hi(x.y) * bf_hi(c.y);
        acc[4] += w1.x * bf_lo(x.z) * bf_lo(c.z); acc[5] += w1.y * bf_hi(x.z) * bf_hi(c.z); acc[6] += w1.z * bf_lo(x.w) * bf_lo(c.w); acc[7] += w1.w * bf_hi(x.w) * bf_hi(c.w);
    }
    u32x4 o; o.x = cvt_pk_bf16(acc[0] * bf_lo(bc.x), acc[1] * bf_hi(bc.x)); o.y = cvt_pk_bf16(acc[2] * bf_lo(bc.y), acc[3] * bf_hi(bc.y));
    o.z = cvt_pk_bf16(acc[4] * bf_lo(bc.z), acc[5] * bf_hi(bc.z)); o.w = cvt_pk_bf16(acc[6] * bf_lo(bc.w), acc[7] * bf_hi(bc.w));
    return o;
}
__device__ __forceinline__ void conv_phase(const bf16_t* P, const float* cw, bf16_t* Yb, int gtid, int ngt) {
    for (int item = gtid; item < M * 64; item += 4 * ngt) {
        u32x4 o[4];
#pragma unroll
        for (int q = 0; q < 4; ++q) o[q] = conv_item(P, cw, item + q * ngt);
#pragma unroll
        for (int q = 0; q < 4; ++q) { const int it = item + q * ngt; *(u32x4*)(Yb + (size_t)(it >> 6) * YW + (it & 63) * 8) = o[q]; }
    }
}

#define XB_TMO      128
#define XB_XCNT(j)  (256  + 64 * (j))
#define XB_XSUB(j)  (1280 + 64 * (j))
#define XB_XGEN(j)  (2304 + 64 * (j))
#define XB_TOP      3328
#define XB_TOPGEN   3392
#define XCD_BAR_WORDS 3456
#define XB_SPIN_CAP (1u << 18)
__device__ __forceinline__ unsigned xb_ld(unsigned* p)              { return __hip_atomic_load(p, __ATOMIC_RELAXED, __HIP_MEMORY_SCOPE_AGENT); }
__device__ __forceinline__ unsigned xb_add(unsigned* p, unsigned v) { return __hip_atomic_fetch_add(p, v, __ATOMIC_RELAXED, __HIP_MEMORY_SCOPE_AGENT); }
__device__ __forceinline__ unsigned xb_xcc_id() { return (unsigned)__builtin_amdgcn_s_getreg((3 << 11) | 20) & 0xFu; }
#define XB_SPIN(cond, bar) do { unsigned _sp = 0; while (cond) { __builtin_amdgcn_s_sleep(1); \
    if ((++_sp & 255u) == 0u) { if (xb_ld(&(bar)[XB_TMO])) break; if (_sp > XB_SPIN_CAP) { atomicAdd(&(bar)[XB_TMO], 1u); break; } } } } while (0)
struct XcdBarrier { unsigned* bar; unsigned x; volatile LAS unsigned* st; };
__device__ __forceinline__ XcdBarrier xcd_barrier_post(unsigned* bar, volatile LAS unsigned* st) {
    XcdBarrier b; b.bar = bar; b.x = xb_xcc_id(); b.st = st;
    if (threadIdx.x == 0) (void)xb_add(&bar[XB_XCNT(b.x)], 1u);
    return b;
}
__device__ __forceinline__ void xcd_barrier_complete(unsigned* bar, unsigned x, unsigned& nloc, unsigned& nx) {
    const unsigned G = gridDim.x * gridDim.y * gridDim.z;
    unsigned sum, cnt, mine, sp = 0u;
    for (;;) {
        sum = 0u; cnt = 0u; mine = 0u;
#pragma unroll
        for (unsigned j = 0; j < 16; ++j) { const unsigned c = xb_ld(&bar[XB_XCNT(j)]); sum += c; cnt += (c > 0u) ? 1u : 0u; mine = (j == x) ? c : mine; }
        if (sum == G) break;
        __builtin_amdgcn_s_sleep(1);
        if ((++sp & 255u) == 0u) { if (xb_ld(&bar[XB_TMO])) break; if (sp > XB_SPIN_CAP) { atomicAdd(&bar[XB_TMO], 1u); break; } }
    }
    nloc = mine > 0u ? mine : 1u; nx = cnt > 0u ? cnt : 1u;
}
__device__ __forceinline__ void xcd_barrier(const XcdBarrier& b) {
    asm volatile("s_waitcnt vmcnt(0) lgkmcnt(0)" ::: "memory");
    __syncthreads();
    if (threadIdx.x == 0) {
        unsigned* bar = b.bar; unsigned bx = b.x;
        asm volatile("" : "+s"(bar), "+s"(bx));
        __builtin_amdgcn_s_waitcnt(0);
        unsigned nloc = b.st[0], nx = b.st[1];
        if (nloc == 0u) { xcd_barrier_complete(bar, bx, nloc, nx); b.st[0] = nloc; b.st[1] = nx; }
        const unsigned old = xb_add(&bar[XB_XSUB(bx)], 1u);
        const unsigned gen = old / nloc;
        if (old + 1u == (gen + 1u) * nloc) {
            __builtin_amdgcn_fence(__ATOMIC_RELEASE, "agent");
            asm volatile("s_waitcnt vmcnt(0)" ::: "memory");
            const unsigned og = xb_add(&bar[XB_TOP], 1u);
            const unsigned tg = og / nx;
            if (og + 1u == (tg + 1u) * nx) xb_add(&bar[XB_TOPGEN], 1u);
            else XB_SPIN(xb_ld(&bar[XB_TOPGEN]) == tg, bar);
            __builtin_amdgcn_fence(__ATOMIC_ACQUIRE, "agent");
            xb_add(&bar[XB_XGEN(bx)], 1u);
            asm volatile("s_waitcnt vmcnt(0)" ::: "memory");
        } else {
            XB_SPIN(xb_ld(&bar[XB_XGEN(bx)]) == gen, bar);
            __builtin_amdgcn_fence(__ATOMIC_ACQUIRE, "agent");
            asm volatile("s_waitcnt vmcnt(0)" ::: "memory");
        }
    }
    __syncthreads();
}
__device__ __forceinline__ void cg_barrier(cg::grid_group& grid) {
    asm volatile("s_waitcnt vmcnt(0) lgkmcnt(0)" ::: "memory");
    __syncthreads();
    grid.sync();
    if (threadIdx.x == 0) { __builtin_amdgcn_fence(__ATOMIC_ACQUIRE, "agent"); asm volatile("s_waitcnt vmcnt(0)" ::: "memory"); }
    __syncthreads();
}
#define grid_barrier(g_) xcd_barrier(xbar)

#ifndef DIAG_STAGE
#define DIAG_STAGE 0
#endif
__device__ __forceinline__ void diag_dump(float* out, const bf16_t* src, int ld, int ncols) {
    for (size_t i = (size_t)blockIdx.x * 512 + threadIdx.x; i < (size_t)M * DM; i += (size_t)gridDim.x * 512) {
        const size_t row = i >> 10; const int c = (int)(i & 1023); float v = 0.f;
        for (int cc = c; cc < ncols; cc += 1024) v += bf_lo((unsigned)src[row * ld + cc]);
        out[i] = v;
    }
}
#define DIAG(k, src, ld, ncols) do { if (DIAG_STAGE == (k)) { grid_barrier(grid); diag_dump(A_->out, (src), (ld), (ncols)); return; } } while (0)

typedef const __attribute__((address_space(4))) Args* KArgP;
__device__ __forceinline__ KArgP launder_args(KArgP p) { asm volatile("" : "+s"(p)); return p; }
#define A_ (launder_args(argp))
__global__ void __launch_bounds__(512, 2) fwd_kernel(Args a) {
    KArgP argp = (KArgP)__builtin_amdgcn_kernarg_segment_ptr(); (void)a;
    extern __shared__ __attribute__((aligned(16))) unsigned char lds_raw[];
    LAS unsigned char* lds = (LAS unsigned char*)lds_raw;
    cg::grid_group grid = cg::this_grid();
    if (gridDim.z == 12345u) grid.sync();
    volatile LAS unsigned* xst = (volatile LAS unsigned*)((LAS unsigned char*)lds_raw + LDS_BYTES - 64);
    if (threadIdx.x == 0) { xst[0] = 0u; xst[1] = 0u; }
    __syncthreads();
    const XcdBarrier xbar = xcd_barrier_post((unsigned*)(A_->ws + 16384), xst);
    const int G = gridDim.x, bid = blockIdx.x, ngw = G * 8;
#define FRESH() const int tid = launder_i(threadIdx.x), lane = tid & 63, w = __builtin_amdgcn_readfirstlane(tid >> 6), gw = bid * 8 + w; (void)lane; (void)gw
    unsigned char* ws = A_->ws;
    bf16_t* XN = (bf16_t*)(ws + WS_XN); bf16_t* PR = (bf16_t*)(ws + WS_P); bf16_t* Y = (bf16_t*)(ws + WS_Y);
    float* LOGF = (float*)(ws + WS_LOGF); float* CUM = (float*)(ws + WS_CUM);

    {
        FRESH();
#ifndef NO_TAB
        for (int u = bid; u < 256; u += G) s5_tables(lds, a, u >> 7, (u >> 2) & 31, u & 3, tid);
#endif
        LAS float* scr = (LAS float*)(lds + w * 16640);
        constexpr int I_A = 16 * 56, I_G = 16 * 48, I_B = 8 * 16, I_O = 16 * 16, I_1 = 16 * 64, I_2 = 64 * 16, I_L = I_A + I_G + 3 * I_B + I_O + I_1 + I_2;
        for (int it = gw; it < 2 * I_L; it += ngw) {
            const int l = it / I_L; int r = it - l * I_L;
            unsigned char* wl = ws + WS_W + (size_t)l * W_LAYER;
            const float* win = A_->in[2] + (size_t)l * DM * INW;
            if (r < I_A) { transpose_item(win, INW, 0, DM, NA, (bf16_t*)(wl + W_INA), scr, r, lane); continue; } r -= I_A;
            if (r < I_G) { transpose_item(win, INW, COL_G, DM, NG, (bf16_t*)(wl + W_G), scr, r, lane); continue; } r -= I_G;
            if (r < 3 * I_B) { const int br = r / I_B; transpose_item(A_->in[15] + (size_t)l * 1536 * DM + (size_t)br * 512 * DM, DM, 0, 512, DM, (bf16_t*)(wl + W_BR) + (size_t)br * DM * 512, scr, r - br * I_B, lane); continue; } r -= 3 * I_B;
            if (r < I_O) { transpose_item(A_->in[16] + (size_t)l * DM * DM, DM, 0, DM, DM, (bf16_t*)(wl + W_OUT), scr, r, lane); continue; } r -= I_O;
            if (r < I_1) { transpose_item(A_->in[19] + (size_t)l * DM * FF, FF, 0, DM, FF, (bf16_t*)(wl + W_1), scr, r, lane); continue; } r -= I_1;
            transpose_item(A_->in[20] + (size_t)l * FF * DM, DM, 0, FF, DM, (bf16_t*)(wl + W_2), scr, r, lane);
        }
        __syncthreads();
        NormArgs n{A_->in[0], nullptr, nullptr, nullptr, A_->in[1], XN, A_->in[2] + COL_F, A_->in[14], LOGF};
        norm_phase(lds, n, gw, ngw, lane, tid);
    }
    xcd_barrier(xbar);

    DIAG(1, XN, DM, DM);
#pragma unroll 1
    for (int l = 0; l < DEPTH; ++l) {
        unsigned char* wl = ws + WS_W + (size_t)l * W_LAYER;
        const unsigned char* s5tab = ws + WS_S5 + (size_t)l * S5_LAYER;
        const float* xin = (l == 0) ? A_->in[0] : A_->out;

        { FRESH(); for (int bh = bid; bh < 64; bh += G) cum_scan(lds, LOGF, CUM, bh, tid, lane, w); }
        {
            pg8::Gemm g{XN, (const bf16_t*)(wl + W_INA), M, NA, DM, 0, 0}; pg8::StaticOrder S; S.init(M, NA, G, bid, 1);
            pg8::Epi<pg8::EPI_PROJ> E{PR, NA, nullptr, nullptr};
#if (PHMASK >> 0) & 1
            pg8::gemm_phase<pg8::Epi<pg8::EPI_PROJ>, pg8::StaticOrder, true, true>(lds, g, S, E);
#endif
        }
        grid_barrier(grid);

        DIAG(2, PR, NA, NA);
        if ((bid >> 3) & 1) {
        for (int v = bid; v < 256; v += G) {
            FRESH(); const int bh = v >> 2, s = v & 3;
#pragma unroll 1
            for (int k = 0; k < 4; ++k) { const int qb = (k == 0) ? 15 - s : (k == 1) ? s : (k == 2) ? 11 - s : s + 4;
                attn_unit(lds, PR, CUM, Y + 2 * (size_t)M * YW, bh >> 3, bh & 7, qb, tid, lane, w); }
        }
        { FRESH(); for (int v = bid; v < 256; v += G) s5_unit(lds, PR, s5tab, Y, v >> 5, 4 * (v & 7) + ((v >> 3) & 3), tid, lane, w);     }
        } else {
        { FRESH(); for (int v = bid; v < 256; v += G) s5_unit(lds, PR, s5tab, Y, v >> 5, 4 * (v & 7) + ((v >> 3) & 3), tid, lane, w);     }
        for (int v = bid; v < 256; v += G) {
            FRESH(); const int bh = v >> 2, s = v & 3;
#pragma unroll 1
            for (int k = 0; k < 4; ++k) { const int qb = (k == 0) ? 15 - s : (k == 1) ? s : (k == 2) ? 11 - s : s + 4;
                attn_unit(lds, PR, CUM, Y + 2 * (size_t)M * YW, bh >> 3, bh & 7, qb, tid, lane, w); }
        }
        }
        grid_barrier(grid);
        { FRESH(); conv_phase(PR, A_->in[13] + (size_t)l * 3 * 512, Y + (size_t)M * YW, bid * 512 + tid, G * 512); }
        grid_barrier(grid);

        if (DIAG_STAGE == 3) { grid_barrier(grid); for (size_t i = (size_t)blockIdx.x * 512 + threadIdx.x; i < (size_t)M * DM; i += (size_t)gridDim.x * 512) { const size_t row = i >> 10; const int c = (int)(i & 511); A_->out[i] = bf_lo((unsigned)Y[row * YW + c]) + bf_lo((unsigned)Y[(size_t)M * YW + row * YW + c]) + bf_lo((unsigned)Y[2 * (size_t)M * YW + row * YW + c]); } return; }
        DIAG(31, Y + (size_t)M * YW, YW, YW); DIAG(32, Y + 2 * (size_t)M * YW, YW, YW);
        {
            pg8::Gemm g{XN, (const bf16_t*)(wl + W_G), M, NG, DM, 0, 0}; pg8::StaticOrder S; S.init(M, NG, G, bid, 1);
            pg8::Epi<pg8::EPI_GATE> E{PR, NG, A_->in[3] + (size_t)l * NG, nullptr};
#if (PHMASK >> 1) & 1
            pg8::gemm_phase<pg8::Epi<pg8::EPI_GATE>, pg8::StaticOrder, true, true>(lds, g, S, E);
#endif
        }
        grid_barrier(grid);

        DIAG(4, PR, NG, NG);
        {
            pg8::Gemm g{Y, (const bf16_t*)(wl + W_BR), M, DM, 512, (size_t)M * YW * 2, (size_t)DM * 512 * 2}; pg8::StaticOrder S; S.init(M, DM, G, bid, 3);
            pg8::Epi<pg8::EPI_BRANCH> E{XN, DM, nullptr, PR};
#if (PHMASK >> 2) & 1
            pg8::gemm_phase<pg8::Epi<pg8::EPI_BRANCH>, pg8::StaticOrder, true, true>(lds, g, S, E);
#endif
        }
        grid_barrier(grid);

        DIAG(5, XN, DM, DM);
        {
            pg8::Gemm g{XN, (const bf16_t*)(wl + W_OUT), M, DM, DM, 0, 0}; pg8::StaticOrder S; S.init(M, DM, G, bid, 1);
            pg8::Epi<pg8::EPI_PLAIN> E{PR, DM, nullptr, nullptr};
#if (PHMASK >> 3) & 1
            pg8::gemm_phase<pg8::Epi<pg8::EPI_PLAIN>, pg8::StaticOrder, true, true>(lds, g, S, E);
#endif
        }
        grid_barrier(grid);

        DIAG(6, PR, DM, DM);
        {
            FRESH(); NormArgs n{xin, PR, A_->in[17] + (size_t)l * DM, A_->out, A_->in[18] + (size_t)l * DM, XN, nullptr, nullptr, nullptr};
            norm_phase(lds, n, gw, ngw, lane, tid);
        }
        grid_barrier(grid);

        DIAG(7, XN, DM, DM);
        {
            pg8::Gemm g{XN, (const bf16_t*)(wl + W_1), M, FF, DM, 0, 0}; pg8::StaticOrder S; S.init(M, FF, G, bid, 1);
            pg8::Epi<pg8::EPI_RELU2> E{PR, FF, nullptr, nullptr};
#if (PHMASK >> 4) & 1
            pg8::gemm_phase<pg8::Epi<pg8::EPI_RELU2>, pg8::StaticOrder, true, true>(lds, g, S, E);
#endif
        }
        grid_barrier(grid);

        DIAG(8, PR, FF, FF);
        {
            pg8::Gemm g{PR, (const bf16_t*)(wl + W_2), M, DM, FF, 0, 0}; pg8::StaticOrder S; S.init(M, DM, G, bid, 1);
            pg8::Epi<pg8::EPI_PLAIN> E{XN, DM, nullptr, nullptr};
#if (PHMASK >> 5) & 1
            pg8::gemm_phase<pg8::Epi<pg8::EPI_PLAIN>, pg8::StaticOrder, true, true>(lds, g, S, E);
#endif
        }
        grid_barrier(grid);

        DIAG(9, XN, DM, DM);
        if (l + 1 < DEPTH) {
            FRESH(); NormArgs n{A_->out, XN, A_->in[21] + (size_t)l * DM, A_->out, A_->in[1] + (size_t)(l + 1) * DM, XN, A_->in[2] + (size_t)(l + 1) * DM * INW + COL_F, A_->in[14] + (l + 1) * 8, LOGF};
            norm_phase(lds, n, gw, ngw, lane, tid);
            grid_barrier(grid);
        } else {
            FRESH(); NormArgs n{A_->out, XN, A_->in[21] + (size_t)l * DM, A_->out, nullptr, nullptr, nullptr, nullptr, nullptr};
            norm_phase(lds, n, gw, ngw, lane, tid);
        }
    }
}

extern "C" void kernel_launch(void* const* d_in, const int* in_sizes, int n_in, void* d_out, int out_size, void* d_ws, size_t ws_size, hipStream_t stream) {
    static int grid = 0;
    if (grid == 0) {
        if (n_in != 22 || in_sizes[0] != M * DM || out_size != M * DM || ws_size < WS_END) { fprintf(stderr, "kernel_launch: unexpected shapes (n_in %d, in0 %d, out %d, ws %zu)\n", n_in, n_in > 0 ? in_sizes[0] : -1, out_size, ws_size); grid = -1; return; }
        int dev = 0, cus = 0, per_cu = 0;
        (void)hipGetDevice(&dev);
        (void)hipDeviceGetAttribute(&cus, hipDeviceAttributeMultiprocessorCount, dev);
        if (hipFuncSetAttribute((const void*)fwd_kernel, hipFuncAttributeMaxDynamicSharedMemorySize, LDS_BYTES) != hipSuccess) fprintf(stderr, "kernel_launch: hipFuncSetAttribute failed\n");
        if (hipOccupancyMaxActiveBlocksPerMultiprocessor(&per_cu, (const void*)fwd_kernel, 512, LDS_BYTES) != hipSuccess || per_cu < 1) { fprintf(stderr, "kernel_launch: occupancy query gave %d\n", per_cu); per_cu = 1; }
        (void)hipGetLastError();
        grid = cus * per_cu; if (grid > 256) grid = 256; if (grid < 1) grid = 256;
    }
    if (grid < 0) return;
    (void)hipMemsetAsync(d_ws, 0, 65536, stream);
    Args a{};
    for (int i = 0; i < 22; ++i) a.in[i] = (const float*)d_in[i];
    a.out = (float*)d_out; a.ws = (unsigned char*)d_ws;
    void* args[] = {&a};
    hipError_t e = hipLaunchCooperativeKernel((const void*)fwd_kernel, dim3(grid), dim3(512), args, LDS_BYTES, stream);
    if (e != hipSuccess) fprintf(stderr, "kernel_launch: cooperative launch failed: %s (grid %d)\n", hipGetErrorString(e), grid);
}
```

```cpp
#include <hip/hip_runtime.h>
#include <hip/hip_cooperative_groups.h>
#include <cstdio>
#include <cstdint>
namespace cg = cooperative_groups;

#define DIAG_STAGE 0
#ifndef PHMASK
#define PHMASK 0xff
#endif

#define LAS __attribute__((address_space(3)))
typedef unsigned short bf16_t;
typedef short bf16x8 __attribute__((ext_vector_type(8)));
typedef short s16x4 __attribute__((ext_vector_type(4)));
typedef float f32x2 __attribute__((ext_vector_type(2)));
typedef float f32x4 __attribute__((ext_vector_type(4)));
typedef float f32x16 __attribute__((ext_vector_type(16)));
typedef unsigned u32x2 __attribute__((ext_vector_type(2)));
typedef unsigned u32x4 __attribute__((ext_vector_type(4)));

constexpr int BATCH = 8, SEQ = 4096, DM = 1024, M = BATCH * SEQ, DEPTH = 2;
constexpr int INW = 6664, NA = 3584, NG = 3072, FF = 4096, YW = 512;
constexpr int COL_XC = 512, COL_BC = 1024, COL_CC = 1536, COL_Q = 2048, COL_K = 2560, COL_V = 3072, COL_F = 3584, COL_G = 3592;
constexpr float EPS = 1e-6f;
constexpr float LOG2E = 1.4426950408889634f;
constexpr float C2 = 0.125f * LOG2E;

constexpr size_t MiB = 1u << 20;
constexpr size_t WS_W = 1 * MiB, W_LAYER = 34 * MiB;
constexpr size_t W_INA = 0, W_G = 7 * MiB, W_BR = 13 * MiB, W_OUT = 16 * MiB, W_1 = 18 * MiB, W_2 = 26 * MiB;
constexpr size_t WS_S5 = 69 * MiB, S5_LAYER = 17 * MiB + 512 * 1024;
constexpr size_t S5_KT = 0, S5_WE = MiB + 256 * 1024, S5_WC = S5_WE + 8 * MiB, S5_A64 = S5_WC + 8 * MiB, S5_GLU = S5_A64 + 64 * 1024;
constexpr size_t WS_LOGF = 104 * MiB, WS_CUM = 105 * MiB, WS_XN = 106 * MiB, WS_P = 170 * MiB, WS_Y = 394 * MiB, WS_END = 490 * MiB;
constexpr int KT_BYTES = 65 * 512;

constexpr int LDS_BYTES = 147456;

typedef __bf16 bf16x2_t __attribute__((ext_vector_type(2)));
__device__ __forceinline__ unsigned cvt_pk_bf16(float lo, float hi) { const f32x2 v = {lo, hi}; const bf16x2_t b = __builtin_convertvector(v, bf16x2_t); return __builtin_bit_cast(unsigned, b); }
__device__ __forceinline__ float bf_lo(unsigned u) { return __uint_as_float(u << 16); }
__device__ __forceinline__ float bf_hi(unsigned u) { return __uint_as_float(u & 0xffff0000u); }
template <int O> __device__ __forceinline__ float swz_xor(float v) { return __int_as_float(__builtin_amdgcn_ds_swizzle(__float_as_int(v), (O << 10) | 0x1f)); }
__device__ __forceinline__ float half_sum(float v) { auto rr = __builtin_amdgcn_permlane32_swap(__float_as_uint(v), __float_as_uint(v), false, false); return __uint_as_float(rr[0]) + __uint_as_float(rr[1]); }
__device__ __forceinline__ float half_max(float v) { auto rr = __builtin_amdgcn_permlane32_swap(__float_as_uint(v), __float_as_uint(v), false, false); return fmaxf(__uint_as_float(rr[0]), __uint_as_float(rr[1])); }
__device__ __forceinline__ float wave_sum(float v) {
    v += swz_xor<1>(v); v += swz_xor<2>(v); v += swz_xor<4>(v); v += swz_xor<8>(v); v += swz_xor<16>(v);
    return half_sum(v);
}
__device__ __forceinline__ int launder_i(int x) { asm volatile("" : "+v"(x)); return x; }
__device__ __forceinline__ float fast_exp2(float x) { return __builtin_amdgcn_exp2f(x); }
__device__ __forceinline__ float fast_rcp(float x) { return __builtin_amdgcn_rcpf(x); }
__device__ __forceinline__ float sigmoid_f(float z) { return fast_rcp(1.0f + fast_exp2(-LOG2E * z)); }
__device__ __forceinline__ float gelu_tanh(float y) { const float t = y + 0.044715f * y * y * y; return y * fast_rcp(1.0f + fast_exp2(-2.302208198f * t)); }

namespace pg8 {
#define PG8_LAS __attribute__((address_space(3)))
constexpr int BM = 256, BK = 64, HALF = 128, HTB = HALF * BK * 2, STAGE_BYTES = 8 * HTB, NXCD = 8, WGM = 8;

__host__ __device__ __forceinline__ int lds_byte(int r, int c) { const int st = (r >> 4) * 2 + (c >> 5), rr = r & 15, cc = c & 31, ob = rr * 64 + cc * 2; return st * 1024 + (ob ^ (((ob >> 9) & 1) << 5)); }
__host__ __device__ __forceinline__ void stage_rc(int b, int& R, int& C) { const int st = b / 1024, sb = b % 1024, swz = sb ^ (((sb >> 9) & 1) << 5); R = (st >> 1) * 16 + swz / 64; C = (st & 1) * 32 + (swz % 64) / 2; }
__host__ __device__ __forceinline__ int perm32(int rho) { const int n = rho >> 4, i = rho & 15; return 8 * (i >> 2) + 4 * n + (i & 3); }

struct Unit { int pm, pn, br; };
struct Gemm { const bf16_t* A; const bf16_t* Bt; int M, N, K; size_t abr, bbr; };

struct StaticOrder {
    int nM, nN, nwg, G, c, nbr;
    __device__ void init(int M_, int N_, int G_, int c_, int nbr_) { nM = M_ / BM; nN = N_ / BM; nwg = nM * nN; G = G_; c = c_; nbr = nbr_; }
    __device__ bool next(int i, Unit& u) const {
        const int it = i / nbr; u.br = i - it * nbr;
        const long L = (long)it * G + c; if (L >= nwg) return false;
        int wgid = (int)L; { const int q = nwg / NXCD, r = nwg % NXCD, xcd = wgid % NXCD, off = wgid / NXCD; wgid = (xcd < r ? xcd * (q + 1) : r * (q + 1) + (xcd - r) * q) + off; }
        const int nig = WGM * nN, gid = wgid / nig, fm = gid * WGM, gsz = (nM - fm) < WGM ? (nM - fm) : WGM;
        u.pm = fm + ((wgid % nig) % gsz); u.pn = (wgid % nig) / gsz; return true;
    }
};

enum { EPI_PROJ = 0, EPI_GATE = 1, EPI_RELU2 = 2, EPI_BRANCH = 3, EPI_PLAIN = 4 };
template <int MODE> struct Epi {
    static constexpr bool PERM = true;
    bf16_t* O; int ldc; const float* bias; const bf16_t* G;
    __device__ __forceinline__ void operator()(const f32x4 (&acc)[2][2][4][2], const Unit& u, int wr, int wc, int fr, int fq) const {
        const int row0 = u.pm * BM + wr * 64 + fr; const int col0 = u.pn * BM + wc * 32 + 8 * fq;
        float sc = 1.f; if (MODE == EPI_PROJ) { if (u.pn >= COL_Q / 256 && u.pn < COL_K / 256) sc = C2; }
        f32x4 bv[2][2];
        if (MODE == EPI_GATE) {
#pragma unroll
            for (int bj = 0; bj < 2; ++bj)
#pragma unroll
                for (int n = 0; n < 2; ++n) bv[bj][n] = *(const f32x4*)(bias + col0 + bj * HALF + 4 * n);
        }
        if (MODE == EPI_BRANCH) {
#pragma unroll
            for (int ai = 0; ai < 2; ++ai) {
                u32x2 gt[4][2]; u32x4 pv[4][2];
#pragma unroll
                for (int m = 0; m < 4; ++m)
#pragma unroll
                    for (int bj = 0; bj < 2; ++bj) {
                        const size_t row = (size_t)(row0 + ai * HALF + m * 16);
                        gt[m][bj] = *(const u32x2*)((const unsigned char*)G + row * NG + (size_t)u.br * DM + col0 + bj * HALF);
                        pv[m][bj] = (u.br > 0) ? *(const u32x4*)(O + row * ldc + col0 + bj * HALF) : (u32x4){0u, 0u, 0u, 0u};
                    }
                __builtin_amdgcn_sched_barrier(0);
#pragma unroll
                for (int m = 0; m < 4; ++m)
#pragma unroll
                    for (int bj = 0; bj < 2; ++bj) {
                        const size_t row = (size_t)(row0 + ai * HALF + m * 16);
                        f32x4 v0 = acc[ai][bj][m][0], v1 = acc[ai][bj][m][1];
                        const u32x2 g8 = gt[m][bj]; const u32x4 p4 = pv[m][bj];
                        v0 = v0 * (1.f / 255.f); v1 = v1 * (1.f / 255.f);
                        v0[0] = v0[0] * (float)(g8.x & 0xffu) + bf_lo(p4.x); v0[1] = v0[1] * (float)((g8.x >> 8) & 0xffu) + bf_hi(p4.x); v0[2] = v0[2] * (float)((g8.x >> 16) & 0xffu) + bf_lo(p4.y); v0[3] = v0[3] * (float)(g8.x >> 24) + bf_hi(p4.y);
                        v1[0] = v1[0] * (float)(g8.y & 0xffu) + bf_lo(p4.z); v1[1] = v1[1] * (float)((g8.y >> 8) & 0xffu) + bf_hi(p4.z); v1[2] = v1[2] * (float)((g8.y >> 16) & 0xffu) + bf_lo(p4.w); v1[3] = v1[3] * (float)(g8.y >> 24) + bf_hi(p4.w);
                        u32x4 wv; wv.x = cvt_pk_bf16(v0[0], v0[1]); wv.y = cvt_pk_bf16(v0[2], v0[3]); wv.z = cvt_pk_bf16(v1[0], v1[1]); wv.w = cvt_pk_bf16(v1[2], v1[3]);
                        *(u32x4*)(O + row * ldc + col0 + bj * HALF) = wv;
                    }
                __builtin_amdgcn_sched_barrier(0);
            }
            return;
        }
#pragma unroll
        for (int ai = 0; ai < 2; ++ai)
#pragma unroll
            for (int m = 0; m < 4; ++m) {
                const size_t row = (size_t)(row0 + ai * HALF + m * 16);
                bf16_t* rowp = O + row * ldc + col0;
#pragma unroll
                for (int bj = 0; bj < 2; ++bj) {
                    f32x4 v0 = acc[ai][bj][m][0], v1 = acc[ai][bj][m][1];
                    if (MODE == EPI_PROJ) { v0 = v0 * sc; v1 = v1 * sc; }
                    if (MODE == EPI_GATE) {
                        v0 = v0 + bv[bj][0]; v1 = v1 + bv[bj][1];
                        u32x2 w8; w8.x = 0u; w8.y = 0u;
#pragma unroll
                        for (int i = 0; i < 4; ++i) { w8.x |= (unsigned)(sigmoid_f(v0[i]) * 255.f + 0.5f) << (8 * i); w8.y |= (unsigned)(sigmoid_f(v1[i]) * 255.f + 0.5f) << (8 * i); }
                        *(u32x2*)((unsigned char*)O + row * ldc + col0 + bj * HALF) = w8;
                        continue;
                    }
                    if (MODE == EPI_RELU2) {
#pragma unroll
                        for (int i = 0; i < 4; ++i) { const float a = fmaxf(v0[i], 0.f), b = fmaxf(v1[i], 0.f); v0[i] = a * a; v1[i] = b * b; }
                    }
                    if (MODE == EPI_BRANCH) {
                        const u32x4 gt = *(const u32x4*)(G + row * NG + (size_t)u.br * DM + col0 + bj * HALF);
                        v0[0] *= bf_lo(gt.x); v0[1] *= bf_hi(gt.x); v0[2] *= bf_lo(gt.y); v0[3] *= bf_hi(gt.y);
                        v1[0] *= bf_lo(gt.z); v1[1] *= bf_hi(gt.z); v1[2] *= bf_lo(gt.w); v1[3] *= bf_hi(gt.w);
                        if (u.br > 0) {
                            const u32x4 pv = *(const u32x4*)(rowp + bj * HALF);
                            v0[0] += bf_lo(pv.x); v0[1] += bf_hi(pv.x); v0[2] += bf_lo(pv.y); v0[3] += bf_hi(pv.y);
                            v1[0] += bf_lo(pv.z); v1[1] += bf_hi(pv.z); v1[2] += bf_lo(pv.w); v1[3] += bf_hi(pv.w);
                        }
                    }
                    u32x4 w; w.x = cvt_pk_bf16(v0[0], v0[1]); w.y = cvt_pk_bf16(v0[2], v0[3]); w.z = cvt_pk_bf16(v1[0], v1[1]); w.w = cvt_pk_bf16(v1[2], v1[3]);
                    *(u32x4*)(rowp + bj * HALF) = w;
                }
            }
    }
};

template <class EpiT, class Sched, bool ALIGN_EPI, bool SP2>
__device__ __forceinline__ void gemm_phase(PG8_LAS unsigned char* lds, const Gemm g, const Sched& S, const EpiT& E) {
    const int tid = launder_i(threadIdx.x), wid = __builtin_amdgcn_readfirstlane(tid >> 6), lane = tid & 63, wr = wid >> 2, wc = wid & 3, fr = lane & 15, fq = lane >> 4;
    const int K = g.K, nt = K / BK;
    unsigned voffA[2], voffB[2];
#pragma unroll
    for (int i = 0; i < 2; ++i) { int R, C; stage_rc(tid * 16 + i * 8192, R, C); const int Rb = EpiT::PERM ? ((R & ~31) + perm32(R & 31)) : R;
        voffA[i] = (unsigned)(R * K + C) * 2u; voffB[i] = (unsigned)(Rb * K + C) * 2u; }
    const size_t kstep = (size_t)(BK * 2);
    const size_t hstep = (size_t)HALF * K * 2;
    const size_t tstep = 2 * hstep;
    const unsigned ldsw = (unsigned)wid * 1024u;
    const int aoff = lds_byte(wr * 64 + fr, fq * 8), boff = lds_byte(wc * 32 + fr, fq * 8);
#define PG8_SA(b, h) (((b) * 2 + (h)) * HTB)
#define PG8_SB(b, h) ((4 + (b) * 2 + (h)) * HTB)
#define PG8_STAGE(bufoff, gbase, voff) do { _Pragma("unroll") for (int _i = 0; _i < 2; ++_i) \
        __builtin_amdgcn_global_load_lds((const unsigned*)((const char*)(gbase) + (voff)[_i]), (PG8_LAS unsigned*)(lds + (bufoff) + ldsw + _i * 8192), 16, 0, 0); } while (0)
#define PG8_LDA(dst, b, h) do { _Pragma("unroll") for (int m = 0; m < 4; ++m) _Pragma("unroll") for (int k = 0; k < 2; ++k) dst[m][k] = *(const PG8_LAS bf16x8*)(lds + PG8_SA(b, h) + aoff + m * 2048 + k * 1024); } while (0)
#define PG8_LDB(dst, b, h) do { _Pragma("unroll") for (int n = 0; n < 2; ++n) _Pragma("unroll") for (int k = 0; k < 2; ++k) dst[n][k] = *(const PG8_LAS bf16x8*)(lds + PG8_SB(b, h) + boff + n * 2048 + k * 1024); } while (0)
#define PG8_MMA(ai, bj, At, Bt) do { __builtin_amdgcn_s_setprio(1); _Pragma("unroll") for (int m = 0; m < 4; ++m) _Pragma("unroll") for (int n = 0; n < 2; ++n) _Pragma("unroll") for (int k = 0; k < 2; ++k) \
        acc[ai][bj][m][n] = __builtin_amdgcn_mfma_f32_16x16x32_bf16(Bt[n][k], At[m][k], acc[ai][bj][m][n], 0, 0, 0); __builtin_amdgcn_s_setprio(0); } while (0)
#define PG8_WAIT_V(n) asm volatile("s_waitcnt vmcnt(" #n ")" ::: "memory")
#define PG8_WAIT_L(n) asm volatile("s_waitcnt lgkmcnt(" #n ")" ::: "memory")
#define PG8_BAR __builtin_amdgcn_s_barrier()
#define PG8_SCHED __builtin_amdgcn_sched_barrier(0)
    Unit cur, nxt; int ui = 0;
    if (!S.next(0, cur)) return;
    f32x4 acc[2][2][4][2];
#pragma unroll
    for (int a = 0; a < 2; ++a)
#pragma unroll
        for (int b = 0; b < 2; ++b)
#pragma unroll
            for (int m = 0; m < 4; ++m)
#pragma unroll
                for (int n = 0; n < 2; ++n) acc[a][b][m][n] = (f32x4){0.f, 0.f, 0.f, 0.f};
    bf16x8 At[4][2], B0[2][2], B1[2][2];
    const char* cA = (const char*)g.A + (size_t)cur.pm * tstep + (size_t)cur.br * g.abr; const char* cB = (const char*)g.Bt + (size_t)cur.pn * tstep + (size_t)cur.br * g.bbr;
    if constexpr (SP2) {
        PG8_STAGE(PG8_SB(0, 0), cB, voffB); PG8_STAGE(PG8_SB(0, 1), cB + hstep, voffB); PG8_STAGE(PG8_SA(0, 0), cA, voffA); PG8_STAGE(PG8_SA(0, 1), cA + hstep, voffA);
        if (wr == 1) PG8_BAR;
        PG8_WAIT_V(2); PG8_BAR;
        PG8_STAGE(PG8_SB(1, 0), cB + kstep, voffB); PG8_STAGE(PG8_SA(1, 0), cA + kstep, voffA); PG8_STAGE(PG8_SB(1, 1), cB + hstep + kstep, voffB);
        PG8_WAIT_V(6); PG8_BAR;
    } else {
        PG8_STAGE(PG8_SB(0, 0), cB, voffB); PG8_STAGE(PG8_SA(0, 0), cA, voffA); PG8_STAGE(PG8_SB(0, 1), cB + hstep, voffB); PG8_STAGE(PG8_SA(0, 1), cA + hstep, voffA);
        if (wr == 1) PG8_BAR;
        PG8_WAIT_V(4); PG8_BAR;
        PG8_STAGE(PG8_SB(1, 0), cB + kstep, voffB); PG8_STAGE(PG8_SA(1, 0), cA + kstep, voffA); PG8_STAGE(PG8_SB(1, 1), cB + hstep + kstep, voffB);
        PG8_WAIT_V(6); PG8_BAR;
    }
    for (;;) {
        const bool has_next = S.next(ui + 1, nxt);
        const char* nA = has_next ? (const char*)g.A + (size_t)nxt.pm * tstep + (size_t)nxt.br * g.abr : cA;
        const char* nB = has_next ? (const char*)g.Bt + (size_t)nxt.pn * tstep + (size_t)nxt.br * g.bbr : cB;
        for (int t = 0; t < nt; t += 2) {
            const bool last = (t == nt - 2);
            const char* a1 = cA + (size_t)(t + 1) * kstep;
            const char* a2 = last ? nA : cA + (size_t)(t + 2) * kstep; const char* b2 = last ? nB : cB + (size_t)(t + 2) * kstep;
            const char* a3 = a2 + kstep; const char* b3 = b2 + kstep;
            if constexpr (SP2) {
            PG8_LDB(B0, 0, 0); PG8_LDB(B1, 0, 1); PG8_SCHED; PG8_LDA(At, 0, 0); PG8_STAGE(PG8_SA(1, 1), a1 + hstep, voffA);
            PG8_WAIT_V(8); PG8_WAIT_L(0); PG8_BAR; PG8_MMA(0, 0, At, B0); PG8_MMA(0, 1, At, B1); PG8_BAR; PG8_SCHED;
            PG8_LDA(At, 0, 1); PG8_STAGE(PG8_SB(0, 0), b2, voffB); PG8_STAGE(PG8_SB(0, 1), b2 + hstep, voffB); PG8_STAGE(PG8_SA(0, 0), a2, voffA);
            PG8_WAIT_V(8); PG8_WAIT_L(0); PG8_BAR; PG8_MMA(1, 0, At, B0); PG8_MMA(1, 1, At, B1); PG8_BAR; PG8_SCHED;
            PG8_LDB(B0, 1, 0); PG8_LDB(B1, 1, 1); PG8_SCHED; PG8_LDA(At, 1, 0); PG8_STAGE(PG8_SA(0, 1), a2 + hstep, voffA);
            PG8_WAIT_V(8); PG8_WAIT_L(0); PG8_BAR; PG8_MMA(0, 0, At, B0); PG8_MMA(0, 1, At, B1); PG8_BAR; PG8_SCHED;
            PG8_LDA(At, 1, 1); PG8_STAGE(PG8_SB(1, 0), b3, voffB); PG8_STAGE(PG8_SB(1, 1), b3 + hstep, voffB); PG8_STAGE(PG8_SA(1, 0), a3, voffA);
            PG8_WAIT_V(8); PG8_WAIT_L(0); PG8_BAR; PG8_MMA(1, 0, At, B0); PG8_MMA(1, 1, At, B1); PG8_BAR; PG8_SCHED;
            } else {
            PG8_LDB(B0, 0, 0); PG8_SCHED; PG8_LDA(At, 0, 0); PG8_STAGE(PG8_SA(1, 1), a1 + hstep, voffA);
            PG8_WAIT_L(8); PG8_BAR; PG8_WAIT_L(0); PG8_MMA(0, 0, At, B0); PG8_BAR; PG8_SCHED;
            PG8_LDB(B1, 0, 1); PG8_STAGE(PG8_SB(0, 0), b2, voffB);
            PG8_BAR; PG8_WAIT_L(0); PG8_MMA(0, 1, At, B1); PG8_BAR;
            PG8_LDA(At, 0, 1); PG8_STAGE(PG8_SA(0, 0), a2, voffA);
            PG8_BAR; PG8_WAIT_L(0); PG8_MMA(1, 0, At, B0); PG8_BAR; PG8_SCHED;
            PG8_STAGE(PG8_SB(0, 1), b2 + hstep, voffB);
            PG8_WAIT_V(6); PG8_BAR; PG8_MMA(1, 1, At, B1); PG8_BAR;
            PG8_LDB(B0, 1, 0); PG8_SCHED; PG8_LDA(At, 1, 0); PG8_STAGE(PG8_SA(0, 1), a2 + hstep, voffA);
            PG8_WAIT_L(8); PG8_BAR; PG8_WAIT_L(0); PG8_MMA(0, 0, At, B0); PG8_BAR; PG8_SCHED;
            PG8_LDB(B1, 1, 1); PG8_STAGE(PG8_SB(1, 0), b3, voffB);
            PG8_BAR; PG8_WAIT_L(0); PG8_MMA(0, 1, At, B1); PG8_BAR;
            PG8_LDA(At, 1, 1); PG8_STAGE(PG8_SA(1, 0), a3, voffA);
            PG8_BAR; PG8_WAIT_L(0); PG8_MMA(1, 0, At, B0); PG8_BAR; PG8_SCHED;
            PG8_STAGE(PG8_SB(1, 1), b3 + hstep, voffB);
            PG8_WAIT_V(6); PG8_BAR; PG8_MMA(1, 1, At, B1); PG8_BAR;
            }
        }
        if constexpr (ALIGN_EPI) { if (wr == 0) PG8_BAR; }
        E(acc, cur, wr, wc, fr, fq);
        if (!has_next) break;
#pragma unroll
        for (int a = 0; a < 2; ++a)
#pragma unroll
            for (int b = 0; b < 2; ++b)
#pragma unroll
                for (int m = 0; m < 4; ++m)
#pragma unroll
                    for (int n = 0; n < 2; ++n) acc[a][b][m][n] = (f32x4){0.f, 0.f, 0.f, 0.f};
        cur = nxt; cA = nA; cB = nB; ++ui;
        if constexpr (ALIGN_EPI) { if (wr == 1) PG8_BAR; }
    }
    PG8_WAIT_V(0);
    if constexpr (!ALIGN_EPI) { if (wr == 0) PG8_BAR; }
    PG8_BAR;
#undef PG8_SA
#undef PG8_SB
#undef PG8_STAGE
#undef PG8_LDA
#undef PG8_LDB
#undef PG8_MMA
#undef PG8_WAIT_V
#undef PG8_WAIT_L
#undef PG8_BAR
#undef PG8_SCHED
}
}

struct Args { const float* in[22]; float* out; unsigned char* ws; };

__device__ __forceinline__ void transpose_item(const float* W, int ldw, int col_off, int K, int N, bf16_t* WT, LAS float* scr, int item, int lane) {
    const int nblk = N / 64, kb = item / nblk, nb = item % nblk, k0 = 64 * kb, n0 = 64 * nb;
    const int r = lane >> 4, c4 = lane & 15;
    f32x4 v[16];
#pragma unroll
    for (int i = 0; i < 16; ++i) v[i] = *(const f32x4*)(W + (size_t)(k0 + 4 * i + r) * ldw + col_off + n0 + 4 * c4);
#pragma unroll
    for (int i = 0; i < 16; ++i) { LAS float* d = scr + (4 * i + r) * 65 + 4 * c4; d[0] = v[i].x; d[1] = v[i].y; d[2] = v[i].z; d[3] = v[i].w; }
    asm volatile("s_waitcnt lgkmcnt(0)" ::: "memory");
    const int c = lane & 7;
#pragma unroll
    for (int j = 0; j < 8; ++j) { const int n = (lane >> 3) + 8 * j; const LAS float* s = scr + (8 * c) * 65 + n;
        u32x4 o; o.x = cvt_pk_bf16(s[0 * 65], s[1 * 65]); o.y = cvt_pk_bf16(s[2 * 65], s[3 * 65]); o.z = cvt_pk_bf16(s[4 * 65], s[5 * 65]); o.w = cvt_pk_bf16(s[6 * 65], s[7 * 65]);
        *(u32x4*)(WT + (size_t)(n0 + n) * K + k0 + 8 * c) = o; }
    asm volatile("s_waitcnt lgkmcnt(0)" ::: "memory");
}

__device__ __forceinline__ void s5_tables(LAS unsigned char* lds, const Args& a, int l, int g, int qt, int tid) {
    LAS f32x2* AP = (LAS f32x2*)lds;
    LAS f32x2* BB = AP + 65 * 64;
    LAS f32x2* CC = BB + 64 * 16;
    const int lg = l * 32 + g;
    const float* are = a.in[4] + lg * 64; const float* aim = a.in[5] + lg * 64;
    const float dt = expf(a.in[6][lg]);
    unsigned char* tab = a.ws + WS_S5 + (size_t)l * S5_LAYER;
    for (int idx = tid; idx < 65 * 64; idx += 512) {
        const int d = idx >> 6, p = idx & 63;
        const float lr = fminf(are[p], -1e-4f), li = aim[p];
        const float mag = expf(lr * dt * (float)d);
        double rev = (double)li * (double)dt * (double)d * 0.15915494309189535;
        rev -= floor(rev); if (rev > 0.5) rev -= 1.0;
        const float th = (float)(rev * 6.283185307179586);
        AP[idx] = (f32x2){mag * cosf(th), mag * sinf(th)};
    }
    for (int idx = tid; idx < 1024; idx += 512) CC[idx] = (f32x2){a.in[9][(size_t)lg * 1024 + idx], a.in[10][(size_t)lg * 1024 + idx]};
    for (int idx = tid; idx < 1024; idx += 512) {
        const int p = idx >> 4;
        const float lr = fminf(are[p], -1e-4f), li = aim[p];
        double rev = (double)li * (double)dt * 0.15915494309189535;
        rev -= floor(rev); if (rev > 0.5) rev -= 1.0;
        const float th = (float)(rev * 6.283185307179586);
        const float em1 = expm1f(lr * dt), c = cosf(th), s = sinf(th), sh = sinf(0.5f * th);
        const float nr = em1 * c - 2.f * sh * sh, ni = (1.f + em1) * s;
        const float den = 1.f / (lr * lr + li * li);
        const float qr = (nr * lr + ni * li) * den, qi = (ni * lr - nr * li) * den;
        const float br = a.in[7][(size_t)lg * 1024 + idx], bi = a.in[8][(size_t)lg * 1024 + idx];
        BB[idx] = (f32x2){qr * br - qi * bi, qr * bi + qi * br};
    }
    __syncthreads();
    bf16_t* kt = (bf16_t*)(tab + S5_KT) + (size_t)g * (65 * 256);
    if (tid < 256) { const int s = qt * 256 + tid;
        const int d = s >> 4, h = s & 15;
        float acc[16];
#pragma unroll
        for (int i = 0; i < 16; ++i) acc[i] = 0.f;
        for (int p = 0; p < 64; ++p) {
            const f32x2 cc = CC[h * 64 + p], ap = AP[d * 64 + p];
            const float cr = cc.x * ap.x - cc.y * ap.y, ci = cc.x * ap.y + cc.y * ap.x;
#pragma unroll
            for (int i = 0; i < 16; ++i) { const f32x2 bb = BB[p * 16 + i]; acc[i] += cr * bb.x - ci * bb.y; }
        }
        if (d == 0) { const float dsk = a.in[11][lg * 16 + h];
#pragma unroll
            for (int i = 0; i < 16; ++i) if (i == h) acc[i] += dsk; }
        u32x4 o0, o1;
        o0.x = cvt_pk_bf16(acc[0], acc[1]); o0.y = cvt_pk_bf16(acc[2], acc[3]); o0.z = cvt_pk_bf16(acc[4], acc[5]); o0.w = cvt_pk_bf16(acc[6], acc[7]);
        o1.x = cvt_pk_bf16(acc[8], acc[9]); o1.y = cvt_pk_bf16(acc[10], acc[11]); o1.z = cvt_pk_bf16(acc[12], acc[13]); o1.w = cvt_pk_bf16(acc[14], acc[15]);
        bf16_t* dst = kt + (size_t)(63 - d) * 256 + h * 8;
        *(u32x4*)dst = o0; *(u32x4*)(dst + 128) = o1;
    }
    if (qt == 0 && tid >= 256 && tid < 288) ((u32x4*)(kt + 64 * 256))[tid - 256] = (u32x4){0u, 0u, 0u, 0u};
    bf16_t* we = (bf16_t*)(tab + S5_WE) + (size_t)g * 128 * 1024;
    for (int idx = qt * 4096 + tid; idx < (qt + 1) * 4096; idx += 512) {
        const int half = idx & 1, j = (idx >> 1) & 63, row = idx >> 7, p = row & 63, im = row >> 6;
        const f32x2 ap = AP[(63 - j) * 64 + p];
        float v[8];
#pragma unroll
        for (int i = 0; i < 8; ++i) { const f32x2 bb = BB[p * 16 + 8 * half + i]; v[i] = im ? (ap.x * bb.y + ap.y * bb.x) : (ap.x * bb.x - ap.y * bb.y); }
        u32x4 o; o.x = cvt_pk_bf16(v[0], v[1]); o.y = cvt_pk_bf16(v[2], v[3]); o.z = cvt_pk_bf16(v[4], v[5]); o.w = cvt_pk_bf16(v[6], v[7]);
        *(u32x4*)(we + (size_t)row * 1024 + j * 16 + 8 * half) = o;
    }
    bf16_t* wc = (bf16_t*)(tab + S5_WC) + (size_t)g * 1024 * 128;
    for (int idx = qt * 4096 + tid; idx < (qt + 1) * 4096; idx += 512) {
        const int kgp = idx & 15, rowi = idx >> 4, t = rowi >> 4, h = rowi & 15, im = kgp >> 3, p0 = (kgp & 7) * 8;
        float v[8];
#pragma unroll
        for (int i = 0; i < 8; ++i) { const f32x2 cc = CC[h * 64 + p0 + i], ap = AP[(t + 1) * 64 + p0 + i];
            v[i] = im ? -(cc.x * ap.y + cc.y * ap.x) : (cc.x * ap.x - cc.y * ap.y); }
        u32x4 o; o.x = cvt_pk_bf16(v[0], v[1]); o.y = cvt_pk_bf16(v[2], v[3]); o.z = cvt_pk_bf16(v[4], v[5]); o.w = cvt_pk_bf16(v[6], v[7]);
        *(u32x4*)(wc + (size_t)rowi * 128 + kgp * 8) = o;
    }
    if (qt == 1 && tid < 64) {
        ((f32x2*)(tab + S5_A64))[g * 64 + tid] = AP[64 * 64 + tid];
        const int k = tid & 15, kg = tid >> 4; const float* wg = a.in[12] + (size_t)lg * 256;
        u32x4 o; o.x = cvt_pk_bf16(wg[(4 * kg + 0) * 16 + k], wg[(4 * kg + 1) * 16 + k]); o.y = cvt_pk_bf16(wg[(4 * kg + 2) * 16 + k], wg[(4 * kg + 3) * 16 + k]); o.z = 0u; o.w = 0u;
        ((u32x4*)(tab + S5_GLU))[g * 64 + tid] = o;
    }
    __syncthreads();
}

struct NormArgs { const float* resid; const bf16_t* add; const float* g_add; float* xout; const float* g_xn; bf16_t* xn; const float* wf; const float* bfh; float* logf; };
__device__ __forceinline__ void norm_phase(LAS unsigned char* lds, const NormArgs n, int gw, int ngw, int lane, int tid) {
    if (n.wf) {
        for (int i = tid; i < 2048; i += 512) { const int d = i >> 1, hh = i & 1; const f32x4 v = *(const f32x4*)(n.wf + (size_t)d * INW + 4 * hh);
            const int k = 4 * (d >> 8) + (d & 3), ln = (d >> 2) & 63;
            *(LAS f32x4*)(lds + ((k * 2 + hh) * 64 + ln) * 16) = v; }
        __syncthreads();
    }
    f32x4 ga[4], gx[4];
#pragma unroll
    for (int j = 0; j < 4; ++j) { ga[j] = n.add ? *(const f32x4*)(n.g_add + 4 * lane + 256 * j) : (f32x4){0.f, 0.f, 0.f, 0.f}; gx[j] = n.xn ? *(const f32x4*)(n.g_xn + 4 * lane + 256 * j) : (f32x4){0.f, 0.f, 0.f, 0.f}; }
    for (int rbase = gw; rbase < M; rbase += 2 * ngw) {
        f32x4 v[2][4]; f32x4 av[2][4];
#pragma unroll
        for (int rr = 0; rr < 2; ++rr) { const size_t row = (size_t)rbase + (size_t)rr * ngw;
#pragma unroll
            for (int j = 0; j < 4; ++j) v[rr][j] = *(const f32x4*)(n.resid + row * DM + 4 * lane + 256 * j);
            if (n.add) {
#pragma unroll
                for (int j = 0; j < 4; ++j) { const u32x2 u = *(const u32x2*)(n.add + row * DM + 4 * lane + 256 * j); av[rr][j] = (f32x4){bf_lo(u.x), bf_hi(u.x), bf_lo(u.y), bf_hi(u.y)}; }
            }
        }
#pragma unroll
        for (int rr = 0; rr < 2; ++rr) { const size_t row = (size_t)rbase + (size_t)rr * ngw;
            if (n.add) {
                float ss = 0.f;
#pragma unroll
                for (int j = 0; j < 4; ++j) ss += (av[rr][j].x * av[rr][j].x + av[rr][j].y * av[rr][j].y) + (av[rr][j].z * av[rr][j].z + av[rr][j].w * av[rr][j].w);
                const float rs = rsqrtf(wave_sum(ss) * (1.f / DM) + EPS);
#pragma unroll
                for (int j = 0; j < 4; ++j) v[rr][j] = v[rr][j] + av[rr][j] * rs * ga[j];
            }
            if (n.xout) {
#pragma unroll
                for (int j = 0; j < 4; ++j) *(f32x4*)(n.xout + row * DM + 4 * lane + 256 * j) = v[rr][j];
            }
            if (n.xn) {
                float ss = 0.f;
#pragma unroll
                for (int j = 0; j < 4; ++j) ss += (v[rr][j].x * v[rr][j].x + v[rr][j].y * v[rr][j].y) + (v[rr][j].z * v[rr][j].z + v[rr][j].w * v[rr][j].w);
                const float rs = rsqrtf(wave_sum(ss) * (1.f / DM) + EPS);
                f32x4 hn[4];
#pragma unroll
                for (int j = 0; j < 4; ++j) { hn[j] = v[rr][j] * rs * gx[j]; u32x2 o; o.x = cvt_pk_bf16(hn[j].x, hn[j].y); o.y = cvt_pk_bf16(hn[j].z, hn[j].w);
                    *(u32x2*)(n.xn + row * DM + 4 * lane + 256 * j) = o; }
                if (n.wf) {
                    f32x4 f0 = (f32x4){0.f, 0.f, 0.f, 0.f}, f1 = f0;
#pragma unroll
                    for (int j = 0; j < 4; ++j)
#pragma unroll
                        for (int i = 0; i < 4; ++i) { const LAS unsigned char* wp = lds + (((4 * j + i) * 2) * 64 + lane) * 16;
                            const f32x4 w0 = *(const LAS f32x4*)wp, w1 = *(const LAS f32x4*)(wp + 1024); f0 = f0 + w0 * hn[j][i]; f1 = f1 + w1 * hn[j][i]; }
                    float z = 0.f;
#pragma unroll
                    for (int hh = 0; hh < 4; ++hh) { const float s0 = wave_sum(f0[hh]), s1 = wave_sum(f1[hh]); if (lane == hh) z = s0; if (lane == hh + 4) z = s1; }
                    if (lane < 8) { z += n.bfh[lane]; n.logf[row * 8 + lane] = fminf(z, 0.f) - log1pf(expf(-fabsf(z))); }
                }
            }
        }
    }
}

__device__ __forceinline__ void cum_scan(LAS unsigned char* lds, const float* logf, float* cum, int bh, int tid, int lane, int w) {
    LAS float* ws = (LAS float*)lds;
    const int b = bh >> 3, h = bh & 7;
    float v[8]; float run = 0.f;
#pragma unroll
    for (int i = 0; i < 8; ++i) { run += logf[((size_t)b * SEQ + 8 * tid + i) * 8 + h]; v[i] = run; }
    float inc = run;
#pragma unroll
    for (int o = 1; o < 64; o <<= 1) { const float t = __int_as_float(__builtin_amdgcn_ds_bpermute((lane - o) << 2, __float_as_int(inc))); if (lane >= o) inc += t; }
    if (lane == 63) ws[w] = inc;
    __syncthreads();
    float base = inc - run;
    for (int i = 0; i < w; ++i) base += ws[i];
#pragma unroll
    for (int i = 0; i < 8; ++i) cum[(size_t)bh * SEQ + 8 * tid + i] = (base + v[i]) * LOG2E;
    __syncthreads();
}

#define MFMA16(a, b, c) __builtin_amdgcn_mfma_f32_16x16x32_bf16((a), (b), (c), 0, 0, 0)
#define MFMA32(a, b, c) __builtin_amdgcn_mfma_f32_32x32x16_bf16((a), (b), (c), 0, 0, 0)
__device__ __forceinline__ bf16x8 ldg16(const void* ubase, unsigned off) { return *(const bf16x8*)((const char*)ubase + off); }
__device__ __forceinline__ void s5_unit(LAS unsigned char* lds, const bf16_t* P, const unsigned char* tab, bf16_t* Ya, const int b, const int g, int tid, int lane, int w) {
    LAS unsigned char* KT = lds; LAS float* EL = (LAS float*)lds; LAS unsigned char* SPT = lds + 33280; LAS unsigned char* ULO = lds + 50688;
    const unsigned char* ktab = tab + S5_KT + (size_t)g * KT_BYTES;
    const int n = lane & 15, kg = lane >> 4, ntile = w & 3, wh = w >> 2;
    const bf16_t* WEu = (const bf16_t*)(tab + S5_WE) + (size_t)g * 128 * 1024 + (size_t)(64 * wh) * 1024;
    const bf16_t* WCu = (const bf16_t*)(tab + S5_WC) + (size_t)g * 1024 * 128 + (size_t)(wh * 16) * 128;
    const bf16_t* Uu = P + ((size_t)b * SEQ + (size_t)(16 * ntile) * 64) * NA + 16 * g;
    const unsigned uoff = (unsigned)((n * 64 + (kg >> 1)) * NA + 8 * (kg & 1)) * 2u;
    const unsigned weoff = (unsigned)(n * 1024 + 8 * kg) * 2u;
    const unsigned wcoff = (unsigned)(n * 128 + 8 * kg) * 2u;
    {
        u32x4 st[8];
#pragma unroll
        for (int i = 0; i < 8; ++i) { const int f = w * 8 + i, nt = f >> 4, jp = f & 15;
            st[i] = *(const u32x4*)((const char*)(P + ((size_t)b * SEQ + (size_t)(16 * nt) * 64 + 2 * jp) * NA + 16 * g) + uoff); }
#pragma unroll
        for (int i = 0; i < 8; ++i) *(LAS u32x4*)(ULO + ((w * 8 + i) * 64 + lane) * 16) = st[i];
    }
    __syncthreads();
    {
        f32x4 e[4];
#pragma unroll
        for (int mt = 0; mt < 4; ++mt) e[mt] = (f32x4){0.f, 0.f, 0.f, 0.f};
        bf16x8 eb[4], ea[4][4];
#define S5_ELD(ks) do { eb[(ks) & 3] = ((ks) < 16) ? *(const LAS bf16x8*)(ULO + ((ntile * 16 + ((ks) & 15)) * 64 + lane) * 16) : ldg16(Uu + (size_t)(2 * (ks)) * NA, uoff); _Pragma("unroll") for (int _m = 0; _m < 4; ++_m) ea[(ks) & 3][_m] = ldg16(WEu + (size_t)(16 * _m) * 1024 + 32 * (ks), weoff); } while (0)
        S5_ELD(0); S5_ELD(1); S5_ELD(2);
        __builtin_amdgcn_sched_barrier(0);
#pragma unroll
        for (int ks = 0; ks < 32; ++ks) {
            if (ks + 3 < 32) S5_ELD(ks + 3);
#pragma unroll
            for (int mt = 0; mt < 4; ++mt) e[mt] = MFMA16(ea[ks & 3][mt], eb[ks & 3], e[mt]);
            __builtin_amdgcn_sched_barrier(0);
        }
#undef S5_ELD
#pragma unroll
        for (int mt = 0; mt < 4; ++mt)
#pragma unroll
            for (int i = 0; i < 4; ++i) EL[(64 * wh + 16 * mt + 4 * kg + i) * 65 + 16 * ntile + n] = e[mt][i];
    }
    __syncthreads();
    {
        const int p = tid & 63, seg = tid >> 6;
        const f32x2 a1 = ((const f32x2*)(tab + S5_A64))[g * 64 + p];
        float lr[8], li[8]; float sr = 0.f, si = 0.f;
#pragma unroll
        for (int j = 0; j < 8; ++j) { const float er = EL[p * 65 + 8 * seg + j], ei = EL[(64 + p) * 65 + 8 * seg + j];
            const float nr = a1.x * sr - a1.y * si + er, ni = a1.x * si + a1.y * sr + ei; sr = nr; si = ni; lr[j] = sr; li[j] = si; }
        LAS f32x2* TT = (LAS f32x2*)(lds + 116224);
        TT[seg * 64 + p] = (f32x2){sr, si};
        f32x2 a2 = {a1.x * a1.x - a1.y * a1.y, 2.f * a1.x * a1.y}; f32x2 a4 = {a2.x * a2.x - a2.y * a2.y, 2.f * a2.x * a2.y}; const f32x2 a8 = {a4.x * a4.x - a4.y * a4.y, 2.f * a4.x * a4.y};
        __syncthreads();
        float cr = 0.f, ci = 0.f;
        for (int s2 = 0; s2 < seg; ++s2) { const f32x2 t = TT[s2 * 64 + p]; const float nr = a8.x * cr - a8.y * ci + t.x, ni = a8.x * ci + a8.y * cr + t.y; cr = nr; ci = ni; }
        float pr = cr, pi = ci, wr_ = cr, wi_ = ci;
#pragma unroll
        for (int j = 0; j < 8; ++j) {
            *(LAS bf16_t*)(SPT + (8 * seg + j) * 272 + 2 * p) = (bf16_t)(cvt_pk_bf16(pr, 0.f) & 0xffffu);
            *(LAS bf16_t*)(SPT + (8 * seg + j) * 272 + 2 * (64 + p)) = (bf16_t)(cvt_pk_bf16(pi, 0.f) & 0xffffu);
            const float nr = a1.x * wr_ - a1.y * wi_, ni = a1.x * wi_ + a1.y * wr_; wr_ = nr; wi_ = ni;
            pr = lr[j] + wr_; pi = li[j] + wi_;
        }
    }
    __syncthreads();
    for (int i = tid; i < KT_BYTES / 16; i += 512) *(LAS u32x4*)(KT + i * 16) = *(const u32x4*)(ktab + i * 16);
    __syncthreads();
    const LAS unsigned char* klow = KT + (1 - wh + (lane >> 5)) * 512 + ((lane >> 4) & 1) * 256 + (lane & 15) * 16;
    const LAS unsigned char* spb = SPT + (16 * ntile + n) * 272 + 16 * kg;
    const bf16x8 aglu = *(const bf16x8*)(tab + S5_GLU + (size_t)(g * 64 + lane) * 16);
    const unsigned yoff = (unsigned)(n * 64 * YW + 4 * kg) * 2u;
#pragma unroll 1
    for (int pass = 0; pass < 2; ++pass) {
        f32x4 acc[16];
#pragma unroll
        for (int i = 0; i < 16; ++i) acc[i] = (f32x4){0.f, 0.f, 0.f, 0.f};
        bf16x8 bq[4], ca[2][4], bt[8], bu[8];
        const bf16_t* Up = Uu + (size_t)(32 * pass) * NA;
        const bf16_t* WCp = WCu + (size_t)(32 * pass) * 2048;
#define S5_LDC(st, slot) do { _Pragma("unroll") for (int _q = 0; _q < 4; ++_q) ca[slot][_q] = ldg16(WCp + (size_t)(2 * (4 * ((st) & 3) + _q)) * 2048 + 32 * ((st) >> 2), wcoff); } while (0)
        if (pass == 1) {
#pragma unroll
            for (int jj = 0; jj < 8; ++jj) bt[jj] = ldg16(Up + (size_t)(2 * jj) * NA, uoff);
        }
        S5_LDC(0, 0); S5_LDC(1, 1);
        if (pass == 0) {
#pragma unroll
            for (int jj = 0; jj < 8; ++jj) { bt[jj] = *(const LAS bf16x8*)(ULO + ((ntile * 16 + jj) * 64 + lane) * 16); bu[jj] = *(const LAS bf16x8*)(ULO + ((ntile * 16 + 8 + jj) * 64 + lane) * 16); }
        }
        if (pass == 1) {
            __builtin_amdgcn_sched_barrier(0);
#pragma unroll
            for (int jj = 0; jj < 16; ++jj) {
                bq[jj & 3] = *(const LAS bf16x8*)(ULO + ((ntile * 16 + jj) * 64 + lane) * 16);
#pragma unroll
                for (int ii = 0; ii < 16; ++ii) { const bf16x8 af = *(const LAS bf16x8*)(klow + (30 - 2 * (ii - jj)) * 512); acc[ii] = MFMA16(af, bq[jj & 3], acc[ii]); }
                __builtin_amdgcn_sched_barrier(0);
            }
        }
        __builtin_amdgcn_sched_barrier(0);
#pragma unroll
        for (int jj = 0; jj < 16; ++jj) {
            const bf16x8 cb = *(const LAS bf16x8*)(spb + 64 * (jj >> 2));
            if (jj < 8 && pass == 1) bu[jj] = ldg16(Up + (size_t)(2 * (jj + 8)) * NA, uoff);
#pragma unroll
            for (int ii = 0; ii < 16; ++ii) if (ii >= jj) { const bf16x8 af = *(const LAS bf16x8*)(klow + (62 - 2 * (ii - jj)) * 512); acc[ii] = MFMA16(af, (jj < 8 ? bt[jj & 7] : bu[jj & 7]), acc[ii]); }
#pragma unroll
            for (int q = 0; q < 4; ++q) acc[4 * (jj & 3) + q] = MFMA16(ca[jj & 1][q], cb, acc[4 * (jj & 3) + q]);
            __builtin_amdgcn_sched_barrier(0);
            if (jj + 2 < 16) S5_LDC(jj + 2, jj & 1);
            __builtin_amdgcn_sched_barrier(0);
        }
#undef S5_LDC
        bf16_t* Yu = Ya + ((size_t)b * SEQ + (size_t)(16 * ntile) * 64 + wh + 32 * pass) * YW + 16 * g;
#pragma unroll
        for (int ii = 0; ii < 16; ++ii) {
            f32x4 y;
#pragma unroll
            for (int k = 0; k < 4; ++k) y[k] = gelu_tanh(acc[ii][k]);
            u32x4 bp; bp.x = cvt_pk_bf16(y[0], y[1]); bp.y = cvt_pk_bf16(y[2], y[3]); bp.z = 0u; bp.w = 0u;
            const f32x4 z = MFMA16(aglu, __builtin_bit_cast(bf16x8, bp), ((f32x4){0.f, 0.f, 0.f, 0.f}));
            u32x2 o; o.x = cvt_pk_bf16(y[0] * sigmoid_f(z[0]), y[1] * sigmoid_f(z[1])); o.y = cvt_pk_bf16(y[2] * sigmoid_f(z[2]), y[3] * sigmoid_f(z[3]));
            *(u32x2*)((char*)(Yu + (size_t)(2 * ii) * YW) + yoff) = o;
        }
    }
    __syncthreads();
}

constexpr int AT_KS = 0, AT_VT = 9216, AT_VP = 192, AT_BS = 9216 + 64 * AT_VP, AT_BUF = AT_BS + 256;
__device__ __forceinline__ int crow(int r, int hi) { return (r & 3) + 8 * (r >> 2) + 4 * hi; }
__device__ __forceinline__ void attn_unit(LAS unsigned char* lds, const bf16_t* P, const float* cum, bf16_t* Yc, const int b, const int h, const int qb, int tid, int lane, int w) {
    const int r32 = lane & 31, hi = lane >> 5;
    const size_t row0 = (size_t)b * SEQ;
    const int q0 = qb * 256, qrow = q0 + 32 * w + r32;
    bf16x8 qf[4];
    { const bf16_t* qp = P + (row0 + qrow) * NA + COL_Q + 64 * h + 8 * hi;
#pragma unroll
      for (int s = 0; s < 4; ++s) qf[s] = *(const bf16x8*)(qp + 16 * s); }
    const float* cumbh = cum + (size_t)(b * 8 + h) * SEQ;
    const float ref = cumbh[q0];
    const int vlane = (4 * hi + ((lane & 15) >> 2)) * AT_VP + 32 * ((lane >> 4) & 1) + 8 * (lane & 3);
    const int skey = tid >> 3, spc = tid & 7;
    const bf16_t* kgp = P + (row0 + skey) * NA + COL_K + 64 * h + 8 * spc;
    const int NT = 4 * qb + 4;
    u32x4 kreg = *(const u32x4*)kgp, vreg = *(const u32x4*)(kgp + (COL_V - COL_K)); float breg = 0.f; if (tid < 64) breg = ref - cumbh[tid];
#define AT_WRITE(bufp) do { LAS unsigned char* _b = (bufp); *(LAS u32x4*)(_b + AT_KS + skey * 144 + 16 * spc) = kreg; \
        *(LAS u32x4*)(_b + AT_VT + skey * AT_VP + 16 * spc) = vreg; \
        if (tid < 64) *(LAS float*)(_b + AT_BS + 4 * tid) = breg; } while (0)
    AT_WRITE(lds);
    __syncthreads();
    float mrun = -1e30f, lrun = 0.f; f32x16 o0, o1;
#pragma unroll
    for (int r = 0; r < 16; ++r) { o0[r] = 0.f; o1[r] = 0.f; }
    for (int kt = 0; kt < NT; ++kt) {
        const int cur = kt & 1; const bool more = (kt + 1 < NT);
        if (more) { const bf16_t* kp = kgp + (size_t)(kt + 1) * 64 * NA; kreg = *(const u32x4*)kp; vreg = *(const u32x4*)(kp + (COL_V - COL_K)); if (tid < 64) breg = ref - cumbh[64 * (kt + 1) + tid]; }
        if (64 * kt <= q0 + 32 * w + 31) {
            const LAS unsigned char* Kb = lds + cur * AT_BUF + AT_KS; const LAS unsigned char* Vb = lds + cur * AT_BUF + AT_VT; const LAS unsigned char* Bb = lds + cur * AT_BUF + AT_BS;
            f32x16 p[2];
#pragma unroll
            for (int rb = 0; rb < 2; ++rb) {
                f32x16 c;
#pragma unroll
                for (int g4 = 0; g4 < 4; ++g4) { const f32x4 bv = *(const LAS f32x4*)(Bb + (32 * rb + 8 * g4 + 4 * hi) * 4); c[4 * g4 + 0] = bv.x; c[4 * g4 + 1] = bv.y; c[4 * g4 + 2] = bv.z; c[4 * g4 + 3] = bv.w; }
#pragma unroll
                for (int s = 0; s < 4; ++s) { const bf16x8 af = *(const LAS bf16x8*)(Kb + (32 * rb + r32) * 144 + 32 * s + 16 * hi); c = MFMA32(af, qf[s], c); }
                p[rb] = c;
            }
            if (64 * kt + 63 > q0 + 32 * w) {
#pragma unroll
                for (int rb = 0; rb < 2; ++rb)
#pragma unroll
                    for (int r = 0; r < 16; ++r) { const int key = 64 * kt + 32 * rb + crow(r, hi); if (key > qrow) p[rb][r] = -1e30f; }
            }
            float mt = p[0][0];
#pragma unroll
            for (int r = 1; r < 16; ++r) mt = fmaxf(mt, p[0][r]);
#pragma unroll
            for (int r = 0; r < 16; ++r) mt = fmaxf(mt, p[1][r]);
            mt = half_max(mt);
            const float mnew = fmaxf(mrun, mt), alpha = fast_exp2(mrun - mnew);
            mrun = mnew;
            float ls = 0.f;
#pragma unroll
            for (int rb = 0; rb < 2; ++rb)
#pragma unroll
                for (int r = 0; r < 16; ++r) { p[rb][r] = fast_exp2(p[rb][r] - mnew); ls += p[rb][r]; }
            lrun = lrun * alpha + ls;
#pragma unroll
            for (int r = 0; r < 16; ++r) { o0[r] *= alpha; o1[r] *= alpha; }
            bf16x8 pf[4];
#pragma unroll
            for (int s = 0; s < 4; ++s) { const int rb = s >> 1, r0 = 8 * (s & 1); u32x4 pk; pk.x = cvt_pk_bf16(p[rb][r0 + 0], p[rb][r0 + 1]); pk.y = cvt_pk_bf16(p[rb][r0 + 2], p[rb][r0 + 3]);
                pk.z = cvt_pk_bf16(p[rb][r0 + 4], p[rb][r0 + 5]); pk.w = cvt_pk_bf16(p[rb][r0 + 6], p[rb][r0 + 7]); pf[s] = __builtin_bit_cast(bf16x8, pk); }
#pragma unroll
            for (int s = 0; s < 4; ++s) {
                typedef short v4i16_t __attribute__((ext_vector_type(4)));
                const LAS unsigned char* vp = Vb + vlane + 16 * s * AT_VP;
                { const s16x4 lo = __builtin_bit_cast(s16x4, __builtin_amdgcn_ds_read_tr16_b64_v4i16((LAS v4i16_t*)(vp))), hh = __builtin_bit_cast(s16x4, __builtin_amdgcn_ds_read_tr16_b64_v4i16((LAS v4i16_t*)(vp + 8 * AT_VP)));
                  const bf16x8 af = __builtin_shufflevector(lo, hh, 0, 1, 2, 3, 4, 5, 6, 7); o0 = MFMA32(af, pf[s], o0); }
                { const s16x4 lo = __builtin_bit_cast(s16x4, __builtin_amdgcn_ds_read_tr16_b64_v4i16((LAS v4i16_t*)(vp + 64))), hh = __builtin_bit_cast(s16x4, __builtin_amdgcn_ds_read_tr16_b64_v4i16((LAS v4i16_t*)(vp + 64 + 8 * AT_VP)));
                  const bf16x8 af = __builtin_shufflevector(lo, hh, 0, 1, 2, 3, 4, 5, 6, 7); o1 = MFMA32(af, pf[s], o1); }
            }
        }
        if (more) AT_WRITE(lds + (cur ^ 1) * AT_BUF);
        __syncthreads();
    }
#undef AT_WRITE
    const float ltot = half_sum(lrun);
    const float inv = 1.0f / ltot;
    bf16_t* op = Yc + (row0 + qrow) * YW + 64 * h + 4 * hi;
#pragma unroll
    for (int g4 = 0; g4 < 4; ++g4) {
        u32x2 a, c2;
        a.x = cvt_pk_bf16(o0[4 * g4 + 0] * inv, o0[4 * g4 + 1] * inv); a.y = cvt_pk_bf16(o0[4 * g4 + 2] * inv, o0[4 * g4 + 3] * inv);
        c2.x = cvt_pk_bf16(o1[4 * g4 + 0] * inv, o1[4 * g4 + 1] * inv); c2.y = cvt_pk_bf16(o1[4 * g4 + 2] * inv, o1[4 * g4 + 3] * inv);
        *(u32x2*)(op + 8 * g4) = a; *(u32x2*)(op + 32 + 8 * g4) = c2;
    }
}

__device__ __forceinline__ u32x4 conv_item(const bf16_t* P, const float* cw, int item) {
    const int token = item >> 6, c0 = (item & 63) * 8, t = token & (SEQ - 1);
    float acc[8];
#pragma unroll
    for (int i = 0; i < 8; ++i) acc[i] = 0.f;
    u32x4 xc[3], cc[3];
#pragma unroll
    for (int tap = 0; tap < 3; ++tap) {
        const bool ok = (t - 2 + tap >= 0);
        const bf16_t* rp = P + (size_t)(ok ? token - 2 + tap : token) * NA + c0;
        xc[tap] = *(const u32x4*)(rp + COL_XC); cc[tap] = *(const u32x4*)(rp + COL_CC);
        if (!ok) { xc[tap] = (u32x4){0u, 0u, 0u, 0u}; }
    }
    const u32x4 bc = *(const u32x4*)(P + (size_t)token * NA + COL_BC + c0);
#pragma unroll
    for (int tap = 0; tap < 3; ++tap) {
        const f32x4 w0 = *(const f32x4*)(cw + tap * 512 + c0), w1 = *(const f32x4*)(cw + tap * 512 + c0 + 4);
        const u32x4 x = xc[tap], c = cc[tap];
        acc[0] += w0.x * bf_lo(x.x) * bf_lo(c.x); acc[1] += w0.y * bf_hi(x.x) * bf_hi(c.x); acc[2] += w0.z * bf_lo(x.y) * bf_lo(c.y); acc[3] += w0.w * bf_hi(x.y) * bf_hi(c.y);
        acc[4] += w1.x * bf_lo(x.z) * bf_lo(c.z); acc[5] += w1.y * bf_hi(x.z) * bf_hi(c.z); acc[6] += w1.z * bf_lo(x.w) * bf_lo(c.w); acc[7] += w1.w * bf_hi(x.w) * bf_hi(c.w);
    }
    u32x4 o; o.x = cvt_pk_bf16(acc[0] * bf_lo(bc.x), acc[1] * bf_hi(bc.x)); o.y = cvt_pk_bf16(acc[2] * bf_lo(bc.y), acc[3] * bf_hi(bc.y));
    o.z = cvt_pk_bf16(acc[4] * bf_lo(bc.z), acc[5] * bf_hi(bc.z)); o.w = cvt_pk_bf16(acc[6] * bf_lo(bc.w), acc[7] * bf_hi(bc.w));
    return o;
}
__device__ __forceinline__ void conv_phase(const bf16_t* P, const float* cw, bf16_t* Yb, int gtid, int ngt) {
    for (int item = gtid; item < M * 64; item += 4 * ngt) {
        u32x4 o[4];
#pragma unroll
        for (int q = 0; q < 4; ++q) o[q] = conv_item(P, cw, item + q * ngt);
#pragma unroll
        for (int q = 0; q < 4; ++q) { const int it = item + q * ngt; *(u32x4*)(Yb + (size_t)(it >> 6) * YW + (it & 63) * 8) = o[q]; }
    }
}

#define XB_TMO      128
#define XB_XCNT(j)  (256  + 64 * (j))
#define XB_XSUB(j)  (1280 + 64 * (j))
#define XB_XGEN(j)  (2304 + 64 * (j))
#define XB_TOP      3328
#define XB_TOPGEN   3392
#define XCD_BAR_WORDS 3456
#define XB_SPIN_CAP (1u << 18)
__device__ __forceinline__ unsigned xb_ld(unsigned* p)              { return __hip_atomic_load(p, __ATOMIC_RELAXED, __HIP_MEMORY_SCOPE_AGENT); }
__device__ __forceinline__ unsigned xb_add(unsigned* p, unsigned v) { return __hip_atomic_fetch_add(p, v, __ATOMIC_RELAXED, __HIP_MEMORY_SCOPE_AGENT); }
__device__ __forceinline__ unsigned xb_xcc_id() { return (unsigned)__builtin_amdgcn_s_getreg((3 << 11) | 20) & 0xFu; }
#define XB_SPIN(cond, bar) do { unsigned _sp = 0; while (cond) { __builtin_amdgcn_s_sleep(1); \
    if ((++_sp & 255u) == 0u) { if (xb_ld(&(bar)[XB_TMO])) break; if (_sp > XB_SPIN_CAP) { atomicAdd(&(bar)[XB_TMO], 1u); break; } } } } while (0)
struct XcdBarrier { unsigned* bar; unsigned x; volatile LAS unsigned* st; };
__device__ __forceinline__ XcdBarrier xcd_barrier_post(unsigned* bar, volatile LAS unsigned* st) {
    XcdBarrier b; b.bar = bar; b.x = xb_xcc_id(); b.st = st;
    if (threadIdx.x == 0) (void)xb_add(&bar[XB_XCNT(b.x)], 1u);
    return b;
}
__device__ __forceinline__ void xcd_barrier_complete(unsigned* bar, unsigned x, unsigned& nloc, unsigned& nx) {
    const unsigned G = gridDim.x * gridDim.y * gridDim.z;
    unsigned sum, cnt, mine, sp = 0u;
    for (;;) {
        sum = 0u; cnt = 0u; mine = 0u;
#pragma unroll
        for (unsigned j = 0; j < 16; ++j) { const unsigned c = xb_ld(&bar[XB_XCNT(j)]); sum += c; cnt += (c > 0u) ? 1u : 0u; mine = (j == x) ? c : mine; }
        if (sum == G) break;
        __builtin_amdgcn_s_sleep(1);
        if ((++sp & 255u) == 0u) { if (xb_ld(&bar[XB_TMO])) break; if (sp > XB_SPIN_CAP) { atomicAdd(&bar[XB_TMO], 1u); break; } }
    }
    nloc = mine > 0u ? mine : 1u; nx = cnt > 0u ? cnt : 1u;
}
__device__ __forceinline__ void xcd_barrier(const XcdBarrier& b) {
    asm volatile("s_waitcnt vmcnt(0) lgkmcnt(0)" ::: "memory");
    __syncthreads();
    if (threadIdx.x == 0) {
        unsigned* bar = b.bar; unsigned bx = b.x;
        asm volatile("" : "+s"(bar), "+s"(bx));
        __builtin_amdgcn_s_waitcnt(0);
        unsigned nloc = b.st[0], nx = b.st[1];
        if (nloc == 0u) { xcd_barrier_complete(bar, bx, nloc, nx); b.st[0] = nloc; b.st[1] = nx; }
        const unsigned old = xb_add(&bar[XB_XSUB(bx)], 1u);
        const unsigned gen = old / nloc;
        if (old + 1u == (gen + 1u) * nloc) {
            __builtin_amdgcn_fence(__ATOMIC_RELEASE, "agent");
            asm volatile("s_waitcnt vmcnt(0)" ::: "memory");
            const unsigned og = xb_add(&bar[XB_TOP], 1u);
            const unsigned tg = og / nx;
            if (og + 1u == (tg + 1u) * nx) xb_add(&bar[XB_TOPGEN], 1u);
            else XB_SPIN(xb_ld(&bar[XB_TOPGEN]) == tg, bar);
            __builtin_amdgcn_fence(__ATOMIC_ACQUIRE, "agent");
            xb_add(&bar[XB_XGEN(bx)], 1u);
            asm volatile("s_waitcnt vmcnt(0)" ::: "memory");
        } else {
            XB_SPIN(xb_ld(&bar[XB_XGEN(bx)]) == gen, bar);
            __builtin_amdgcn_fence(__ATOMIC_ACQUIRE, "agent");
            asm volatile("s_waitcnt vmcnt(0)" ::: "memory");
        }
    }
    __syncthreads();
}
__device__ __forceinline__ void cg_barrier(cg::grid_group& grid) {
    asm volatile("s_waitcnt vmcnt(0) lgkmcnt(0)" ::: "memory");
    __syncthreads();
    grid.sync();
    if (threadIdx.x == 0) { __builtin_amdgcn_fence(__ATOMIC_ACQUIRE, "agent"); asm volatile("s_waitcnt vmcnt(0)" ::: "memory"); }
    __syncthreads();
}
#define grid_barrier(g_) xcd_barrier(xbar)

#ifndef DIAG_STAGE
#define DIAG_STAGE 0
#endif
__device__ __forceinline__ void diag_dump(float* out, const bf16_t* src, int ld, int ncols) {
    for (size_t i = (size_t)blockIdx.x * 512 + threadIdx.x; i < (size_t)M * DM; i += (size_t)gridDim.x * 512) {
        const size_t row = i >> 10; const int c = (int)(i & 1023); float v = 0.f;
        for (int cc = c; cc < ncols; cc += 1024) v += bf_lo((unsigned)src[row * ld + cc]);
        out[i] = v;
    }
}
#define DIAG(k, src, ld, ncols) do { if (DIAG_STAGE == (k)) { grid_barrier(grid); diag_dump(A_->out, (src), (ld), (ncols)); return; } } while (0)

typedef const __attribute__((address_space(4))) Args* KArgP;
__device__ __forceinline__ KArgP launder_args(KArgP p) { asm volatile("" : "+s"(p)); return p; }
#define A_ (launder_args(argp))
__global__ void __launch_bounds__(512, 2) fwd_kernel(Args a) {
    KArgP argp = (KArgP)__builtin_amdgcn_kernarg_segment_ptr(); (void)a;
    extern __shared__ __attribute__((aligned(16))) unsigned char lds_raw[];
    LAS unsigned char* lds = (LAS unsigned char*)lds_raw;
    cg::grid_group grid = cg::this_grid();
    if (gridDim.z == 12345u) grid.sync();
    volatile LAS unsigned* xst = (volatile LAS unsigned*)((LAS unsigned char*)lds_raw + LDS_BYTES - 64);
    if (threadIdx.x == 0) { xst[0] = 0u; xst[1] = 0u; }
    __syncthreads();
    const XcdBarrier xbar = xcd_barrier_post((unsigned*)(A_->ws + 16384), xst);
    const int G = gridDim.x, bid = blockIdx.x, ngw = G * 8;
#define FRESH() const int tid = launder_i(threadIdx.x), lane = tid & 63, w = __builtin_amdgcn_readfirstlane(tid >> 6), gw = bid * 8 + w; (void)lane; (void)gw
    unsigned char* ws = A_->ws;
    bf16_t* XN = (bf16_t*)(ws + WS_XN); bf16_t* PR = (bf16_t*)(ws + WS_P); bf16_t* Y = (bf16_t*)(ws + WS_Y);
    float* LOGF = (float*)(ws + WS_LOGF); float* CUM = (float*)(ws + WS_CUM);

    {
        FRESH();
#ifndef NO_TAB
        for (int u = bid; u < 256; u += G) s5_tables(lds, a, u >> 7, (u >> 2) & 31, u & 3, tid);
#endif
        LAS float* scr = (LAS float*)(lds + w * 16640);
        constexpr int I_A = 16 * 56, I_G = 16 * 48, I_B = 8 * 16, I_O = 16 * 16, I_1 = 16 * 64, I_2 = 64 * 16, I_L = I_A + I_G + 3 * I_B + I_O + I_1 + I_2;
        for (int it = gw; it < 2 * I_L; it += ngw) {
            const int l = it / I_L; int r = it - l * I_L;
            unsigned char* wl = ws + WS_W + (size_t)l * W_LAYER;
            const float* win = A_->in[2] + (size_t)l * DM * INW;
            if (r < I_A) { transpose_item(win, INW, 0, DM, NA, (bf16_t*)(wl + W_INA), scr, r, lane); continue; } r -= I_A;
            if (r < I_G) { transpose_item(win, INW, COL_G, DM, NG, (bf16_t*)(wl + W_G), scr, r, lane); continue; } r -= I_G;
            if (r < 3 * I_B) { const int br = r / I_B; transpose_item(A_->in[15] + (size_t)l * 1536 * DM + (size_t)br * 512 * DM, DM, 0, 512, DM, (bf16_t*)(wl + W_BR) + (size_t)br * DM * 512, scr, r - br * I_B, lane); continue; } r -= 3 * I_B;
            if (r < I_O) { transpose_item(A_->in[16] + (size_t)l * DM * DM, DM, 0, DM, DM, (bf16_t*)(wl + W_OUT), scr, r, lane); continue; } r -= I_O;
            if (r < I_1) { transpose_item(A_->in[19] + (size_t)l * DM * FF, FF, 0, DM, FF, (bf16_t*)(wl + W_1), scr, r, lane); continue; } r -= I_1;
            transpose_item(A_->in[20] + (size_t)l * FF * DM, DM, 0, FF, DM, (bf16_t*)(wl + W_2), scr, r, lane);
        }
        __syncthreads();
        NormArgs n{A_->in[0], nullptr, nullptr, nullptr, A_->in[1], XN, A_->in[2] + COL_F, A_->in[14], LOGF};
        norm_phase(lds, n, gw, ngw, lane, tid);
    }
    xcd_barrier(xbar);

    DIAG(1, XN, DM, DM);
#pragma unroll 1
    for (int l = 0; l < DEPTH; ++l) {
        unsigned char* wl = ws + WS_W + (size_t)l * W_LAYER;
        const unsigned char* s5tab = ws + WS_S5 + (size_t)l * S5_LAYER;
        const float* xin = (l == 0) ? A_->in[0] : A_->out;

        { FRESH(); for (int bh = bid; bh < 64; bh += G) cum_scan(lds, LOGF, CUM, bh, tid, lane, w); }
        {
            pg8::Gemm g{XN, (const bf16_t*)(wl + W_INA), M, NA, DM, 0, 0}; pg8::StaticOrder S; S.init(M, NA, G, bid, 1);
            pg8::Epi<pg8::EPI_PROJ> E{PR, NA, nullptr, nullptr};
#if (PHMASK >> 0) & 1
            pg8::gemm_phase<pg8::Epi<pg8::EPI_PROJ>, pg8::StaticOrder, true, true>(lds, g, S, E);
#endif
        }
        grid_barrier(grid);

        DIAG(2, PR, NA, NA);
        if ((bid >> 3) & 1) {
        for (int v = bid; v < 256; v += G) {
            FRESH(); const int bh = v >> 2, s = v & 3;
#pragma unroll 1
            for (int k = 0; k < 4; ++k) { const int qb = (k == 0) ? 15 - s : (k == 1) ? s : (k == 2) ? 11 - s : s + 4;
                attn_unit(lds, PR, CUM, Y + 2 * (size_t)M * YW, bh >> 3, bh & 7, qb, tid, lane, w); }
        }
        { FRESH(); for (int v = bid; v < 256; v += G) s5_unit(lds, PR, s5tab, Y, v >> 5, 4 * (v & 7) + ((v >> 3) & 3), tid, lane, w);     }
        } else {
        { FRESH(); for (int v = bid; v < 256; v += G) s5_unit(lds, PR, s5tab, Y, v >> 5, 4 * (v & 7) + ((v >> 3) & 3), tid, lane, w);     }
        for (int v = bid; v < 256; v += G) {
            FRESH(); const int bh = v >> 2, s = v & 3;
#pragma unroll 1
            for (int k = 0; k < 4; ++k) { const int qb = (k == 0) ? 15 - s : (k == 1) ? s : (k == 2) ? 11 - s : s + 4;
                attn_unit(lds, PR, CUM, Y + 2 * (size_t)M * YW, bh >> 3, bh & 7, qb, tid, lane, w); }
        }
        }
        grid_barrier(grid);
        { FRESH(); conv_phase(PR, A_->in[13] + (size_t)l * 3 * 512, Y + (size_t)M * YW, bid * 512 + tid, G * 512); }
        grid_barrier(grid);

        if (DIAG_STAGE == 3) { grid_barrier(grid); for (size_t i = (size_t)blockIdx.x * 512 + threadIdx.x; i < (size_t)M * DM; i += (size_t)gridDim.x * 512) { const size_t row = i >> 10; const int c = (int)(i & 511); A_->out[i] = bf_lo((unsigned)Y[row * YW + c]) + bf_lo((unsigned)Y[(size_t)M * YW + row * YW + c]) + bf_lo((unsigned)Y[2 * (size_t)M * YW + row * YW + c]); } return; }
        DIAG(31, Y + (size_t)M * YW, YW, YW); DIAG(32, Y + 2 * (size_t)M * YW, YW, YW);
        {
            pg8::Gemm g{XN, (const bf16_t*)(wl + W_G), M, NG, DM, 0, 0}; pg8::StaticOrder S; S.init(M, NG, G, bid, 1);
            pg8::Epi<pg8::EPI_GATE> E{PR, NG, A_->in[3] + (size_t)l * NG, nullptr};
#if (PHMASK >> 1) & 1
            pg8::gemm_phase<pg8::Epi<pg8::EPI_GATE>, pg8::StaticOrder, true, true>(lds, g, S, E);
#endif
        }
        grid_barrier(grid);

        DIAG(4, PR, NG, NG);
        {
            pg8::Gemm g{Y, (const bf16_t*)(wl + W_BR), M, DM, 512, (size_t)M * YW * 2, (size_t)DM * 512 * 2}; pg8::StaticOrder S; S.init(M, DM, G, bid, 3);
            pg8::Epi<pg8::EPI_BRANCH> E{XN, DM, nullptr, PR};
#if (PHMASK >> 2) & 1
            pg8::gemm_phase<pg8::Epi<pg8::EPI_BRANCH>, pg8::StaticOrder, true, true>(lds, g, S, E);
#endif
        }
        grid_barrier(grid);

        DIAG(5, XN, DM, DM);
        {
            pg8::Gemm g{XN, (const bf16_t*)(wl + W_OUT), M, DM, DM, 0, 0}; pg8::StaticOrder S; S.init(M, DM, G, bid, 1);
            pg8::Epi<pg8::EPI_PLAIN> E{PR, DM, nullptr, nullptr};
#if (PHMASK >> 3) & 1
            pg8::gemm_phase<pg8::Epi<pg8::EPI_PLAIN>, pg8::StaticOrder, true, true>(lds, g, S, E);
#endif
        }
        grid_barrier(grid);

        DIAG(6, PR, DM, DM);
        {
            FRESH(); NormArgs n{xin, PR, A_->in[17] + (size_t)l * DM, A_->out, A_->in[18] + (size_t)l * DM, XN, nullptr, nullptr, nullptr};
            norm_phase(lds, n, gw, ngw, lane, tid);
        }
        grid_barrier(grid);

        DIAG(7, XN, DM, DM);
        {
            pg8::Gemm g{XN, (const bf16_t*)(wl + W_1), M, FF, DM, 0, 0}; pg8::StaticOrder S; S.init(M, FF, G, bid, 1);
            pg8::Epi<pg8::EPI_RELU2> E{PR, FF, nullptr, nullptr};
#if (PHMASK >> 4) & 1
            pg8::gemm_phase<pg8::Epi<pg8::EPI_RELU2>, pg8::StaticOrder, true, true>(lds, g, S, E);
#endif
        }
        grid_barrier(grid);

        DIAG(8, PR, FF, FF);
        {
            pg8::Gemm g{PR, (const bf16_t*)(wl + W_2), M, DM, FF, 0, 0}; pg8::StaticOrder S; S.init(M, DM, G, bid, 1);
            pg8::Epi<pg8::EPI_PLAIN> E{XN, DM, nullptr, nullptr};
#if (PHMASK >> 5) & 1
            pg8::gemm_phase<pg8::Epi<pg8::EPI_PLAIN>, pg8::StaticOrder, true, true>(lds, g, S, E);
#endif
        }
        grid_barrier(grid);

        DIAG(9, XN, DM, DM);
        if (l + 1 < DEPTH) {
            FRESH(); NormArgs n{A_->out, XN, A_->in[21] + (size_t)l * DM, A_->out, A_->in[1] + (size_t)(l + 1) * DM, XN, A_->in[2] + (size_t)(l + 1) * DM * INW + COL_F, A_->in[14] + (l + 1) * 8, LOGF};
            norm_phase(lds, n, gw, ngw, lane, tid);
            grid_barrier(grid);
        } else {
            FRESH(); NormArgs n{A_->out, XN, A_->in[21] + (size_t)l * DM, A_->out, nullptr, nullptr, nullptr, nullptr, nullptr};
            norm_phase(lds, n, gw, ngw, lane, tid);
        }
    }
}

extern "C" void kernel_launch(void* const* d_in, const int* in_sizes, int n_in, void* d_out, int out_size, void* d_ws, size_t ws_size, hipStream_t stream) {
    static int grid = 0;
    if (grid == 0) {
        if (n_in != 22 || in_sizes[0] != M * DM || out_size != M * DM || ws_size < WS_END) { fprintf(stderr, "kernel_launch: unexpected shapes (n_in %d, in0 %d, out %d, ws %zu)\n", n_in, n_in > 0 ? in_sizes[0] : -1, out_size, ws_size); grid = -1; return; }
        int dev = 0, cus = 0, per_cu = 0;
        (void)hipGetDevice(&dev);
        (void)hipDeviceGetAttribute(&cus, hipDeviceAttributeMultiprocessorCount, dev);
        if (hipFuncSetAttribute((const void*)fwd_kernel, hipFuncAttributeMaxDynamicSharedMemorySize, LDS_BYTES) != hipSuccess) fprintf(stderr, "kernel_launch: hipFuncSetAttribute failed\n");
        if (hipOccupancyMaxActiveBlocksPerMultiprocessor(&per_cu, (const void*)fwd_kernel, 512, LDS_BYTES) != hipSuccess || per_cu < 1) { fprintf(stderr, "kernel_launch: occupancy query gave %d\n", per_cu); per_cu = 1; }
        (void)hipGetLastError();
        grid = cus * per_cu; if (grid > 256) grid = 256; if (grid < 1) grid = 256;
    }
    if (grid < 0) return;
    (void)hipMemsetAsync(d_ws, 0, 65536, stream);
    Args a{};
    for (int i = 0; i < 22; ++i) a.in[i] = (const float*)d_in[i];
    a.out = (float*)d_out; a.ws = (unsigned char*)d_ws;
    void* args[] = {&a};
    hipError_t e = hipLaunchCooperativeKernel((const void*)fwd_kernel, dim3(grid), dim3(512), args, LDS_BYTES, stream);
    if (e != hipSuccess) fprintf(stderr, "kernel_launch: cooperative launch failed: %s (grid %d)\n", hipGetErrorString(e), grid);
}
```

```cpp
#include <hip/hip_runtime.h>
#include <hip/hip_cooperative_groups.h>
#include <cstdio>
#include <cstdint>
namespace cg = cooperative_groups;

#define DIAG_STAGE 0
#ifndef PHMASK
#define PHMASK 0xff
#endif

#define LAS __attribute__((address_space(3)))
typedef unsigned short bf16_t;
typedef short bf16x8 __attribute__((ext_vector_type(8)));
typedef short s16x4 __attribute__((ext_vector_type(4)));
typedef float f32x2 __attribute__((ext_vector_type(2)));
typedef float f32x4 __attribute__((ext_vector_type(4)));
typedef float f32x16 __attribute__((ext_vector_type(16)));
typedef unsigned u32x2 __attribute__((ext_vector_type(2)));
typedef unsigned u32x4 __attribute__((ext_vector_type(4)));

constexpr int BATCH = 8, SEQ = 4096, DM = 1024, M = BATCH * SEQ, DEPTH = 2;
constexpr int INW = 6664, NA = 3584, NG = 3072, FF = 4096, YW = 512;
constexpr int COL_XC = 512, COL_BC = 1024, COL_CC = 1536, COL_Q = 2048, COL_K = 2560, COL_V = 3072, COL_F = 3584, COL_G = 3592;
constexpr float EPS = 1e-6f;
constexpr float LOG2E = 1.4426950408889634f;
constexpr float C2 = 0.125f * LOG2E;

constexpr size_t MiB = 1u << 20;
constexpr size_t WS_W = 1 * MiB, W_LAYER = 34 * MiB;
constexpr size_t W_INA = 0, W_G = 7 * MiB, W_BR = 13 * MiB, W_OUT = 16 * MiB, W_1 = 18 * MiB, W_2 = 26 * MiB;
constexpr size_t WS_S5 = 69 * MiB, S5_LAYER = 17 * MiB + 512 * 1024;
constexpr size_t S5_KT = 0, S5_WE = MiB + 256 * 1024, S5_WC = S5_WE + 8 * MiB, S5_A64 = S5_WC + 8 * MiB, S5_GLU = S5_A64 + 64 * 1024;
constexpr size_t WS_LOGF = 104 * MiB, WS_CUM = 105 * MiB, WS_XN = 106 * MiB, WS_P = 170 * MiB, WS_Y = 394 * MiB, WS_END = 490 * MiB;
constexpr int KT_BYTES = 65 * 512;

constexpr int LDS_BYTES = 147456;

typedef __bf16 bf16x2_t __attribute__((ext_vector_type(2)));
__device__ __forceinline__ unsigned cvt_pk_bf16(float lo, float hi) { const f32x2 v = {lo, hi}; const bf16x2_t b = __builtin_convertvector(v, bf16x2_t); return __builtin_bit_cast(unsigned, b); }
__device__ __forceinline__ float bf_lo(unsigned u) { return __uint_as_float(u << 16); }
__device__ __forceinline__ float bf_hi(unsigned u) { return __uint_as_float(u & 0xffff0000u); }
template <int O> __device__ __forceinline__ float swz_xor(float v) { return __int_as_float(__builtin_amdgcn_ds_swizzle(__float_as_int(v), (O << 10) | 0x1f)); }
__device__ __forceinline__ float half_sum(float v) { auto rr = __builtin_amdgcn_permlane32_swap(__float_as_uint(v), __float_as_uint(v), false, false); return __uint_as_float(rr[0]) + __uint_as_float(rr[1]); }
__device__ __forceinline__ float half_max(float v) { auto rr = __builtin_amdgcn_permlane32_swap(__float_as_uint(v), __float_as_uint(v), false, false); return fmaxf(__uint_as_float(rr[0]), __uint_as_float(rr[1])); }
__device__ __forceinline__ float wave_sum(float v) {
    v += swz_xor<1>(v); v += swz_xor<2>(v); v += swz_xor<4>(v); v += swz_xor<8>(v); v += swz_xor<16>(v);
    return half_sum(v);
}
__device__ __forceinline__ int launder_i(int x) { asm volatile("" : "+v"(x)); return x; }
__device__ __forceinline__ float fast_exp2(float x) { return __builtin_amdgcn_exp2f(x); }
__device__ __forceinline__ float fast_rcp(float x) { return __builtin_amdgcn_rcpf(x); }
__device__ __forceinline__ float sigmoid_f(float z) { return fast_rcp(1.0f + fast_exp2(-LOG2E * z)); }
__device__ __forceinline__ float gelu_tanh(float y) { const float t = y + 0.044715f * y * y * y; return y * fast_rcp(1.0f + fast_exp2(-2.302208198f * t)); }

namespace pg8 {
#define PG8_LAS __attribute__((address_space(3)))
constexpr int BM = 256, BK = 64, HALF = 128, HTB = HALF * BK * 2, STAGE_BYTES = 8 * HTB, NXCD = 8, WGM = 8;

__host__ __device__ __forceinline__ int lds_byte(int r, int c) { const int st = (r >> 4) * 2 + (c >> 5), rr = r & 15, cc = c & 31, ob = rr * 64 + cc * 2; return st * 1024 + (ob ^ (((ob >> 9) & 1) << 5)); }
__host__ __device__ __forceinline__ void stage_rc(int b, int& R, int& C) { const int st = b / 1024, sb = b % 1024, swz = sb ^ (((sb >> 9) & 1) << 5); R = (st >> 1) * 16 + swz / 64; C = (st & 1) * 32 + (swz % 64) / 2; }
__host__ __device__ __forceinline__ int perm32(int rho) { const int n = rho >> 4, i = rho & 15; return 8 * (i >> 2) + 4 * n + (i & 3); }

struct Unit { int pm, pn, br; };
struct Gemm { const bf16_t* A; const bf16_t* Bt; int M, N, K; size_t abr, bbr; };

struct StaticOrder {
    int nM, nN, nwg, G, c, nbr;
    __device__ void init(int M_, int N_, int G_, int c_, int nbr_) { nM = M_ / BM; nN = N_ / BM; nwg = nM * nN; G = G_; c = c_; nbr = nbr_; }
    __device__ bool next(int i, Unit& u) const {
        const int it = i / nbr; u.br = i - it * nbr;
        const long L = (long)it * G + c; if (L >= nwg) return false;
        int wgid = (int)L; { const int q = nwg / NXCD, r = nwg % NXCD, xcd = wgid % NXCD, off = wgid / NXCD; wgid = (xcd < r ? xcd * (q + 1) : r * (q + 1) + (xcd - r) * q) + off; }
        const int nig = WGM * nN, gid = wgid / nig, fm = gid * WGM, gsz = (nM - fm) < WGM ? (nM - fm) : WGM;
        u.pm = fm + ((wgid % nig) % gsz); u.pn = (wgid % nig) / gsz; return true;
    }
};

enum { EPI_PROJ = 0, EPI_GATE = 1, EPI_RELU2 = 2, EPI_BRANCH = 3, EPI_PLAIN = 4 };
template <int MODE> struct Epi {
    static constexpr bool PERM = true;
    bf16_t* O; int ldc; const float* bias; const bf16_t* G;
    __device__ __forceinline__ void operator()(const f32x4 (&acc)[2][2][4][2], const Unit& u, int wr, int wc, int fr, int fq) const {
        const int row0 = u.pm * BM + wr * 64 + fr; const int col0 = u.pn * BM + wc * 32 + 8 * fq;
        float sc = 1.f; if (MODE == EPI_PROJ) { if (u.pn >= COL_Q / 256 && u.pn < COL_K / 256) sc = C2; }
        f32x4 bv[2][2];
        if (MODE == EPI_GATE) {
#pragma unroll
            for (int bj = 0; bj < 2; ++bj)
#pragma unroll
                for (int n = 0; n < 2; ++n) bv[bj][n] = *(const f32x4*)(bias + col0 + bj * HALF + 4 * n);
        }
        if (MODE == EPI_BRANCH) {
#pragma unroll
            for (int ai = 0; ai < 2; ++ai) {
                u32x2 gt[4][2]; u32x4 pv[4][2];
#pragma unroll
                for (int m = 0; m < 4; ++m)
#pragma unroll
                    for (int bj = 0; bj < 2; ++bj) {
                        const size_t row = (size_t)(row0 + ai * HALF + m * 16);
                        gt[m][bj] = *(const u32x2*)((const unsigned char*)G + row * NG + (size_t)u.br * DM + col0 + bj * HALF);
                        pv[m][bj] = (u.br > 0) ? *(const u32x4*)(O + row * ldc + col0 + bj * HALF) : (u32x4){0u, 0u, 0u, 0u};
                    }
                __builtin_amdgcn_sched_barrier(0);
#pragma unroll
                for (int m = 0; m < 4; ++m)
#pragma unroll
                    for (int bj = 0; bj < 2; ++bj) {
                        const size_t row = (size_t)(row0 + ai * HALF + m * 16);
                        f32x4 v0 = acc[ai][bj][m][0], v1 = acc[ai][bj][m][1];
                        const u32x2 g8 = gt[m][bj]; const u32x4 p4 = pv[m][bj];
                        v0 = v0 * (1.f / 255.f); v1 = v1 * (1.f / 255.f);
                        v0[0] = v0[0] * (float)(g8.x & 0xffu) + bf_lo(p4.x); v0[1] = v0[1] * (float)((g8.x >> 8) & 0xffu) + bf_hi(p4.x); v0[2] = v0[2] * (float)((g8.x >> 16) & 0xffu) + bf_lo(p4.y); v0[3] = v0[3] * (float)(g8.x >> 24) + bf_hi(p4.y);
                        v1[0] = v1[0] * (float)(g8.y & 0xffu) + bf_lo(p4.z); v1[1] = v1[1] * (float)((g8.y >> 8) & 0xffu) + bf_hi(p4.z); v1[2] = v1[2] * (float)((g8.y >> 16) & 0xffu) + bf_lo(p4.w); v1[3] = v1[3] * (float)(g8.y >> 24) + bf_hi(p4.w);
                        u32x4 wv; wv.x = cvt_pk_bf16(v0[0], v0[1]); wv.y = cvt_pk_bf16(v0[2], v0[3]); wv.z = cvt_pk_bf16(v1[0], v1[1]); wv.w = cvt_pk_bf16(v1[2], v1[3]);
                        *(u32x4*)(O + row * ldc + col0 + bj * HALF) = wv;
                    }
                __builtin_amdgcn_sched_barrier(0);
            }
            return;
        }
#pragma unroll
        for (int ai = 0; ai < 2; ++ai)
#pragma unroll
            for (int m = 0; m < 4; ++m) {
                const size_t row = (size_t)(row0 + ai * HALF + m * 16);
                bf16_t* rowp = O + row * ldc + col0;
#pragma unroll
                for (int bj = 0; bj < 2; ++bj) {
                    f32x4 v0 = acc[ai][bj][m][0], v1 = acc[ai][bj][m][1];
                    if (MODE == EPI_PROJ) { v0 = v0 * sc; v1 = v1 * sc; }
                    if (MODE == EPI_GATE) {
                        v0 = v0 + bv[bj][0]; v1 = v1 + bv[bj][1];
                        u32x2 w8; w8.x = 0u; w8.y = 0u;
#pragma unroll
                        for (int i = 0; i < 4; ++i) { w8.x |= (unsigned)(sigmoid_f(v0[i]) * 255.f + 0.5f) << (8 * i); w8.y |= (unsigned)(sigmoid_f(v1[i]) * 255.f + 0.5f) << (8 * i); }
                        *(u32x2*)((unsigned char*)O + row * ldc + col0 + bj * HALF) = w8;
                        continue;
                    }
                    if (MODE == EPI_RELU2) {
#pragma unroll
                        for (int i = 0; i < 4; ++i) { const float a = fmaxf(v0[i], 0.f), b = fmaxf(v1[i], 0.f); v0[i] = a * a; v1[i] = b * b; }
                    }
                    if (MODE == EPI_BRANCH) {
                        const u32x4 gt = *(const u32x4*)(G + row * NG + (size_t)u.br * DM + col0 + bj * HALF);
                        v0[0] *= bf_lo(gt.x); v0[1] *= bf_hi(gt.x); v0[2] *= bf_lo(gt.y); v0[3] *= bf_hi(gt.y);
                        v1[0] *= bf_lo(gt.z); v1[1] *= bf_hi(gt.z); v1[2] *= bf_lo(gt.w); v1[3] *= bf_hi(gt.w);
                        if (u.br > 0) {
                            const u32x4 pv = *(const u32x4*)(rowp + bj * HALF);
                            v0[0] += bf_lo(pv.x); v0[1] += bf_hi(pv.x); v0[2] += bf_lo(pv.y); v0[3] += bf_hi(pv.y);
                            v1[0] += bf_lo(pv.z); v1[1] += bf_hi(pv.z); v1[2] += bf_lo(pv.w); v1[3] += bf_hi(pv.w);
                        }
                    }
                    u32x4 w; w.x = cvt_pk_bf16(v0[0], v0[1]); w.y = cvt_pk_bf16(v0[2], v0[3]); w.z = cvt_pk_bf16(v1[0], v1[1]); w.w = cvt_pk_bf16(v1[2], v1[3]);
                    *(u32x4*)(rowp + bj * HALF) = w;
                }
            }
    }
};

template <class EpiT, class Sched, bool ALIGN_EPI, bool SP2>
__device__ __forceinline__ void gemm_phase(PG8_LAS unsigned char* lds, const Gemm g, const Sched& S, const EpiT& E) {
    const int tid = launder_i(threadIdx.x), wid = __builtin_amdgcn_readfirstlane(tid >> 6), lane = tid & 63, wr = wid >> 2, wc = wid & 3, fr = lane & 15, fq = lane >> 4;
    const int K = g.K, nt = K / BK;
    unsigned voffA[2], voffB[2];
#pragma unroll
    for (int i = 0; i < 2; ++i) { int R, C; stage_rc(tid * 16 + i * 8192, R, C); const int Rb = EpiT::PERM ? ((R & ~31) + perm32(R & 31)) : R;
        voffA[i] = (unsigned)(R * K + C) * 2u; voffB[i] = (unsigned)(Rb * K + C) * 2u; }
    const size_t kstep = (size_t)(BK * 2);
    const size_t hstep = (size_t)HALF * K * 2;
    const size_t tstep = 2 * hstep;
    const unsigned ldsw = (unsigned)wid * 1024u;
    const int aoff = lds_byte(wr * 64 + fr, fq * 8), boff = lds_byte(wc * 32 + fr, fq * 8);
#define PG8_SA(b, h) (((b) * 2 + (h)) * HTB)
#define PG8_SB(b, h) ((4 + (b) * 2 + (h)) * HTB)
#define PG8_STAGE(bufoff, gbase, voff) do { _Pragma("unroll") for (int _i = 0; _i < 2; ++_i) \
        __builtin_amdgcn_global_load_lds((const unsigned*)((const char*)(gbase) + (voff)[_i]), (PG8_LAS unsigned*)(lds + (bufoff) + ldsw + _i * 8192), 16, 0, 0); } while (0)
#define PG8_LDA(dst, b, h) do { _Pragma("unroll") for (int m = 0; m < 4; ++m) _Pragma("unroll") for (int k = 0; k < 2; ++k) dst[m][k] = *(const PG8_LAS bf16x8*)(lds + PG8_SA(b, h) + aoff + m * 2048 + k * 1024); } while (0)
#define PG8_LDB(dst, b, h) do { _Pragma("unroll") for (int n = 0; n < 2; ++n) _Pragma("unroll") for (int k = 0; k < 2; ++k) dst[n][k] = *(const PG8_LAS bf16x8*)(lds + PG8_SB(b, h) + boff + n * 2048 + k * 1024); } while (0)
#define PG8_MMA(ai, bj, At, Bt) do { __builtin_amdgcn_s_setprio(1); _Pragma("unroll") for (int m = 0; m < 4; ++m) _Pragma("unroll") for (int n = 0; n < 2; ++n) _Pragma("unroll") for (int k = 0; k < 2; ++k) \
        acc[ai][bj][m][n] = __builtin_amdgcn_mfma_f32_16x16x32_bf16(Bt[n][k], At[m][k], acc[ai][bj][m][n], 0, 0, 0); __builtin_amdgcn_s_setprio(0); } while (0)
#define PG8_WAIT_V(n) asm volatile("s_waitcnt vmcnt(" #n ")" ::: "memory")
#define PG8_WAIT_L(n) asm volatile("s_waitcnt lgkmcnt(" #n ")" ::: "memory")
#define PG8_BAR __builtin_amdgcn_s_barrier()
#define PG8_SCHED __builtin_amdgcn_sched_barrier(0)
    Unit cur, nxt; int ui = 0;
    if (!S.next(0, cur)) return;
    f32x4 acc[2][2][4][2];
#pragma unroll
    for (int a = 0; a < 2; ++a)
#pragma unroll
        for (int b = 0; b < 2; ++b)
#pragma unroll
            for (int m = 0; m < 4; ++m)
#pragma unroll
                for (int n = 0; n < 2; ++n) acc[a][b][m][n] = (f32x4){0.f, 0.f, 0.f, 0.f};
    bf16x8 At[4][2], B0[2][2], B1[2][2];
    const char* cA = (const char*)g.A + (size_t)cur.pm * tstep + (size_t)cur.br * g.abr; const char* cB = (const char*)g.Bt + (size_t)cur.pn * tstep + (size_t)cur.br * g.bbr;
    if constexpr (SP2) {
        PG8_STAGE(PG8_SB(0, 0), cB, voffB); PG8_STAGE(PG8_SB(0, 1), cB + hstep, voffB); PG8_STAGE(PG8_SA(0, 0), cA, voffA); PG8_STAGE(PG8_SA(0, 1), cA + hstep, voffA);
        if (wr == 1) PG8_BAR;
        PG8_WAIT_V(2); PG8_BAR;
        PG8_STAGE(PG8_SB(1, 0), cB + kstep, voffB); PG8_STAGE(PG8_SA(1, 0), cA + kstep, voffA); PG8_STAGE(PG8_SB(1, 1), cB + hstep + kstep, voffB);
        PG8_WAIT_V(6); PG8_BAR;
    } else {
        PG8_STAGE(PG8_SB(0, 0), cB, voffB); PG8_STAGE(PG8_SA(0, 0), cA, voffA); PG8_STAGE(PG8_SB(0, 1), cB + hstep, voffB); PG8_STAGE(PG8_SA(0, 1), cA + hstep, voffA);
        if (wr == 1) PG8_BAR;
        PG8_WAIT_V(4); PG8_BAR;
        PG8_STAGE(PG8_SB(1, 0), cB + kstep, voffB); PG8_STAGE(PG8_SA(1, 0), cA + kstep, voffA); PG8_STAGE(PG8_SB(1, 1), cB + hstep + kstep, voffB);
        PG8_WAIT_V(6); PG8_BAR;
    }
    for (;;) {
        const bool has_next = S.next(ui + 1, nxt);
        const char* nA = has_next ? (const char*)g.A + (size_t)nxt.pm * tstep + (size_t)nxt.br * g.abr : cA;
        const char* nB = has_next ? (const char*)g.Bt + (size_t)nxt.pn * tstep + (size_t)nxt.br * g.bbr : cB;
        for (int t = 0; t < nt; t += 2) {
            const bool last = (t == nt - 2);
            const char* a1 = cA + (size_t)(t + 1) * kstep;
            const char* a2 = last ? nA : cA + (size_t)(t + 2) * kstep; const char* b2 = last ? nB : cB + (size_t)(t + 2) * kstep;
            const char* a3 = a2 + kstep; const char* b3 = b2 + kstep;
            if constexpr (SP2) {
            PG8_LDB(B0, 0, 0); PG8_LDB(B1, 0, 1); PG8_SCHED; PG8_LDA(At, 0, 0); PG8_STAGE(PG8_SA(1, 1), a1 + hstep, voffA);
            PG8_WAIT_V(8); PG8_WAIT_L(0); PG8_BAR; PG8_MMA(0, 0, At, B0); PG8_MMA(0, 1, At, B1); PG8_BAR; PG8_SCHED;
            PG8_LDA(At, 0, 1); PG8_STAGE(PG8_SB(0, 0), b2, voffB); PG8_STAGE(PG8_SB(0, 1), b2 + hstep, voffB); PG8_STAGE(PG8_SA(0, 0), a2, voffA);
            PG8_WAIT_V(8); PG8_WAIT_L(0); PG8_BAR; PG8_MMA(1, 0, At, B0); PG8_MMA(1, 1, At, B1); PG8_BAR; PG8_SCHED;
            PG8_LDB(B0, 1, 0); PG8_LDB(B1, 1, 1); PG8_SCHED; PG8_LDA(At, 1, 0); PG8_STAGE(PG8_SA(0, 1), a2 + hstep, voffA);
            PG8_WAIT_V(8); PG8_WAIT_L(0); PG8_BAR; PG8_MMA(0, 0, At, B0); PG8_MMA(0, 1, At, B1); PG8_BAR; PG8_SCHED;
            PG8_LDA(At, 1, 1); PG8_STAGE(PG8_SB(1, 0), b3, voffB); PG8_STAGE(PG8_SB(1, 1), b3 + hstep, voffB); PG8_STAGE(PG8_SA(1, 0), a3, voffA);
            PG8_WAIT_V(8); PG8_WAIT_L(0); PG8_BAR; PG8_MMA(1, 0, At, B0); PG8_MMA(1, 1, At, B1); PG8_BAR; PG8_SCHED;
            } else {
            PG8_LDB(B0, 0, 0); PG8_SCHED; PG8_LDA(At, 0, 0); PG8_STAGE(PG8_SA(1, 1), a1 + hstep, voffA);
            PG8_WAIT_L(8); PG8_BAR; PG8_WAIT_L(0); PG8_MMA(0, 0, At, B0); PG8_BAR; PG8_SCHED;
            PG8_LDB(B1, 0, 1); PG8_STAGE(PG8_SB(0, 0), b2, voffB);
            PG8_BAR; PG8_WAIT_L(0); PG8_MMA(0, 1, At, B1); PG8_BAR;
            PG8_LDA(At, 0, 1); PG8_STAGE(PG8_SA(0, 0), a2, voffA);
            PG8_BAR; PG8_WAIT_L(0); PG8_MMA(1, 0, At, B0); PG8_BAR; PG8_SCHED;
            PG8_STAGE(PG8_SB(0, 1), b2 + hstep, voffB);
            PG8_WAIT_V(6); PG8_BAR; PG8_MMA(1, 1, At, B1); PG8_BAR;
            PG8_LDB(B0, 1, 0); PG8_SCHED; PG8_LDA(At, 1, 0); PG8_STAGE(PG8_SA(0, 1), a2 + hstep, voffA);
            PG8_WAIT_L(8); PG8_BAR; PG8_WAIT_L(0); PG8_MMA(0, 0, At, B0); PG8_BAR; PG8_SCHED;
            PG8_LDB(B1, 1, 1); PG8_STAGE(PG8_SB(1, 0), b3, voffB);
            PG8_BAR; PG8_WAIT_L(0); PG8_MMA(0, 1, At, B1); PG8_BAR;
            PG8_LDA(At, 1, 1); PG8_STAGE(PG8_SA(1, 0), a3, voffA);
            PG8_BAR; PG8_WAIT_L(0); PG8_MMA(1, 0, At, B0); PG8_BAR; PG8_SCHED;
            PG8_STAGE(PG8_SB(1, 1), b3 + hstep, voffB);
            PG8_WAIT_V(6); PG8_BAR; PG8_MMA(1, 1, At, B1); PG8_BAR;
            }
        }
        if constexpr (ALIGN_EPI) { if (wr == 0) PG8_BAR; }
        E(acc, cur, wr, wc, fr, fq);
        if (!has_next) break;
#pragma unroll
        for (int a = 0; a < 2; ++a)
#pragma unroll
            for (int b = 0; b < 2; ++b)
#pragma unroll
                for (int m = 0; m < 4; ++m)
#pragma unroll
                    for (int n = 0; n < 2; ++n) acc[a][b][m][n] = (f32x4){0.f, 0.f, 0.f, 0.f};
        cur = nxt; cA = nA; cB = nB; ++ui;
        if constexpr (ALIGN_EPI) { if (wr == 1) PG8_BAR; }
    }
    PG8_WAIT_V(0);
    if constexpr (!ALIGN_EPI) { if (wr == 0) PG8_BAR; }
    PG8_BAR;
#undef PG8_SA
#undef PG8_SB
#undef PG8_STAGE
#undef PG8_LDA
#undef PG8_LDB
#undef PG8_MMA
#undef PG8_WAIT_V
#undef PG8_WAIT_L
#undef PG8_BAR
#undef PG8_SCHED
}
}

struct Args { const float* in[22]; float* out; unsigned char* ws; };

__device__ __forceinline__ void transpose_item(const float* W, int ldw, int col_off, int K, int N, bf16_t* WT, LAS float* scr, int item, int lane) {
    const int nblk = N / 64, kb = item / nblk, nb = item % nblk, k0 = 64 * kb, n0 = 64 * nb;
    const int r = lane >> 4, c4 = lane & 15;
    f32x4 v[16];
#pragma unroll
    for (int i = 0; i < 16; ++i) v[i] = *(const f32x4*)(W + (size_t)(k0 + 4 * i + r) * ldw + col_off + n0 + 4 * c4);
#pragma unroll
    for (int i = 0; i < 16; ++i) { LAS float* d = scr + (4 * i + r) * 65 + 4 * c4; d[0] = v[i].x; d[1] = v[i].y; d[2] = v[i].z; d[3] = v[i].w; }
    asm volatile("s_waitcnt lgkmcnt(0)" ::: "memory");
    const int c = lane & 7;
#pragma unroll
    for (int j = 0; j < 8; ++j) { const int n = (lane >> 3) + 8 * j; const LAS float* s = scr + (8 * c) * 65 + n;
        u32x4 o; o.x = cvt_pk_bf16(s[0 * 65], s[1 * 65]); o.y = cvt_pk_bf16(s[2 * 65], s[3 * 65]); o.z = cvt_pk_bf16(s[4 * 65], s[5 * 65]); o.w = cvt_pk_bf16(s[6 * 65], s[7 * 65]);
        *(u32x4*)(WT + (size_t)(n0 + n) * K + k0 + 8 * c) = o; }
    asm volatile("s_waitcnt lgkmcnt(0)" ::: "memory");
}

__device__ __forceinline__ void s5_tables(LAS unsigned char* lds, const Args& a, int l, int g, int qt, int tid) {
    LAS f32x2* AP = (LAS f32x2*)lds;
    LAS f32x2* BB = AP + 65 * 64;
    LAS f32x2* CC = BB + 64 * 16;
    const int lg = l * 32 + g;
    const float* are = a.in[4] + lg * 64; const float* aim = a.in[5] + lg * 64;
    const float dt = expf(a.in[6][lg]);
    unsigned char* tab = a.ws + WS_S5 + (size_t)l * S5_LAYER;
    for (int idx = tid; idx < 65 * 64; idx += 512) {
        const int d = idx >> 6, p = idx & 63;
        const float lr = fminf(are[p], -1e-4f), li = aim[p];
        const float mag = expf(lr * dt * (float)d);
        double rev = (double)li * (double)dt * (double)d * 0.15915494309189535;
        rev -= floor(rev); if (rev > 0.5) rev -= 1.0;
        const float th = (float)(rev * 6.283185307179586);
        AP[idx] = (f32x2){mag * cosf(th), mag * sinf(th)};
    }
    for (int idx = tid; idx < 1024; idx += 512) CC[idx] = (f32x2){a.in[9][(size_t)lg * 1024 + idx], a.in[10][(size_t)lg * 1024 + idx]};
    for (int idx = tid; idx < 1024; idx += 512) {
        const int p = idx >> 4;
        const float lr = fminf(are[p], -1e-4f), li = aim[p];
        double rev = (double)li * (double)dt * 0.15915494309189535;
        rev -= floor(rev); if (rev > 0.5) rev -= 1.0;
        const float th = (float)(rev * 6.283185307179586);
        const float em1 = expm1f(lr * dt), c = cosf(th), s = sinf(th), sh = sinf(0.5f * th);
        const float nr = em1 * c - 2.f * sh * sh, ni = (1.f + em1) * s;
        const float den = 1.f / (lr * lr + li * li);
        const float qr = (nr * lr + ni * li) * den, qi = (ni * lr - nr * li) * den;
        const float br = a.in[7][(size_t)lg * 1024 + idx], bi = a.in[8][(size_t)lg * 1024 + idx];
        BB[idx] = (f32x2){qr * br - qi * bi, qr * bi + qi * br};
    }
    __syncthreads();
    bf16_t* kt = (bf16_t*)(tab + S5_KT) + (size_t)g * (65 * 256);
    if (tid < 256) { const int s = qt * 256 + tid;
        const int d = s >> 4, h = s & 15;
        float acc[16];
#pragma unroll
        for (int i = 0; i < 16; ++i) acc[i] = 0.f;
        for (int p = 0; p < 64; ++p) {
            const f32x2 cc = CC[h * 64 + p], ap = AP[d * 64 + p];
            const float cr = cc.x * ap.x - cc.y * ap.y, ci = cc.x * ap.y + cc.y * ap.x;
#pragma unroll
            for (int i = 0; i < 16; ++i) { const f32x2 bb = BB[p * 16 + i]; acc[i] += cr * bb.x - ci * bb.y; }
        }
        if (d == 0) { const float dsk = a.in[11][lg * 16 + h];
#pragma unroll
            for (int i = 0; i < 16; ++i) if (i == h) acc[i] += dsk; }
        u32x4 o0, o1;
        o0.x = cvt_pk_bf16(acc[0], acc[1]); o0.y = cvt_pk_bf16(acc[2], acc[3]); o0.z = cvt_pk_bf16(acc[4], acc[5]); o0.w = cvt_pk_bf16(acc[6], acc[7]);
        o1.x = cvt_pk_bf16(acc[8], acc[9]); o1.y = cvt_pk_bf16(acc[10], acc[11]); o1.z = cvt_pk_bf16(acc[12], acc[13]); o1.w = cvt_pk_bf16(acc[14], acc[15]);
        bf16_t* dst = kt + (size_t)(63 - d) * 256 + h * 8;
        *(u32x4*)dst = o0; *(u32x4*)(dst + 128) = o1;
    }
    if (qt == 0 && tid >= 256 && tid < 288) ((u32x4*)(kt + 64 * 256))[tid - 256] = (u32x4){0u, 0u, 0u, 0u};
    if (qt == 2) {
        bf16_t* ea = (bf16_t*)(tab + S5_WE) + (size_t)g * 128 * 32;
        const int row = tid >> 2, cq = tid & 3, p = row & 63, im = row >> 6, jj = cq >> 1, half = cq & 1;
        const f32x2 ap = AP[(1 - jj) * 64 + p];
        float v[8];
#pragma unroll
        for (int i = 0; i < 8; ++i) { const f32x2 bb = BB[p * 16 + 8 * half + i]; v[i] = im ? (ap.x * bb.y + ap.y * bb.x) : (ap.x * bb.x - ap.y * bb.y); }
        u32x4 o; o.x = cvt_pk_bf16(v[0], v[1]); o.y = cvt_pk_bf16(v[2], v[3]); o.z = cvt_pk_bf16(v[4], v[5]); o.w = cvt_pk_bf16(v[6], v[7]);
        *(u32x4*)(ea + (size_t)row * 32 + 8 * cq) = o;
        u32x4 o2; o2.x = cvt_pk_bf16(v[0] - bf_lo(o.x), v[1] - bf_hi(o.x)); o2.y = cvt_pk_bf16(v[2] - bf_lo(o.y), v[3] - bf_hi(o.y)); o2.z = cvt_pk_bf16(v[4] - bf_lo(o.z), v[5] - bf_hi(o.z)); o2.w = cvt_pk_bf16(v[6] - bf_lo(o.w), v[7] - bf_hi(o.w));
        *(u32x4*)(ea + (size_t)32 * 128 * 32 + (size_t)row * 32 + 8 * cq) = o2;
        if (tid < 64) ((f32x2*)(tab + S5_A64 + 32768))[g * 64 + tid] = AP[2 * 64 + tid];
    }
    bf16_t* wc = (bf16_t*)(tab + S5_WC) + (size_t)g * 1024 * 128;
    for (int idx = qt * 4096 + tid; idx < (qt + 1) * 4096; idx += 512) {
        const int kgp = idx & 15, rowi = idx >> 4, t = rowi >> 4, h = rowi & 15, im = kgp >> 3, p0 = (kgp & 7) * 8;
        float v[8];
#pragma unroll
        for (int i = 0; i < 8; ++i) { const f32x2 cc = CC[h * 64 + p0 + i], ap = AP[(t + 1) * 64 + p0 + i];
            v[i] = im ? -(cc.x * ap.y + cc.y * ap.x) : (cc.x * ap.x - cc.y * ap.y); }
        u32x4 o; o.x = cvt_pk_bf16(v[0], v[1]); o.y = cvt_pk_bf16(v[2], v[3]); o.z = cvt_pk_bf16(v[4], v[5]); o.w = cvt_pk_bf16(v[6], v[7]);
        *(u32x4*)(wc + (size_t)rowi * 128 + kgp * 8) = o;
    }
    if (qt == 1 && tid < 64) {
        ((f32x2*)(tab + S5_A64))[g * 64 + tid] = AP[64 * 64 + tid];
        const int k = tid & 15, kg = tid >> 4; const float* wg = a.in[12] + (size_t)lg * 256;
        u32x4 o; o.x = cvt_pk_bf16(wg[(4 * kg + 0) * 16 + k], wg[(4 * kg + 1) * 16 + k]); o.y = cvt_pk_bf16(wg[(4 * kg + 2) * 16 + k], wg[(4 * kg + 3) * 16 + k]); o.z = 0u; o.w = 0u;
        ((u32x4*)(tab + S5_GLU))[g * 64 + tid] = o;
    }
    __syncthreads();
}

struct NormArgs { const float* resid; const bf16_t* add; const float* g_add; float* xout; const float* g_xn; bf16_t* xn; const float* wf; const float* bfh; float* logf; };
__device__ __forceinline__ void norm_phase(LAS unsigned char* lds, const NormArgs n, int gw, int ngw, int lane, int tid) {
    if (n.wf) {
        for (int i = tid; i < 2048; i += 512) { const int d = i >> 1, hh = i & 1; const f32x4 v = *(const f32x4*)(n.wf + (size_t)d * INW + 4 * hh);
            const int k = 4 * (d >> 8) + (d & 3), ln = (d >> 2) & 63;
            *(LAS f32x4*)(lds + ((k * 2 + hh) * 64 + ln) * 16) = v; }
        __syncthreads();
    }
    f32x4 ga[4], gx[4];
#pragma unroll
    for (int j = 0; j < 4; ++j) { ga[j] = n.add ? *(const f32x4*)(n.g_add + 4 * lane + 256 * j) : (f32x4){0.f, 0.f, 0.f, 0.f}; gx[j] = n.xn ? *(const f32x4*)(n.g_xn + 4 * lane + 256 * j) : (f32x4){0.f, 0.f, 0.f, 0.f}; }
    for (int rbase = gw; rbase < M; rbase += 2 * ngw) {
        f32x4 v[2][4]; f32x4 av[2][4];
#pragma unroll
        for (int rr = 0; rr < 2; ++rr) { const size_t row = (size_t)rbase + (size_t)rr * ngw;
#pragma unroll
            for (int j = 0; j < 4; ++j) v[rr][j] = *(const f32x4*)(n.resid + row * DM + 4 * lane + 256 * j);
            if (n.add) {
#pragma unroll
                for (int j = 0; j < 4; ++j) { const u32x2 u = *(const u32x2*)(n.add + row * DM + 4 * lane + 256 * j); av[rr][j] = (f32x4){bf_lo(u.x), bf_hi(u.x), bf_lo(u.y), bf_hi(u.y)}; }
            }
        }
#pragma unroll
        for (int rr = 0; rr < 2; ++rr) { const size_t row = (size_t)rbase + (size_t)rr * ngw;
            if (n.add) {
                float ss = 0.f;
#pragma unroll
                for (int j = 0; j < 4; ++j) ss += (av[rr][j].x * av[rr][j].x + av[rr][j].y * av[rr][j].y) + (av[rr][j].z * av[rr][j].z + av[rr][j].w * av[rr][j].w);
                const float rs = rsqrtf(wave_sum(ss) * (1.f / DM) + EPS);
#pragma unroll
                for (int j = 0; j < 4; ++j) v[rr][j] = v[rr][j] + av[rr][j] * rs * ga[j];
            }
            if (n.xout) {
#pragma unroll
                for (int j = 0; j < 4; ++j) *(f32x4*)(n.xout + row * DM + 4 * lane + 256 * j) = v[rr][j];
            }
            if (n.xn) {
                float ss = 0.f;
#pragma unroll
                for (int j = 0; j < 4; ++j) ss += (v[rr][j].x * v[rr][j].x + v[rr][j].y * v[rr][j].y) + (v[rr][j].z * v[rr][j].z + v[rr][j].w * v[rr][j].w);
                const float rs = rsqrtf(wave_sum(ss) * (1.f / DM) + EPS);
                f32x4 hn[4];
#pragma unroll
                for (int j = 0; j < 4; ++j) { hn[j] = v[rr][j] * rs * gx[j]; u32x2 o; o.x = cvt_pk_bf16(hn[j].x, hn[j].y); o.y = cvt_pk_bf16(hn[j].z, hn[j].w);
                    *(u32x2*)(n.xn + row * DM + 4 * lane + 256 * j) = o; }
                if (n.wf) {
                    f32x4 f0 = (f32x4){0.f, 0.f, 0.f, 0.f}, f1 = f0;
#pragma unroll
                    for (int j = 0; j < 4; ++j)
#pragma unroll
                        for (int i = 0; i < 4; ++i) { const LAS unsigned char* wp = lds + (((4 * j + i) * 2) * 64 + lane) * 16;
                            const f32x4 w0 = *(const LAS f32x4*)wp, w1 = *(const LAS f32x4*)(wp + 1024); f0 = f0 + w0 * hn[j][i]; f1 = f1 + w1 * hn[j][i]; }
                    float z = 0.f;
#pragma unroll
                    for (int hh = 0; hh < 4; ++hh) { const float s0 = wave_sum(f0[hh]), s1 = wave_sum(f1[hh]); if (lane == hh) z = s0; if (lane == hh + 4) z = s1; }
                    if (lane < 8) { z += n.bfh[lane]; n.logf[row * 8 + lane] = fminf(z, 0.f) - 0.6931471806f * __builtin_amdgcn_logf(1.0f + fast_exp2(-LOG2E * fabsf(z))); }
                }
            }
        }
    }
}

__device__ __forceinline__ void cum_scan(LAS unsigned char* lds, const float* logf, float* cum, int bh, int tid, int lane, int w) {
    LAS float* ws = (LAS float*)lds;
    const int b = bh >> 3, h = bh & 7;
    float v[8]; float run = 0.f;
#pragma unroll
    for (int i = 0; i < 8; ++i) { run += logf[((size_t)b * SEQ + 8 * tid + i) * 8 + h]; v[i] = run; }
    float inc = run;
#pragma unroll
    for (int o = 1; o < 64; o <<= 1) { const float t = __int_as_float(__builtin_amdgcn_ds_bpermute((lane - o) << 2, __float_as_int(inc))); if (lane >= o) inc += t; }
    if (lane == 63) ws[w] = inc;
    __syncthreads();
    float base = inc - run;
    for (int i = 0; i < w; ++i) base += ws[i];
#pragma unroll
    for (int i = 0; i < 8; ++i) cum[(size_t)bh * SEQ + 8 * tid + i] = (base + v[i]) * LOG2E;
    __syncthreads();
}

#define MFMA16(a, b, c) __builtin_amdgcn_mfma_f32_16x16x32_bf16((a), (b), (c), 0, 0, 0)
#define MFMA32(a, b, c) __builtin_amdgcn_mfma_f32_32x32x16_bf16((a), (b), (c), 0, 0, 0)
__device__ __forceinline__ bf16x8 ldg16(const void* ubase, unsigned off) { return *(const bf16x8*)((const char*)ubase + off); }
__device__ __forceinline__ void s5_unit(LAS unsigned char* lds, const bf16_t* P, const unsigned char* tab, bf16_t* Ya, const int b, const int g, int tid, int lane, int w) {
    LAS unsigned char* KT = lds; LAS float* EL = (LAS float*)lds; LAS unsigned char* SPT = lds + 33280; LAS unsigned char* ULO = lds + 50688;
    const unsigned char* ktab = tab + S5_KT + (size_t)g * KT_BYTES;
    const int n = lane & 15, kg = lane >> 4, ntile = w & 3, wh = w >> 2;
    const bf16_t* WCu = (const bf16_t*)(tab + S5_WC) + (size_t)g * 1024 * 128 + (size_t)(wh * 16) * 128;
    const bf16_t* Uu = P + ((size_t)b * SEQ + (size_t)(16 * ntile) * 64) * NA + 16 * g;
    const unsigned uoff = (unsigned)((n * 64 + (kg >> 1)) * NA + 8 * (kg & 1)) * 2u;
    const unsigned wcoff = (unsigned)(n * 128 + 8 * kg) * 2u;
    {
        u32x4 st[8];
#pragma unroll
        for (int i = 0; i < 8; ++i) { const int f = w * 8 + i, nt = f >> 4, jp = f & 15;
            st[i] = *(const u32x4*)((const char*)(P + ((size_t)b * SEQ + (size_t)(16 * nt) * 64 + 2 * jp) * NA + 16 * g) + uoff); }
#pragma unroll
        for (int i = 0; i < 8; ++i) *(LAS u32x4*)(ULO + ((w * 8 + i) * 64 + lane) * 16) = st[i];
    }
    __syncthreads();
    {
        const bf16_t* EAg = (const bf16_t*)(tab + S5_WE) + (size_t)g * 128 * 32;
        bf16x8 are[2], aim[2], arl[2], ail[2]; f32x4 er[2], ei[2]; float a2r[2][4], a2i[2][4];
#pragma unroll
        for (int m = 0; m < 2; ++m) {
            are[m] = *(const bf16x8*)(EAg + (size_t)(32 * wh + 16 * m + n) * 32 + 8 * kg);
            aim[m] = *(const bf16x8*)(EAg + (size_t)(64 + 32 * wh + 16 * m + n) * 32 + 8 * kg);
            arl[m] = *(const bf16x8*)(EAg + (size_t)32 * 128 * 32 + (size_t)(32 * wh + 16 * m + n) * 32 + 8 * kg);
            ail[m] = *(const bf16x8*)(EAg + (size_t)32 * 128 * 32 + (size_t)(64 + 32 * wh + 16 * m + n) * 32 + 8 * kg);
            er[m] = (f32x4){0.f, 0.f, 0.f, 0.f}; ei[m] = er[m];
#pragma unroll
            for (int i = 0; i < 4; ++i) { const f32x2 q2 = ((const f32x2*)(tab + S5_A64 + 32768))[g * 64 + 32 * wh + 16 * m + 4 * kg + i]; a2r[m][i] = q2.x; a2i[m][i] = q2.y; }
        }
        bf16x8 eg[4];
#define S5_ELG(ks) do { eg[(ks) & 3] = ldg16(Uu + (size_t)(2 * (ks)) * NA, uoff); } while (0)
        S5_ELG(16); S5_ELG(17); S5_ELG(18);
#pragma unroll
        for (int ks = 0; ks < 32; ++ks) {
            bf16x8 bcur;
            if (ks < 16) bcur = *(const LAS bf16x8*)(ULO + ((ntile * 16 + ks) * 64 + lane) * 16);
            else { if (ks + 3 < 32) S5_ELG(ks + 3); bcur = eg[ks & 3]; }
            if (ks > 0) {
#pragma unroll
                for (int m = 0; m < 2; ++m)
#pragma unroll
                    for (int i = 0; i < 4; ++i) { const float xr = er[m][i], xi = ei[m][i]; er[m][i] = a2r[m][i] * xr - a2i[m][i] * xi; ei[m][i] = a2r[m][i] * xi + a2i[m][i] * xr; }
            }
#pragma unroll
            for (int m = 0; m < 2; ++m) { er[m] = MFMA16(are[m], bcur, er[m]); ei[m] = MFMA16(aim[m], bcur, ei[m]); er[m] = MFMA16(arl[m], bcur, er[m]); ei[m] = MFMA16(ail[m], bcur, ei[m]); }
        }
#undef S5_ELG
#pragma unroll
        for (int m = 0; m < 2; ++m)
#pragma unroll
            for (int i = 0; i < 4; ++i) { const int p = 32 * wh + 16 * m + 4 * kg + i; EL[p * 65 + 16 * ntile + n] = er[m][i]; EL[(64 + p) * 65 + 16 * ntile + n] = ei[m][i]; }
    }
    __syncthreads();
    {
        const int p = tid & 63, seg = tid >> 6;
        const f32x2 a1 = ((const f32x2*)(tab + S5_A64))[g * 64 + p];
        float lr[8], li[8]; float sr = 0.f, si = 0.f;
#pragma unroll
        for (int j = 0; j < 8; ++j) { const float er = EL[p * 65 + 8 * seg + j], ei = EL[(64 + p) * 65 + 8 * seg + j];
            const float nr = a1.x * sr - a1.y * si + er, ni = a1.x * si + a1.y * sr + ei; sr = nr; si = ni; lr[j] = sr; li[j] = si; }
        LAS f32x2* TT = (LAS f32x2*)(lds + 116224);
        TT[seg * 64 + p] = (f32x2){sr, si};
        f32x2 a2 = {a1.x * a1.x - a1.y * a1.y, 2.f * a1.x * a1.y}; f32x2 a4 = {a2.x * a2.x - a2.y * a2.y, 2.f * a2.x * a2.y}; const f32x2 a8 = {a4.x * a4.x - a4.y * a4.y, 2.f * a4.x * a4.y};
        __syncthreads();
        float cr = 0.f, ci = 0.f;
        for (int s2 = 0; s2 < seg; ++s2) { const f32x2 t = TT[s2 * 64 + p]; const float nr = a8.x * cr - a8.y * ci + t.x, ni = a8.x * ci + a8.y * cr + t.y; cr = nr; ci = ni; }
        float pr = cr, pi = ci, wr_ = cr, wi_ = ci;
#pragma unroll
        for (int j = 0; j < 8; ++j) {
            *(LAS bf16_t*)(SPT + (8 * seg + j) * 272 + 2 * p) = (bf16_t)(cvt_pk_bf16(pr, 0.f) & 0xffffu);
            *(LAS bf16_t*)(SPT + (8 * seg + j) * 272 + 2 * (64 + p)) = (bf16_t)(cvt_pk_bf16(pi, 0.f) & 0xffffu);
            const float nr = a1.x * wr_ - a1.y * wi_, ni = a1.x * wi_ + a1.y * wr_; wr_ = nr; wi_ = ni;
            pr = lr[j] + wr_; pi = li[j] + wi_;
        }
    }
    __syncthreads();
    for (int i = tid; i < KT_BYTES / 16; i += 512) *(LAS u32x4*)(KT + i * 16) = *(const u32x4*)(ktab + i * 16);
    __syncthreads();
    const LAS unsigned char* klow = KT + (1 - wh + (lane >> 5)) * 512 + ((lane >> 4) & 1) * 256 + (lane & 15) * 16;
    const LAS unsigned char* spb = SPT + (16 * ntile + n) * 272 + 16 * kg;
    const bf16x8 aglu = *(const bf16x8*)(tab + S5_GLU + (size_t)(g * 64 + lane) * 16);
    const unsigned yoff = (unsigned)(n * 64 * YW + 4 * kg) * 2u;
#pragma unroll 1
    for (int pass = 0; pass < 2; ++pass) {
        f32x4 acc[16];
#pragma unroll
        for (int i = 0; i < 16; ++i) acc[i] = (f32x4){0.f, 0.f, 0.f, 0.f};
        bf16x8 bq[4], ca[2][4], bt[8], bu[8];
        const bf16_t* Up = Uu + (size_t)(32 * pass) * NA;
        const bf16_t* WCp = WCu + (size_t)(32 * pass) * 2048;
#define S5_LDC(st, slot) do { _Pragma("unroll") for (int _q = 0; _q < 4; ++_q) ca[slot][_q] = ldg16(WCp + (size_t)(2 * (4 * ((st) & 3) + _q)) * 2048 + 32 * ((st) >> 2), wcoff); } while (0)
        if (pass == 1) {
#pragma unroll
            for (int jj = 0; jj < 8; ++jj) bt[jj] = ldg16(Up + (size_t)(2 * jj) * NA, uoff);
        }
        S5_LDC(0, 0); S5_LDC(1, 1);
        if (pass == 0) {
#pragma unroll
            for (int jj = 0; jj < 8; ++jj) { bt[jj] = *(const LAS bf16x8*)(ULO + ((ntile * 16 + jj) * 64 + lane) * 16); bu[jj] = *(const LAS bf16x8*)(ULO + ((ntile * 16 + 8 + jj) * 64 + lane) * 16); }
        }
        if (pass == 1) {
            __builtin_amdgcn_sched_barrier(0);
#pragma unroll
            for (int jj = 0; jj < 16; ++jj) {
                bq[jj & 3] = *(const LAS bf16x8*)(ULO + ((ntile * 16 + jj) * 64 + lane) * 16);
#pragma unroll
                for (int ii = 0; ii < 16; ++ii) { const bf16x8 af = *(const LAS bf16x8*)(klow + (30 - 2 * (ii - jj)) * 512); acc[ii] = MFMA16(af, bq[jj & 3], acc[ii]); }
                __builtin_amdgcn_sched_barrier(0);
            }
        }
        __builtin_amdgcn_sched_barrier(0);
#pragma unroll
        for (int jj = 0; jj < 16; ++jj) {
            const bf16x8 cb = *(const LAS bf16x8*)(spb + 64 * (jj >> 2));
            if (jj < 8 && pass == 1) bu[jj] = ldg16(Up + (size_t)(2 * (jj + 8)) * NA, uoff);
#pragma unroll
            for (int ii = 0; ii < 16; ++ii) if (ii >= jj) { const bf16x8 af = *(const LAS bf16x8*)(klow + (62 - 2 * (ii - jj)) * 512); acc[ii] = MFMA16(af, (jj < 8 ? bt[jj & 7] : bu[jj & 7]), acc[ii]); }
#pragma unroll
            for (int q = 0; q < 4; ++q) acc[4 * (jj & 3) + q] = MFMA16(ca[jj & 1][q], cb, acc[4 * (jj & 3) + q]);
            __builtin_amdgcn_sched_barrier(0);
            if (jj + 2 < 16) S5_LDC(jj + 2, jj & 1);
            __builtin_amdgcn_sched_barrier(0);
        }
#undef S5_LDC
        bf16_t* Yu = Ya + ((size_t)b * SEQ + (size_t)(16 * ntile) * 64 + wh + 32 * pass) * YW + 16 * g;
#pragma unroll
        for (int ii = 0; ii < 16; ++ii) {
            f32x4 y;
#pragma unroll
            for (int k = 0; k < 4; ++k) y[k] = gelu_tanh(acc[ii][k]);
            u32x4 bp; bp.x = cvt_pk_bf16(y[0], y[1]); bp.y = cvt_pk_bf16(y[2], y[3]); bp.z = 0u; bp.w = 0u;
            const f32x4 z = MFMA16(aglu, __builtin_bit_cast(bf16x8, bp), ((f32x4){0.f, 0.f, 0.f, 0.f}));
            u32x2 o; o.x = cvt_pk_bf16(y[0] * sigmoid_f(z[0]), y[1] * sigmoid_f(z[1])); o.y = cvt_pk_bf16(y[2] * sigmoid_f(z[2]), y[3] * sigmoid_f(z[3]));
            *(u32x2*)((char*)(Yu + (size_t)(2 * ii) * YW) + yoff) = o;
        }
    }
    __syncthreads();
}

constexpr int AT_KS = 0, AT_VT = 9216, AT_VP = 192, AT_BS = 9216 + 64 * AT_VP, AT_BUF = AT_BS + 256;
__device__ __forceinline__ int crow(int r, int hi) { return (r & 3) + 8 * (r >> 2) + 4 * hi; }
__device__ __forceinline__ void attn_unit(LAS unsigned char* lds, const bf16_t* P, const float* cum, bf16_t* Yc, const int b, const int h, const int qb, int tid, int lane, int w) {
    const int r32 = lane & 31, hi = lane >> 5;
    const size_t row0 = (size_t)b * SEQ;
    const int q0 = qb * 256, qrow = q0 + 32 * w + r32;
    bf16x8 qf[4];
    { const bf16_t* qp = P + (row0 + qrow) * NA + COL_Q + 64 * h + 8 * hi;
#pragma unroll
      for (int s = 0; s < 4; ++s) qf[s] = *(const bf16x8*)(qp + 16 * s); }
    const float* cumbh = cum + (size_t)(b * 8 + h) * SEQ;
    const float ref = cumbh[q0];
    const int vlane = (4 * hi + ((lane & 15) >> 2)) * AT_VP + 32 * ((lane >> 4) & 1) + 8 * (lane & 3);
    const int skey = tid >> 3, spc = tid & 7;
    const bf16_t* kgp = P + (row0 + skey) * NA + COL_K + 64 * h + 8 * spc;
    const int NT = 4 * qb + 4;
    u32x4 kreg = *(const u32x4*)kgp, vreg = *(const u32x4*)(kgp + (COL_V - COL_K)); float breg = 0.f; if (tid < 64) breg = ref - cumbh[tid];
#define AT_WRITE(bufp) do { LAS unsigned char* _b = (bufp); *(LAS u32x4*)(_b + AT_KS + skey * 144 + 16 * spc) = kreg; \
        *(LAS u32x4*)(_b + AT_VT + skey * AT_VP + 16 * spc) = vreg; \
        if (tid < 64) *(LAS float*)(_b + AT_BS + 4 * tid) = breg; } while (0)
    AT_WRITE(lds);
    __syncthreads();
    float mrun = -1e30f, lrun = 0.f; f32x16 o0, o1;
#pragma unroll
    for (int r = 0; r < 16; ++r) { o0[r] = 0.f; o1[r] = 0.f; }
    for (int kt = 0; kt < NT; ++kt) {
        const int cur = kt & 1; const bool more = (kt + 1 < NT);
        if (more) { const bf16_t* kp = kgp + (size_t)(kt + 1) * 64 * NA; kreg = *(const u32x4*)kp; vreg = *(const u32x4*)(kp + (COL_V - COL_K)); if (tid < 64) breg = ref - cumbh[64 * (kt + 1) + tid]; }
        if (64 * kt <= q0 + 32 * w + 31) {
            const LAS unsigned char* Kb = lds + cur * AT_BUF + AT_KS; const LAS unsigned char* Vb = lds + cur * AT_BUF + AT_VT; const LAS unsigned char* Bb = lds + cur * AT_BUF + AT_BS;
            f32x16 p[2];
#pragma unroll
            for (int rb = 0; rb < 2; ++rb) {
                f32x16 c;
#pragma unroll
                for (int g4 = 0; g4 < 4; ++g4) { const f32x4 bv = *(const LAS f32x4*)(Bb + (32 * rb + 8 * g4 + 4 * hi) * 4); c[4 * g4 + 0] = bv.x; c[4 * g4 + 1] = bv.y; c[4 * g4 + 2] = bv.z; c[4 * g4 + 3] = bv.w; }
#pragma unroll
                for (int s = 0; s < 4; ++s) { const bf16x8 af = *(const LAS bf16x8*)(Kb + (32 * rb + r32) * 144 + 32 * s + 16 * hi); c = MFMA32(af, qf[s], c); }
                p[rb] = c;
            }
            if (64 * kt + 63 > q0 + 32 * w) {
#pragma unroll
                for (int rb = 0; rb < 2; ++rb)
#pragma unroll
                    for (int r = 0; r < 16; ++r) { const int key = 64 * kt + 32 * rb + crow(r, hi); if (key > qrow) p[rb][r] = -1e30f; }
            }
            float mt = p[0][0];
#pragma unroll
            for (int r = 1; r < 16; ++r) mt = fmaxf(mt, p[0][r]);
#pragma unroll
            for (int r = 0; r < 16; ++r) mt = fmaxf(mt, p[1][r]);
            mt = half_max(mt);
            const float mnew = fmaxf(mrun, mt), alpha = fast_exp2(mrun - mnew);
            mrun = mnew;
            float ls = 0.f;
#pragma unroll
            for (int rb = 0; rb < 2; ++rb)
#pragma unroll
                for (int r = 0; r < 16; ++r) { p[rb][r] = fast_exp2(p[rb][r] - mnew); ls += p[rb][r]; }
            lrun = lrun * alpha + ls;
#pragma unroll
            for (int r = 0; r < 16; ++r) { o0[r] *= alpha; o1[r] *= alpha; }
            bf16x8 pf[4];
#pragma unroll
            for (int s = 0; s < 4; ++s) { const int rb = s >> 1, r0 = 8 * (s & 1); u32x4 pk; pk.x = cvt_pk_bf16(p[rb][r0 + 0], p[rb][r0 + 1]); pk.y = cvt_pk_bf16(p[rb][r0 + 2], p[rb][r0 + 3]);
                pk.z = cvt_pk_bf16(p[rb][r0 + 4], p[rb][r0 + 5]); pk.w = cvt_pk_bf16(p[rb][r0 + 6], p[rb][r0 + 7]); pf[s] = __builtin_bit_cast(bf16x8, pk); }
#pragma unroll
            for (int s = 0; s < 4; ++s) {
                typedef short v4i16_t __attribute__((ext_vector_type(4)));
                const LAS unsigned char* vp = Vb + vlane + 16 * s * AT_VP;
                { const s16x4 lo = __builtin_bit_cast(s16x4, __builtin_amdgcn_ds_read_tr16_b64_v4i16((LAS v4i16_t*)(vp))), hh = __builtin_bit_cast(s16x4, __builtin_amdgcn_ds_read_tr16_b64_v4i16((LAS v4i16_t*)(vp + 8 * AT_VP)));
                  const bf16x8 af = __builtin_shufflevector(lo, hh, 0, 1, 2, 3, 4, 5, 6, 7); o0 = MFMA32(af, pf[s], o0); }
                { const s16x4 lo = __builtin_bit_cast(s16x4, __builtin_amdgcn_ds_read_tr16_b64_v4i16((LAS v4i16_t*)(vp + 64))), hh = __builtin_bit_cast(s16x4, __builtin_amdgcn_ds_read_tr16_b64_v4i16((LAS v4i16_t*)(vp + 64 + 8 * AT_VP)));
                  const bf16x8 af = __builtin_shufflevector(lo, hh, 0, 1, 2, 3, 4, 5, 6, 7); o1 = MFMA32(af, pf[s], o1); }
            }
        }
        if (more) AT_WRITE(lds + (cur ^ 1) * AT_BUF);
        __syncthreads();
    }
#undef AT_WRITE
    const float ltot = half_sum(lrun);
    const float inv = 1.0f / ltot;
    bf16_t* op = Yc + (row0 + qrow) * YW + 64 * h + 4 * hi;
#pragma unroll
    for (int g4 = 0; g4 < 4; ++g4) {
        u32x2 a, c2;
        a.x = cvt_pk_bf16(o0[4 * g4 + 0] * inv, o0[4 * g4 + 1] * inv); a.y = cvt_pk_bf16(o0[4 * g4 + 2] * inv, o0[4 * g4 + 3] * inv);
        c2.x = cvt_pk_bf16(o1[4 * g4 + 0] * inv, o1[4 * g4 + 1] * inv); c2.y = cvt_pk_bf16(o1[4 * g4 + 2] * inv, o1[4 * g4 + 3] * inv);
        *(u32x2*)(op + 8 * g4) = a; *(u32x2*)(op + 32 + 8 * g4) = c2;
    }
}

__device__ __forceinline__ u32x4 conv_item(const bf16_t* P, const float* cw, int item) {
    const int token = item >> 6, c0 = (item & 63) * 8, t = token & (SEQ - 1);
    float acc[8];
#pragma unroll
    for (int i = 0; i < 8; ++i) acc[i] = 0.f;
    u32x4 xc[3], cc[3];
#pragma unroll
    for (int tap = 0; tap < 3; ++tap) {
        const bool ok = (t - 2 + tap >= 0);
        const bf16_t* rp = P + (size_t)(ok ? token - 2 + tap : token) * NA + c0;
        xc[tap] = *(const u32x4*)(rp + COL_XC); cc[tap] = *(const u32x4*)(rp + COL_CC);
        if (!ok) { xc[tap] = (u32x4){0u, 0u, 0u, 0u}; }
    }
    const u32x4 bc = *(const u32x4*)(P + (size_t)token * NA + COL_BC + c0);
#pragma unroll
    for (int tap = 0; tap < 3; ++tap) {
        const f32x4 w0 = *(const f32x4*)(cw + tap * 512 + c0), w1 = *(const f32x4*)(cw + tap * 512 + c0 + 4);
        const u32x4 x = xc[tap], c = cc[tap];
        acc[0] += w0.x * bf_lo(x.x) * bf_lo(c.x); acc[1] += w0.y * bf_hi(x.x) * bf_hi(c.x); acc[2] += w0.z * bf_lo(x.y) * bf_lo(c.y); acc[3] += w0.w * bf_hi(x.y) * bf_hi(c.y);
        acc[4] += w1.x * bf_lo(x.z) * bf_lo(c.z); acc[5] += w1.y * bf_hi(x.z) * bf_hi(c.z); acc[6] += w1.z * bf_lo(x.w) * bf_lo(c.w); acc[7] += w1.w * bf_hi(x.w) * bf_hi(c.w);
    }
    u32x4 o; o.x = cvt_pk_bf16(acc[0] * bf_lo(bc.x), acc[1] * bf_hi(bc.x)); o.y = cvt_pk_bf16(acc[2] * bf_lo(bc.y), acc[3] * bf_hi(bc.y));
    o.z = cvt_pk_bf16(acc[4] * bf_lo(bc.z), acc[5] * bf_hi(bc.z)); o.w = cvt_pk_bf16(acc[6] * bf_lo(bc.w), acc[7] * bf_hi(bc.w));
    return o;
}
__device__ __forceinline__ void conv_phase(const bf16_t* P, const float* cw, bf16_t* Yb, int gtid, int ngt) {
    for (int item = gtid; item < M * 64; item += 4 * ngt) {
        u32x4 o[4];
#pragma unroll
        for (int q = 0; q < 4; ++q) o[q] = conv_item(P, cw, item + q * ngt);
#pragma unroll
        for (int q = 0; q < 4; ++q) { const int it = item + q * ngt; *(u32x4*)(Yb + (size_t)(it >> 6) * YW + (it & 63) * 8) = o[q]; }
    }
}

#define XB_TMO      128
#define XB_XCNT(j)  (256  + 64 * (j))
#define XB_XSUB(j)  (1280 + 64 * (j))
#define XB_XGEN(j)  (2304 + 64 * (j))
#define XB_TOP      3328
#define XB_TOPGEN   3392
#define XCD_BAR_WORDS 3456
#define XB_SPIN_CAP (1u << 18)
__device__ __forceinline__ unsigned xb_ld(unsigned* p)              { return __hip_atomic_load(p, __ATOMIC_RELAXED, __HIP_MEMORY_SCOPE_AGENT); }
__device__ __forceinline__ unsigned xb_add(unsigned* p, unsigned v) { return __hip_atomic_fetch_add(p, v, __ATOMIC_RELAXED, __HIP_MEMORY_SCOPE_AGENT); }
__device__ __forceinline__ unsigned xb_xcc_id() { return (unsigned)__builtin_amdgcn_s_getreg((3 << 11) | 20) & 0xFu; }
#define XB_SPIN(cond, bar) do { unsigned _sp = 0; while (cond) { __builtin_amdgcn_s_sleep(1); \
    if ((++_sp & 255u) == 0u) { if (xb_ld(&(bar)[XB_TMO])) break; if (_sp > XB_SPIN_CAP) { atomicAdd(&(bar)[XB_TMO], 1u); break; } } } } while (0)
struct XcdBarrier { unsigned* bar; unsigned x; volatile LAS unsigned* st; };
__device__ __forceinline__ XcdBarrier xcd_barrier_post(unsigned* bar, volatile LAS unsigned* st) {
    XcdBarrier b; b.bar = bar; b.x = xb_xcc_id(); b.st = st;
    if (threadIdx.x == 0) (void)xb_add(&bar[XB_XCNT(b.x)], 1u);
    return b;
}
__device__ __forceinline__ void xcd_barrier_complete(unsigned* bar, unsigned x, unsigned& nloc, unsigned& nx) {
    const unsigned G = gridDim.x * gridDim.y * gridDim.z;
    unsigned sum, cnt, mine, sp = 0u;
    for (;;) {
        sum = 0u; cnt = 0u; mine = 0u;
#pragma unroll
        for (unsigned j = 0; j < 16; ++j) { const unsigned c = xb_ld(&bar[XB_XCNT(j)]); sum += c; cnt += (c > 0u) ? 1u : 0u; mine = (j == x) ? c : mine; }
        if (sum == G) break;
        __builtin_amdgcn_s_sleep(1);
        if ((++sp & 255u) == 0u) { if (xb_ld(&bar[XB_TMO])) break; if (sp > XB_SPIN_CAP) { atomicAdd(&bar[XB_TMO], 1u); break; } }
    }
    nloc = mine > 0u ? mine : 1u; nx = cnt > 0u ? cnt : 1u;
}
__device__ __forceinline__ void xcd_barrier(const XcdBarrier& b) {
    asm volatile("s_waitcnt vmcnt(0) lgkmcnt(0)" ::: "memory");
    __syncthreads();
    if (threadIdx.x == 0) {
        unsigned* bar = b.bar; unsigned bx = b.x;
        asm volatile("" : "+s"(bar), "+s"(bx));
        __builtin_amdgcn_s_waitcnt(0);
        unsigned nloc = b.st[0], nx = b.st[1];
        if (nloc == 0u) { xcd_barrier_complete(bar, bx, nloc, nx); b.st[0] = nloc; b.st[1] = nx; }
        const unsigned old = xb_add(&bar[XB_XSUB(bx)], 1u);
        const unsigned gen = old / nloc;
        if (old + 1u == (gen + 1u) * nloc) {
            __builtin_amdgcn_fence(__ATOMIC_RELEASE, "agent");
            asm volatile("s_waitcnt vmcnt(0)" ::: "memory");
            const unsigned og = xb_add(&bar[XB_TOP], 1u);
            const unsigned tg = og / nx;
            if (og + 1u == (tg + 1u) * nx) xb_add(&bar[XB_TOPGEN], 1u);
            else XB_SPIN(xb_ld(&bar[XB_TOPGEN]) == tg, bar);
            __builtin_amdgcn_fence(__ATOMIC_ACQUIRE, "agent");
            xb_add(&bar[XB_XGEN(bx)], 1u);
            asm volatile("s_waitcnt vmcnt(0)" ::: "memory");
        } else {
            XB_SPIN(xb_ld(&bar[XB_XGEN(bx)]) == gen, bar);
            __builtin_amdgcn_fence(__ATOMIC_ACQUIRE, "agent");
            asm volatile("s_waitcnt vmcnt(0)" ::: "memory");
        }
    }
    __syncthreads();
}
__device__ __forceinline__ void cg_barrier(cg::grid_group& grid) {
    asm volatile("s_waitcnt vmcnt(0) lgkmcnt(0)" ::: "memory");
    __syncthreads();
    grid.sync();
    if (threadIdx.x == 0) { __builtin_amdgcn_fence(__ATOMIC_ACQUIRE, "agent"); asm volatile("s_waitcnt vmcnt(0)" ::: "memory"); }
    __syncthreads();
}
#define grid_barrier(g_) xcd_barrier(xbar)

#ifndef DIAG_STAGE
#define DIAG_STAGE 0
#endif
__device__ __forceinline__ void diag_dump(float* out, const bf16_t* src, int ld, int ncols) {
    for (size_t i = (size_t)blockIdx.x * 512 + threadIdx.x; i < (size_t)M * DM; i += (size_t)gridDim.x * 512) {
        const size_t row = i >> 10; const int c = (int)(i & 1023); float v = 0.f;
        for (int cc = c; cc < ncols; cc += 1024) v += bf_lo((unsigned)src[row * ld + cc]);
        out[i] = v;
    }
}
#define DIAG(k, src, ld, ncols) do { if (DIAG_STAGE == (k)) { grid_barrier(grid); diag_dump(A_->out, (src), (ld), (ncols)); return; } } while (0)

typedef const __attribute__((address_space(4))) Args* KArgP;
__device__ __forceinline__ KArgP launder_args(KArgP p) { asm volatile("" : "+s"(p)); return p; }
#define A_ (launder_args(argp))
__global__ void __launch_bounds__(512, 2) fwd_kernel(Args a) {
    KArgP argp = (KArgP)__builtin_amdgcn_kernarg_segment_ptr(); (void)a;
    extern __shared__ __attribute__((aligned(16))) unsigned char lds_raw[];
    LAS unsigned char* lds = (LAS unsigned char*)lds_raw;
    cg::grid_group grid = cg::this_grid();
    if (gridDim.z == 12345u) grid.sync();
    volatile LAS unsigned* xst = (volatile LAS unsigned*)((LAS unsigned char*)lds_raw + LDS_BYTES - 64);
    if (threadIdx.x == 0) { xst[0] = 0u; xst[1] = 0u; }
    __syncthreads();
    const XcdBarrier xbar = xcd_barrier_post((unsigned*)(A_->ws + 16384), xst);
    const int G = gridDim.x, bid = blockIdx.x, ngw = G * 8;
#define FRESH() const int tid = launder_i(threadIdx.x), lane = tid & 63, w = __builtin_amdgcn_readfirstlane(tid >> 6), gw = bid * 8 + w; (void)lane; (void)gw
    unsigned char* ws = A_->ws;
    bf16_t* XN = (bf16_t*)(ws + WS_XN); bf16_t* PR = (bf16_t*)(ws + WS_P); bf16_t* Y = (bf16_t*)(ws + WS_Y);
    float* LOGF = (float*)(ws + WS_LOGF); float* CUM = (float*)(ws + WS_CUM);

    {
        FRESH();
#ifndef NO_TAB
        for (int u = bid; u < 256; u += G) s5_tables(lds, a, u >> 7, (u >> 2) & 31, u & 3, tid);
#endif
        LAS float* scr = (LAS float*)(lds + w * 16640);
        constexpr int I_A = 16 * 56, I_G = 16 * 48, I_B = 8 * 16, I_O = 16 * 16, I_1 = 16 * 64, I_2 = 64 * 16, I_L = I_A + I_G + 3 * I_B + I_O + I_1 + I_2;
        for (int it = gw; it < 2 * I_L; it += ngw) {
            const int l = it / I_L; int r = it - l * I_L;
            unsigned char* wl = ws + WS_W + (size_t)l * W_LAYER;
            const float* win = A_->in[2] + (size_t)l * DM * INW;
            if (r < I_A) { transpose_item(win, INW, 0, DM, NA, (bf16_t*)(wl + W_INA), scr, r, lane); continue; } r -= I_A;
            if (r < I_G) { transpose_item(win, INW, COL_G, DM, NG, (bf16_t*)(wl + W_G), scr, r, lane); continue; } r -= I_G;
            if (r < 3 * I_B) { const int br = r / I_B; transpose_item(A_->in[15] + (size_t)l * 1536 * DM + (size_t)br * 512 * DM, DM, 0, 512, DM, (bf16_t*)(wl + W_BR) + (size_t)br * DM * 512, scr, r - br * I_B, lane); continue; } r -= 3 * I_B;
            if (r < I_O) { transpose_item(A_->in[16] + (size_t)l * DM * DM, DM, 0, DM, DM, (bf16_t*)(wl + W_OUT), scr, r, lane); continue; } r -= I_O;
            if (r < I_1) { transpose_item(A_->in[19] + (size_t)l * DM * FF, FF, 0, DM, FF, (bf16_t*)(wl + W_1), scr, r, lane); continue; } r -= I_1;
            transpose_item(A_->in[20] + (size_t)l * FF * DM, DM, 0, FF, DM, (bf16_t*)(wl + W_2), scr, r, lane);
        }
        __syncthreads();
        NormArgs n{A_->in[0], nullptr, nullptr, nullptr, A_->in[1], XN, A_->in[2] + COL_F, A_->in[14], LOGF};
        norm_phase(lds, n, gw, ngw, lane, tid);
    }
    xcd_barrier(xbar);

    DIAG(1, XN, DM, DM);
#pragma unroll 1
    for (int l = 0; l < DEPTH; ++l) {
        unsigned char* wl = ws + WS_W + (size_t)l * W_LAYER;
        const unsigned char* s5tab = ws + WS_S5 + (size_t)l * S5_LAYER;
        const float* xin = (l == 0) ? A_->in[0] : A_->out;

        { FRESH(); for (int bh = bid; bh < 64; bh += G) cum_scan(lds, LOGF, CUM, bh, tid, lane, w); }
        {
            pg8::Gemm g{XN, (const bf16_t*)(wl + W_INA), M, NA, DM, 0, 0}; pg8::StaticOrder S; S.init(M, NA, G, bid, 1);
            pg8::Epi<pg8::EPI_PROJ> E{PR, NA, nullptr, nullptr};
#if (PHMASK >> 0) & 1
            pg8::gemm_phase<pg8::Epi<pg8::EPI_PROJ>, pg8::StaticOrder, true, true>(lds, g, S, E);
#endif
        }
        grid_barrier(grid);

        DIAG(2, PR, NA, NA);
        if ((bid >> 3) & 1) {
        for (int v = bid; v < 256; v += G) {
            FRESH(); const int bh = v >> 2, s = v & 3;
#pragma unroll 1
            for (int k = 0; k < 4; ++k) { const int qb = (k == 0) ? 15 - s : (k == 1) ? s : (k == 2) ? 11 - s : s + 4;
                attn_unit(lds, PR, CUM, Y + 2 * (size_t)M * YW, bh >> 3, bh & 7, qb, tid, lane, w); }
        }
        { FRESH(); for (int v = bid; v < 256; v += G) s5_unit(lds, PR, s5tab, Y, v >> 5, 4 * (v & 7) + ((v >> 3) & 3), tid, lane, w);     }
        } else {
        { FRESH(); for (int v = bid; v < 256; v += G) s5_unit(lds, PR, s5tab, Y, v >> 5, 4 * (v & 7) + ((v >> 3) & 3), tid, lane, w);     }
        for (int v = bid; v < 256; v += G) {
            FRESH(); const int bh = v >> 2, s = v & 3;
#pragma unroll 1
            for (int k = 0; k < 4; ++k) { const int qb = (k == 0) ? 15 - s : (k == 1) ? s : (k == 2) ? 11 - s : s + 4;
                attn_unit(lds, PR, CUM, Y + 2 * (size_t)M * YW, bh >> 3, bh & 7, qb, tid, lane, w); }
        }
        }
        grid_barrier(grid);
        { FRESH(); conv_phase(PR, A_->in[13] + (size_t)l * 3 * 512, Y + (size_t)M * YW, bid * 512 + tid, G * 512); }
        grid_barrier(grid);

        if (DIAG_STAGE == 3) { grid_barrier(grid); for (size_t i = (size_t)blockIdx.x * 512 + threadIdx.x; i < (size_t)M * DM; i += (size_t)gridDim.x * 512) { const size_t row = i >> 10; const int c = (int)(i & 511); A_->out[i] = bf_lo((unsigned)Y[row * YW + c]) + bf_lo((unsigned)Y[(size_t)M * YW + row * YW + c]) + bf_lo((unsigned)Y[2 * (size_t)M * YW + row * YW + c]); } return; }
        DIAG(31, Y + (size_t)M * YW, YW, YW); DIAG(32, Y + 2 * (size_t)M * YW, YW, YW);
        {
            pg8::Gemm g{XN, (const bf16_t*)(wl + W_G), M, NG, DM, 0, 0}; pg8::StaticOrder S; S.init(M, NG, G, bid, 1);
            pg8::Epi<pg8::EPI_GATE> E{PR, NG, A_->in[3] + (size_t)l * NG, nullptr};
#if (PHMASK >> 1) & 1
            pg8::gemm_phase<pg8::Epi<pg8::EPI_GATE>, pg8::StaticOrder, true, true>(lds, g, S, E);
#endif
        }
        grid_barrier(grid);

        DIAG(4, PR, NG, NG);
        {
            pg8::Gemm g{Y, (const bf16_t*)(wl + W_BR), M, DM, 512, (size_t)M * YW * 2, (size_t)DM * 512 * 2}; pg8::StaticOrder S; S.init(M, DM, G, bid, 3);
            pg8::Epi<pg8::EPI_BRANCH> E{XN, DM, nullptr, PR};
#if (PHMASK >> 2) & 1
            pg8::gemm_phase<pg8::Epi<pg8::EPI_BRANCH>, pg8::StaticOrder, true, true>(lds, g, S, E);
#endif
        }
        grid_barrier(grid);

        DIAG(5, XN, DM, DM);
        {
            pg8::Gemm g{XN, (const bf16_t*)(wl + W_OUT), M, DM, DM, 0, 0}; pg8::StaticOrder S; S.init(M, DM, G, bid, 1);
            pg8::Epi<pg8::EPI_PLAIN> E{PR, DM, nullptr, nullptr};
#if (PHMASK >> 3) & 1
            pg8::gemm_phase<pg8::Epi<pg8::EPI_PLAIN>, pg8::StaticOrder, true, true>(lds, g, S, E);
#endif
        }
        grid_barrier(grid);

        DIAG(6, PR, DM, DM);
        {
            FRESH(); NormArgs n{xin, PR, A_->in[17] + (size_t)l * DM, A_->out, A_->in[18] + (size_t)l * DM, XN, nullptr, nullptr, nullptr};
            norm_phase(lds, n, gw, ngw, lane, tid);
        }
        grid_barrier(grid);

        DIAG(7, XN, DM, DM);
        {
            pg8::Gemm g{XN, (const bf16_t*)(wl + W_1), M, FF, DM, 0, 0}; pg8::StaticOrder S; S.init(M, FF, G, bid, 1);
            pg8::Epi<pg8::EPI_RELU2> E{PR, FF, nullptr, nullptr};
#if (PHMASK >> 4) & 1
            pg8::gemm_phase<pg8::Epi<pg8::EPI_RELU2>, pg8::StaticOrder, true, true>(lds, g, S, E);
#endif
        }
        grid_barrier(grid);

        DIAG(8, PR, FF, FF);
        {
            pg8::Gemm g{PR, (const bf16_t*)(wl + W_2), M, DM, FF, 0, 0}; pg8::StaticOrder S; S.init(M, DM, G, bid, 1);
            pg8::Epi<pg8::EPI_PLAIN> E{XN, DM, nullptr, nullptr};
#if (PHMASK >> 5) & 1
            pg8::gemm_phase<pg8::Epi<pg8::EPI_PLAIN>, pg8::StaticOrder, true, true>(lds, g, S, E);
#endif
        }
        grid_barrier(grid);

        DIAG(9, XN, DM, DM);
        if (l + 1 < DEPTH) {
            FRESH(); NormArgs n{A_->out, XN, A_->in[21] + (size_t)l * DM, A_->out, A_->in[1] + (size_t)(l + 1) * DM, XN, A_->in[2] + (size_t)(l + 1) * DM * INW + COL_F, A_->in[14] + (l + 1) * 8, LOGF};
            norm_phase(lds, n, gw, ngw, lane, tid);
            grid_barrier(grid);
        } else {
            FRESH(); NormArgs n{A_->out, XN, A_->in[21] + (size_t)l * DM, A_->out, nullptr, nullptr, nullptr, nullptr, nullptr};
            norm_phase(lds, n, gw, ngw, lane, tid);
        }
    }
}

extern "C" void kernel_launch(void* const* d_in, const int* in_sizes, int n_in, void* d_out, int out_size, void* d_ws, size_t ws_size, hipStream_t stream) {
    static int grid = 0;
    if (grid == 0) {
        if (n_in != 22 || in_sizes[0] != M * DM || out_size != M * DM || ws_size < WS_END) { fprintf(stderr, "kernel_launch: unexpected shapes (n_in %d, in0 %d, out %d, ws %zu)\n", n_in, n_in > 0 ? in_sizes[0] : -1, out_size, ws_size); grid = -1; return; }
        int dev = 0, cus = 0, per_cu = 0;
        (void)hipGetDevice(&dev);
        (void)hipDeviceGetAttribute(&cus, hipDeviceAttributeMultiprocessorCount, dev);
        if (hipFuncSetAttribute((const void*)fwd_kernel, hipFuncAttributeMaxDynamicSharedMemorySize, LDS_BYTES) != hipSuccess) fprintf(stderr, "kernel_launch: hipFuncSetAttribute failed\n");
        if (hipOccupancyMaxActiveBlocksPerMultiprocessor(&per_cu, (const void*)fwd_kernel, 512, LDS_BYTES) != hipSuccess || per_cu < 1) { fprintf(stderr, "kernel_launch: occupancy query gave %d\n", per_cu); per_cu = 1; }
        (void)hipGetLastError();
        grid = cus * per_cu; if (grid > 256) grid = 256; if (grid < 1) grid = 256;
    }
    if (grid < 0) return;
    (void)hipMemsetAsync(d_ws, 0, 65536, stream);
    Args a{};
    for (int i = 0; i < 22; ++i) a.in[i] = (const float*)d_in[i];
    a.out = (float*)d_out; a.ws = (unsigned char*)d_ws;
    void* args[] = {&a};
    hipError_t e = hipLaunchCooperativeKernel((const void*)fwd_kernel, dim3(grid), dim3(512), args, LDS_BYTES, stream);
    if (e != hipSuccess) fprintf(stderr, "kernel_launch: cooperative launch failed: %s (grid %d)\n", hipGetErrorString(e), grid);
}
```
